# Optimizing an MI355X kernel written in HIP

```python
import numpy as np
import jax, jax.numpy as jnp
from jax import lax

D_MODEL = 1024
BATCH = 4
SEQ = 8192
DEPTH = 2

GRID_W = 64
CTX_LEN = 256
EPS = 1e-6
ROPE_BASE = 10000.0

RET_HEADS = 4
RET_DK = 64
RET_DV = 64
RET_CHUNK = 128
NA_HEADS = 8
NA_HD = 64
NA_KH = 8
NA_KW = 16
NA_QBLOCK = 128
MLA_HEADS = 4
MLA_NOPE = 64
MLA_ROPE = 32
MLA_VD = 64
MLA_Q_RANK = 384
MLA_KV_RANK = 256
MLA_QBLOCK = 128
N_EXPERTS = 16
N_GROUPS = 4
EXPERTS_PER_GROUP = N_EXPERTS // N_GROUPS
TOP_K = 2
EXPERT_FF = 256

D_MIX = RET_HEADS * RET_DV + NA_HEADS * NA_HD + MLA_HEADS * MLA_VD
PROJ_SIZES = (RET_HEADS * RET_DK, RET_HEADS * RET_DK, RET_HEADS * RET_DV, RET_HEADS * RET_DV,
              NA_HEADS * NA_HD, NA_HEADS * NA_HD, NA_HEADS * NA_HD,
              MLA_Q_RANK, MLA_KV_RANK, MLA_ROPE)
PROJ_SPLITS = tuple(int(v) for v in np.cumsum(PROJ_SIZES)[:-1])
D_PROJ = int(sum(PROJ_SIZES))

kernel_name = "hybrid_parallel_heads_flow_block"


def rms_norm(x, g):
    xf = x.astype(jnp.float32)
    y = xf * lax.rsqrt(jnp.mean(xf * xf, axis=-1, keepdims=True) + EPS)
    return (y * g.astype(jnp.float32)).astype(x.dtype)


def head_norm(o):
    mu = jnp.mean(o, axis=-1, keepdims=True)
    var = jnp.mean(jnp.square(o - mu), axis=-1, keepdims=True)
    return (o - mu) * lax.rsqrt(var + EPS)


def ada_modulation(cvec, w_mod, b_mod):
    m = jax.nn.silu(cvec) @ w_mod + b_mod
    return jnp.split(m[..., None, :], 6, axis=-1)


def to_heads(a, n):
    b, l, w = a.shape
    return a.reshape(b, l, n, w // n)


def rope_1d(x, pos):
    half = x.shape[-1] // 2
    inv = ROPE_BASE ** (-jnp.arange(half, dtype=jnp.float32) / half)
    ang = pos[:, None] * inv[None, :]
    cos = jnp.cos(ang)[:, None, :]
    sin = jnp.sin(ang)[:, None, :]
    xf = x.astype(jnp.float32)
    x1, x2 = xf[..., :half], xf[..., half:]
    return jnp.concatenate([x1 * cos - x2 * sin, x2 * cos + x1 * sin], axis=-1).astype(x.dtype)


def axial_rope(x, pos_r, pos_c):
    h = x.shape[-1] // 2
    return jnp.concatenate([rope_1d(x[..., :h], pos_r), rope_1d(x[..., h:], pos_c)], axis=-1)


def retention_chunkwise(q, k, v, log_gamma, s0, strict):
    b, h, l, dk = q.shape
    dv = v.shape[-1]
    n = l // RET_CHUNK
    qc = q.reshape(b, h, n, RET_CHUNK, dk)
    kc = k.reshape(b, h, n, RET_CHUNK, dk)
    vc = v.reshape(b, h, n, RET_CHUNK, dv)
    pos = jnp.arange(RET_CHUNK, dtype=jnp.float32)
    diff = pos[:, None] - pos[None, :]
    keep = diff > 0 if strict else diff >= 0
    lg = log_gamma[:, None, None]
    dmat = jnp.where(keep[None], jnp.exp(lg * jnp.maximum(diff, 0.0)[None]), 0.0)
    scores = jnp.einsum('bhncd,bhnkd->bhnck', qc, kc) * dmat[None, :, None]
    intra = jnp.einsum('bhnck,bhnke->bhnce', scores, vc)
    k_w = jnp.exp(log_gamma[:, None] * (RET_CHUNK - 1.0 - pos)[None])
    chunk_kv = jnp.einsum('bhnkd,hk,bhnke->nbhde', kc, k_w, vc)
    g_chunk = jnp.exp(log_gamma * RET_CHUNK)[None, :, None, None]

    def step(state, kv):
        return g_chunk * state + kv, state

    s_final, states = lax.scan(step, s0, chunk_kv)
    q_w = jnp.exp(log_gamma[:, None] * (pos + 1.0)[None])
    inter = jnp.einsum('bhncd,hc,nbhde->bhnce', qc, q_w, states)
    return (intra + inter).reshape(b, h, l, dv), s_final


def bidir_retention(q, k, v, lg_f, lg_b, s0_f, s0_b):
    o_f, s_f = retention_chunkwise(q, k, v, lg_f, s0_f, False)
    o_b, s_b = retention_chunkwise(jnp.flip(q, 2), jnp.flip(k, 2), jnp.flip(v, 2), lg_b, s0_b, True)
    return o_f + jnp.flip(o_b, 2), s_f, s_b


def retention_heads(q_cols, k_cols, v_cols, pos):
    q = to_heads(q_cols, RET_HEADS)
    k = to_heads(k_cols, RET_HEADS)
    v = to_heads(v_cols, RET_HEADS)
    if pos is not None:
        q = axial_rope(q, pos[0], pos[1])
        k = axial_rope(k, pos[0], pos[1])
    q = q.astype(jnp.float32).transpose(0, 2, 1, 3) * (RET_DK ** -0.5)
    k = k.astype(jnp.float32).transpose(0, 2, 1, 3)
    v = v.astype(jnp.float32).transpose(0, 2, 1, 3)
    return q, k, v


def retention_output(o, g):
    b, h, l, dv = o.shape
    on = head_norm(o).transpose(0, 2, 1, 3).reshape(b, l, h * dv)
    return on.astype(g.dtype) * jax.nn.silu(g)


def neighbourhood_tables(rows):
    kh = min(NA_KH, rows)
    s = rows * GRID_W
    t = jnp.arange(s)
    r = t // GRID_W
    c = t % GRID_W
    r0 = jnp.clip(r - kh // 2, 0, rows - kh)
    c0 = jnp.clip(c - NA_KW // 2, 0, GRID_W - NA_KW)
    kr = r0[:, None, None] + jnp.arange(kh)[None, :, None]
    kc = c0[:, None, None] + jnp.arange(NA_KW)[None, None, :]
    idx = (kr * GRID_W + kc).reshape(s, kh * NA_KW)
    dr = kr - r[:, None, None]
    dc = kc - c[:, None, None]
    bidx = ((dr + NA_KH - 1) * (2 * NA_KW - 1) + (dc + NA_KW - 1)).reshape(s, kh * NA_KW)
    return idx.astype(jnp.int32), bidx.astype(jnp.int32)


def neighbourhood_attention(q, k, v, k_ctx, v_ctx, rpb, idx, bidx):
    b, s, h, d = q.shape
    nblk = s // NA_QBLOCK
    nk = idx.shape[-1]
    scale = d ** -0.5
    rpb_flat = rpb.reshape(h, -1)
    qb = jnp.moveaxis(q.reshape(b, nblk, NA_QBLOCK, h, d), 1, 0)
    idx_b = idx.reshape(nblk, NA_QBLOCK, nk)
    bidx_b = bidx.reshape(nblk, NA_QBLOCK, nk)

    def block(args):
        qi, ii, bi = args
        kg = k[:, ii]
        vg = v[:, ii]
        s_loc = jnp.einsum('bqhd,bqkhd->bhqk', qi, kg).astype(jnp.float32) * scale
        s_loc = s_loc + rpb_flat[:, bi].astype(jnp.float32)[None]
        s_ctx = jnp.einsum('bqhd,bkhd->bhqk', qi, k_ctx).astype(jnp.float32) * scale
        p = jax.nn.softmax(jnp.concatenate([s_loc, s_ctx], axis=-1), axis=-1).astype(v.dtype)
        return (jnp.einsum('bhqk,bqkhd->bqhd', p[..., :nk], vg)
                + jnp.einsum('bhqk,bkhd->bqhd', p[..., nk:], v_ctx))

    o = lax.map(block, (qb, idx_b, bidx_b))
    return jnp.moveaxis(o, 0, 1).reshape(b, s, h * d)


def dense_attention(q, k, v):
    b, l, h, dq = q.shape
    s = jnp.einsum('bqhd,bkhd->bhqk', q, k).astype(jnp.float32) * (dq ** -0.5)
    p = jax.nn.softmax(s, axis=-1).astype(v.dtype)
    return jnp.einsum('bhqk,bkhd->bqhd', p, v).reshape(b, l, h * v.shape[-1])


def blocked_attention(q, k, v):
    b, s, h, dq = q.shape
    nblk = s // MLA_QBLOCK
    scale = dq ** -0.5
    qb = jnp.moveaxis(q.reshape(b, nblk, MLA_QBLOCK, h, dq), 1, 0)

    def block(qi):
        sc = jnp.einsum('bqhd,bkhd->bhqk', qi, k).astype(jnp.float32) * scale
        p = jax.nn.softmax(sc, axis=-1).astype(v.dtype)
        return jnp.einsum('bhqk,bkhd->bqhd', p, v)

    o = lax.map(block, qb)
    return jnp.moveaxis(o, 0, 1).reshape(b, s, h * v.shape[-1])


def mla_heads(c_q, c_kv, k_pe, q_norm, kv_norm, w_uq, w_ukv, pos):
    b, l, _ = c_q.shape
    q = (rms_norm(c_q, q_norm) @ w_uq).reshape(b, l, MLA_HEADS, MLA_NOPE + MLA_ROPE)
    kv = (rms_norm(c_kv, kv_norm) @ w_ukv).reshape(b, l, MLA_HEADS, MLA_NOPE + MLA_VD)
    q_nope, q_pe = q[..., :MLA_NOPE], q[..., MLA_NOPE:]
    k_nope, v = kv[..., :MLA_NOPE], kv[..., MLA_NOPE:]
    k_pe = k_pe[:, :, None, :]
    if pos is not None:
        q_pe = axial_rope(q_pe, pos[0], pos[1])
        k_pe = axial_rope(k_pe, pos[0], pos[1])
    k_pe = jnp.broadcast_to(k_pe, (b, l, MLA_HEADS, MLA_ROPE))
    q = jnp.concatenate([q_nope, q_pe], axis=-1)
    k = jnp.concatenate([k_nope, k_pe], axis=-1)
    return q, k, v


def moe_ffn(u, router_w, router_b, w1, w3, w2):
    shp = u.shape
    t = u.reshape(-1, shp[-1])
    scores = jax.nn.sigmoid((t @ router_w).astype(jnp.float32))
    sel = scores + router_b.astype(jnp.float32)
    grp_score = jnp.sum(lax.top_k(sel.reshape(-1, N_GROUPS, EXPERTS_PER_GROUP), TOP_K)[0], axis=-1)
    best = jnp.argmax(grp_score, axis=-1)
    in_grp = (jnp.arange(N_EXPERTS) // EXPERTS_PER_GROUP)[None, :] == best[:, None]
    _, top_idx = lax.top_k(jnp.where(in_grp, sel, -jnp.inf), TOP_K)
    top_w = jnp.take_along_axis(scores, top_idx, axis=-1)
    top_w = top_w / jnp.sum(top_w, axis=-1, keepdims=True)
    gates = jnp.sum(jax.nn.one_hot(top_idx, N_EXPERTS, dtype=jnp.float32) * top_w[..., None], axis=1)
    gates = gates.astype(t.dtype)
    y = jnp.zeros_like(t)
    for e in range(N_EXPERTS):
        hdn = jax.nn.silu(t @ w1[e]) * (t @ w3[e])
        y = y + (hdn @ w2[e]) * gates[:, e:e + 1]
    return y.reshape(shp)


def setup_inputs(seed: int = 0) -> dict:
    key = jax.random.key(seed)
    ks = jax.random.split(key, 24)
    f32 = jnp.float32

    def nrm(k, shape, s):
        return jax.random.normal(k, shape, f32) * s

    base_gamma = 1.0 - 2.0 ** (-5.0 - jnp.arange(RET_HEADS, dtype=f32))
    base_logit = jnp.log(base_gamma) - jnp.log1p(-base_gamma)
    return {
        "x": nrm(ks[0], (BATCH, SEQ, D_MODEL), 1.0),
        "c": nrm(ks[1], (BATCH, D_MODEL), 1.0),
        "ctx": nrm(ks[2], (BATCH, CTX_LEN, D_MODEL), 1.0),
        "c_ctx": nrm(ks[3], (D_MODEL,), 1.0),
        "w_mod": nrm(ks[4], (DEPTH, D_MODEL, 6 * D_MODEL), 0.5 * D_MODEL ** -0.5),
        "b_mod": nrm(ks[5], (DEPTH, 6 * D_MODEL), 0.02),
        "norm1_g": 1.0 + nrm(ks[6], (DEPTH, D_MODEL), 0.02),
        "norm2_g": 1.0 + nrm(ks[7], (DEPTH, D_MODEL), 0.02),
        "w_in": nrm(ks[8], (DEPTH, D_MODEL, D_PROJ), D_MODEL ** -0.5),
        "ret_decay_f": base_logit + nrm(ks[9], (DEPTH, RET_HEADS), 0.1),
        "ret_decay_b": base_logit + nrm(ks[10], (DEPTH, RET_HEADS), 0.1),
        "na_rpb": nrm(ks[11], (DEPTH, NA_HEADS, 2 * NA_KH - 1, 2 * NA_KW - 1), 0.1),
        "mla_q_norm": 1.0 + nrm(ks[12], (DEPTH, MLA_Q_RANK), 0.02),
        "mla_kv_norm": 1.0 + nrm(ks[13], (DEPTH, MLA_KV_RANK), 0.02),
        "w_uq": nrm(ks[14], (DEPTH, MLA_Q_RANK, MLA_HEADS * (MLA_NOPE + MLA_ROPE)), MLA_Q_RANK ** -0.5),
        "w_ukv": nrm(ks[15], (DEPTH, MLA_KV_RANK, MLA_HEADS * (MLA_NOPE + MLA_VD)), MLA_KV_RANK ** -0.5),
        "w_out": nrm(ks[16], (DEPTH, D_MIX, D_MODEL), D_MIX ** -0.5),
        "router_w": nrm(ks[17], (D_MODEL, N_EXPERTS), D_MODEL ** -0.5),
        "router_b": nrm(ks[18], (N_EXPERTS,), 0.01),
        "w1": nrm(ks[19], (DEPTH, N_EXPERTS, D_MODEL, EXPERT_FF), D_MODEL ** -0.5),
        "w3": nrm(ks[20], (DEPTH, N_EXPERTS, D_MODEL, EXPERT_FF), D_MODEL ** -0.5),
        "w2": nrm(ks[21], (DEPTH, N_EXPERTS, EXPERT_FF, D_MODEL), EXPERT_FF ** -0.5),
        "final_norm_g": 1.0 + nrm(ks[22], (D_MODEL,), 0.02),
    }


def reference(x, c, ctx, c_ctx, w_mod, b_mod, norm1_g, norm2_g, w_in, ret_decay_f, ret_decay_b,
              na_rpb, mla_q_norm, mla_kv_norm, w_uq, w_ukv, w_out, router_w, router_b, w1, w3, w2,
              final_norm_g):
    b, s, _ = x.shape
    rows = s // GRID_W
    t = jnp.arange(s)
    pos = ((t // GRID_W).astype(jnp.float32), (t % GRID_W).astype(jnp.float32))
    nb_idx, nb_bias_idx = neighbourhood_tables(rows)
    h, hc = x, ctx
    for l in range(DEPTH):
        last = l == DEPTH - 1
        sh1, sc1, g1, sh2, sc2, g2 = ada_modulation(c, w_mod[l], b_mod[l])
        csh1, csc1, cg1, csh2, csc2, cg2 = ada_modulation(c_ctx, w_mod[l], b_mod[l])

        u = rms_norm(h, norm1_g[l]) * (1.0 + sc1) + sh1
        uc = rms_norm(hc, norm1_g[l]) * (1.0 + csc1) + csh1
        p = jnp.split(u @ w_in[l], PROJ_SPLITS, axis=-1)
        pc = jnp.split(uc @ w_in[l], PROJ_SPLITS, axis=-1)

        lg_f = jax.nn.log_sigmoid(ret_decay_f[l].astype(jnp.float32))
        lg_b = jax.nn.log_sigmoid(ret_decay_b[l].astype(jnp.float32))
        rq_c, rk_c, rv_c = retention_heads(pc[0], pc[1], pc[2], None)
        rq, rk, rv = retention_heads(p[0], p[1], p[2], pos)
        zero_state = jnp.zeros((b, RET_HEADS, RET_DK, RET_DV), jnp.float32)
        ro_c, st_f, st_b = bidir_retention(rq_c, rk_c, rv_c, lg_f, lg_b, zero_state, zero_state)
        ro, _, _ = bidir_retention(rq, rk, rv, lg_f, lg_b, st_f, st_b)
        ret_lat = retention_output(ro, p[3])

        nq_c, nk_c, nv_c = to_heads(pc[4], NA_HEADS), to_heads(pc[5], NA_HEADS), to_heads(pc[6], NA_HEADS)
        nq, nk, nv = to_heads(p[4], NA_HEADS), to_heads(p[5], NA_HEADS), to_heads(p[6], NA_HEADS)
        na_lat = neighbourhood_attention(nq, nk, nv, nk_c, nv_c, na_rpb[l], nb_idx, nb_bias_idx)

        mq_c, mk_c, mv_c = mla_heads(pc[7], pc[8], pc[9], mla_q_norm[l], mla_kv_norm[l], w_uq[l], w_ukv[l], None)
        mq, mk, mv = mla_heads(p[7], p[8], p[9], mla_q_norm[l], mla_kv_norm[l], w_uq[l], w_ukv[l], pos)
        mla_lat = blocked_attention(mq, jnp.concatenate([mk, mk_c], axis=1), jnp.concatenate([mv, mv_c], axis=1))

        h = h + g1 * (jnp.concatenate([ret_lat, na_lat, mla_lat], axis=-1) @ w_out[l])
        u2 = rms_norm(h, norm2_g[l]) * (1.0 + sc2) + sh2
        h = h + g2 * moe_ffn(u2, router_w, router_b, w1[l], w3[l], w2[l])

        if not last:
            ret_ctx = retention_output(ro_c, pc[3])
            na_ctx = dense_attention(nq_c, nk_c, nv_c)
            mla_ctx = dense_attention(mq_c, mk_c, mv_c)
            hc = hc + cg1 * (jnp.concatenate([ret_ctx, na_ctx, mla_ctx], axis=-1) @ w_out[l])
            uc2 = rms_norm(hc, norm2_g[l]) * (1.0 + csc2) + csh2
            hc = hc + cg2 * moe_ffn(uc2, router_w, router_b, w1[l], w3[l], w2[l])
    return rms_norm(h, final_norm_g)
```

```cpp
#include <hip/hip_runtime.h>
#include <stdint.h>
#include <math.h>

typedef unsigned short bf16_t;
#define LAS __attribute__((address_space(3)))

constexpr int DM = 1024, NB = 4, SEQ = 8192, GW = 64, CTXL = 256;
constexpr int NLAT = NB * SEQ;
constexpr int NCTX = NB * CTXL;
constexpr int NROW = NLAT + NCTX;
constexpr int DPROJ = 3232, LDP = 3328;
constexpr int PC_RQ = 0, PC_RK = 256, PC_RV = 512, PC_RG = 768, PC_NQ = 1024, PC_NK = 1536, PC_NV = 2048, PC_CQ = 2560, PC_CKV = 2944, PC_KPE = 3200;
constexpr int NE = 16, FF = 256;
constexpr int MAXSLOT = 2 * NROW + NE * 256;
constexpr int NCHUNK_TOK = 128;
constexpr int RET_ITEMS = 16 * 64 + 16 * 2;

constexpr size_t MiB = 1u << 20;
constexpr size_t WS_CTL = 0;
constexpr size_t WS_MOD = 1 * MiB;
constexpr size_t WS_HC = 2 * MiB;
constexpr size_t WS_RT = 6 * MiB;
constexpr size_t WS_U = 8 * MiB;
constexpr size_t WS_QM = 74 * MiB;
constexpr size_t WS_KM = 99 * MiB;
constexpr size_t WS_VM = 124 * MiB;
constexpr size_t WS_RKV = 141 * MiB;
constexpr size_t WS_P = 174 * MiB;
constexpr size_t WS_XS = WS_P;
constexpr size_t WS_HDN = WS_P + 140 * MiB;
constexpr size_t RT_E = 0, RT_W = 512 * 1024, RT_RSTD = 1024 * 1024, RT_SLOT = 1280 * 1024, RT_CNT = 1792 * 1024, RT_SEG = 1920 * 1024;

struct Params { const float* in[23]; float* out; unsigned char* ws; int lo, hi; };
enum { I_X = 0, I_C, I_CTX, I_CCTX, I_WMOD, I_BMOD, I_N1G, I_N2G, I_WIN, I_RDF, I_RDB, I_RPB, I_QN, I_KVN, I_WUQ, I_WUKV, I_WOUT, I_RW, I_RB, I_W1, I_W3, I_W2, I_FNG };

__device__ __forceinline__ float bf2f(bf16_t v) { return __uint_as_float(((unsigned)v) << 16); }
__device__ __forceinline__ bf16_t f2bf(float f) { unsigned u = __float_as_uint(f); return (bf16_t)((u + 0x7fffu + ((u >> 16) & 1u)) >> 16); }
__device__ __forceinline__ float wave_sum(float v) {
#pragma unroll
    for (int o = 32; o >= 1; o >>= 1) v += __shfl_xor(v, o);
    return v;
}
__device__ __forceinline__ float wave_max(float v) {
#pragma unroll
    for (int o = 32; o >= 1; o >>= 1) v = fmaxf(v, __shfl_xor(v, o));
    return v;
}
__device__ __forceinline__ float silu_f(float x) { return x / (1.f + expf(-x)); }
__device__ __forceinline__ int row_modv(int row) { return row < NLAT ? (row >> 13) : 4; }
__device__ __forceinline__ float* hrow2(float* hl, float* hc, int row) { return row < NLAT ? hl + (size_t)row * DM : hc + (size_t)(row - NLAT) * DM; }

#define XB_TMO      128
#define XB_XCNT(j)  (256  + 64 * (j))
#define XB_XSUB(j)  (1280 + 64 * (j))
#define XB_XGEN(j)  (2304 + 64 * (j))
#define XB_TOP      3328
#define XB_TOPGEN   3392
#define XCD_BAR_WORDS 3456
#define XB_SPIN_CAP (1u << 18)
__device__ __forceinline__ unsigned xb_ld(unsigned* p)              { return __hip_atomic_load(p, __ATOMIC_RELAXED, __HIP_MEMORY_SCOPE_AGENT); }
__device__ __forceinline__ unsigned xb_add(unsigned* p, unsigned v) { return __hip_atomic_fetch_add(p, v, __ATOMIC_RELAXED, __HIP_MEMORY_SCOPE_AGENT); }
__device__ __forceinline__ unsigned xb_xcc_id() { return (unsigned)__builtin_amdgcn_s_getreg((3 << 11) | 20) & 0xFu; }
#define XB_SPIN(cond, bar) do { unsigned _sp = 0; while (cond) { __builtin_amdgcn_s_sleep(1); \
    if ((++_sp & 255u) == 0u) { if (xb_ld(&(bar)[XB_TMO])) break; if (_sp > XB_SPIN_CAP) { atomicAdd(&(bar)[XB_TMO], 1u); break; } } } } while (0)
struct XcdBarrier { unsigned* bar; unsigned x; volatile LAS unsigned* st; };
__device__ __forceinline__ XcdBarrier xcd_barrier_post(unsigned* bar, volatile LAS unsigned* st) {
    XcdBarrier b; b.bar = bar; b.x = xb_xcc_id(); b.st = st;
    if (threadIdx.x == 0) (void)xb_add(&bar[XB_XCNT(b.x)], 1u);
    return b;
}
__device__ __forceinline__ void xcd_barrier_complete(unsigned* bar, unsigned x, unsigned& nloc, unsigned& nx) {
    const unsigned G = gridDim.x * gridDim.y * gridDim.z;
    unsigned sum, cnt, mine, sp = 0u;
    for (;;) {
        sum = 0u; cnt = 0u; mine = 0u;
#pragma unroll
        for (unsigned j = 0; j < 16; ++j) { const unsigned c = xb_ld(&bar[XB_XCNT(j)]); sum += c; cnt += (c > 0u) ? 1u : 0u; mine = (j == x) ? c : mine; }
        if (sum == G) break;
        __builtin_amdgcn_s_sleep(1);
        if ((++sp & 255u) == 0u) { if (xb_ld(&bar[XB_TMO])) break; if (sp > XB_SPIN_CAP) { atomicAdd(&bar[XB_TMO], 1u); break; } }
    }
    nloc = mine > 0u ? mine : 1u; nx = cnt > 0u ? cnt : 1u;
}
__device__ __forceinline__ void xcd_barrier(const XcdBarrier& b) {
    asm volatile("s_waitcnt vmcnt(0)" ::: "memory");
    __syncthreads();
    if (threadIdx.x == 0) {
        unsigned* bar = b.bar;
        __builtin_amdgcn_s_waitcnt(0);
        unsigned nloc = b.st[0], nx = b.st[1];
        if (nloc == 0u) { xcd_barrier_complete(bar, b.x, nloc, nx); b.st[0] = nloc; b.st[1] = nx; }
        const unsigned old = xb_add(&bar[XB_XSUB(b.x)], 1u);
        const unsigned gen = old / nloc;
        if (old + 1u == (gen + 1u) * nloc) {
            __builtin_amdgcn_fence(__ATOMIC_RELEASE, "agent");
            asm volatile("s_waitcnt vmcnt(0)" ::: "memory");
            const unsigned og = xb_add(&bar[XB_TOP], 1u);
            const unsigned tg = og / nx;
            if (og + 1u == (tg + 1u) * nx) xb_add(&bar[XB_TOPGEN], 1u);
            else XB_SPIN(xb_ld(&bar[XB_TOPGEN]) == tg, bar);
            __builtin_amdgcn_fence(__ATOMIC_ACQUIRE, "agent");
            xb_add(&bar[XB_XGEN(b.x)], 1u);
            asm volatile("s_waitcnt vmcnt(0)" ::: "memory");
        } else {
            XB_SPIN(xb_ld(&bar[XB_XGEN(b.x)]) == gen, bar);
            __builtin_amdgcn_fence(__ATOMIC_ACQUIRE, "agent");
            asm volatile("s_waitcnt vmcnt(0)" ::: "memory");
        }
    }
    __syncthreads();
}

struct SegInfo { const int* seg; size_t wstride; };
template <bool DUAL, class Epi>
__device__ __forceinline__ void gemm_simple(char* smem, const bf16_t* A, int lda, int M, const float* W, const float* W2, int ldw, int N, int K, SegInfo sg, const Epi& epi) {
    float* As = (float*)smem;
    float* Ws = As + 16 * 132;
    float* Ws2 = Ws + 16 * 68;
    const int t = threadIdx.x, ty = t >> 4, tx = t & 15;
    const int ntm = (M + 127) / 128, ntn = (N + 63) / 64;
    for (int tile = blockIdx.x; tile < ntm * ntn; tile += gridDim.x) {
        const int tm = tile / ntn, tn = tile % ntn, m0 = tm * 128, n0 = tn * 64;
        const float* Wt = W; const float* Wt2 = W2; int mvalid = M;
        if (sg.seg) {
            int e = 0;
#pragma unroll
            for (int i = 1; i < 16; ++i) if (m0 >= sg.seg[i]) e = i;
            mvalid = sg.seg[e] + sg.seg[17 + e];
            if (m0 >= sg.seg[16] || m0 >= mvalid) continue;
            Wt = W + (size_t)e * sg.wstride; if (DUAL) Wt2 = W2 + (size_t)e * sg.wstride;
        }
        float acc[4][4], acc2[4][4];
#pragma unroll
        for (int i = 0; i < 4; ++i)
#pragma unroll
            for (int j = 0; j < 4; ++j) { acc[i][j] = 0.f; acc2[i][j] = 0.f; }
        for (int k0 = 0; k0 < K; k0 += 16) {
            {
                const int r = t >> 2, kq = (t & 3) * 4, row = m0 + r;
                uint2 v = make_uint2(0u, 0u);
                if (row < M) v = *(const uint2*)(A + (size_t)row * lda + k0 + kq);
                As[(kq + 0) * 132 + r] = __uint_as_float(v.x << 16);
                As[(kq + 1) * 132 + r] = __uint_as_float(v.x & 0xffff0000u);
                As[(kq + 2) * 132 + r] = __uint_as_float(v.y << 16);
                As[(kq + 3) * 132 + r] = __uint_as_float(v.y & 0xffff0000u);
            }
            {
                const int k = t >> 5, n = (t & 31) * 2, col = n0 + n;
                float2 w = make_float2(0.f, 0.f), w2 = make_float2(0.f, 0.f);
                if (col < N) { w = *(const float2*)(Wt + (size_t)(k0 + k) * ldw + col); if (DUAL) w2 = *(const float2*)(Wt2 + (size_t)(k0 + k) * ldw + col); }
                Ws[k * 68 + n] = w.x; Ws[k * 68 + n + 1] = w.y;
                if (DUAL) { Ws2[k * 68 + n] = w2.x; Ws2[k * 68 + n + 1] = w2.y; }
            }
            __syncthreads();
#pragma unroll
            for (int kk = 0; kk < 16; ++kk) {
                const float4 a = *(const float4*)&As[kk * 132 + ty * 4];
                const float4 w = *(const float4*)&Ws[kk * 68 + tx * 4];
                const float av[4] = {a.x, a.y, a.z, a.w}, wv[4] = {w.x, w.y, w.z, w.w};
#pragma unroll
                for (int i = 0; i < 4; ++i)
#pragma unroll
                    for (int j = 0; j < 4; ++j) acc[i][j] = fmaf(av[i], wv[j], acc[i][j]);
                if (DUAL) {
                    const float4 w2 = *(const float4*)&Ws2[kk * 68 + tx * 4];
                    const float wv2[4] = {w2.x, w2.y, w2.z, w2.w};
#pragma unroll
                    for (int i = 0; i < 4; ++i)
#pragma unroll
                        for (int j = 0; j < 4; ++j) acc2[i][j] = fmaf(av[i], wv2[j], acc2[i][j]);
                }
            }
            __syncthreads();
        }
#pragma unroll
        for (int i = 0; i < 4; ++i) {
            const int row = m0 + ty * 4 + i;
            if (row < M && row < mvalid) {
#pragma unroll
                for (int j = 0; j < 4; ++j) { const int col = n0 + tx * 4 + j; if (col < N) epi(row, col, acc[i][j], acc2[i][j]); }
            }
        }
    }
}

template <int DQK, int DV>
__device__ __forceinline__ void attn_simple(char* smem, const bf16_t* Q, int ldq, int nq, const bf16_t* K0, const bf16_t* V0, int n0, const bf16_t* K1, const bf16_t* V1, int n1,
                                            int ldk, int ldv, float qscale_log2, bf16_t* O, int ldo) {
    float* Ks = (float*)smem;
    float* Vs = Ks + 32 * DQK;
    const int t = threadIdx.x;
    const bool act = t < nq;
    float q[DQK];
#pragma unroll
    for (int c = 0; c < DQK; ++c) q[c] = act ? bf2f(Q[(size_t)t * ldq + c]) * qscale_log2 : 0.f;
    float o[DV];
#pragma unroll
    for (int e = 0; e < DV; ++e) o[e] = 0.f;
    float mrun = -INFINITY, lrun = 0.f;
    const int ntile = (n0 + n1) / 32;
    for (int tl = 0; tl < ntile; ++tl) {
        const int j0 = tl * 32;
        const bf16_t* Kp; const bf16_t* Vp;
        if (j0 < n0) { Kp = K0 + (size_t)j0 * ldk; Vp = V0 + (size_t)j0 * ldv; } else { Kp = K1 + (size_t)(j0 - n0) * ldk; Vp = V1 + (size_t)(j0 - n0) * ldv; }
        __syncthreads();
        for (int idx = t; idx < 32 * DQK; idx += 512) { const int r = idx / DQK, c = idx % DQK; Ks[idx] = bf2f(Kp[(size_t)r * ldk + c]); }
        for (int idx = t; idx < 32 * DV; idx += 512) { const int r = idx / DV, c = idx % DV; Vs[idx] = bf2f(Vp[(size_t)r * ldv + c]); }
        __syncthreads();
#pragma unroll 1
        for (int r = 0; r < 32; ++r) {
            float a = 0.f;
#pragma unroll
            for (int c = 0; c < DQK; c += 4) { const float4 kv = *(const float4*)&Ks[r * DQK + c]; a = fmaf(q[c], kv.x, a); a = fmaf(q[c + 1], kv.y, a); a = fmaf(q[c + 2], kv.z, a); a = fmaf(q[c + 3], kv.w, a); }
            if (a > mrun) {
                const float alpha = exp2f(mrun - a);
                mrun = a; lrun *= alpha;
#pragma unroll
                for (int e = 0; e < DV; ++e) o[e] *= alpha;
            }
            const float pr = exp2f(a - mrun);
            lrun += pr;
#pragma unroll
            for (int e = 0; e < DV; e += 4) { const float4 vv = *(const float4*)&Vs[r * DV + e]; o[e] = fmaf(pr, vv.x, o[e]); o[e + 1] = fmaf(pr, vv.y, o[e + 1]); o[e + 2] = fmaf(pr, vv.z, o[e + 2]); o[e + 3] = fmaf(pr, vv.w, o[e + 3]); }
        }
    }
    if (act) {
        const float inv = 1.f / lrun;
#pragma unroll
        for (int e = 0; e < DV; ++e) O[(size_t)t * ldo + e] = f2bf(o[e] * inv);
    }
    __syncthreads();
}

__device__ __forceinline__ void rope_pair(float& x1, float& x2, float pos, int i, int half) {
    const float inv = powf(10000.0f, -(float)i / (float)half);
    float sn, cs; sincosf(pos * inv, &sn, &cs);
    const float a = x1 * cs - x2 * sn, b = x2 * cs + x1 * sn; x1 = a; x2 = b;
}
__device__ __forceinline__ float log_sigmoid_f(float x) { return -log1pf(expf(-x)); }

template <int KIND> __global__ void __launch_bounds__(512, 2) k_ph(Params p, int l) {
    extern __shared__ __attribute__((aligned(16))) char smem[];
    const int tid = threadIdx.x, lane = tid & 63, wid = tid >> 6;
    const int nblk = gridDim.x, bid = blockIdx.x;
    unsigned char* ws = p.ws;
    float* MOD = (float*)(ws + WS_MOD);
    bf16_t* U = (bf16_t*)(ws + WS_U);
    bf16_t* P = (bf16_t*)(ws + WS_P);
    bf16_t* QM = (bf16_t*)(ws + WS_QM);
    bf16_t* KM = (bf16_t*)(ws + WS_KM);
    bf16_t* VM = (bf16_t*)(ws + WS_VM);
    float* RKV = (float*)(ws + WS_RKV);
    bf16_t* XS = (bf16_t*)(ws + WS_XS);
    bf16_t* HDN = (bf16_t*)(ws + WS_HDN);
    int2* RTE = (int2*)(ws + WS_RT + RT_E);
    float2* RTW = (float2*)(ws + WS_RT + RT_W);
    float* RTR = (float*)(ws + WS_RT + RT_RSTD);
    int2* RTS = (int2*)(ws + WS_RT + RT_SLOT);
    int* CNT = (int*)(ws + WS_RT + RT_CNT);
    int* SEG = (int*)(ws + WS_RT + RT_SEG);
    float* const Hlat = p.out; float* const Hctx = (float*)(ws + WS_HC);

    if constexpr (KIND == 0) {
        float* sc = (float*)smem;
        for (int i = tid; i < 5 * DM; i += 512) { const int v = i / DM, k = i % DM; const float x = v < 4 ? p.in[I_C][v * DM + k] : p.in[I_CCTX][k]; sc[i] = silu_f(x); }
        __syncthreads();
        for (int idx = bid * 512 + tid; idx < 2 * 6144; idx += nblk * 512) {
            const int l = idx / 6144, j = idx % 6144;
            const float* wm = p.in[I_WMOD] + (size_t)l * DM * 6144 + j;
            float a0 = 0.f, a1 = 0.f, a2 = 0.f, a3 = 0.f, a4 = 0.f;
            for (int k = 0; k < DM; ++k) { const float w = wm[(size_t)k * 6144]; a0 = fmaf(sc[k], w, a0); a1 = fmaf(sc[DM + k], w, a1); a2 = fmaf(sc[2 * DM + k], w, a2); a3 = fmaf(sc[3 * DM + k], w, a3); a4 = fmaf(sc[4 * DM + k], w, a4); }
            const float bm = p.in[I_BMOD][l * 6144 + j];
            float* mo = MOD + (size_t)l * 5 * 6144 + j;
            mo[0] = a0 + bm; mo[6144] = a1 + bm; mo[2 * 6144] = a2 + bm; mo[3 * 6144] = a3 + bm; mo[4 * 6144] = a4 + bm;
        }
        const float4* xs = (const float4*)p.in[I_X]; float4* xo = (float4*)p.out;
        for (size_t i = (size_t)bid * 512 + tid; i < (size_t)NLAT * DM / 4; i += (size_t)nblk * 512) xo[i] = xs[i];
        const float4* cs = (const float4*)p.in[I_CTX]; float4* co = (float4*)(ws + WS_HC);
        for (size_t i = (size_t)bid * 512 + tid; i < (size_t)NCTX * DM / 4; i += (size_t)nblk * 512) co[i] = cs[i];
    }

    {
        const bool last = (l == 1);
        const float* modl = MOD + (size_t)l * 5 * 6144;
        const int rows_mix = last ? NLAT : NROW;

        if constexpr (KIND == 1) {
            const float* g = p.in[I_N1G] + l * DM;
            for (int row = bid * 8 + wid; row < NROW; row += nblk * 8) {
                const float* h = hrow2(Hlat, Hctx, row); const float* mv = modl + row_modv(row) * 6144;
                float4 x[4]; float ss = 0.f;
#pragma unroll
                for (int i = 0; i < 4; ++i) { x[i] = *(const float4*)(h + lane * 4 + 256 * i); ss += x[i].x * x[i].x + x[i].y * x[i].y + x[i].z * x[i].z + x[i].w * x[i].w; }
                ss = wave_sum(ss);
                const float rstd = rsqrtf(ss * (1.f / DM) + 1e-6f);
#pragma unroll
                for (int i = 0; i < 4; ++i) {
                    const int c = lane * 4 + 256 * i;
                    const float4 gg = *(const float4*)(g + c), sh = *(const float4*)(mv + c), sc = *(const float4*)(mv + 1024 + c);
                    const float y0 = x[i].x * rstd * gg.x * (1.f + sc.x) + sh.x, y1 = x[i].y * rstd * gg.y * (1.f + sc.y) + sh.y;
                    const float y2 = x[i].z * rstd * gg.z * (1.f + sc.z) + sh.z, y3 = x[i].w * rstd * gg.w * (1.f + sc.w) + sh.w;
                    uint2 o; o.x = (unsigned)f2bf(y0) | ((unsigned)f2bf(y1) << 16); o.y = (unsigned)f2bf(y2) | ((unsigned)f2bf(y3) << 16);
                    *(uint2*)(U + (size_t)row * DM + c) = o;
                }
            }
        }
        if constexpr (KIND == 2) {
            auto epi = [=](int row, int col, float a, float) { P[(size_t)row * LDP + col] = f2bf(a); };
            gemm_simple<false>(smem, U, DM, NROW, p.in[I_WIN] + (size_t)l * DM * DPROJ, nullptr, DPROJ, DPROJ, DM, SegInfo{nullptr, 0}, epi);
        }
        if constexpr (KIND == 3) {
            const float* qn = p.in[I_QN] + l * 384; const float* kvn = p.in[I_KVN] + l * 256;
            for (int row = bid * 8 + wid; row < NROW; row += nblk * 8) {
                bf16_t* pr = P + (size_t)row * LDP;
                const bool lat = row < NLAT; const int tt = row & (SEQ - 1);
                const float posr = (float)(tt >> 6), posc = (float)(tt & 63);
#pragma unroll
                for (int i = 0; i < 4; ++i) {
                    const int pi = lane + 64 * i, arr = pi >> 7, hd = (pi >> 5) & 3, pp = pi & 31, sec = pp >> 4, ii = pp & 15;
                    bf16_t* b = pr + (arr ? PC_RK : PC_RQ) + hd * 64 + sec * 32 + ii;
                    float x1 = bf2f(b[0]), x2 = bf2f(b[16]);
                    if (lat) rope_pair(x1, x2, sec ? posc : posr, ii, 16);
                    if (!arr) { x1 *= 0.125f; x2 *= 0.125f; }
                    b[0] = f2bf(x1); b[16] = f2bf(x2);
                }
                if (lat && lane < 16) {
                    const int sec = lane >> 3, ii = lane & 7;
                    bf16_t* b = pr + PC_KPE + sec * 16 + ii;
                    float x1 = bf2f(b[0]), x2 = bf2f(b[8]);
                    rope_pair(x1, x2, sec ? posc : posr, ii, 8);
                    b[0] = f2bf(x1); b[8] = f2bf(x2);
                }
                {
                    float v[6]; float ss = 0.f;
#pragma unroll
                    for (int i = 0; i < 6; ++i) { v[i] = bf2f(pr[PC_CQ + lane + 64 * i]); ss += v[i] * v[i]; }
                    ss = wave_sum(ss); const float rs = rsqrtf(ss * (1.f / 384.f) + 1e-6f);
#pragma unroll
                    for (int i = 0; i < 6; ++i) pr[PC_CQ + lane + 64 * i] = f2bf(v[i] * rs * qn[lane + 64 * i]);
                    float w[4]; float s2 = 0.f;
#pragma unroll
                    for (int i = 0; i < 4; ++i) { w[i] = bf2f(pr[PC_CKV + lane + 64 * i]); s2 += w[i] * w[i]; }
                    s2 = wave_sum(s2); const float rs2 = rsqrtf(s2 * (1.f / 256.f) + 1e-6f);
#pragma unroll
                    for (int i = 0; i < 4; ++i) pr[PC_CKV + lane + 64 * i] = f2bf(w[i] * rs2 * kvn[lane + 64 * i]);
                }
            }
        }
        if constexpr (KIND == 4) {
            auto epq = [=](int row, int col, float a, float) { QM[(size_t)row * 384 + col] = f2bf(a); };
            gemm_simple<false>(smem, P + PC_CQ, LDP, NROW, p.in[I_WUQ] + (size_t)l * 384 * 384, nullptr, 384, 384, 384, SegInfo{nullptr, 0}, epq);
            auto epkv = [=](int row, int col, float a, float) { const int hd = col >> 7, j = col & 127; if (j < 64) KM[(size_t)row * 384 + hd * 96 + j] = f2bf(a); else VM[(size_t)row * 256 + hd * 64 + (j - 64)] = f2bf(a); };
            gemm_simple<false>(smem, P + PC_CKV, LDP, NROW, p.in[I_WUKV] + (size_t)l * 256 * 512, nullptr, 512, 512, 256, SegInfo{nullptr, 0}, epkv);
            float* Ks = (float*)smem; float* Vs = Ks + 128 * 64; float* pwf = Vs + 128 * 64; float* pwb = pwf + 132;
            for (int it = bid; it < RET_ITEMS; it += nblk) {
                int b, hd, j, row0;
                if (it < 1024) { b = it >> 8; hd = (it >> 6) & 3; j = it & 63; row0 = b * SEQ + j * 128; } else { const int q = it - 1024; b = q >> 3; hd = (q >> 1) & 3; j = q & 1; row0 = NLAT + b * CTXL + j * 128; }
                const float lgf = log_sigmoid_f(p.in[I_RDF][l * 4 + hd]), lgb = log_sigmoid_f(p.in[I_RDB][l * 4 + hd]);
                __syncthreads();
                for (int idx = tid; idx < 128 * 64; idx += 512) { const int r = idx >> 6, c = idx & 63; const bf16_t* pr = P + (size_t)(row0 + r) * LDP + hd * 64 + c; Ks[idx] = bf2f(pr[PC_RK]); Vs[idx] = bf2f(pr[PC_RV]); }
                if (tid < 129) { pwf[tid] = expf(lgf * (float)tid); pwb[tid] = expf(lgb * (float)tid); }
                __syncthreads();
                const int d = tid >> 3, e0 = (tid & 7) * 8;
                float af[8], ab[8];
#pragma unroll
                for (int e = 0; e < 8; ++e) { af[e] = 0.f; ab[e] = 0.f; }
                for (int i = 0; i < 128; ++i) {
                    const float kd = Ks[i * 64 + d], wf = pwf[127 - i] * kd, wb = pwb[i] * kd;
#pragma unroll
                    for (int e = 0; e < 8; ++e) { const float v = Vs[i * 64 + e0 + e]; af[e] = fmaf(wf, v, af[e]); ab[e] = fmaf(wb, v, ab[e]); }
                }
                float* of = RKV + ((size_t)it * 2 + 0) * 4096 + d * 64 + e0; float* ob = RKV + ((size_t)it * 2 + 1) * 4096 + d * 64 + e0;
#pragma unroll
                for (int e = 0; e < 8; ++e) { of[e] = af[e]; ob[e] = ab[e]; }
            }
        }
        if constexpr (KIND == 5) {
            for (int row = bid * 8 + wid; row < NROW; row += nblk * 8) {
                const bool lat = row < NLAT; const int tt = row & (SEQ - 1);
                const float posr = (float)(tt >> 6), posc = (float)(tt & 63);
                {
                    const int hd = lane >> 4, pp = lane & 15, sec = pp >> 3, ii = pp & 7;
                    bf16_t* b = QM + (size_t)row * 384 + hd * 96 + 64 + sec * 16 + ii;
                    float x1 = bf2f(b[0]), x2 = bf2f(b[8]);
                    if (lat) { rope_pair(x1, x2, sec ? posc : posr, ii, 8); b[0] = f2bf(x1); b[8] = f2bf(x2); }
                }
#pragma unroll
                for (int i = 0; i < 2; ++i) { const int q = lane + 64 * i, hd = q >> 5, c = q & 31; KM[(size_t)row * 384 + hd * 96 + 64 + c] = P[(size_t)row * LDP + PC_KPE + c]; }
            }
            for (int gid = bid * 512 + tid; gid < 2 * 16 * 4096; gid += nblk * 512) {
                const int el = gid & 4095, bh = (gid >> 12) & 15, dir = gid >> 16, hd = bh & 3;
                const float lg = log_sigmoid_f(dir ? p.in[I_RDB][l * 4 + hd] : p.in[I_RDF][l * 4 + hd]);
                const float g128 = expf(128.f * lg);
                float* c0p = RKV + ((size_t)(1024 + bh * 2 + 0) * 2 + dir) * 4096 + el;
                float* c1p = RKV + ((size_t)(1024 + bh * 2 + 1) * 2 + dir) * 4096 + el;
                const float c0 = *c0p, c1 = *c1p; float S;
                if (dir == 0) { *c0p = 0.f; *c1p = c0; S = g128 * c0 + c1; } else { *c1p = 0.f; *c0p = c1; S = g128 * c1 + c0; }
                for (int jj = 0; jj < 64; ++jj) {
                    const int j = dir ? 63 - jj : jj;
                    float* q = RKV + ((size_t)(bh * 64 + j) * 2 + dir) * 4096 + el;
                    const float tmp = *q; *q = S; S = fmaf(g128, S, tmp);
                }
            }
        }
        if constexpr (KIND == 6) {
            bf16_t* MIX = U;
            const float sc_mla = 0.10206207261596577f * 1.4426950408889634f;
            const int n_mla = 256 + (last ? 0 : 16);
            for (int it = bid; it < n_mla; it += nblk) {
                if (it < 256) {
                    const int b = it >> 6, hd = (it >> 4) & 3, qb = it & 15; const size_t r0 = (size_t)b * SEQ + qb * 512, kr0 = (size_t)b * SEQ, cr0 = (size_t)NLAT + b * CTXL;
                    attn_simple<96, 64>(smem, QM + r0 * 384 + hd * 96, 384, 512, KM + kr0 * 384 + hd * 96, VM + kr0 * 256 + hd * 64, SEQ, KM + cr0 * 384 + hd * 96, VM + cr0 * 256 + hd * 64, CTXL,
                                        384, 256, sc_mla, MIX + r0 * DM + 768 + hd * 64, DM);
                } else {
                    const int q = it - 256, b = q >> 2, hd = q & 3; const size_t cr0 = (size_t)NLAT + b * CTXL;
                    attn_simple<96, 64>(smem, QM + cr0 * 384 + hd * 96, 384, 256, KM + cr0 * 384 + hd * 96, VM + cr0 * 256 + hd * 64, CTXL, nullptr, nullptr, 0,
                                        384, 256, sc_mla, MIX + cr0 * DM + 768 + hd * 64, DM);
                }
            }
            if (!last) {
                const float sc_na = 0.125f * 1.4426950408889634f;
                for (int it = bid; it < 32; it += nblk) {
                    const int b = it >> 3, hd = it & 7; const size_t cr0 = (size_t)NLAT + b * CTXL;
                    attn_simple<64, 64>(smem, P + cr0 * LDP + PC_NQ + hd * 64, LDP, 256, P + cr0 * LDP + PC_NK + hd * 64, P + cr0 * LDP + PC_NV + hd * 64, CTXL, nullptr, nullptr, 0,
                                        LDP, LDP, sc_na, MIX + cr0 * DM + 256 + hd * 64, DM);
                }
            }
            {
                float* Ks = (float*)smem; float* Vs = Ks + 128 * 64; float* Sf = Vs + 128 * 64; float* Sb = Sf + 4096; float* pwf = Sb + 4096; float* pwb = pwf + 132; float* Qs = pwb + 132;
                const int n_it = last ? 1024 : RET_ITEMS;
                for (int it = bid; it < n_it; it += nblk) {
                    int b, hd, j, row0;
                    if (it < 1024) { b = it >> 8; hd = (it >> 6) & 3; j = it & 63; row0 = b * SEQ + j * 128; } else { const int q = it - 1024; b = q >> 3; hd = (q >> 1) & 3; j = q & 1; row0 = NLAT + b * CTXL + j * 128; }
                    const float lgf = log_sigmoid_f(p.in[I_RDF][l * 4 + hd]), lgb = log_sigmoid_f(p.in[I_RDB][l * 4 + hd]);
                    __syncthreads();
                    for (int idx = tid; idx < 128 * 64; idx += 512) { const int r = idx >> 6, c = idx & 63; const bf16_t* pr = P + (size_t)(row0 + r) * LDP + hd * 64 + c; Ks[idx] = bf2f(pr[PC_RK]); Vs[idx] = bf2f(pr[PC_RV]); Qs[r * 68 + c] = bf2f(pr[PC_RQ]); }
                    for (int idx = tid; idx < 4096; idx += 512) { Sf[idx] = RKV[((size_t)it * 2 + 0) * 4096 + idx]; Sb[idx] = RKV[((size_t)it * 2 + 1) * 4096 + idx]; }
                    if (tid < 129) { pwf[tid] = expf(lgf * (float)tid); pwb[tid] = expf(lgb * (float)tid); }
                    __syncthreads();
                    const int i = tid >> 2, part = tid & 3, row = row0 + i;
                    const float* qp = Qs + i * 68;
                    float acc[16];
#pragma unroll
                    for (int e = 0; e < 16; ++e) acc[e] = 0.f;
#pragma unroll 1
                    for (int m = 0; m < 128; ++m) {
                        float s = 0.f;
#pragma unroll 4
                        for (int d = 0; d < 64; d += 4) { const float4 kv = *(const float4*)&Ks[m * 64 + d]; const float4 qv = *(const float4*)&qp[d]; s = fmaf(qv.x, kv.x, s); s = fmaf(qv.y, kv.y, s); s = fmaf(qv.z, kv.z, s); s = fmaf(qv.w, kv.w, s); }
                        const float w = (m <= i) ? pwf[i - m] : pwb[m - i];
                        s *= w;
#pragma unroll
                        for (int e = 0; e < 16; e += 4) { const float4 vv = *(const float4*)&Vs[m * 64 + part * 16 + e]; acc[e] = fmaf(s, vv.x, acc[e]); acc[e + 1] = fmaf(s, vv.y, acc[e + 1]); acc[e + 2] = fmaf(s, vv.z, acc[e + 2]); acc[e + 3] = fmaf(s, vv.w, acc[e + 3]); }
                    }
                    const float cf = pwf[i + 1], cb = pwb[128 - i];
#pragma unroll 1
                    for (int d = 0; d < 64; ++d) {
                        const float qd = qp[d], qf = qd * cf, qb = qd * cb;
#pragma unroll
                        for (int e = 0; e < 16; e += 4) {
                            const float4 sf = *(const float4*)&Sf[d * 64 + part * 16 + e], sb = *(const float4*)&Sb[d * 64 + part * 16 + e];
                            acc[e] = fmaf(qf, sf.x, fmaf(qb, sb.x, acc[e])); acc[e + 1] = fmaf(qf, sf.y, fmaf(qb, sb.y, acc[e + 1]));
                            acc[e + 2] = fmaf(qf, sf.z, fmaf(qb, sb.z, acc[e + 2])); acc[e + 3] = fmaf(qf, sf.w, fmaf(qb, sb.w, acc[e + 3]));
                        }
                    }
                    float sm = 0.f;
#pragma unroll
                    for (int e = 0; e < 16; ++e) sm += acc[e];
                    sm += __shfl_xor(sm, 1); sm += __shfl_xor(sm, 2);
                    const float mu = sm * (1.f / 64.f);
                    float vr = 0.f;
#pragma unroll
                    for (int e = 0; e < 16; ++e) { const float dd = acc[e] - mu; vr += dd * dd; }
                    vr += __shfl_xor(vr, 1); vr += __shfl_xor(vr, 2);
                    const float rs = rsqrtf(vr * (1.f / 64.f) + 1e-6f);
#pragma unroll
                    for (int e = 0; e < 16; ++e) {
                        const float gg = bf2f(P[(size_t)row * LDP + PC_RG + hd * 64 + part * 16 + e]);
                        MIX[(size_t)row * DM + hd * 64 + part * 16 + e] = f2bf((acc[e] - mu) * rs * silu_f(gg));
                    }
                }
            }
            {
                __syncthreads();
                int* rk = (int*)smem; float* pw = (float*)(smem + 2048);
                const float* rpb = p.in[I_RPB] + (size_t)l * 8 * 15 * 31;
                for (int tok = bid; tok < NLAT; tok += nblk) {
                    const int b = tok >> 13, tt = tok & (SEQ - 1), r = tt >> 6, c = tt & 63;
                    int r0 = r - 4; r0 = r0 < 0 ? 0 : (r0 > 120 ? 120 : r0);
                    int c0 = c - 8; c0 = c0 < 0 ? 0 : (c0 > 48 ? 48 : c0);
                    __syncthreads();
                    if (tid < 128) rk[tid] = b * SEQ + (r0 + (tid >> 4)) * 64 + c0 + (tid & 15);
                    else if (tid < 384) rk[tid] = NLAT + b * CTXL + (tid - 128);
                    __syncthreads();
                    const int hd = wid;
                    float q[64];
#pragma unroll
                    for (int d = 0; d < 64; ++d) q[d] = bf2f(P[(size_t)tok * LDP + PC_NQ + hd * 64 + d]) * 0.125f;
                    float sv[6]; float mx = -INFINITY;
#pragma unroll
                    for (int i = 0; i < 6; ++i) {
                        const int j = lane + 64 * i; const bf16_t* kp = P + (size_t)rk[j] * LDP + PC_NK + hd * 64;
                        float s = 0.f;
#pragma unroll
                        for (int d = 0; d < 64; d += 2) { const unsigned kk = *(const unsigned*)(kp + d); s = fmaf(q[d], __uint_as_float(kk << 16), s); s = fmaf(q[d + 1], __uint_as_float(kk & 0xffff0000u), s); }
                        if (j < 128) { const int kr = r0 + (j >> 4), kc = c0 + (j & 15); s += rpb[hd * 465 + (kr - r + 7) * 31 + (kc - c + 15)]; }
                        sv[i] = s; mx = fmaxf(mx, s);
                    }
                    mx = wave_max(mx);
                    float sum = 0.f;
#pragma unroll
                    for (int i = 0; i < 6; ++i) { sv[i] = expf(sv[i] - mx); sum += sv[i]; }
                    sum = wave_sum(sum);
                    const float inv = 1.f / sum;
#pragma unroll
                    for (int i = 0; i < 6; ++i) pw[hd * 384 + lane + 64 * i] = sv[i] * inv;
                    __syncthreads();
                    float o = 0.f;
                    for (int j = 0; j < 384; ++j) o = fmaf(pw[hd * 384 + j], bf2f(P[(size_t)rk[j] * LDP + PC_NV + hd * 64 + lane]), o);
                    MIX[(size_t)tok * DM + 256 + hd * 64 + lane] = f2bf(o);
                }
                __syncthreads();
            }
        }
        if constexpr (KIND == 7) {
            auto epi = [=](int row, int col, float a, float) { float* h = hrow2(Hlat, Hctx, row) + col; *h = *h + modl[row_modv(row) * 6144 + 2048 + col] * a; };
            gemm_simple<false>(smem, U, DM, rows_mix, p.in[I_WOUT] + (size_t)l * DM * DM, nullptr, DM, DM, DM, SegInfo{nullptr, 0}, epi);
        }
        if constexpr (KIND == 8) {
            const float* g = p.in[I_N2G] + l * DM; const float* rw = p.in[I_RW]; const float* rb = p.in[I_RB];
            int* hist = (int*)smem;
            const int nch = rows_mix / NCHUNK_TOK;
            for (int ch = bid; ch < nch; ch += nblk) {
                __syncthreads();
                if (tid < 16) hist[tid] = 0;
                __syncthreads();
                for (int i = wid; i < NCHUNK_TOK; i += 8) {
                    const int row = ch * NCHUNK_TOK + i;
                    const float* h = hrow2(Hlat, Hctx, row); const float* mv = modl + row_modv(row) * 6144;
                    float4 x[4]; float ss = 0.f;
#pragma unroll
                    for (int k = 0; k < 4; ++k) { x[k] = *(const float4*)(h + lane * 4 + 256 * k); ss += x[k].x * x[k].x + x[k].y * x[k].y + x[k].z * x[k].z + x[k].w * x[k].w; }
                    ss = wave_sum(ss);
                    const float rstd = rsqrtf(ss * (1.f / DM) + 1e-6f);
                    float lg[16];
#pragma unroll
                    for (int e = 0; e < 16; ++e) lg[e] = 0.f;
#pragma unroll
                    for (int k = 0; k < 4; ++k) {
                        const int c = lane * 4 + 256 * k;
                        const float4 gg = *(const float4*)(g + c), sh = *(const float4*)(mv + 3072 + c), sc = *(const float4*)(mv + 4096 + c);
                        const float u0 = x[k].x * rstd * gg.x * (1.f + sc.x) + sh.x, u1 = x[k].y * rstd * gg.y * (1.f + sc.y) + sh.y;
                        const float u2 = x[k].z * rstd * gg.z * (1.f + sc.z) + sh.z, u3 = x[k].w * rstd * gg.w * (1.f + sc.w) + sh.w;
#pragma unroll
                        for (int e4 = 0; e4 < 4; ++e4) {
                            const float4 w0 = *(const float4*)(rw + (size_t)(c + 0) * 16 + e4 * 4), w1 = *(const float4*)(rw + (size_t)(c + 1) * 16 + e4 * 4);
                            const float4 w2 = *(const float4*)(rw + (size_t)(c + 2) * 16 + e4 * 4), w3 = *(const float4*)(rw + (size_t)(c + 3) * 16 + e4 * 4);
                            lg[e4 * 4 + 0] += u0 * w0.x + u1 * w1.x + u2 * w2.x + u3 * w3.x;
                            lg[e4 * 4 + 1] += u0 * w0.y + u1 * w1.y + u2 * w2.y + u3 * w3.y;
                            lg[e4 * 4 + 2] += u0 * w0.z + u1 * w1.z + u2 * w2.z + u3 * w3.z;
                            lg[e4 * 4 + 3] += u0 * w0.w + u1 * w1.w + u2 * w2.w + u3 * w3.w;
                        }
                    }
#pragma unroll
                    for (int e = 0; e < 16; ++e) lg[e] = wave_sum(lg[e]);
                    float scv[16], sel[16];
#pragma unroll
                    for (int e = 0; e < 16; ++e) { scv[e] = 1.f / (1.f + expf(-lg[e])); sel[e] = scv[e] + rb[e]; }
                    int best = 0; float bestv = -INFINITY;
#pragma unroll
                    for (int gI = 0; gI < 4; ++gI) {
                        float m1 = -INFINITY, m2 = -INFINITY;
#pragma unroll
                        for (int k = 0; k < 4; ++k) { const float v = sel[gI * 4 + k]; if (v > m1) { m2 = m1; m1 = v; } else if (v > m2) m2 = v; }
                        const float gs = m1 + m2; if (gs > bestv) { bestv = gs; best = gI; }
                    }
                    int ia = -1, ib = -1; float va = -INFINITY, vb = -INFINITY, wa = 0.f, wb = 0.f;
#pragma unroll
                    for (int e = 0; e < 16; ++e) {
                        if ((e >> 2) == best) { const float v = sel[e]; if (v > va) { vb = va; ib = ia; wb = wa; va = v; ia = e; wa = scv[e]; } else if (v > vb) { vb = v; ib = e; wb = scv[e]; } }
                    }
                    if (lane == 0) {
                        const float inv = 1.f / (wa + wb);
                        RTE[row] = make_int2(ia, ib); RTW[row] = make_float2(wa * inv, wb * inv); RTR[row] = rstd;
                        atomicAdd(&hist[ia], 1); atomicAdd(&hist[ib], 1);
                    }
                }
                __syncthreads();
                if (tid < 16) CNT[ch * 16 + tid] = hist[tid];
            }
        }
        if constexpr (KIND == 9) {
            const float* g = p.in[I_N2G] + l * DM;
            int* tots = (int*)smem; int* befo = tots + 16; int* offs = befo + 16; int* sla = offs + 32; int* slb = sla + 128; int* ea = slb + 128; int* eb = ea + 128;
            const int nch = rows_mix / NCHUNK_TOK;
            for (int ch = bid; ch < nch; ch += nblk) {
                __syncthreads();
                if (tid < 16) { int tot = 0, bef = 0; for (int c2 = 0; c2 < nch; ++c2) { const int v = CNT[c2 * 16 + tid]; if (c2 < ch) bef += v; tot += v; } tots[tid] = tot; befo[tid] = bef; }
                if (tid >= 64 && tid < 64 + 128) { const int2 e2 = RTE[ch * NCHUNK_TOK + tid - 64]; ea[tid - 64] = e2.x; eb[tid - 64] = e2.y; }
                __syncthreads();
                if (tid == 0) { int o = 0; for (int e = 0; e < 16; ++e) { offs[e] = o; o += (tots[e] + 255) & ~255; } offs[16] = o; }
                __syncthreads();
                if (tid < 16) { int pos = offs[tid] + befo[tid]; for (int i = 0; i < 128; ++i) { if (ea[i] == tid) sla[i] = pos++; else if (eb[i] == tid) slb[i] = pos++; } }
                if (ch == 0 && tid >= 64 && tid < 64 + 33) { const int q = tid - 64; SEG[q] = q < 17 ? offs[q] : tots[q - 17]; }
                __syncthreads();
                for (int i = wid; i < NCHUNK_TOK; i += 8) {
                    const int row = ch * NCHUNK_TOK + i;
                    const float* h = hrow2(Hlat, Hctx, row); const float* mv = modl + row_modv(row) * 6144;
                    const float rstd = RTR[row]; const int sa = sla[i], sb = slb[i];
#pragma unroll
                    for (int k = 0; k < 4; ++k) {
                        const int c = lane * 4 + 256 * k;
                        const float4 x = *(const float4*)(h + c), gg = *(const float4*)(g + c), sh = *(const float4*)(mv + 3072 + c), sc = *(const float4*)(mv + 4096 + c);
                        const float u0 = x.x * rstd * gg.x * (1.f + sc.x) + sh.x, u1 = x.y * rstd * gg.y * (1.f + sc.y) + sh.y;
                        const float u2 = x.z * rstd * gg.z * (1.f + sc.z) + sh.z, u3 = x.w * rstd * gg.w * (1.f + sc.w) + sh.w;
                        uint2 o; o.x = (unsigned)f2bf(u0) | ((unsigned)f2bf(u1) << 16); o.y = (unsigned)f2bf(u2) | ((unsigned)f2bf(u3) << 16);
                        *(uint2*)(XS + (size_t)sa * DM + c) = o; *(uint2*)(XS + (size_t)sb * DM + c) = o;
                    }
                    if (lane == 0) RTS[row] = make_int2(sa, sb);
                }
            }
        }
        if constexpr (KIND == 10) {
            auto epi = [=](int row, int col, float a, float b2) { HDN[(size_t)row * FF + col] = f2bf(silu_f(a) * b2); };
            gemm_simple<true>(smem, XS, DM, MAXSLOT, p.in[I_W1] + (size_t)l * NE * DM * FF, p.in[I_W3] + (size_t)l * NE * DM * FF, FF, FF, DM, SegInfo{SEG, (size_t)DM * FF}, epi);
        }
        if constexpr (KIND == 11) {
            auto epi = [=](int row, int col, float a, float) { XS[(size_t)row * DM + col] = f2bf(a); };
            gemm_simple<false>(smem, HDN, FF, MAXSLOT, p.in[I_W2] + (size_t)l * NE * FF * DM, nullptr, DM, DM, FF, SegInfo{SEG, (size_t)FF * DM}, epi);
        }
        if constexpr (KIND == 12) {
            for (int row = bid * 8 + wid; row < rows_mix; row += nblk * 8) {
                float* h = hrow2(Hlat, Hctx, row); const float* mv = modl + row_modv(row) * 6144 + 5120;
                const int2 s2 = RTS[row]; const float2 w2 = RTW[row];
#pragma unroll
                for (int k = 0; k < 4; ++k) {
                    const int c = lane * 4 + 256 * k;
                    const uint2 ya = *(const uint2*)(XS + (size_t)s2.x * DM + c), yb = *(const uint2*)(XS + (size_t)s2.y * DM + c);
                    float4 x = *(float4*)(h + c); const float4 gg = *(const float4*)(mv + c);
                    x.x += gg.x * (w2.x * __uint_as_float(ya.x << 16) + w2.y * __uint_as_float(yb.x << 16));
                    x.y += gg.y * (w2.x * __uint_as_float(ya.x & 0xffff0000u) + w2.y * __uint_as_float(yb.x & 0xffff0000u));
                    x.z += gg.z * (w2.x * __uint_as_float(ya.y << 16) + w2.y * __uint_as_float(yb.y << 16));
                    x.w += gg.w * (w2.x * __uint_as_float(ya.y & 0xffff0000u) + w2.y * __uint_as_float(yb.y & 0xffff0000u));
                    *(float4*)(h + c) = x;
                }
            }
        }
    }
    if constexpr (KIND == 13) {
        const float* g = p.in[I_FNG];
        for (int row = bid * 8 + wid; row < NLAT; row += nblk * 8) {
            float* h = p.out + (size_t)row * DM;
            float4 x[4]; float ss = 0.f;
#pragma unroll
            for (int i = 0; i < 4; ++i) { x[i] = *(const float4*)(h + lane * 4 + 256 * i); ss += x[i].x * x[i].x + x[i].y * x[i].y + x[i].z * x[i].z + x[i].w * x[i].w; }
            ss = wave_sum(ss);
            const float rstd = rsqrtf(ss * (1.f / DM) + 1e-6f);
#pragma unroll
            for (int i = 0; i < 4; ++i) { const int c = lane * 4 + 256 * i; const float4 gg = *(const float4*)(g + c); float4 y; y.x = x[i].x * rstd * gg.x; y.y = x[i].y * rstd * gg.y; y.z = x[i].z * rstd * gg.z; y.w = x[i].w * rstd * gg.w; *(float4*)(h + c) = y; }
        }
    }
}

constexpr int LDS_BYTES = 132 * 1024;
template <int KIND> static void launch_ph(const Params& p, int l, int grid, hipStream_t stream) {
    static bool attr_done = false;
    if (!attr_done) { (void)hipFuncSetAttribute((const void*)k_ph<KIND>, hipFuncAttributeMaxDynamicSharedMemorySize, LDS_BYTES); attr_done = true; }
    hipLaunchKernelGGL(k_ph<KIND>, dim3(grid), dim3(512), LDS_BYTES, stream, p, l);
}

extern "C" void kernel_launch(void* const* d_in, const int* in_sizes, int n_in, void* d_out, int out_size, void* d_ws, size_t ws_size, hipStream_t stream) {
    (void)in_sizes; (void)n_in; (void)out_size; (void)ws_size;
    static int grid = 0;
    if (!grid) {
        int dev = 0, cus = 0; (void)hipGetDevice(&dev); (void)hipDeviceGetAttribute(&cus, hipDeviceAttributeMultiprocessorCount, dev);
        grid = cus > 0 ? cus : 256;
    }
    Params p{};
    for (int i = 0; i < 23; ++i) p.in[i] = (const float*)d_in[i];
    p.out = (float*)d_out; p.ws = (unsigned char*)d_ws;
    launch_ph<0>(p, 0, grid, stream);
    for (int l = 0; l < 2; ++l) {
        launch_ph<1>(p, l, grid, stream); launch_ph<2>(p, l, grid, stream); launch_ph<3>(p, l, grid, stream); launch_ph<4>(p, l, grid, stream);
        launch_ph<5>(p, l, grid, stream); launch_ph<6>(p, l, grid, stream); launch_ph<7>(p, l, grid, stream); launch_ph<8>(p, l, grid, stream);
        launch_ph<9>(p, l, grid, stream); launch_ph<10>(p, l, grid, stream); launch_ph<11>(p, l, grid, stream); launch_ph<12>(p, l, grid, stream);
    }
    launch_ph<13>(p, 0, grid, stream);
}
```

```cpp
#include <hip/hip_runtime.h>
#include <stdint.h>
#include <math.h>

typedef unsigned short bf16_t;
#define LAS __attribute__((address_space(3)))

constexpr int DM = 1024, NB = 4, SEQ = 8192, GW = 64, CTXL = 256;
constexpr int NLAT = NB * SEQ;
constexpr int NCTX = NB * CTXL;
constexpr int NROW = NLAT + NCTX;
constexpr int DPROJ = 3232, LDP = 3328;
constexpr int PC_RQ = 0, PC_RK = 256, PC_RV = 512, PC_RG = 768, PC_NQ = 1024, PC_NK = 1536, PC_NV = 2048, PC_CQ = 2560, PC_CKV = 2944, PC_KPE = 3200;
constexpr int NE = 16, FF = 256;
constexpr int MAXSLOT = 2 * NROW + NE * 256;
constexpr int NCHUNK_TOK = 128;
constexpr int RET_ITEMS = 16 * 64 + 16 * 2;

constexpr size_t MiB = 1u << 20;
constexpr size_t WS_CTL = 0;
constexpr size_t WS_MOD = 1 * MiB;
constexpr size_t WS_HC = 2 * MiB;
constexpr size_t WS_RT = 6 * MiB;
constexpr size_t WS_U = 8 * MiB;
constexpr size_t WS_QM = 74 * MiB;
constexpr size_t WS_KM = 99 * MiB;
constexpr size_t WS_VM = 124 * MiB;
constexpr size_t WS_RKV = 141 * MiB;
constexpr size_t WS_P = 174 * MiB;
constexpr size_t WS_XS = WS_P;
constexpr size_t WS_HDN = WS_P + 140 * MiB;
constexpr size_t WS_WT = 389 * MiB;
constexpr size_t WT_IN = 0, WT_IN_L = (size_t)3328 * 1024;
constexpr size_t WT_UQ = WT_IN + 2 * WT_IN_L, WT_UQ_L = (size_t)512 * 384;
constexpr size_t WT_UKV = WT_UQ + 2 * WT_UQ_L, WT_UKV_L = (size_t)512 * 256;
constexpr size_t WT_OUT = WT_UKV + 2 * WT_UKV_L, WT_OUT_L = (size_t)1024 * 1024;
constexpr size_t WT_13 = WT_OUT + 2 * WT_OUT_L, WT_13_L = (size_t)16 * 512 * 1024;
constexpr size_t WT_2 = WT_13 + 2 * WT_13_L, WT_2_L = (size_t)16 * 1024 * 256;
constexpr size_t WT_END = WT_2 + 2 * WT_2_L;
static_assert(WS_WT + WT_END * 2 <= 512 * MiB, "workspace");
constexpr size_t WS_VT = 456 * MiB;
constexpr size_t RT_TILE = 1984 * 1024;
constexpr size_t RT_E = 0, RT_W = 512 * 1024, RT_RSTD = 1024 * 1024, RT_SLOT = 1280 * 1024, RT_CNT = 1792 * 1024, RT_SEG = 1920 * 1024;

struct Params { const float* in[23]; float* out; unsigned char* ws; int lo, hi; };
enum { I_X = 0, I_C, I_CTX, I_CCTX, I_WMOD, I_BMOD, I_N1G, I_N2G, I_WIN, I_RDF, I_RDB, I_RPB, I_QN, I_KVN, I_WUQ, I_WUKV, I_WOUT, I_RW, I_RB, I_W1, I_W3, I_W2, I_FNG };

__device__ __forceinline__ float bf2f(bf16_t v) { return __uint_as_float(((unsigned)v) << 16); }
__device__ __forceinline__ bf16_t f2bf(float f) { unsigned u = __float_as_uint(f); return (bf16_t)((u + 0x7fffu + ((u >> 16) & 1u)) >> 16); }
__device__ __forceinline__ float wave_sum(float v) {
#pragma unroll
    for (int o = 32; o >= 1; o >>= 1) v += __shfl_xor(v, o);
    return v;
}
__device__ __forceinline__ float wave_max(float v) {
#pragma unroll
    for (int o = 32; o >= 1; o >>= 1) v = fmaxf(v, __shfl_xor(v, o));
    return v;
}
__device__ __forceinline__ float silu_f(float x) { return x / (1.f + expf(-x)); }
__device__ __forceinline__ int row_modv(int row) { return row < NLAT ? (row >> 13) : 4; }
__device__ __forceinline__ float* hrow2(float* hl, float* hc, int row) { return row < NLAT ? hl + (size_t)row * DM : hc + (size_t)(row - NLAT) * DM; }

#define XB_TMO      128
#define XB_XCNT(j)  (256  + 64 * (j))
#define XB_XSUB(j)  (1280 + 64 * (j))
#define XB_XGEN(j)  (2304 + 64 * (j))
#define XB_TOP      3328
#define XB_TOPGEN   3392
#define XCD_BAR_WORDS 3456
#define XB_SPIN_CAP (1u << 18)
__device__ __forceinline__ unsigned xb_ld(unsigned* p)              { return __hip_atomic_load(p, __ATOMIC_RELAXED, __HIP_MEMORY_SCOPE_AGENT); }
__device__ __forceinline__ unsigned xb_add(unsigned* p, unsigned v) { return __hip_atomic_fetch_add(p, v, __ATOMIC_RELAXED, __HIP_MEMORY_SCOPE_AGENT); }
__device__ __forceinline__ unsigned xb_xcc_id() { return (unsigned)__builtin_amdgcn_s_getreg((3 << 11) | 20) & 0xFu; }
#define XB_SPIN(cond, bar) do { unsigned _sp = 0; while (cond) { __builtin_amdgcn_s_sleep(1); \
    if ((++_sp & 255u) == 0u) { if (xb_ld(&(bar)[XB_TMO])) break; if (_sp > XB_SPIN_CAP) { atomicAdd(&(bar)[XB_TMO], 1u); break; } } } } while (0)
struct XcdBarrier { unsigned* bar; unsigned x; volatile LAS unsigned* st; };
__device__ __forceinline__ XcdBarrier xcd_barrier_post(unsigned* bar, volatile LAS unsigned* st) {
    XcdBarrier b; b.bar = bar; b.x = xb_xcc_id(); b.st = st;
    if (threadIdx.x == 0) (void)xb_add(&bar[XB_XCNT(b.x)], 1u);
    return b;
}
__device__ __forceinline__ void xcd_barrier_complete(unsigned* bar, unsigned x, unsigned& nloc, unsigned& nx) {
    const unsigned G = gridDim.x * gridDim.y * gridDim.z;
    unsigned sum, cnt, mine, sp = 0u;
    for (;;) {
        sum = 0u; cnt = 0u; mine = 0u;
#pragma unroll
        for (unsigned j = 0; j < 16; ++j) { const unsigned c = xb_ld(&bar[XB_XCNT(j)]); sum += c; cnt += (c > 0u) ? 1u : 0u; mine = (j == x) ? c : mine; }
        if (sum == G) break;
        __builtin_amdgcn_s_sleep(1);
        if ((++sp & 255u) == 0u) { if (xb_ld(&bar[XB_TMO])) break; if (sp > XB_SPIN_CAP) { atomicAdd(&bar[XB_TMO], 1u); break; } }
    }
    nloc = mine > 0u ? mine : 1u; nx = cnt > 0u ? cnt : 1u;
}
__device__ __forceinline__ void xcd_barrier(const XcdBarrier& b) {
    asm volatile("s_waitcnt vmcnt(0)" ::: "memory");
    __syncthreads();
    if (threadIdx.x == 0) {
        unsigned* bar = b.bar;
        __builtin_amdgcn_s_waitcnt(0);
        unsigned nloc = b.st[0], nx = b.st[1];
        if (nloc == 0u) { xcd_barrier_complete(bar, b.x, nloc, nx); b.st[0] = nloc; b.st[1] = nx; }
        const unsigned old = xb_add(&bar[XB_XSUB(b.x)], 1u);
        const unsigned gen = old / nloc;
        if (old + 1u == (gen + 1u) * nloc) {
            __builtin_amdgcn_fence(__ATOMIC_RELEASE, "agent");
            asm volatile("s_waitcnt vmcnt(0)" ::: "memory");
            const unsigned og = xb_add(&bar[XB_TOP], 1u);
            const unsigned tg = og / nx;
            if (og + 1u == (tg + 1u) * nx) xb_add(&bar[XB_TOPGEN], 1u);
            else XB_SPIN(xb_ld(&bar[XB_TOPGEN]) == tg, bar);
            __builtin_amdgcn_fence(__ATOMIC_ACQUIRE, "agent");
            xb_add(&bar[XB_XGEN(b.x)], 1u);
            asm volatile("s_waitcnt vmcnt(0)" ::: "memory");
        } else {
            XB_SPIN(xb_ld(&bar[XB_XGEN(b.x)]) == gen, bar);
            __builtin_amdgcn_fence(__ATOMIC_ACQUIRE, "agent");
            asm volatile("s_waitcnt vmcnt(0)" ::: "memory");
        }
    }
    __syncthreads();
}

struct SegInfo { const int* seg; size_t wstride; };
template <bool DUAL, class Epi>
__device__ __forceinline__ void gemm_simple(char* smem, const bf16_t* A, int lda, int M, const float* W, const float* W2, int ldw, int N, int K, SegInfo sg, const Epi& epi) {
    float* As = (float*)smem;
    float* Ws = As + 16 * 132;
    float* Ws2 = Ws + 16 * 68;
    const int t = threadIdx.x, ty = t >> 4, tx = t & 15;
    const int ntm = (M + 127) / 128, ntn = (N + 63) / 64;
    for (int tile = blockIdx.x; tile < ntm * ntn; tile += gridDim.x) {
        const int tm = tile / ntn, tn = tile % ntn, m0 = tm * 128, n0 = tn * 64;
        const float* Wt = W; const float* Wt2 = W2; int mvalid = M;
        if (sg.seg) {
            int e = 0;
#pragma unroll
            for (int i = 1; i < 16; ++i) if (m0 >= sg.seg[i]) e = i;
            mvalid = sg.seg[e] + sg.seg[17 + e];
            if (m0 >= sg.seg[16] || m0 >= mvalid) continue;
            Wt = W + (size_t)e * sg.wstride; if (DUAL) Wt2 = W2 + (size_t)e * sg.wstride;
        }
        float acc[4][4], acc2[4][4];
#pragma unroll
        for (int i = 0; i < 4; ++i)
#pragma unroll
            for (int j = 0; j < 4; ++j) { acc[i][j] = 0.f; acc2[i][j] = 0.f; }
        for (int k0 = 0; k0 < K; k0 += 16) {
            {
                const int r = t >> 2, kq = (t & 3) * 4, row = m0 + r;
                uint2 v = make_uint2(0u, 0u);
                if (row < M) v = *(const uint2*)(A + (size_t)row * lda + k0 + kq);
                As[(kq + 0) * 132 + r] = __uint_as_float(v.x << 16);
                As[(kq + 1) * 132 + r] = __uint_as_float(v.x & 0xffff0000u);
                As[(kq + 2) * 132 + r] = __uint_as_float(v.y << 16);
                As[(kq + 3) * 132 + r] = __uint_as_float(v.y & 0xffff0000u);
            }
            {
                const int k = t >> 5, n = (t & 31) * 2, col = n0 + n;
                float2 w = make_float2(0.f, 0.f), w2 = make_float2(0.f, 0.f);
                if (col < N) { w = *(const float2*)(Wt + (size_t)(k0 + k) * ldw + col); if (DUAL) w2 = *(const float2*)(Wt2 + (size_t)(k0 + k) * ldw + col); }
                Ws[k * 68 + n] = w.x; Ws[k * 68 + n + 1] = w.y;
                if (DUAL) { Ws2[k * 68 + n] = w2.x; Ws2[k * 68 + n + 1] = w2.y; }
            }
            __syncthreads();
#pragma unroll
            for (int kk = 0; kk < 16; ++kk) {
                const float4 a = *(const float4*)&As[kk * 132 + ty * 4];
                const float4 w = *(const float4*)&Ws[kk * 68 + tx * 4];
                const float av[4] = {a.x, a.y, a.z, a.w}, wv[4] = {w.x, w.y, w.z, w.w};
#pragma unroll
                for (int i = 0; i < 4; ++i)
#pragma unroll
                    for (int j = 0; j < 4; ++j) acc[i][j] = fmaf(av[i], wv[j], acc[i][j]);
                if (DUAL) {
                    const float4 w2 = *(const float4*)&Ws2[kk * 68 + tx * 4];
                    const float wv2[4] = {w2.x, w2.y, w2.z, w2.w};
#pragma unroll
                    for (int i = 0; i < 4; ++i)
#pragma unroll
                        for (int j = 0; j < 4; ++j) acc2[i][j] = fmaf(av[i], wv2[j], acc2[i][j]);
                }
            }
            __syncthreads();
        }
#pragma unroll
        for (int i = 0; i < 4; ++i) {
            const int row = m0 + ty * 4 + i;
            if (row < M && row < mvalid) {
#pragma unroll
                for (int j = 0; j < 4; ++j) { const int col = n0 + tx * 4 + j; if (col < N) epi(row, col, acc[i][j], acc2[i][j]); }
            }
        }
    }
}

template <int DQK, int DV>
__device__ __forceinline__ void attn_simple(char* smem, const bf16_t* Q, int ldq, int nq, const bf16_t* K0, const bf16_t* V0, int n0, const bf16_t* K1, const bf16_t* V1, int n1,
                                            int ldk, int ldv, float qscale_log2, bf16_t* O, int ldo) {
    float* Ks = (float*)smem;
    float* Vs = Ks + 32 * DQK;
    const int t = threadIdx.x;
    const bool act = t < nq;
    float q[DQK];
#pragma unroll
    for (int c = 0; c < DQK; ++c) q[c] = act ? bf2f(Q[(size_t)t * ldq + c]) * qscale_log2 : 0.f;
    float o[DV];
#pragma unroll
    for (int e = 0; e < DV; ++e) o[e] = 0.f;
    float mrun = -INFINITY, lrun = 0.f;
    const int ntile = (n0 + n1) / 32;
    for (int tl = 0; tl < ntile; ++tl) {
        const int j0 = tl * 32;
        const bf16_t* Kp; const bf16_t* Vp;
        if (j0 < n0) { Kp = K0 + (size_t)j0 * ldk; Vp = V0 + (size_t)j0 * ldv; } else { Kp = K1 + (size_t)(j0 - n0) * ldk; Vp = V1 + (size_t)(j0 - n0) * ldv; }
        __syncthreads();
        for (int idx = t; idx < 32 * DQK; idx += 512) { const int r = idx / DQK, c = idx % DQK; Ks[idx] = bf2f(Kp[(size_t)r * ldk + c]); }
        for (int idx = t; idx < 32 * DV; idx += 512) { const int r = idx / DV, c = idx % DV; Vs[idx] = bf2f(Vp[(size_t)r * ldv + c]); }
        __syncthreads();
#pragma unroll 1
        for (int r = 0; r < 32; ++r) {
            float a = 0.f;
#pragma unroll
            for (int c = 0; c < DQK; c += 4) { const float4 kv = *(const float4*)&Ks[r * DQK + c]; a = fmaf(q[c], kv.x, a); a = fmaf(q[c + 1], kv.y, a); a = fmaf(q[c + 2], kv.z, a); a = fmaf(q[c + 3], kv.w, a); }
            if (a > mrun) {
                const float alpha = exp2f(mrun - a);
                mrun = a; lrun *= alpha;
#pragma unroll
                for (int e = 0; e < DV; ++e) o[e] *= alpha;
            }
            const float pr = exp2f(a - mrun);
            lrun += pr;
#pragma unroll
            for (int e = 0; e < DV; e += 4) { const float4 vv = *(const float4*)&Vs[r * DV + e]; o[e] = fmaf(pr, vv.x, o[e]); o[e + 1] = fmaf(pr, vv.y, o[e + 1]); o[e + 2] = fmaf(pr, vv.z, o[e + 2]); o[e + 3] = fmaf(pr, vv.w, o[e + 3]); }
        }
    }
    if (act) {
        const float inv = 1.f / lrun;
#pragma unroll
        for (int e = 0; e < DV; ++e) O[(size_t)t * ldo + e] = f2bf(o[e] * inv);
    }
    __syncthreads();
}

__device__ __forceinline__ void rope_pair(float& x1, float& x2, float pos, int i, int half) {
    const float inv = powf(10000.0f, -(float)i / (float)half);
    float sn, cs; sincosf(pos * inv, &sn, &cs);
    const float a = x1 * cs - x2 * sn, b = x2 * cs + x1 * sn; x1 = a; x2 = b;
}
__device__ __forceinline__ float log_sigmoid_f(float x) { return -log1pf(expf(-x)); }

namespace pg8 {
#define PG8_LAS __attribute__((address_space(3)))
typedef unsigned short bf16_t;
typedef short bf16x8 __attribute__((ext_vector_type(8)));
typedef float f32x4 __attribute__((ext_vector_type(4)));
typedef unsigned u32x4 __attribute__((ext_vector_type(4)));
constexpr int BM = 256, BK = 64, HALF = 128, HTB = HALF * BK * 2  , STAGE_BYTES = 8 * HTB, NXCD = 8, WGM = 8;

__host__ __device__ __forceinline__ int lds_byte(int r, int c) { const int st = (r >> 4) * 2 + (c >> 5), rr = r & 15, cc = c & 31, ob = rr * 64 + cc * 2; return st * 1024 + (ob ^ (((ob >> 9) & 1) << 5)); }
__host__ __device__ __forceinline__ void stage_rc(int b, int& R, int& C) { const int st = b / 1024, sb = b % 1024, swz = sb ^ (((sb >> 9) & 1) << 5); R = (st >> 1) * 16 + swz / 64; C = (st & 1) * 32 + (swz % 64) / 2; }
__host__ __device__ __forceinline__ int perm32(int rho) { const int n = rho >> 4, i = rho & 15; return 8 * (i >> 2) + 4 * n + (i & 3); }

struct Unit { int pm, pn; };
struct Gemm { const bf16_t* A; const bf16_t* Bt; int lda, ldb, K; };

__device__ __forceinline__ unsigned cvt_pk_bf16(float lo, float hi) { unsigned r; asm volatile("v_cvt_pk_bf16_f32 %0, %1, %2" : "=v"(r) : "v"(lo), "v"(hi)); return r; }
template <class Epi, class Sched, bool ALIGN_EPI = false, bool SP2 = false>
__device__ __forceinline__ void gemm_phase(PG8_LAS unsigned char* lds, const Gemm g, const Sched& S, const Epi& E) {
    const int tid = threadIdx.x, wid = __builtin_amdgcn_readfirstlane(tid >> 6), lane = tid & 63, wr = wid >> 2, wc = wid & 3, fr = lane & 15, fq = lane >> 4;
    int K = g.K; asm volatile("" : "+s"(K));
    const int nt = K / BK;
    unsigned voffA[2], voffB[2];
#pragma unroll
    for (int i = 0; i < 2; ++i) { int R, C; stage_rc(tid * 16 + i * 8192, R, C); const int Rb = Epi::PERM ? ((R & ~31) + perm32(R & 31)) : R;
        voffA[i] = (unsigned)(R * g.lda + C) * 2u; voffB[i] = (unsigned)(Rb * g.ldb + C) * 2u; }
    const size_t kstep = (size_t)(BK * 2);
    const size_t hstepA = (size_t)HALF * g.lda * 2, hstepB = (size_t)HALF * g.ldb * 2;
    const size_t tstepA = 2 * hstepA, tstepB = 2 * hstepB;
    const unsigned ldsw = (unsigned)wid * 1024u;
    const int aoff = lds_byte(wr * 64 + fr, fq * 8), boff = lds_byte(wc * 32 + fr, fq * 8);
#define PG8_SA(b, h) (((b) * 2 + (h)) * HTB)
#define PG8_SB(b, h) ((4 + (b) * 2 + (h)) * HTB)
#define PG8_STAGE(bufoff, gbase, voff) do { _Pragma("unroll") for (int _i = 0; _i < 2; ++_i) \
        __builtin_amdgcn_global_load_lds((const unsigned*)((const char*)(gbase) + (voff)[_i]), (PG8_LAS unsigned*)(lds + (bufoff) + ldsw + _i * 8192), 16, 0, 0); } while (0)
#define PG8_LDA(dst, b, h) do { _Pragma("unroll") for (int m = 0; m < 4; ++m) _Pragma("unroll") for (int k = 0; k < 2; ++k) dst[m][k] = *(const PG8_LAS bf16x8*)(lds + PG8_SA(b, h) + aoff + m * 2048 + k * 1024); } while (0)
#define PG8_LDB(dst, b, h) do { _Pragma("unroll") for (int n = 0; n < 2; ++n) _Pragma("unroll") for (int k = 0; k < 2; ++k) dst[n][k] = *(const PG8_LAS bf16x8*)(lds + PG8_SB(b, h) + boff + n * 2048 + k * 1024); } while (0)
#define PG8_MMA(ai, bj, At, Bt) do { __builtin_amdgcn_s_setprio(1); _Pragma("unroll") for (int m = 0; m < 4; ++m) _Pragma("unroll") for (int n = 0; n < 2; ++n) _Pragma("unroll") for (int k = 0; k < 2; ++k) \
        acc[ai][bj][m][n] = __builtin_amdgcn_mfma_f32_16x16x32_bf16(Bt[n][k], At[m][k], acc[ai][bj][m][n], 0, 0, 0); __builtin_amdgcn_s_setprio(0); } while (0)
#define PG8_WAIT_V(n) asm volatile("s_waitcnt vmcnt(" #n ")" ::: "memory")
#define PG8_WAIT_L(n) asm volatile("s_waitcnt lgkmcnt(" #n ")" ::: "memory")
#define PG8_BAR __builtin_amdgcn_s_barrier()
#define PG8_SCHED __builtin_amdgcn_sched_barrier(0)
    Unit cur, nxt; int ui = 0;
    if (!S.next(0, cur)) return;
    f32x4 acc[2][2][4][2];
#pragma unroll
    for (int a = 0; a < 2; ++a)
#pragma unroll
        for (int b = 0; b < 2; ++b)
#pragma unroll
            for (int m = 0; m < 4; ++m)
#pragma unroll
                for (int n = 0; n < 2; ++n) acc[a][b][m][n] = (f32x4){0.f, 0.f, 0.f, 0.f};
    bf16x8 At[4][2], B0[2][2], B1[2][2];
    const char* cA = (const char*)g.A + (size_t)cur.pm * tstepA; const char* cB = (const char*)g.Bt + (size_t)cur.pn * tstepB;
    S.a_ready(cur);
    if constexpr (SP2) {
        PG8_STAGE(PG8_SB(0, 0), cB, voffB); PG8_STAGE(PG8_SB(0, 1), cB + hstepB, voffB); PG8_STAGE(PG8_SA(0, 0), cA, voffA); PG8_STAGE(PG8_SA(0, 1), cA + hstepA, voffA);
        if (wr == 1) PG8_BAR;
        PG8_WAIT_V(2); PG8_BAR;
        PG8_STAGE(PG8_SB(1, 0), cB + kstep, voffB); PG8_STAGE(PG8_SA(1, 0), cA + kstep, voffA); PG8_STAGE(PG8_SB(1, 1), cB + hstepB + kstep, voffB);
        PG8_WAIT_V(6); PG8_BAR;
    } else {
        PG8_STAGE(PG8_SB(0, 0), cB, voffB); PG8_STAGE(PG8_SA(0, 0), cA, voffA); PG8_STAGE(PG8_SB(0, 1), cB + hstepB, voffB); PG8_STAGE(PG8_SA(0, 1), cA + hstepA, voffA);
        if (wr == 1) PG8_BAR;
        PG8_WAIT_V(4); PG8_BAR;
        PG8_STAGE(PG8_SB(1, 0), cB + kstep, voffB); PG8_STAGE(PG8_SA(1, 0), cA + kstep, voffA); PG8_STAGE(PG8_SB(1, 1), cB + hstepB + kstep, voffB);
        PG8_WAIT_V(6); PG8_BAR;
    }
    for (;;) {
        const bool has_next = S.next(ui + 1, nxt);
        const char* nA = has_next ? (const char*)g.A + (size_t)nxt.pm * tstepA : cA; const char* nB = has_next ? (const char*)g.Bt + (size_t)nxt.pn * tstepB : cB;
        for (int t = 0; t < nt; t += 2) {
            const bool last = (t == nt - 2);
            const char* a1 = cA + (size_t)(t + 1) * kstep;
            const char* a2 = last ? nA : cA + (size_t)(t + 2) * kstep; const char* b2 = last ? nB : cB + (size_t)(t + 2) * kstep;
            const char* a3 = a2 + kstep; const char* b3 = b2 + kstep;
            if (last && has_next) S.a_ready(nxt);
            if constexpr (SP2) {
            PG8_LDB(B0, 0, 0); PG8_LDB(B1, 0, 1); PG8_SCHED; PG8_LDA(At, 0, 0); PG8_STAGE(PG8_SA(1, 1), a1 + hstepA, voffA);
            PG8_WAIT_V(8); PG8_WAIT_L(0); PG8_BAR; PG8_MMA(0, 0, At, B0); PG8_MMA(0, 1, At, B1); PG8_BAR; PG8_SCHED;
            PG8_LDA(At, 0, 1); PG8_STAGE(PG8_SB(0, 0), b2, voffB); PG8_STAGE(PG8_SB(0, 1), b2 + hstepB, voffB); PG8_STAGE(PG8_SA(0, 0), a2, voffA);
            PG8_WAIT_V(8); PG8_WAIT_L(0); PG8_BAR; PG8_MMA(1, 0, At, B0); PG8_MMA(1, 1, At, B1); PG8_BAR; PG8_SCHED;
            PG8_LDB(B0, 1, 0); PG8_LDB(B1, 1, 1); PG8_SCHED; PG8_LDA(At, 1, 0); PG8_STAGE(PG8_SA(0, 1), a2 + hstepA, voffA);
            PG8_WAIT_V(8); PG8_WAIT_L(0); PG8_BAR; PG8_MMA(0, 0, At, B0); PG8_MMA(0, 1, At, B1); PG8_BAR; PG8_SCHED;
            PG8_LDA(At, 1, 1); PG8_STAGE(PG8_SB(1, 0), b3, voffB); PG8_STAGE(PG8_SB(1, 1), b3 + hstepB, voffB); PG8_STAGE(PG8_SA(1, 0), a3, voffA);
            PG8_WAIT_V(8); PG8_WAIT_L(0); PG8_BAR; PG8_MMA(1, 0, At, B0); PG8_MMA(1, 1, At, B1); PG8_BAR; PG8_SCHED;
            } else {
            PG8_LDB(B0, 0, 0); PG8_SCHED; PG8_LDA(At, 0, 0); PG8_STAGE(PG8_SA(1, 1), a1 + hstepA, voffA);
            PG8_WAIT_L(8); PG8_BAR; PG8_WAIT_L(0); PG8_MMA(0, 0, At, B0); PG8_BAR; PG8_SCHED;
            PG8_LDB(B1, 0, 1); PG8_STAGE(PG8_SB(0, 0), b2, voffB);
            PG8_BAR; PG8_WAIT_L(0); PG8_MMA(0, 1, At, B1); PG8_BAR;
            PG8_LDA(At, 0, 1); PG8_STAGE(PG8_SA(0, 0), a2, voffA);
            PG8_BAR; PG8_WAIT_L(0); PG8_MMA(1, 0, At, B0); PG8_BAR; PG8_SCHED;
            PG8_STAGE(PG8_SB(0, 1), b2 + hstepB, voffB);
            PG8_WAIT_V(6); PG8_BAR; PG8_MMA(1, 1, At, B1); PG8_BAR;
            PG8_LDB(B0, 1, 0); PG8_SCHED; PG8_LDA(At, 1, 0); PG8_STAGE(PG8_SA(0, 1), a2 + hstepA, voffA);
            PG8_WAIT_L(8); PG8_BAR; PG8_WAIT_L(0); PG8_MMA(0, 0, At, B0); PG8_BAR; PG8_SCHED;
            PG8_LDB(B1, 1, 1); PG8_STAGE(PG8_SB(1, 0), b3, voffB);
            PG8_BAR; PG8_WAIT_L(0); PG8_MMA(0, 1, At, B1); PG8_BAR;
            PG8_LDA(At, 1, 1); PG8_STAGE(PG8_SA(1, 0), a3, voffA);
            PG8_BAR; PG8_WAIT_L(0); PG8_MMA(1, 0, At, B0); PG8_BAR; PG8_SCHED;
            PG8_STAGE(PG8_SB(1, 1), b3 + hstepB, voffB);
            PG8_WAIT_V(6); PG8_BAR; PG8_MMA(1, 1, At, B1); PG8_BAR;
            }
        }
        if constexpr (ALIGN_EPI) { if (wr == 0) PG8_BAR; }
        if constexpr (!Epi::AFTER_DRAIN) { E(acc, cur, wr, wc, fr, fq); S.done(cur); }
        if (!has_next) break;
#pragma unroll
        for (int a = 0; a < 2; ++a)
#pragma unroll
            for (int b = 0; b < 2; ++b)
#pragma unroll
                for (int m = 0; m < 4; ++m)
#pragma unroll
                    for (int n = 0; n < 2; ++n) acc[a][b][m][n] = (f32x4){0.f, 0.f, 0.f, 0.f};
        cur = nxt; cA = nA; cB = nB; ++ui;
        if constexpr (ALIGN_EPI) { if (wr == 1) PG8_BAR; }
    }
    PG8_WAIT_V(0);
    if constexpr (!ALIGN_EPI) { if (wr == 0) PG8_BAR; }
    PG8_BAR;
    if constexpr (Epi::AFTER_DRAIN) { E.fused(acc, cur, wr, wc, fr, fq, lds, wid, lane); S.done(cur); }
#undef PG8_SA
#undef PG8_SB
#undef PG8_STAGE
#undef PG8_LDA
#undef PG8_LDB
#undef PG8_MMA
#undef PG8_WAIT_V
#undef PG8_WAIT_L
#undef PG8_BAR
#undef PG8_SCHED
}


struct StaticOrder {
    int nM, nN, nwg, G, c;
    __device__ void init(int M, int N, int G_, int c_) { nM = M / BM; nN = N / BM; nwg = nM * nN; G = G_; c = c_; }
    __device__ bool next(int i, Unit& u) const {
        const long L = (long)i * G + c; if (L >= nwg) return false;
        int wgid = (int)L; { const int q = nwg / NXCD, r = nwg % NXCD, xcd = wgid % NXCD, off = wgid / NXCD; wgid = (xcd < r ? xcd * (q + 1) : r * (q + 1) + (xcd - r) * q) + off; }
        const int nig = WGM * nN, gid = wgid / nig, fm = gid * WGM, gsz = (nM - fm) < WGM ? (nM - fm) : WGM;
        u.pm = fm + ((wgid % nig) % gsz); u.pn = (wgid % nig) / gsz; return true;
    }
    __device__ __forceinline__ void a_ready(const Unit&) const {}
    __device__ __forceinline__ void done(const Unit&) const {}
};
struct GroupedOrder {
    const PG8_LAS int* list; int n;
    __device__ __forceinline__ bool next(int i, Unit& u) const { if (i >= n) return false; u.pm = __builtin_amdgcn_readfirstlane(list[2 * i]); u.pn = __builtin_amdgcn_readfirstlane(list[2 * i + 1]); return true; }
    __device__ __forceinline__ void a_ready(const Unit&) const {}
    __device__ __forceinline__ void done(const Unit&) const {}
};
__device__ __forceinline__ int grouped_units(PG8_LAS int* list, const int* tile, int ncol, int G, int c) {
    const int nrt = tile[0]; int n = 0;
    for (int i = 0; i < 16; ++i) { const int L = i * G + c, rt = L / ncol; if (rt >= nrt) break; if (threadIdx.x == 0) { list[2 * i] = tile[17 + 2 * rt]; list[2 * i + 1] = tile[16 + 2 * rt] * ncol + (L % ncol); } ++n; }
    __syncthreads();
    return n;
}
__device__ __forceinline__ u32x4 pack8(const f32x4& v0, const f32x4& v1) { u32x4 w; w.x = cvt_pk_bf16(v0[0], v0[1]); w.y = cvt_pk_bf16(v0[2], v0[3]); w.z = cvt_pk_bf16(v1[0], v1[1]); w.w = cvt_pk_bf16(v1[2], v1[3]); return w; }
#define EPI_ROWS_BEGIN _Pragma("unroll") for (int ai = 0; ai < 2; ++ai) _Pragma("unroll") for (int m = 0; m < 4; ++m) { const int row = u.pm * BM + ai * HALF + wr * 64 + m * 16 + fr; \
    _Pragma("unroll") for (int bj = 0; bj < 2; ++bj) { const f32x4 v0 = acc[ai][bj][m][0], v1 = acc[ai][bj][m][1];
#define EPI_ROWS_END } }
struct EpiP { static constexpr bool PERM = true, AFTER_DRAIN = false; bf16_t* O; int ldc;
    __device__ __forceinline__ void operator()(const f32x4 (&acc)[2][2][4][2], const Unit& u, int wr, int wc, int fr, int fq) const {
        EPI_ROWS_BEGIN const int col = u.pn * BM + bj * HALF + wc * 32 + 8 * fq; *(u32x4*)(O + (size_t)row * ldc + col) = pack8(v0, v1); EPI_ROWS_END } };
struct EpiUQ { static constexpr bool PERM = true, AFTER_DRAIN = false; bf16_t* Q;
    __device__ __forceinline__ void operator()(const f32x4 (&acc)[2][2][4][2], const Unit& u, int wr, int wc, int fr, int fq) const {
        EPI_ROWS_BEGIN const int col = u.pn * BM + bj * HALF + wc * 32 + 8 * fq; if (col < 384) *(u32x4*)(Q + (size_t)row * 384 + col) = pack8(v0, v1); EPI_ROWS_END } };
struct EpiUKV { static constexpr bool PERM = true, AFTER_DRAIN = false; bf16_t* Kn; bf16_t* Vn;
    __device__ __forceinline__ void operator()(const f32x4 (&acc)[2][2][4][2], const Unit& u, int wr, int wc, int fr, int fq) const {
        bf16_t* base = wc < 2 ? Kn + wc * 32 + 8 * fq : Vn + (wc - 2) * 32 + 8 * fq; const int rp = wc < 2 ? 384 : 256, hp = wc < 2 ? 96 : 64;
        EPI_ROWS_BEGIN const int hd = u.pn * 2 + bj; *(u32x4*)(base + (size_t)row * rp + hd * hp) = pack8(v0, v1); EPI_ROWS_END } };
struct EpiOut { static constexpr bool PERM = true, AFTER_DRAIN = false; float* hl; float* hc; const float* gate;
    __device__ __forceinline__ void operator()(const f32x4 (&acc)[2][2][4][2], const Unit& u, int wr, int wc, int fr, int fq) const {
        EPI_ROWS_BEGIN const int col = u.pn * BM + bj * HALF + wc * 32 + 8 * fq;
            float* h = (row < 32768 ? hl + (size_t)row * 1024 : hc + (size_t)(row - 32768) * 1024) + col; const float* g = gate + (row < 32768 ? (row >> 13) : 4) * 6144 + col;
            const f32x4 g0 = *(const f32x4*)g, g1 = *(const f32x4*)(g + 4); f32x4 h0 = *(f32x4*)h, h1 = *(f32x4*)(h + 4);
            h0 = h0 + g0 * v0; h1 = h1 + g1 * v1; *(f32x4*)h = h0; *(f32x4*)(h + 4) = h1; EPI_ROWS_END } };
__device__ __forceinline__ float silu_fast(float x) { return x / (1.f + __expf(-x)); }
struct EpiMoe1 { static constexpr bool PERM = true, AFTER_DRAIN = false; bf16_t* Hd;
    __device__ __forceinline__ void operator()(const f32x4 (&acc)[2][2][4][2], const Unit& u, int wr, int wc, int fr, int fq) const {
        EPI_ROWS_BEGIN const int col = (u.pn & 1) * BM + bj * HALF + wc * 32 + 8 * fq;
            uint2 w; w.x = cvt_pk_bf16(silu_fast(v0[0]) * v0[1], silu_fast(v0[2]) * v0[3]); w.y = cvt_pk_bf16(silu_fast(v1[0]) * v1[1], silu_fast(v1[2]) * v1[3]);
            *(uint2*)(Hd + (size_t)row * 256 + (col >> 1)) = w; EPI_ROWS_END } };
struct EpiMoe2 { static constexpr bool PERM = true, AFTER_DRAIN = false; bf16_t* Y;
    __device__ __forceinline__ void operator()(const f32x4 (&acc)[2][2][4][2], const Unit& u, int wr, int wc, int fr, int fq) const {
        EPI_ROWS_BEGIN const int col = (u.pn & 3) * BM + bj * HALF + wc * 32 + 8 * fq; *(u32x4*)(Y + (size_t)row * 1024 + col) = pack8(v0, v1); EPI_ROWS_END } };
}

__device__ __forceinline__ void transpose_tile(float* tl, const float* W, int K, int N, bf16_t* dst, int rs, int ro, int tile, int ntn) {
    const int t = threadIdx.x, k0 = (tile / ntn) * 64, n0 = (tile % ntn) * 64;
    __syncthreads();
    { const int k = t >> 3, n8 = (t & 7) * 8;
#pragma unroll
      for (int i = 0; i < 8; ++i) { const int n = n0 + n8 + i; tl[k * 65 + n8 + i] = n < N ? W[(size_t)(k0 + k) * N + n] : 0.f; } }
    __syncthreads();
    { const int n = t >> 3, k8 = (t & 7) * 8; uint4 o;
      o.x = (unsigned)f2bf(tl[(k8 + 0) * 65 + n]) | ((unsigned)f2bf(tl[(k8 + 1) * 65 + n]) << 16); o.y = (unsigned)f2bf(tl[(k8 + 2) * 65 + n]) | ((unsigned)f2bf(tl[(k8 + 3) * 65 + n]) << 16);
      o.z = (unsigned)f2bf(tl[(k8 + 4) * 65 + n]) | ((unsigned)f2bf(tl[(k8 + 5) * 65 + n]) << 16); o.w = (unsigned)f2bf(tl[(k8 + 6) * 65 + n]) | ((unsigned)f2bf(tl[(k8 + 7) * 65 + n]) << 16);
      *(uint4*)(dst + (size_t)((n0 + n) * rs + ro) * K + k0 + k8) = o; }
}
__device__ __forceinline__ void transpose_mat(float* tl, const float* W, int K, int N, int Npad, bf16_t* dst, int rs, int ro, int& base) {
    const int ntn = Npad / 64, nt = (K / 64) * ntn, G = gridDim.x;
    const int first = (((int)blockIdx.x - base) % G + G) % G;
    for (int tile = first; tile < nt; tile += G) transpose_tile(tl, W, K, N, dst, rs, ro, tile, ntn);
    base = (base + nt) % G;
}


namespace fa {
typedef short bf16x8 __attribute__((ext_vector_type(8)));
typedef float f32x16 __attribute__((ext_vector_type(16)));
typedef unsigned u32x4 __attribute__((ext_vector_type(4)));
__device__ __forceinline__ int crow(int r, int hi) { return (r & 3) + 8 * (r >> 2) + 4 * hi; }
__device__ __forceinline__ unsigned cvtpk(float lo, float hi) { unsigned r; asm volatile("v_cvt_pk_bf16_f32 %0, %1, %2" : "=v"(r) : "v"(lo), "v"(hi)); return r; }
__device__ __forceinline__ float xhalf_max(float m) { auto rr = __builtin_amdgcn_permlane32_swap(__float_as_uint(m), __float_as_uint(m), false, false); return fmaxf(__uint_as_float(rr[0]), __uint_as_float(rr[1])); }
__device__ __forceinline__ float xhalf_sum(float m) { auto rr = __builtin_amdgcn_permlane32_swap(__float_as_uint(m), __float_as_uint(m), false, false); return __uint_as_float(rr[0]) + __uint_as_float(rr[1]); }
template <int DQK> struct Lds { static constexpr int KP = DQK * 2 + 16, VP = 144, KB = 64 * KP, VB = 64 * VP, K0 = 0, V0 = 2 * KB, WSF = V0 + 2 * VB, OST = WSF + 8 * 64 * 4, BYTES = OST + 8 * 4096; };
template <int DQK>
__device__ __forceinline__ void attn_unit(char* smem, const bf16_t* Q, int ldq, const bf16_t* K0, int nt0, const bf16_t* K1, int nt1, int ldk, const bf16_t* VT, bf16_t* O, int ldo) {
    typedef Lds<DQK> L; constexpr int KC = DQK / 8, NKC = 64 * KC, NKS = DQK / 16; constexpr float THR = 8.f;
    const int tid = threadIdx.x, lane = tid & 63, r32 = lane & 31, hi = lane >> 5; const int wid = __builtin_amdgcn_readfirstlane(tid >> 6);
    float* wsf = (float*)(smem + L::WSF) + wid * 64;
    bf16x8 qf[NKS];
#pragma unroll
    for (int ks = 0; ks < NKS; ++ks) qf[ks] = *(const bf16x8*)(Q + (size_t)(wid * 32 + r32) * ldq + ks * 16 + hi * 8);
    f32x16 o0, o1, negm;
#pragma unroll
    for (int r = 0; r < 16; ++r) { o0[r] = 0.f; o1[r] = 0.f; negm[r] = 0.f; }
    float mhat = 0.f, lsum = 0.f;
    const int NT = nt0 + nt1;
    const int kr0 = tid / KC, kc0 = tid % KC, kr1 = (tid + 512) / KC, kc1 = (tid + 512) % KC; const bool has1 = (tid + 512) < NKC;
    const int vdv = tid >> 3, vg = tid & 7;
    uint4 sk0, sk1 = make_uint4(0u, 0u, 0u, 0u), sv;
#define FA_GLOAD(t) do { const bf16_t* kt = ((t) < nt0) ? K0 + (size_t)(t) * 64 * ldk : K1 + (size_t)((t) - nt0) * 64 * ldk; \
        sk0 = *(const uint4*)(kt + (size_t)kr0 * ldk + kc0 * 8); if (has1) sk1 = *(const uint4*)(kt + (size_t)kr1 * ldk + kc1 * 8); \
        sv = *(const uint4*)(VT + (size_t)(t) * 4096 + tid * 8); } while (0)
#define FA_SWRITE(buf) do { *(uint4*)(smem + L::K0 + (buf) * L::KB + kr0 * L::KP + kc0 * 16) = sk0; if (has1) *(uint4*)(smem + L::K0 + (buf) * L::KB + kr1 * L::KP + kc1 * 16) = sk1; \
        *(uint4*)(smem + L::V0 + (buf) * L::VB + vdv * L::VP + vg * 16) = sv; } while (0)
    __syncthreads();
    FA_GLOAD(0); FA_SWRITE(0);
    __syncthreads();
    for (int t = 0; t < NT; ++t) {
        const int buf = t & 1;
        if (t + 1 < NT) FA_GLOAD(t + 1);
        const char* kb = smem + L::K0 + buf * L::KB + r32 * L::KP + hi * 16;
        f32x16 p0 = negm, p1 = negm;
#pragma unroll
        for (int ks = 0; ks < NKS; ++ks) {
            const bf16x8 a0 = *(const bf16x8*)(kb + ks * 32), a1 = *(const bf16x8*)(kb + 32 * L::KP + ks * 32);
            p0 = __builtin_amdgcn_mfma_f32_32x32x16_bf16(a0, qf[ks], p0, 0, 0, 0);
            p1 = __builtin_amdgcn_mfma_f32_32x32x16_bf16(a1, qf[ks], p1, 0, 0, 0);
        }
        float rm = fmaxf(p0[0], p1[0]);
#pragma unroll
        for (int r = 1; r < 16; ++r) rm = fmaxf(rm, fmaxf(p0[r], p1[r]));
        rm = xhalf_max(rm);
        const bool first = (t == 0);
        if (first || __any(rm > THR)) {
            const float dl = first ? rm : fmaxf(rm, 0.f);
            mhat += dl;
#pragma unroll
            for (int r = 0; r < 16; ++r) { p0[r] -= dl; p1[r] -= dl; negm[r] = -mhat; }
            if (!first) {
                const float f = __builtin_amdgcn_exp2f(-dl); lsum *= f;
                if (hi == 0) wsf[r32] = f;
                asm volatile("s_waitcnt lgkmcnt(0)" ::: "memory");
#pragma unroll
                for (int r = 0; r < 16; ++r) { const float fr = wsf[crow(r, hi)]; o0[r] *= fr; o1[r] *= fr; }
            }
        }
        float ps = 0.f;
#pragma unroll
        for (int r = 0; r < 16; ++r) { p0[r] = __builtin_amdgcn_exp2f(p0[r]); p1[r] = __builtin_amdgcn_exp2f(p1[r]); ps += p0[r] + p1[r]; }
        lsum += ps;
        u32x4 w0, w1, w2, w3;
        w0.x = cvtpk(p0[0], p0[1]); w0.y = cvtpk(p0[2], p0[3]); w0.z = cvtpk(p0[4], p0[5]); w0.w = cvtpk(p0[6], p0[7]);
        w1.x = cvtpk(p0[8], p0[9]); w1.y = cvtpk(p0[10], p0[11]); w1.z = cvtpk(p0[12], p0[13]); w1.w = cvtpk(p0[14], p0[15]);
        w2.x = cvtpk(p1[0], p1[1]); w2.y = cvtpk(p1[2], p1[3]); w2.z = cvtpk(p1[4], p1[5]); w2.w = cvtpk(p1[6], p1[7]);
        w3.x = cvtpk(p1[8], p1[9]); w3.y = cvtpk(p1[10], p1[11]); w3.z = cvtpk(p1[12], p1[13]); w3.w = cvtpk(p1[14], p1[15]);
        const char* vb = smem + L::V0 + buf * L::VB + r32 * L::VP + hi * 16;
#define FA_PV(W, s) do { const bf16x8 pa = __builtin_bit_cast(bf16x8, W); \
            const bf16x8 v0 = *(const bf16x8*)(vb + (s) * 32), v1 = *(const bf16x8*)(vb + 32 * L::VP + (s) * 32); \
            o0 = __builtin_amdgcn_mfma_f32_32x32x16_bf16(pa, v0, o0, 0, 0, 0); o1 = __builtin_amdgcn_mfma_f32_32x32x16_bf16(pa, v1, o1, 0, 0, 0); } while (0)
        FA_PV(w0, 0); FA_PV(w1, 1); FA_PV(w2, 2); FA_PV(w3, 3);
#undef FA_PV
        if (t + 1 < NT) FA_SWRITE(buf ^ 1);
        __syncthreads();
    }
#undef FA_GLOAD
#undef FA_SWRITE
    lsum = xhalf_sum(lsum);
    if (hi == 0) wsf[32 + r32] = lsum;
    asm volatile("s_waitcnt lgkmcnt(0)" ::: "memory");
    bf16_t* stg = (bf16_t*)(smem + L::OST) + wid * 2048;
#pragma unroll
    for (int r = 0; r < 16; ++r) { const int orow = crow(r, hi); const float rl = 1.f / wsf[32 + orow]; stg[orow * 64 + r32] = f2bf(o0[r] * rl); stg[orow * 64 + 32 + r32] = f2bf(o1[r] * rl); }
    asm volatile("s_waitcnt lgkmcnt(0)" ::: "memory");
#pragma unroll
    for (int i = 0; i < 4; ++i) { const int row = i * 8 + (lane >> 3), ch = lane & 7; const u32x4 v = *(const u32x4*)(stg + row * 64 + ch * 8); *(u32x4*)(O + (size_t)(wid * 32 + row) * ldo + ch * 8) = v; }
}
}

template <int KIND> __global__ void __launch_bounds__(512, 2) k_ph(Params p, int l) {
    extern __shared__ __attribute__((aligned(16))) char smem[];
    const int tid = threadIdx.x, lane = tid & 63, wid = tid >> 6;
    const int nblk = gridDim.x, bid = blockIdx.x;
    unsigned char* ws = p.ws;
    float* MOD = (float*)(ws + WS_MOD);
    bf16_t* U = (bf16_t*)(ws + WS_U);
    bf16_t* P = (bf16_t*)(ws + WS_P);
    bf16_t* QM = (bf16_t*)(ws + WS_QM);
    bf16_t* KM = (bf16_t*)(ws + WS_KM);
    bf16_t* VM = (bf16_t*)(ws + WS_VM);
    float* RKV = (float*)(ws + WS_RKV);
    bf16_t* XS = (bf16_t*)(ws + WS_XS);
    bf16_t* HDN = (bf16_t*)(ws + WS_HDN);
    int2* RTE = (int2*)(ws + WS_RT + RT_E);
    float2* RTW = (float2*)(ws + WS_RT + RT_W);
    float* RTR = (float*)(ws + WS_RT + RT_RSTD);
    int2* RTS = (int2*)(ws + WS_RT + RT_SLOT);
    int* CNT = (int*)(ws + WS_RT + RT_CNT);
    int* SEG = (int*)(ws + WS_RT + RT_SEG);
    int* TILE = (int*)(ws + WS_RT + RT_TILE);
    bf16_t* VT = (bf16_t*)(ws + WS_VT);
    bf16_t* WT = (bf16_t*)(ws + WS_WT);
    PG8_LAS unsigned char* lds3 = (PG8_LAS unsigned char*)smem;
    float* const Hlat = p.out; float* const Hctx = (float*)(ws + WS_HC);

    if constexpr (KIND == 0) {
        float* sc = (float*)smem;
        for (int i = tid; i < 5 * DM; i += 512) { const int v = i / DM, k = i % DM; const float x = v < 4 ? p.in[I_C][v * DM + k] : p.in[I_CCTX][k]; sc[i] = silu_f(x); }
        __syncthreads();
        for (int idx = bid * 512 + tid; idx < 2 * 6144; idx += nblk * 512) {
            const int l = idx / 6144, j = idx % 6144;
            const float* wm = p.in[I_WMOD] + (size_t)l * DM * 6144 + j;
            float a0 = 0.f, a1 = 0.f, a2 = 0.f, a3 = 0.f, a4 = 0.f;
            for (int k = 0; k < DM; ++k) { const float w = wm[(size_t)k * 6144]; a0 = fmaf(sc[k], w, a0); a1 = fmaf(sc[DM + k], w, a1); a2 = fmaf(sc[2 * DM + k], w, a2); a3 = fmaf(sc[3 * DM + k], w, a3); a4 = fmaf(sc[4 * DM + k], w, a4); }
            const float bm = p.in[I_BMOD][l * 6144 + j];
            float* mo = MOD + (size_t)l * 5 * 6144 + j;
            mo[0] = a0 + bm; mo[6144] = a1 + bm; mo[2 * 6144] = a2 + bm; mo[3 * 6144] = a3 + bm; mo[4 * 6144] = a4 + bm;
        }
        const float4* xs = (const float4*)p.in[I_X]; float4* xo = (float4*)p.out;
        for (size_t i = (size_t)bid * 512 + tid; i < (size_t)NLAT * DM / 4; i += (size_t)nblk * 512) xo[i] = xs[i];
        const float4* cs = (const float4*)p.in[I_CTX]; float4* co = (float4*)(ws + WS_HC);
        for (size_t i = (size_t)bid * 512 + tid; i < (size_t)NCTX * DM / 4; i += (size_t)nblk * 512) co[i] = cs[i];
        {
            float* tl = (float*)smem; int base = 0;
            for (int ll = 0; ll < 2; ++ll) {
                transpose_mat(tl, p.in[I_WIN] + (size_t)ll * DM * DPROJ, DM, DPROJ, 3328, WT + WT_IN + ll * WT_IN_L, 1, 0, base);
                transpose_mat(tl, p.in[I_WUQ] + (size_t)ll * 384 * 384, 384, 384, 512, WT + WT_UQ + ll * WT_UQ_L, 1, 0, base);
                transpose_mat(tl, p.in[I_WUKV] + (size_t)ll * 256 * 512, 256, 512, 512, WT + WT_UKV + ll * WT_UKV_L, 1, 0, base);
                transpose_mat(tl, p.in[I_WOUT] + (size_t)ll * DM * DM, DM, DM, DM, WT + WT_OUT + ll * WT_OUT_L, 1, 0, base);
                for (int e = 0; e < NE; ++e) {
                    transpose_mat(tl, p.in[I_W1] + ((size_t)ll * NE + e) * DM * FF, DM, FF, FF, WT + WT_13 + ll * WT_13_L + (size_t)e * 512 * 1024, 2, 0, base);
                    transpose_mat(tl, p.in[I_W3] + ((size_t)ll * NE + e) * DM * FF, DM, FF, FF, WT + WT_13 + ll * WT_13_L + (size_t)e * 512 * 1024, 2, 1, base);
                    transpose_mat(tl, p.in[I_W2] + ((size_t)ll * NE + e) * FF * DM, FF, DM, DM, WT + WT_2 + ll * WT_2_L + (size_t)e * 1024 * 256, 1, 0, base);
                }
            }
        }
    }

    {
        const bool last = (l == 1);
        const float* modl = MOD + (size_t)l * 5 * 6144;
        const int rows_mix = last ? NLAT : NROW;

        if constexpr (KIND == 1) {
            const float* g = p.in[I_N1G] + l * DM;
            for (int row = bid * 8 + wid; row < NROW; row += nblk * 8) {
                const float* h = hrow2(Hlat, Hctx, row); const float* mv = modl + row_modv(row) * 6144;
                float4 x[4]; float ss = 0.f;
#pragma unroll
                for (int i = 0; i < 4; ++i) { x[i] = *(const float4*)(h + lane * 4 + 256 * i); ss += x[i].x * x[i].x + x[i].y * x[i].y + x[i].z * x[i].z + x[i].w * x[i].w; }
                ss = wave_sum(ss);
                const float rstd = rsqrtf(ss * (1.f / DM) + 1e-6f);
#pragma unroll
                for (int i = 0; i < 4; ++i) {
                    const int c = lane * 4 + 256 * i;
                    const float4 gg = *(const float4*)(g + c), sh = *(const float4*)(mv + c), sc = *(const float4*)(mv + 1024 + c);
                    const float y0 = x[i].x * rstd * gg.x * (1.f + sc.x) + sh.x, y1 = x[i].y * rstd * gg.y * (1.f + sc.y) + sh.y;
                    const float y2 = x[i].z * rstd * gg.z * (1.f + sc.z) + sh.z, y3 = x[i].w * rstd * gg.w * (1.f + sc.w) + sh.w;
                    uint2 o; o.x = (unsigned)f2bf(y0) | ((unsigned)f2bf(y1) << 16); o.y = (unsigned)f2bf(y2) | ((unsigned)f2bf(y3) << 16);
                    *(uint2*)(U + (size_t)row * DM + c) = o;
                }
            }
        }
        if constexpr (KIND == 2) {
            pg8::Gemm g{U, WT + WT_IN + l * WT_IN_L, DM, DM, DM}; pg8::StaticOrder S; S.init(NROW, 3328, nblk, bid);
            pg8::EpiP E{P, LDP};
            pg8::gemm_phase<pg8::EpiP, pg8::StaticOrder, true, true>(lds3, g, S, E);
        }
        if constexpr (KIND == 3) {
            const float* qn = p.in[I_QN] + l * 384; const float* kvn = p.in[I_KVN] + l * 256;
            for (int row = bid * 8 + wid; row < NROW; row += nblk * 8) {
                bf16_t* pr = P + (size_t)row * LDP;
                const bool lat = row < NLAT; const int tt = row & (SEQ - 1);
                const float posr = (float)(tt >> 6), posc = (float)(tt & 63);
#pragma unroll
                for (int i = 0; i < 4; ++i) {
                    const int pi = lane + 64 * i, arr = pi >> 7, hd = (pi >> 5) & 3, pp = pi & 31, sec = pp >> 4, ii = pp & 15;
                    bf16_t* b = pr + (arr ? PC_RK : PC_RQ) + hd * 64 + sec * 32 + ii;
                    float x1 = bf2f(b[0]), x2 = bf2f(b[16]);
                    if (lat) rope_pair(x1, x2, sec ? posc : posr, ii, 16);
                    if (!arr) { x1 *= 0.125f; x2 *= 0.125f; }
                    b[0] = f2bf(x1); b[16] = f2bf(x2);
                }
                if (lat && lane < 16) {
                    const int sec = lane >> 3, ii = lane & 7;
                    bf16_t* b = pr + PC_KPE + sec * 16 + ii;
                    float x1 = bf2f(b[0]), x2 = bf2f(b[8]);
                    rope_pair(x1, x2, sec ? posc : posr, ii, 8);
                    b[0] = f2bf(x1); b[8] = f2bf(x2);
                }
                {
                    float v[6]; float ss = 0.f;
#pragma unroll
                    for (int i = 0; i < 6; ++i) { v[i] = bf2f(pr[PC_CQ + lane + 64 * i]); ss += v[i] * v[i]; }
                    ss = wave_sum(ss); const float rs = rsqrtf(ss * (1.f / 384.f) + 1e-6f);
#pragma unroll
                    for (int i = 0; i < 6; ++i) pr[PC_CQ + lane + 64 * i] = f2bf(v[i] * rs * qn[lane + 64 * i]);
                    float w[4]; float s2 = 0.f;
#pragma unroll
                    for (int i = 0; i < 4; ++i) { w[i] = bf2f(pr[PC_CKV + lane + 64 * i]); s2 += w[i] * w[i]; }
                    s2 = wave_sum(s2); const float rs2 = rsqrtf(s2 * (1.f / 256.f) + 1e-6f);
#pragma unroll
                    for (int i = 0; i < 4; ++i) pr[PC_CKV + lane + 64 * i] = f2bf(w[i] * rs2 * kvn[lane + 64 * i]);
                }
            }
        }
        if constexpr (KIND == 14) {
            pg8::Gemm g{P + PC_CKV, WT + WT_UKV + l * WT_UKV_L, LDP, 256, 256}; pg8::StaticOrder S; S.init(NROW, 512, nblk, bid);
            pg8::EpiUKV E{KM, VM};
            pg8::gemm_phase<pg8::EpiUKV, pg8::StaticOrder, true, true>(lds3, g, S, E);
        }
        if constexpr (KIND == 4) {
            {
                pg8::Gemm g{P + PC_CQ, WT + WT_UQ + l * WT_UQ_L, LDP, 384, 384}; pg8::StaticOrder S; S.init(NROW, 512, nblk, bid);
                pg8::EpiUQ E{QM};
                pg8::gemm_phase<pg8::EpiUQ, pg8::StaticOrder, true, true>(lds3, g, S, E);
            }
            __syncthreads();
            float* Ks = (float*)smem; float* Vs = Ks + 128 * 64; float* pwf = Vs + 128 * 64; float* pwb = pwf + 132;
            for (int it = bid; it < RET_ITEMS; it += nblk) {
                int b, hd, j, row0;
                if (it < 1024) { b = it >> 8; hd = (it >> 6) & 3; j = it & 63; row0 = b * SEQ + j * 128; } else { const int q = it - 1024; b = q >> 3; hd = (q >> 1) & 3; j = q & 1; row0 = NLAT + b * CTXL + j * 128; }
                const float lgf = log_sigmoid_f(p.in[I_RDF][l * 4 + hd]), lgb = log_sigmoid_f(p.in[I_RDB][l * 4 + hd]);
                __syncthreads();
                for (int idx = tid; idx < 128 * 64; idx += 512) { const int r = idx >> 6, c = idx & 63; const bf16_t* pr = P + (size_t)(row0 + r) * LDP + hd * 64 + c; Ks[idx] = bf2f(pr[PC_RK]); Vs[idx] = bf2f(pr[PC_RV]); }
                if (tid < 129) { pwf[tid] = expf(lgf * (float)tid); pwb[tid] = expf(lgb * (float)tid); }
                __syncthreads();
                const int d = tid >> 3, e0 = (tid & 7) * 8;
                float af[8], ab[8];
#pragma unroll
                for (int e = 0; e < 8; ++e) { af[e] = 0.f; ab[e] = 0.f; }
                for (int i = 0; i < 128; ++i) {
                    const float kd = Ks[i * 64 + d], wf = pwf[127 - i] * kd, wb = pwb[i] * kd;
#pragma unroll
                    for (int e = 0; e < 8; ++e) { const float v = Vs[i * 64 + e0 + e]; af[e] = fmaf(wf, v, af[e]); ab[e] = fmaf(wb, v, ab[e]); }
                }
                float* of = RKV + ((size_t)it * 2 + 0) * 4096 + d * 64 + e0; float* ob = RKV + ((size_t)it * 2 + 1) * 4096 + d * 64 + e0;
#pragma unroll
                for (int e = 0; e < 8; ++e) { of[e] = af[e]; ob[e] = ab[e]; }
            }
        }
        if constexpr (KIND == 5) {
            for (int row = bid * 8 + wid; row < NROW; row += nblk * 8) {
                const bool lat = row < NLAT; const int tt = row & (SEQ - 1);
                const float posr = (float)(tt >> 6), posc = (float)(tt & 63);
                const float scq = 0.10206207261596577f * 1.4426950408889634f;
                {
                    const int hd = lane >> 4, pp = lane & 15, sec = pp >> 3, ii = pp & 7;
                    bf16_t* b = QM + (size_t)row * 384 + hd * 96 + 64 + sec * 16 + ii;
                    float x1 = bf2f(b[0]), x2 = bf2f(b[8]);
                    if (lat) rope_pair(x1, x2, sec ? posc : posr, ii, 8);
                    b[0] = f2bf(x1 * scq); b[8] = f2bf(x2 * scq);
                }
#pragma unroll
                for (int i = 0; i < 4; ++i) { const int q = lane + 64 * i, hd = q >> 6, c = q & 63; bf16_t* b = QM + (size_t)row * 384 + hd * 96 + c; *b = f2bf(bf2f(*b) * scq); }
#pragma unroll
                for (int i = 0; i < 2; ++i) { const int q = lane + 64 * i, hd = q >> 5, c = q & 31; KM[(size_t)row * 384 + hd * 96 + 64 + c] = P[(size_t)row * LDP + PC_KPE + c]; }
            }
            {
                bf16_t* tl = (bf16_t*)smem;
                for (int it = bid; it < 16 * 132; it += nblk) {
                    const int bh = it / 132, tile = it % 132, b = bh >> 2, hd = bh & 3;
                    const size_t row0 = tile < 128 ? (size_t)b * SEQ + tile * 64 : (size_t)NLAT + b * CTXL + (tile - 128) * 64;
                    __syncthreads();
                    { const int r = tid >> 3, d8 = (tid & 7) * 8; const uint4 v = *(const uint4*)(VM + (row0 + r) * 256 + hd * 64 + d8);
                      unsigned* d = (unsigned*)(tl + r * 66 + d8); d[0] = v.x; d[1] = v.y; d[2] = v.z; d[3] = v.w; }
                    __syncthreads();
                    { const int dv = tid >> 3, g = tid & 7, s4 = g >> 1, hh = g & 1; unsigned short e[8];
#pragma unroll
                      for (int j = 0; j < 8; ++j) e[j] = tl[(16 * s4 + 8 * (j >> 2) + 4 * hh + (j & 3)) * 66 + dv];
                      uint4 o; o.x = e[0] | ((unsigned)e[1] << 16); o.y = e[2] | ((unsigned)e[3] << 16); o.z = e[4] | ((unsigned)e[5] << 16); o.w = e[6] | ((unsigned)e[7] << 16);
                      *(uint4*)(VT + ((size_t)it * 64 + dv) * 64 + g * 8) = o; }
                }
                __syncthreads();
            }
            for (int gid = bid * 512 + tid; gid < 2 * 16 * 4096; gid += nblk * 512) {
                const int el = gid & 4095, bh = (gid >> 12) & 15, dir = gid >> 16, hd = bh & 3;
                const float lg = log_sigmoid_f(dir ? p.in[I_RDB][l * 4 + hd] : p.in[I_RDF][l * 4 + hd]);
                const float g128 = expf(128.f * lg);
                float* c0p = RKV + ((size_t)(1024 + bh * 2 + 0) * 2 + dir) * 4096 + el;
                float* c1p = RKV + ((size_t)(1024 + bh * 2 + 1) * 2 + dir) * 4096 + el;
                const float c0 = *c0p, c1 = *c1p; float S;
                if (dir == 0) { *c0p = 0.f; *c1p = c0; S = g128 * c0 + c1; } else { *c1p = 0.f; *c0p = c1; S = g128 * c1 + c0; }
                for (int jj = 0; jj < 64; ++jj) {
                    const int j = dir ? 63 - jj : jj;
                    float* q = RKV + ((size_t)(bh * 64 + j) * 2 + dir) * 4096 + el;
                    const float tmp = *q; *q = S; S = fmaf(g128, S, tmp);
                }
            }
        }
        if constexpr (KIND == 6) {
            bf16_t* MIX = U;
            for (int it = bid; it < 512; it += nblk) {
                const int bh = it >> 5, qb = it & 31, b = bh >> 2, hd = bh & 3; const size_t r0 = (size_t)b * SEQ + qb * 256, kr0 = (size_t)b * SEQ, cr0 = (size_t)NLAT + b * CTXL;
                fa::attn_unit<96>(smem, QM + r0 * 384 + hd * 96, 384, KM + kr0 * 384 + hd * 96, 128, KM + cr0 * 384 + hd * 96, 4, 384, VT + (size_t)bh * 132 * 4096, MIX + r0 * DM + 768 + hd * 64, DM);
            }
            __syncthreads();
            if (!last) {
                for (int it = bid; it < 16; it += nblk) {
                    const int b = it >> 2, hd = it & 3; const size_t cr0 = (size_t)NLAT + b * CTXL;
                    attn_simple<96, 64>(smem, QM + cr0 * 384 + hd * 96, 384, 256, KM + cr0 * 384 + hd * 96, VM + cr0 * 256 + hd * 64, CTXL, nullptr, nullptr, 0,
                                        384, 256, 1.0f, MIX + cr0 * DM + 768 + hd * 64, DM);
                }
            }
            if (!last) {
                const float sc_na = 0.125f * 1.4426950408889634f;
                for (int it = bid; it < 32; it += nblk) {
                    const int b = it >> 3, hd = it & 7; const size_t cr0 = (size_t)NLAT + b * CTXL;
                    attn_simple<64, 64>(smem, P + cr0 * LDP + PC_NQ + hd * 64, LDP, 256, P + cr0 * LDP + PC_NK + hd * 64, P + cr0 * LDP + PC_NV + hd * 64, CTXL, nullptr, nullptr, 0,
                                        LDP, LDP, sc_na, MIX + cr0 * DM + 256 + hd * 64, DM);
                }
            }
            {
                float* Ks = (float*)smem; float* Vs = Ks + 128 * 64; float* Sf = Vs + 128 * 64; float* Sb = Sf + 4096; float* pwf = Sb + 4096; float* pwb = pwf + 132; float* Qs = pwb + 132;
                const int n_it = last ? 1024 : RET_ITEMS;
                for (int it = bid; it < n_it; it += nblk) {
                    int b, hd, j, row0;
                    if (it < 1024) { b = it >> 8; hd = (it >> 6) & 3; j = it & 63; row0 = b * SEQ + j * 128; } else { const int q = it - 1024; b = q >> 3; hd = (q >> 1) & 3; j = q & 1; row0 = NLAT + b * CTXL + j * 128; }
                    const float lgf = log_sigmoid_f(p.in[I_RDF][l * 4 + hd]), lgb = log_sigmoid_f(p.in[I_RDB][l * 4 + hd]);
                    __syncthreads();
                    for (int idx = tid; idx < 128 * 64; idx += 512) { const int r = idx >> 6, c = idx & 63; const bf16_t* pr = P + (size_t)(row0 + r) * LDP + hd * 64 + c; Ks[idx] = bf2f(pr[PC_RK]); Vs[idx] = bf2f(pr[PC_RV]); Qs[r * 68 + c] = bf2f(pr[PC_RQ]); }
                    for (int idx = tid; idx < 4096; idx += 512) { Sf[idx] = RKV[((size_t)it * 2 + 0) * 4096 + idx]; Sb[idx] = RKV[((size_t)it * 2 + 1) * 4096 + idx]; }
                    if (tid < 129) { pwf[tid] = expf(lgf * (float)tid); pwb[tid] = expf(lgb * (float)tid); }
                    __syncthreads();
                    const int i = tid >> 2, part = tid & 3, row = row0 + i;
                    const float* qp = Qs + i * 68;
                    float acc[16];
#pragma unroll
                    for (int e = 0; e < 16; ++e) acc[e] = 0.f;
#pragma unroll 1
                    for (int m = 0; m < 128; ++m) {
                        float s = 0.f;
#pragma unroll 4
                        for (int d = 0; d < 64; d += 4) { const float4 kv = *(const float4*)&Ks[m * 64 + d]; const float4 qv = *(const float4*)&qp[d]; s = fmaf(qv.x, kv.x, s); s = fmaf(qv.y, kv.y, s); s = fmaf(qv.z, kv.z, s); s = fmaf(qv.w, kv.w, s); }
                        const float w = (m <= i) ? pwf[i - m] : pwb[m - i];
                        s *= w;
#pragma unroll
                        for (int e = 0; e < 16; e += 4) { const float4 vv = *(const float4*)&Vs[m * 64 + part * 16 + e]; acc[e] = fmaf(s, vv.x, acc[e]); acc[e + 1] = fmaf(s, vv.y, acc[e + 1]); acc[e + 2] = fmaf(s, vv.z, acc[e + 2]); acc[e + 3] = fmaf(s, vv.w, acc[e + 3]); }
                    }
                    const float cf = pwf[i + 1], cb = pwb[128 - i];
#pragma unroll 1
                    for (int d = 0; d < 64; ++d) {
                        const float qd = qp[d], qf = qd * cf, qb = qd * cb;
#pragma unroll
                        for (int e = 0; e < 16; e += 4) {
                            const float4 sf = *(const float4*)&Sf[d * 64 + part * 16 + e], sb = *(const float4*)&Sb[d * 64 + part * 16 + e];
                            acc[e] = fmaf(qf, sf.x, fmaf(qb, sb.x, acc[e])); acc[e + 1] = fmaf(qf, sf.y, fmaf(qb, sb.y, acc[e + 1]));
                            acc[e + 2] = fmaf(qf, sf.z, fmaf(qb, sb.z, acc[e + 2])); acc[e + 3] = fmaf(qf, sf.w, fmaf(qb, sb.w, acc[e + 3]));
                        }
                    }
                    float sm = 0.f;
#pragma unroll
                    for (int e = 0; e < 16; ++e) sm += acc[e];
                    sm += __shfl_xor(sm, 1); sm += __shfl_xor(sm, 2);
                    const float mu = sm * (1.f / 64.f);
                    float vr = 0.f;
#pragma unroll
                    for (int e = 0; e < 16; ++e) { const float dd = acc[e] - mu; vr += dd * dd; }
                    vr += __shfl_xor(vr, 1); vr += __shfl_xor(vr, 2);
                    const float rs = rsqrtf(vr * (1.f / 64.f) + 1e-6f);
#pragma unroll
                    for (int e = 0; e < 16; ++e) {
                        const float gg = bf2f(P[(size_t)row * LDP + PC_RG + hd * 64 + part * 16 + e]);
                        MIX[(size_t)row * DM + hd * 64 + part * 16 + e] = f2bf((acc[e] - mu) * rs * silu_f(gg));
                    }
                }
            }
            {
                __syncthreads();
                int* rk = (int*)smem; float* pw = (float*)(smem + 2048);
                const float* rpb = p.in[I_RPB] + (size_t)l * 8 * 15 * 31;
                for (int tok = bid; tok < NLAT; tok += nblk) {
                    const int b = tok >> 13, tt = tok & (SEQ - 1), r = tt >> 6, c = tt & 63;
                    int r0 = r - 4; r0 = r0 < 0 ? 0 : (r0 > 120 ? 120 : r0);
                    int c0 = c - 8; c0 = c0 < 0 ? 0 : (c0 > 48 ? 48 : c0);
                    __syncthreads();
                    if (tid < 128) rk[tid] = b * SEQ + (r0 + (tid >> 4)) * 64 + c0 + (tid & 15);
                    else if (tid < 384) rk[tid] = NLAT + b * CTXL + (tid - 128);
                    __syncthreads();
                    const int hd = wid;
                    float q[64];
#pragma unroll
                    for (int d = 0; d < 64; ++d) q[d] = bf2f(P[(size_t)tok * LDP + PC_NQ + hd * 64 + d]) * 0.125f;
                    float sv[6]; float mx = -INFINITY;
#pragma unroll
                    for (int i = 0; i < 6; ++i) {
                        const int j = lane + 64 * i; const bf16_t* kp = P + (size_t)rk[j] * LDP + PC_NK + hd * 64;
                        float s = 0.f;
#pragma unroll
                        for (int d = 0; d < 64; d += 2) { const unsigned kk = *(const unsigned*)(kp + d); s = fmaf(q[d], __uint_as_float(kk << 16), s); s = fmaf(q[d + 1], __uint_as_float(kk & 0xffff0000u), s); }
                        if (j < 128) { const int kr = r0 + (j >> 4), kc = c0 + (j & 15); s += rpb[hd * 465 + (kr - r + 7) * 31 + (kc - c + 15)]; }
                        sv[i] = s; mx = fmaxf(mx, s);
                    }
                    mx = wave_max(mx);
                    float sum = 0.f;
#pragma unroll
                    for (int i = 0; i < 6; ++i) { sv[i] = expf(sv[i] - mx); sum += sv[i]; }
                    sum = wave_sum(sum);
                    const float inv = 1.f / sum;
#pragma unroll
                    for (int i = 0; i < 6; ++i) pw[hd * 384 + lane + 64 * i] = sv[i] * inv;
                    __syncthreads();
                    float o = 0.f;
                    for (int j = 0; j < 384; ++j) o = fmaf(pw[hd * 384 + j], bf2f(P[(size_t)rk[j] * LDP + PC_NV + hd * 64 + lane]), o);
                    MIX[(size_t)tok * DM + 256 + hd * 64 + lane] = f2bf(o);
                }
                __syncthreads();
            }
        }
        if constexpr (KIND == 7) {
            pg8::Gemm g{U, WT + WT_OUT + l * WT_OUT_L, DM, DM, DM}; pg8::StaticOrder S; S.init(rows_mix, DM, nblk, bid);
            pg8::EpiOut E{Hlat, Hctx, modl + 2048};
            pg8::gemm_phase<pg8::EpiOut, pg8::StaticOrder, true, true>(lds3, g, S, E);
        }
        if constexpr (KIND == 8) {
            const float* g = p.in[I_N2G] + l * DM; const float* rw = p.in[I_RW]; const float* rb = p.in[I_RB];
            int* hist = (int*)smem;
            const int nch = rows_mix / NCHUNK_TOK;
            for (int ch = bid; ch < nch; ch += nblk) {
                __syncthreads();
                if (tid < 16) hist[tid] = 0;
                __syncthreads();
                for (int i = wid; i < NCHUNK_TOK; i += 8) {
                    const int row = ch * NCHUNK_TOK + i;
                    const float* h = hrow2(Hlat, Hctx, row); const float* mv = modl + row_modv(row) * 6144;
                    float4 x[4]; float ss = 0.f;
#pragma unroll
                    for (int k = 0; k < 4; ++k) { x[k] = *(const float4*)(h + lane * 4 + 256 * k); ss += x[k].x * x[k].x + x[k].y * x[k].y + x[k].z * x[k].z + x[k].w * x[k].w; }
                    ss = wave_sum(ss);
                    const float rstd = rsqrtf(ss * (1.f / DM) + 1e-6f);
                    float lg[16];
#pragma unroll
                    for (int e = 0; e < 16; ++e) lg[e] = 0.f;
#pragma unroll
                    for (int k = 0; k < 4; ++k) {
                        const int c = lane * 4 + 256 * k;
                        const float4 gg = *(const float4*)(g + c), sh = *(const float4*)(mv + 3072 + c), sc = *(const float4*)(mv + 4096 + c);
                        const float u0 = x[k].x * rstd * gg.x * (1.f + sc.x) + sh.x, u1 = x[k].y * rstd * gg.y * (1.f + sc.y) + sh.y;
                        const float u2 = x[k].z * rstd * gg.z * (1.f + sc.z) + sh.z, u3 = x[k].w * rstd * gg.w * (1.f + sc.w) + sh.w;
#pragma unroll
                        for (int e4 = 0; e4 < 4; ++e4) {
                            const float4 w0 = *(const float4*)(rw + (size_t)(c + 0) * 16 + e4 * 4), w1 = *(const float4*)(rw + (size_t)(c + 1) * 16 + e4 * 4);
                            const float4 w2 = *(const float4*)(rw + (size_t)(c + 2) * 16 + e4 * 4), w3 = *(const float4*)(rw + (size_t)(c + 3) * 16 + e4 * 4);
                            lg[e4 * 4 + 0] += u0 * w0.x + u1 * w1.x + u2 * w2.x + u3 * w3.x;
                            lg[e4 * 4 + 1] += u0 * w0.y + u1 * w1.y + u2 * w2.y + u3 * w3.y;
                            lg[e4 * 4 + 2] += u0 * w0.z + u1 * w1.z + u2 * w2.z + u3 * w3.z;
                            lg[e4 * 4 + 3] += u0 * w0.w + u1 * w1.w + u2 * w2.w + u3 * w3.w;
                        }
                    }
#pragma unroll
                    for (int e = 0; e < 16; ++e) lg[e] = wave_sum(lg[e]);
                    float scv[16], sel[16];
#pragma unroll
                    for (int e = 0; e < 16; ++e) { scv[e] = 1.f / (1.f + expf(-lg[e])); sel[e] = scv[e] + rb[e]; }
                    int best = 0; float bestv = -INFINITY;
#pragma unroll
                    for (int gI = 0; gI < 4; ++gI) {
                        float m1 = -INFINITY, m2 = -INFINITY;
#pragma unroll
                        for (int k = 0; k < 4; ++k) { const float v = sel[gI * 4 + k]; if (v > m1) { m2 = m1; m1 = v; } else if (v > m2) m2 = v; }
                        const float gs = m1 + m2; if (gs > bestv) { bestv = gs; best = gI; }
                    }
                    int ia = -1, ib = -1; float va = -INFINITY, vb = -INFINITY, wa = 0.f, wb = 0.f;
#pragma unroll
                    for (int e = 0; e < 16; ++e) {
                        if ((e >> 2) == best) { const float v = sel[e]; if (v > va) { vb = va; ib = ia; wb = wa; va = v; ia = e; wa = scv[e]; } else if (v > vb) { vb = v; ib = e; wb = scv[e]; } }
                    }
                    if (lane == 0) {
                        const float inv = 1.f / (wa + wb);
                        RTE[row] = make_int2(ia, ib); RTW[row] = make_float2(wa * inv, wb * inv); RTR[row] = rstd;
                        atomicAdd(&hist[ia], 1); atomicAdd(&hist[ib], 1);
                    }
                }
                __syncthreads();
                if (tid < 16) CNT[ch * 16 + tid] = hist[tid];
            }
        }
        if constexpr (KIND == 9) {
            const float* g = p.in[I_N2G] + l * DM;
            int* tots = (int*)smem; int* befo = tots + 16; int* offs = befo + 16; int* sla = offs + 32; int* slb = sla + 128; int* ea = slb + 128; int* eb = ea + 128;
            const int nch = rows_mix / NCHUNK_TOK;
            for (int ch = bid; ch < nch; ch += nblk) {
                __syncthreads();
                if (tid < 16) { int tot = 0, bef = 0; for (int c2 = 0; c2 < nch; ++c2) { const int v = CNT[c2 * 16 + tid]; if (c2 < ch) bef += v; tot += v; } tots[tid] = tot; befo[tid] = bef; }
                if (tid >= 64 && tid < 64 + 128) { const int2 e2 = RTE[ch * NCHUNK_TOK + tid - 64]; ea[tid - 64] = e2.x; eb[tid - 64] = e2.y; }
                __syncthreads();
                if (tid == 0) { int o = 0; for (int e = 0; e < 16; ++e) { offs[e] = o; o += (tots[e] + 255) & ~255; } offs[16] = o; }
                __syncthreads();
                if (tid < 16) { int pos = offs[tid] + befo[tid]; for (int i = 0; i < 128; ++i) { if (ea[i] == tid) sla[i] = pos++; else if (eb[i] == tid) slb[i] = pos++; } }
                if (ch == 0 && tid >= 64 && tid < 64 + 33) { const int q = tid - 64; SEG[q] = q < 17 ? offs[q] : tots[q - 17]; }
                if (ch == 0 && tid == 128) { int rt = 0; for (int e = 0; e < 16; ++e) { const int nte = (tots[e] + 255) >> 8; for (int k = 0; k < nte; ++k) { TILE[16 + 2 * rt] = e; TILE[17 + 2 * rt] = (offs[e] >> 8) + k; ++rt; } } TILE[0] = rt; }
                __syncthreads();
                for (int i = wid; i < NCHUNK_TOK; i += 8) {
                    const int row = ch * NCHUNK_TOK + i;
                    const float* h = hrow2(Hlat, Hctx, row); const float* mv = modl + row_modv(row) * 6144;
                    const float rstd = RTR[row]; const int sa = sla[i], sb = slb[i];
#pragma unroll
                    for (int k = 0; k < 4; ++k) {
                        const int c = lane * 4 + 256 * k;
                        const float4 x = *(const float4*)(h + c), gg = *(const float4*)(g + c), sh = *(const float4*)(mv + 3072 + c), sc = *(const float4*)(mv + 4096 + c);
                        const float u0 = x.x * rstd * gg.x * (1.f + sc.x) + sh.x, u1 = x.y * rstd * gg.y * (1.f + sc.y) + sh.y;
                        const float u2 = x.z * rstd * gg.z * (1.f + sc.z) + sh.z, u3 = x.w * rstd * gg.w * (1.f + sc.w) + sh.w;
                        uint2 o; o.x = (unsigned)f2bf(u0) | ((unsigned)f2bf(u1) << 16); o.y = (unsigned)f2bf(u2) | ((unsigned)f2bf(u3) << 16);
                        *(uint2*)(XS + (size_t)sa * DM + c) = o; *(uint2*)(XS + (size_t)sb * DM + c) = o;
                    }
                    if (lane == 0) RTS[row] = make_int2(sa, sb);
                }
            }
        }
        if constexpr (KIND == 10) {
            PG8_LAS int* ul = (PG8_LAS int*)(lds3 + 131072); const int nu = pg8::grouped_units(ul, TILE, 2, nblk, bid);
            pg8::Gemm g{XS, WT + WT_13 + l * WT_13_L, DM, DM, DM}; pg8::GroupedOrder S{ul, nu};
            pg8::EpiMoe1 E{HDN};
            pg8::gemm_phase<pg8::EpiMoe1, pg8::GroupedOrder, true, true>(lds3, g, S, E);
        }
        if constexpr (KIND == 11) {
            PG8_LAS int* ul = (PG8_LAS int*)(lds3 + 131072); const int nu = pg8::grouped_units(ul, TILE, 4, nblk, bid);
            pg8::Gemm g{HDN, WT + WT_2 + l * WT_2_L, FF, FF, FF}; pg8::GroupedOrder S{ul, nu};
            pg8::EpiMoe2 E{XS};
            pg8::gemm_phase<pg8::EpiMoe2, pg8::GroupedOrder, true, true>(lds3, g, S, E);
        }
        if constexpr (KIND == 12) {
            for (int row = bid * 8 + wid; row < rows_mix; row += nblk * 8) {
                float* h = hrow2(Hlat, Hctx, row); const float* mv = modl + row_modv(row) * 6144 + 5120;
                const int2 s2 = RTS[row]; const float2 w2 = RTW[row];
#pragma unroll
                for (int k = 0; k < 4; ++k) {
                    const int c = lane * 4 + 256 * k;
                    const uint2 ya = *(const uint2*)(XS + (size_t)s2.x * DM + c), yb = *(const uint2*)(XS + (size_t)s2.y * DM + c);
                    float4 x = *(float4*)(h + c); const float4 gg = *(const float4*)(mv + c);
                    x.x += gg.x * (w2.x * __uint_as_float(ya.x << 16) + w2.y * __uint_as_float(yb.x << 16));
                    x.y += gg.y * (w2.x * __uint_as_float(ya.x & 0xffff0000u) + w2.y * __uint_as_float(yb.x & 0xffff0000u));
                    x.z += gg.z * (w2.x * __uint_as_float(ya.y << 16) + w2.y * __uint_as_float(yb.y << 16));
                    x.w += gg.w * (w2.x * __uint_as_float(ya.y & 0xffff0000u) + w2.y * __uint_as_float(yb.y & 0xffff0000u));
                    *(float4*)(h + c) = x;
                }
            }
        }
    }
    if constexpr (KIND == 13) {
        const float* g = p.in[I_FNG];
        for (int row = bid * 8 + wid; row < NLAT; row += nblk * 8) {
            float* h = p.out + (size_t)row * DM;
            float4 x[4]; float ss = 0.f;
#pragma unroll
            for (int i = 0; i < 4; ++i) { x[i] = *(const float4*)(h + lane * 4 + 256 * i); ss += x[i].x * x[i].x + x[i].y * x[i].y + x[i].z * x[i].z + x[i].w * x[i].w; }
            ss = wave_sum(ss);
            const float rstd = rsqrtf(ss * (1.f / DM) + 1e-6f);
#pragma unroll
            for (int i = 0; i < 4; ++i) { const int c = lane * 4 + 256 * i; const float4 gg = *(const float4*)(g + c); float4 y; y.x = x[i].x * rstd * gg.x; y.y = x[i].y * rstd * gg.y; y.z = x[i].z * rstd * gg.z; y.w = x[i].w * rstd * gg.w; *(float4*)(h + c) = y; }
        }
    }
}

constexpr int LDS_BYTES = 132 * 1024;
template <int KIND> static void launch_ph(const Params& p, int l, int grid, hipStream_t stream) {
    static bool attr_done = false;
    if (!attr_done) { (void)hipFuncSetAttribute((const void*)k_ph<KIND>, hipFuncAttributeMaxDynamicSharedMemorySize, LDS_BYTES); attr_done = true; }
    hipLaunchKernelGGL(k_ph<KIND>, dim3(grid), dim3(512), LDS_BYTES, stream, p, l);
}

extern "C" void kernel_launch(void* const* d_in, const int* in_sizes, int n_in, void* d_out, int out_size, void* d_ws, size_t ws_size, hipStream_t stream) {
    (void)in_sizes; (void)n_in; (void)out_size; (void)ws_size;
    static int grid = 0;
    if (!grid) {
        int dev = 0, cus = 0; (void)hipGetDevice(&dev); (void)hipDeviceGetAttribute(&cus, hipDeviceAttributeMultiprocessorCount, dev);
        grid = cus > 0 ? cus : 256;
    }
    Params p{};
    for (int i = 0; i < 23; ++i) p.in[i] = (const float*)d_in[i];
    p.out = (float*)d_out; p.ws = (unsigned char*)d_ws;
    launch_ph<0>(p, 0, grid, stream);
    for (int l = 0; l < 2; ++l) {
        launch_ph<1>(p, l, grid, stream); launch_ph<2>(p, l, grid, stream); launch_ph<3>(p, l, grid, stream); launch_ph<4>(p, l, grid, stream); launch_ph<14>(p, l, grid, stream);
        launch_ph<5>(p, l, grid, stream); launch_ph<6>(p, l, grid, stream); launch_ph<7>(p, l, grid, stream); launch_ph<8>(p, l, grid, stream);
        launch_ph<9>(p, l, grid, stream); launch_ph<10>(p, l, grid, stream); launch_ph<11>(p, l, grid, stream); launch_ph<12>(p, l, grid, stream);
    }
    launch_ph<13>(p, 0, grid, stream);
}
```

```cpp
#include <hip/hip_runtime.h>
#include <stdint.h>
#include <math.h>

typedef unsigned short bf16_t;
#define LAS __attribute__((address_space(3)))

constexpr int DM = 1024, NB = 4, SEQ = 8192, GW = 64, CTXL = 256;
constexpr int NLAT = NB * SEQ;
constexpr int NCTX = NB * CTXL;
constexpr int NROW = NLAT + NCTX;
constexpr int DPROJ = 3232, LDP = 3328;
constexpr int PC_RQ = 0, PC_RK = 256, PC_RV = 512, PC_RG = 768, PC_NQ = 1024, PC_NK = 1536, PC_NV = 2048, PC_CQ = 2560, PC_CKV = 2944, PC_KPE = 3200;
constexpr int NE = 16, FF = 256;
constexpr int MAXSLOT = 2 * NROW + NE * 256;
constexpr int NCHUNK_TOK = 128;
constexpr int RET_ITEMS = 16 * 64 + 16 * 2;

constexpr size_t MiB = 1u << 20;
constexpr size_t WS_CTL = 0;
constexpr size_t WS_MOD = 1 * MiB;
constexpr size_t WS_HC = 2 * MiB;
constexpr size_t WS_RT = 6 * MiB;
constexpr size_t WS_U = 8 * MiB;
constexpr size_t WS_QM = 74 * MiB;
constexpr size_t WS_KM = 99 * MiB;
constexpr size_t WS_VM = 124 * MiB;
constexpr size_t WS_RKV = 141 * MiB;
constexpr size_t WS_P = 174 * MiB;
constexpr size_t WS_XS = WS_P;
constexpr size_t WS_HDN = WS_P + 140 * MiB;
constexpr size_t WS_WT = 389 * MiB;
constexpr size_t WT_IN = 0, WT_IN_L = (size_t)3328 * 1024;
constexpr size_t WT_UQ = WT_IN + 2 * WT_IN_L, WT_UQ_L = (size_t)512 * 384;
constexpr size_t WT_UKV = WT_UQ + 2 * WT_UQ_L, WT_UKV_L = (size_t)512 * 256;
constexpr size_t WT_OUT = WT_UKV + 2 * WT_UKV_L, WT_OUT_L = (size_t)1024 * 1024;
constexpr size_t WT_13 = WT_OUT + 2 * WT_OUT_L, WT_13_L = (size_t)16 * 512 * 1024;
constexpr size_t WT_2 = WT_13 + 2 * WT_13_L, WT_2_L = (size_t)16 * 1024 * 256;
constexpr size_t WT_END = WT_2 + 2 * WT_2_L;
static_assert(WS_WT + WT_END * 2 <= 512 * MiB, "workspace");
constexpr size_t WS_VT = 456 * MiB;
constexpr size_t WS_NVT = 473 * MiB;
static_assert(WS_NVT + (size_t)32 * 132 * 4096 * 2 <= 512 * MiB, "workspace");
constexpr size_t RT_TILE = 1984 * 1024;
constexpr size_t RT_E = 0, RT_W = 512 * 1024, RT_RSTD = 1024 * 1024, RT_SLOT = 1280 * 1024, RT_CNT = 1792 * 1024, RT_SEG = 1920 * 1024;

struct Params { const float* in[23]; float* out; unsigned char* ws; int lo, hi; };
enum { I_X = 0, I_C, I_CTX, I_CCTX, I_WMOD, I_BMOD, I_N1G, I_N2G, I_WIN, I_RDF, I_RDB, I_RPB, I_QN, I_KVN, I_WUQ, I_WUKV, I_WOUT, I_RW, I_RB, I_W1, I_W3, I_W2, I_FNG };

__device__ __forceinline__ float bf2f(bf16_t v) { return __uint_as_float(((unsigned)v) << 16); }
__device__ __forceinline__ bf16_t f2bf(float f) { unsigned u = __float_as_uint(f); return (bf16_t)((u + 0x7fffu + ((u >> 16) & 1u)) >> 16); }
template <int CTRL> __device__ __forceinline__ float dpp_f(float v) { return __uint_as_float((unsigned)__builtin_amdgcn_mov_dpp((int)__float_as_uint(v), CTRL, 0xF, 0xF, true)); }
__device__ __forceinline__ float xor1_f(float v) { return dpp_f<0xB1>(v); }
__device__ __forceinline__ float xor2_f(float v) { return dpp_f<0x4E>(v); }
__device__ __forceinline__ float wave_sum(float v) {
    v += dpp_f<0xB1>(v); v += dpp_f<0x4E>(v); v += dpp_f<0x141>(v); v += dpp_f<0x140>(v);
    { auto r = __builtin_amdgcn_permlane16_swap(__float_as_uint(v), __float_as_uint(v), false, false); v = __uint_as_float(r[0]) + __uint_as_float(r[1]); }
    { auto r = __builtin_amdgcn_permlane32_swap(__float_as_uint(v), __float_as_uint(v), false, false); v = __uint_as_float(r[0]) + __uint_as_float(r[1]); }
    return v;
}
__device__ __forceinline__ float wave_max(float v) {
    v = fmaxf(v, dpp_f<0xB1>(v)); v = fmaxf(v, dpp_f<0x4E>(v)); v = fmaxf(v, dpp_f<0x141>(v)); v = fmaxf(v, dpp_f<0x140>(v));
    { auto r = __builtin_amdgcn_permlane16_swap(__float_as_uint(v), __float_as_uint(v), false, false); v = fmaxf(__uint_as_float(r[0]), __uint_as_float(r[1])); }
    { auto r = __builtin_amdgcn_permlane32_swap(__float_as_uint(v), __float_as_uint(v), false, false); v = fmaxf(__uint_as_float(r[0]), __uint_as_float(r[1])); }
    return v;
}
__device__ __forceinline__ int tid_() { int t = threadIdx.x; asm volatile("" : "+v"(t)); return t; }
__device__ __forceinline__ int bid_() { int b = blockIdx.x; asm volatile("" : "+s"(b)); return b; }
__device__ __forceinline__ float silu_f(float x) { return x / (1.f + expf(-x)); }
__device__ __forceinline__ int row_modv(int row) { return row < NLAT ? (row >> 13) : 4; }
__device__ __forceinline__ float* hrow2(float* hl, float* hc, int row) { return row < NLAT ? hl + (size_t)row * DM : hc + (size_t)(row - NLAT) * DM; }

#define XB_TMO      128
#define XB_XCNT(j)  (256  + 64 * (j))
#define XB_XSUB(j)  (1280 + 64 * (j))
#define XB_XGEN(j)  (2304 + 64 * (j))
#define XB_TOP      3328
#define XB_TOPGEN   3392
#define XCD_BAR_WORDS 3456
#define XB_SPIN_CAP (1u << 18)
__device__ __forceinline__ unsigned xb_ld(unsigned* p)              { return __hip_atomic_load(p, __ATOMIC_RELAXED, __HIP_MEMORY_SCOPE_AGENT); }
__device__ __forceinline__ unsigned xb_add(unsigned* p, unsigned v) { return __hip_atomic_fetch_add(p, v, __ATOMIC_RELAXED, __HIP_MEMORY_SCOPE_AGENT); }
__device__ __forceinline__ unsigned xb_xcc_id() { return (unsigned)__builtin_amdgcn_s_getreg((3 << 11) | 20) & 0xFu; }
#define XB_SPIN(cond, bar) do { unsigned _sp = 0; while (cond) { __builtin_amdgcn_s_sleep(1); \
    if ((++_sp & 255u) == 0u) { if (xb_ld(&(bar)[XB_TMO])) break; if (_sp > XB_SPIN_CAP) { atomicAdd(&(bar)[XB_TMO], 1u); break; } } } } while (0)
struct XcdBarrier { unsigned* bar; unsigned x; volatile LAS unsigned* st; };
__device__ __forceinline__ XcdBarrier xcd_barrier_post(unsigned* bar, volatile LAS unsigned* st) {
    XcdBarrier b; b.bar = bar; b.x = xb_xcc_id(); b.st = st;
    if (threadIdx.x == 0) (void)xb_add(&bar[XB_XCNT(b.x)], 1u);
    return b;
}
__device__ __forceinline__ void xcd_barrier_complete(unsigned* bar, unsigned x, unsigned& nloc, unsigned& nx) {
    const unsigned G = gridDim.x * gridDim.y * gridDim.z;
    unsigned sum, cnt, mine, sp = 0u;
    for (;;) {
        sum = 0u; cnt = 0u; mine = 0u;
#pragma unroll
        for (unsigned j = 0; j < 16; ++j) { const unsigned c = xb_ld(&bar[XB_XCNT(j)]); sum += c; cnt += (c > 0u) ? 1u : 0u; mine = (j == x) ? c : mine; }
        if (sum == G) break;
        __builtin_amdgcn_s_sleep(1);
        if ((++sp & 255u) == 0u) { if (xb_ld(&bar[XB_TMO])) break; if (sp > XB_SPIN_CAP) { atomicAdd(&bar[XB_TMO], 1u); break; } }
    }
    nloc = mine > 0u ? mine : 1u; nx = cnt > 0u ? cnt : 1u;
}
__device__ __forceinline__ void xcd_barrier(const XcdBarrier& b) {
    asm volatile("s_waitcnt vmcnt(0)" ::: "memory");
    __syncthreads();
    if (threadIdx.x == 0) {
        unsigned* bar = b.bar;
        __builtin_amdgcn_s_waitcnt(0);
        unsigned nloc = b.st[0], nx = b.st[1];
        if (nloc == 0u) { xcd_barrier_complete(bar, b.x, nloc, nx); b.st[0] = nloc; b.st[1] = nx; }
        const unsigned old = xb_add(&bar[XB_XSUB(b.x)], 1u);
        const unsigned gen = old / nloc;
        if (old + 1u == (gen + 1u) * nloc) {
            __builtin_amdgcn_fence(__ATOMIC_RELEASE, "agent");
            asm volatile("s_waitcnt vmcnt(0)" ::: "memory");
            const unsigned og = xb_add(&bar[XB_TOP], 1u);
            const unsigned tg = og / nx;
            if (og + 1u == (tg + 1u) * nx) xb_add(&bar[XB_TOPGEN], 1u);
            else XB_SPIN(xb_ld(&bar[XB_TOPGEN]) == tg, bar);
            __builtin_amdgcn_fence(__ATOMIC_ACQUIRE, "agent");
            xb_add(&bar[XB_XGEN(b.x)], 1u);
            asm volatile("s_waitcnt vmcnt(0)" ::: "memory");
        } else {
            XB_SPIN(xb_ld(&bar[XB_XGEN(b.x)]) == gen, bar);
            __builtin_amdgcn_fence(__ATOMIC_ACQUIRE, "agent");
            asm volatile("s_waitcnt vmcnt(0)" ::: "memory");
        }
    }
    __syncthreads();
}

struct SegInfo { const int* seg; size_t wstride; };
template <bool DUAL, class Epi>
__device__ __forceinline__ void gemm_simple(char* smem, const bf16_t* A, int lda, int M, const float* W, const float* W2, int ldw, int N, int K, SegInfo sg, const Epi& epi) {
    float* As = (float*)smem;
    float* Ws = As + 16 * 132;
    float* Ws2 = Ws + 16 * 68;
    const int t = tid_(), ty = t >> 4, tx = t & 15;
    const int ntm = (M + 127) / 128, ntn = (N + 63) / 64;
    for (int tile = blockIdx.x; tile < ntm * ntn; tile += gridDim.x) {
        const int tm = tile / ntn, tn = tile % ntn, m0 = tm * 128, n0 = tn * 64;
        const float* Wt = W; const float* Wt2 = W2; int mvalid = M;
        if (sg.seg) {
            int e = 0;
#pragma unroll
            for (int i = 1; i < 16; ++i) if (m0 >= sg.seg[i]) e = i;
            mvalid = sg.seg[e] + sg.seg[17 + e];
            if (m0 >= sg.seg[16] || m0 >= mvalid) continue;
            Wt = W + (size_t)e * sg.wstride; if (DUAL) Wt2 = W2 + (size_t)e * sg.wstride;
        }
        float acc[4][4], acc2[4][4];
#pragma unroll
        for (int i = 0; i < 4; ++i)
#pragma unroll
            for (int j = 0; j < 4; ++j) { acc[i][j] = 0.f; acc2[i][j] = 0.f; }
        for (int k0 = 0; k0 < K; k0 += 16) {
            {
                const int r = t >> 2, kq = (t & 3) * 4, row = m0 + r;
                uint2 v = make_uint2(0u, 0u);
                if (row < M) v = *(const uint2*)(A + (size_t)row * lda + k0 + kq);
                As[(kq + 0) * 132 + r] = __uint_as_float(v.x << 16);
                As[(kq + 1) * 132 + r] = __uint_as_float(v.x & 0xffff0000u);
                As[(kq + 2) * 132 + r] = __uint_as_float(v.y << 16);
                As[(kq + 3) * 132 + r] = __uint_as_float(v.y & 0xffff0000u);
            }
            {
                const int k = t >> 5, n = (t & 31) * 2, col = n0 + n;
                float2 w = make_float2(0.f, 0.f), w2 = make_float2(0.f, 0.f);
                if (col < N) { w = *(const float2*)(Wt + (size_t)(k0 + k) * ldw + col); if (DUAL) w2 = *(const float2*)(Wt2 + (size_t)(k0 + k) * ldw + col); }
                Ws[k * 68 + n] = w.x; Ws[k * 68 + n + 1] = w.y;
                if (DUAL) { Ws2[k * 68 + n] = w2.x; Ws2[k * 68 + n + 1] = w2.y; }
            }
            __syncthreads();
#pragma unroll
            for (int kk = 0; kk < 16; ++kk) {
                const float4 a = *(const float4*)&As[kk * 132 + ty * 4];
                const float4 w = *(const float4*)&Ws[kk * 68 + tx * 4];
                const float av[4] = {a.x, a.y, a.z, a.w}, wv[4] = {w.x, w.y, w.z, w.w};
#pragma unroll
                for (int i = 0; i < 4; ++i)
#pragma unroll
                    for (int j = 0; j < 4; ++j) acc[i][j] = fmaf(av[i], wv[j], acc[i][j]);
                if (DUAL) {
                    const float4 w2 = *(const float4*)&Ws2[kk * 68 + tx * 4];
                    const float wv2[4] = {w2.x, w2.y, w2.z, w2.w};
#pragma unroll
                    for (int i = 0; i < 4; ++i)
#pragma unroll
                        for (int j = 0; j < 4; ++j) acc2[i][j] = fmaf(av[i], wv2[j], acc2[i][j]);
                }
            }
            __syncthreads();
        }
#pragma unroll
        for (int i = 0; i < 4; ++i) {
            const int row = m0 + ty * 4 + i;
            if (row < M && row < mvalid) {
#pragma unroll
                for (int j = 0; j < 4; ++j) { const int col = n0 + tx * 4 + j; if (col < N) epi(row, col, acc[i][j], acc2[i][j]); }
            }
        }
    }
}

template <int DQK, int DV>
__device__ __forceinline__ void attn_simple(char* smem, const bf16_t* Q, int ldq, int nq, const bf16_t* K0, const bf16_t* V0, int n0, const bf16_t* K1, const bf16_t* V1, int n1,
                                            int ldk, int ldv, float qscale_log2, bf16_t* O, int ldo) {
    float* Ks = (float*)smem;
    float* Vs = Ks + 32 * DQK;
    const int t = tid_();
    const bool act = t < nq;
    float q[DQK];
#pragma unroll
    for (int c = 0; c < DQK; ++c) q[c] = act ? bf2f(Q[(size_t)t * ldq + c]) * qscale_log2 : 0.f;
    float o[DV];
#pragma unroll
    for (int e = 0; e < DV; ++e) o[e] = 0.f;
    float mrun = -INFINITY, lrun = 0.f;
    const int ntile = (n0 + n1) / 32;
    for (int tl = 0; tl < ntile; ++tl) {
        const int j0 = tl * 32;
        const bf16_t* Kp; const bf16_t* Vp;
        if (j0 < n0) { Kp = K0 + (size_t)j0 * ldk; Vp = V0 + (size_t)j0 * ldv; } else { Kp = K1 + (size_t)(j0 - n0) * ldk; Vp = V1 + (size_t)(j0 - n0) * ldv; }
        __syncthreads();
        for (int idx = t; idx < 32 * DQK; idx += 512) { const int r = idx / DQK, c = idx % DQK; Ks[idx] = bf2f(Kp[(size_t)r * ldk + c]); }
        for (int idx = t; idx < 32 * DV; idx += 512) { const int r = idx / DV, c = idx % DV; Vs[idx] = bf2f(Vp[(size_t)r * ldv + c]); }
        __syncthreads();
#pragma unroll 1
        for (int r = 0; r < 32; ++r) {
            float a = 0.f;
#pragma unroll
            for (int c = 0; c < DQK; c += 4) { const float4 kv = *(const float4*)&Ks[r * DQK + c]; a = fmaf(q[c], kv.x, a); a = fmaf(q[c + 1], kv.y, a); a = fmaf(q[c + 2], kv.z, a); a = fmaf(q[c + 3], kv.w, a); }
            if (a > mrun) {
                const float alpha = exp2f(mrun - a);
                mrun = a; lrun *= alpha;
#pragma unroll
                for (int e = 0; e < DV; ++e) o[e] *= alpha;
            }
            const float pr = exp2f(a - mrun);
            lrun += pr;
#pragma unroll
            for (int e = 0; e < DV; e += 4) { const float4 vv = *(const float4*)&Vs[r * DV + e]; o[e] = fmaf(pr, vv.x, o[e]); o[e + 1] = fmaf(pr, vv.y, o[e + 1]); o[e + 2] = fmaf(pr, vv.z, o[e + 2]); o[e + 3] = fmaf(pr, vv.w, o[e + 3]); }
        }
    }
    if (act) {
        const float inv = 1.f / lrun;
#pragma unroll
        for (int e = 0; e < DV; ++e) O[(size_t)t * ldo + e] = f2bf(o[e] * inv);
    }
    __syncthreads();
}

__device__ __forceinline__ void rope_pair(float& x1, float& x2, float pos, int i, int half) {
    const float inv = powf(10000.0f, -(float)i / (float)half);
    float sn, cs; sincosf(pos * inv, &sn, &cs);
    const float a = x1 * cs - x2 * sn, b = x2 * cs + x1 * sn; x1 = a; x2 = b;
}
__device__ __forceinline__ float log_sigmoid_f(float x) { return -log1pf(expf(-x)); }

namespace pg8 {
#define PG8_LAS __attribute__((address_space(3)))
typedef unsigned short bf16_t;
typedef short bf16x8 __attribute__((ext_vector_type(8)));
typedef float f32x4 __attribute__((ext_vector_type(4)));
typedef unsigned u32x4 __attribute__((ext_vector_type(4)));
constexpr int BM = 256, BK = 64, HALF = 128, HTB = HALF * BK * 2  , STAGE_BYTES = 8 * HTB, NXCD = 8, WGM = 8;

__host__ __device__ __forceinline__ int lds_byte(int r, int c) { const int st = (r >> 4) * 2 + (c >> 5), rr = r & 15, cc = c & 31, ob = rr * 64 + cc * 2; return st * 1024 + (ob ^ (((ob >> 9) & 1) << 5)); }
__host__ __device__ __forceinline__ void stage_rc(int b, int& R, int& C) { const int st = b / 1024, sb = b % 1024, swz = sb ^ (((sb >> 9) & 1) << 5); R = (st >> 1) * 16 + swz / 64; C = (st & 1) * 32 + (swz % 64) / 2; }
__host__ __device__ __forceinline__ int perm32(int rho) { const int n = rho >> 4, i = rho & 15; return 8 * (i >> 2) + 4 * n + (i & 3); }

struct Unit { int pm, pn; };
struct Gemm { const bf16_t* A; const bf16_t* Bt; int lda, ldb, K; };

__device__ __forceinline__ unsigned cvt_pk_bf16(float lo, float hi) { unsigned r; asm volatile("v_cvt_pk_bf16_f32 %0, %1, %2" : "=v"(r) : "v"(lo), "v"(hi)); return r; }
template <class Epi, class Sched, bool ALIGN_EPI = false, bool SP2 = false>
__device__ __forceinline__ void gemm_phase(PG8_LAS unsigned char* lds, const Gemm g, const Sched& S, const Epi& E) {
    const int tid = tid_(), wid = __builtin_amdgcn_readfirstlane(tid >> 6), lane = tid & 63, wr = wid >> 2, wc = wid & 3, fr = lane & 15, fq = lane >> 4;
    int K = g.K; asm volatile("" : "+s"(K));
    const int nt = K / BK;
    unsigned voffA[2], voffB[2];
#pragma unroll
    for (int i = 0; i < 2; ++i) { int R, C; stage_rc(tid * 16 + i * 8192, R, C); const int Rb = Epi::PERM ? ((R & ~31) + perm32(R & 31)) : R;
        voffA[i] = (unsigned)(R * g.lda + C) * 2u; voffB[i] = (unsigned)(Rb * g.ldb + C) * 2u; }
    const size_t kstep = (size_t)(BK * 2);
    const size_t hstepA = (size_t)HALF * g.lda * 2, hstepB = (size_t)HALF * g.ldb * 2;
    const size_t tstepA = 2 * hstepA, tstepB = 2 * hstepB;
    const unsigned ldsw = (unsigned)wid * 1024u;
    const int aoff = lds_byte(wr * 64 + fr, fq * 8), boff = lds_byte(wc * 32 + fr, fq * 8);
#define PG8_SA(b, h) (((b) * 2 + (h)) * HTB)
#define PG8_SB(b, h) ((4 + (b) * 2 + (h)) * HTB)
#define PG8_STAGE(bufoff, gbase, voff) do { _Pragma("unroll") for (int _i = 0; _i < 2; ++_i) \
        __builtin_amdgcn_global_load_lds((const unsigned*)((const char*)(gbase) + (voff)[_i]), (PG8_LAS unsigned*)(lds + (bufoff) + ldsw + _i * 8192), 16, 0, 0); } while (0)
#define PG8_LDA(dst, b, h) do { _Pragma("unroll") for (int m = 0; m < 4; ++m) _Pragma("unroll") for (int k = 0; k < 2; ++k) dst[m][k] = *(const PG8_LAS bf16x8*)(lds + PG8_SA(b, h) + aoff + m * 2048 + k * 1024); } while (0)
#define PG8_LDB(dst, b, h) do { _Pragma("unroll") for (int n = 0; n < 2; ++n) _Pragma("unroll") for (int k = 0; k < 2; ++k) dst[n][k] = *(const PG8_LAS bf16x8*)(lds + PG8_SB(b, h) + boff + n * 2048 + k * 1024); } while (0)
#define PG8_MMA(ai, bj, At, Bt) do { __builtin_amdgcn_s_setprio(1); _Pragma("unroll") for (int m = 0; m < 4; ++m) _Pragma("unroll") for (int n = 0; n < 2; ++n) _Pragma("unroll") for (int k = 0; k < 2; ++k) \
        acc[ai][bj][m][n] = __builtin_amdgcn_mfma_f32_16x16x32_bf16(Bt[n][k], At[m][k], acc[ai][bj][m][n], 0, 0, 0); __builtin_amdgcn_s_setprio(0); } while (0)
#define PG8_WAIT_V(n) asm volatile("s_waitcnt vmcnt(" #n ")" ::: "memory")
#define PG8_WAIT_L(n) asm volatile("s_waitcnt lgkmcnt(" #n ")" ::: "memory")
#define PG8_BAR __builtin_amdgcn_s_barrier()
#define PG8_SCHED __builtin_amdgcn_sched_barrier(0)
    Unit cur, nxt; int ui = 0;
    if (!S.next(0, cur)) return;
    f32x4 acc[2][2][4][2];
#pragma unroll
    for (int a = 0; a < 2; ++a)
#pragma unroll
        for (int b = 0; b < 2; ++b)
#pragma unroll
            for (int m = 0; m < 4; ++m)
#pragma unroll
                for (int n = 0; n < 2; ++n) acc[a][b][m][n] = (f32x4){0.f, 0.f, 0.f, 0.f};
    bf16x8 At[4][2], B0[2][2], B1[2][2];
    const char* cA = (const char*)g.A + (size_t)cur.pm * tstepA; const char* cB = (const char*)g.Bt + (size_t)cur.pn * tstepB;
    S.a_ready(cur);
    if constexpr (SP2) {
        PG8_STAGE(PG8_SB(0, 0), cB, voffB); PG8_STAGE(PG8_SB(0, 1), cB + hstepB, voffB); PG8_STAGE(PG8_SA(0, 0), cA, voffA); PG8_STAGE(PG8_SA(0, 1), cA + hstepA, voffA);
        if (wr == 1) PG8_BAR;
        PG8_WAIT_V(2); PG8_BAR;
        PG8_STAGE(PG8_SB(1, 0), cB + kstep, voffB); PG8_STAGE(PG8_SA(1, 0), cA + kstep, voffA); PG8_STAGE(PG8_SB(1, 1), cB + hstepB + kstep, voffB);
        PG8_WAIT_V(6); PG8_BAR;
    } else {
        PG8_STAGE(PG8_SB(0, 0), cB, voffB); PG8_STAGE(PG8_SA(0, 0), cA, voffA); PG8_STAGE(PG8_SB(0, 1), cB + hstepB, voffB); PG8_STAGE(PG8_SA(0, 1), cA + hstepA, voffA);
        if (wr == 1) PG8_BAR;
        PG8_WAIT_V(4); PG8_BAR;
        PG8_STAGE(PG8_SB(1, 0), cB + kstep, voffB); PG8_STAGE(PG8_SA(1, 0), cA + kstep, voffA); PG8_STAGE(PG8_SB(1, 1), cB + hstepB + kstep, voffB);
        PG8_WAIT_V(6); PG8_BAR;
    }
    for (;;) {
        const bool has_next = S.next(ui + 1, nxt);
        const char* nA = has_next ? (const char*)g.A + (size_t)nxt.pm * tstepA : cA; const char* nB = has_next ? (const char*)g.Bt + (size_t)nxt.pn * tstepB : cB;
        for (int t = 0; t < nt; t += 2) {
            const bool last = (t == nt - 2);
            const char* a1 = cA + (size_t)(t + 1) * kstep;
            const char* a2 = last ? nA : cA + (size_t)(t + 2) * kstep; const char* b2 = last ? nB : cB + (size_t)(t + 2) * kstep;
            const char* a3 = a2 + kstep; const char* b3 = b2 + kstep;
            if (last && has_next) S.a_ready(nxt);
            if constexpr (SP2) {
            PG8_LDB(B0, 0, 0); PG8_LDB(B1, 0, 1); PG8_SCHED; PG8_LDA(At, 0, 0); PG8_STAGE(PG8_SA(1, 1), a1 + hstepA, voffA);
            PG8_WAIT_V(8); PG8_WAIT_L(0); PG8_BAR; PG8_MMA(0, 0, At, B0); PG8_MMA(0, 1, At, B1); PG8_BAR; PG8_SCHED;
            PG8_LDA(At, 0, 1); PG8_STAGE(PG8_SB(0, 0), b2, voffB); PG8_STAGE(PG8_SB(0, 1), b2 + hstepB, voffB); PG8_STAGE(PG8_SA(0, 0), a2, voffA);
            PG8_WAIT_V(8); PG8_WAIT_L(0); PG8_BAR; PG8_MMA(1, 0, At, B0); PG8_MMA(1, 1, At, B1); PG8_BAR; PG8_SCHED;
            PG8_LDB(B0, 1, 0); PG8_LDB(B1, 1, 1); PG8_SCHED; PG8_LDA(At, 1, 0); PG8_STAGE(PG8_SA(0, 1), a2 + hstepA, voffA);
            PG8_WAIT_V(8); PG8_WAIT_L(0); PG8_BAR; PG8_MMA(0, 0, At, B0); PG8_MMA(0, 1, At, B1); PG8_BAR; PG8_SCHED;
            PG8_LDA(At, 1, 1); PG8_STAGE(PG8_SB(1, 0), b3, voffB); PG8_STAGE(PG8_SB(1, 1), b3 + hstepB, voffB); PG8_STAGE(PG8_SA(1, 0), a3, voffA);
            PG8_WAIT_V(8); PG8_WAIT_L(0); PG8_BAR; PG8_MMA(1, 0, At, B0); PG8_MMA(1, 1, At, B1); PG8_BAR; PG8_SCHED;
            } else {
            PG8_LDB(B0, 0, 0); PG8_SCHED; PG8_LDA(At, 0, 0); PG8_STAGE(PG8_SA(1, 1), a1 + hstepA, voffA);
            PG8_WAIT_L(8); PG8_BAR; PG8_WAIT_L(0); PG8_MMA(0, 0, At, B0); PG8_BAR; PG8_SCHED;
            PG8_LDB(B1, 0, 1); PG8_STAGE(PG8_SB(0, 0), b2, voffB);
            PG8_BAR; PG8_WAIT_L(0); PG8_MMA(0, 1, At, B1); PG8_BAR;
            PG8_LDA(At, 0, 1); PG8_STAGE(PG8_SA(0, 0), a2, voffA);
            PG8_BAR; PG8_WAIT_L(0); PG8_MMA(1, 0, At, B0); PG8_BAR; PG8_SCHED;
            PG8_STAGE(PG8_SB(0, 1), b2 + hstepB, voffB);
            PG8_WAIT_V(6); PG8_BAR; PG8_MMA(1, 1, At, B1); PG8_BAR;
            PG8_LDB(B0, 1, 0); PG8_SCHED; PG8_LDA(At, 1, 0); PG8_STAGE(PG8_SA(0, 1), a2 + hstepA, voffA);
            PG8_WAIT_L(8); PG8_BAR; PG8_WAIT_L(0); PG8_MMA(0, 0, At, B0); PG8_BAR; PG8_SCHED;
            PG8_LDB(B1, 1, 1); PG8_STAGE(PG8_SB(1, 0), b3, voffB);
            PG8_BAR; PG8_WAIT_L(0); PG8_MMA(0, 1, At, B1); PG8_BAR;
            PG8_LDA(At, 1, 1); PG8_STAGE(PG8_SA(1, 0), a3, voffA);
            PG8_BAR; PG8_WAIT_L(0); PG8_MMA(1, 0, At, B0); PG8_BAR; PG8_SCHED;
            PG8_STAGE(PG8_SB(1, 1), b3 + hstepB, voffB);
            PG8_WAIT_V(6); PG8_BAR; PG8_MMA(1, 1, At, B1); PG8_BAR;
            }
        }
        if constexpr (ALIGN_EPI) { if (wr == 0) PG8_BAR; }
        if constexpr (!Epi::AFTER_DRAIN) { E(acc, cur, wr, wc, fr, fq); S.done(cur); }
        if (!has_next) break;
#pragma unroll
        for (int a = 0; a < 2; ++a)
#pragma unroll
            for (int b = 0; b < 2; ++b)
#pragma unroll
                for (int m = 0; m < 4; ++m)
#pragma unroll
                    for (int n = 0; n < 2; ++n) acc[a][b][m][n] = (f32x4){0.f, 0.f, 0.f, 0.f};
        cur = nxt; cA = nA; cB = nB; ++ui;
        if constexpr (ALIGN_EPI) { if (wr == 1) PG8_BAR; }
    }
    PG8_WAIT_V(0);
    if constexpr (!ALIGN_EPI) { if (wr == 0) PG8_BAR; }
    PG8_BAR;
    if constexpr (Epi::AFTER_DRAIN) { E.fused(acc, cur, wr, wc, fr, fq, lds, wid, lane); S.done(cur); }
#undef PG8_SA
#undef PG8_SB
#undef PG8_STAGE
#undef PG8_LDA
#undef PG8_LDB
#undef PG8_MMA
#undef PG8_WAIT_V
#undef PG8_WAIT_L
#undef PG8_BAR
#undef PG8_SCHED
}


struct StaticOrder {
    int nM, nN, nwg, G, c;
    __device__ void init(int M, int N, int G_, int c_) { nM = M / BM; nN = N / BM; nwg = nM * nN; G = G_; c = c_; }
    __device__ bool next(int i, Unit& u) const {
        const long L = (long)i * G + c; if (L >= nwg) return false;
        int wgid = (int)L; { const int q = nwg / NXCD, r = nwg % NXCD, xcd = wgid % NXCD, off = wgid / NXCD; wgid = (xcd < r ? xcd * (q + 1) : r * (q + 1) + (xcd - r) * q) + off; }
        const int nig = WGM * nN, gid = wgid / nig, fm = gid * WGM, gsz = (nM - fm) < WGM ? (nM - fm) : WGM;
        u.pm = fm + ((wgid % nig) % gsz); u.pn = (wgid % nig) / gsz; return true;
    }
    __device__ __forceinline__ void a_ready(const Unit&) const {}
    __device__ __forceinline__ void done(const Unit&) const {}
};
struct GroupedOrder {
    const PG8_LAS int* list; int n;
    __device__ __forceinline__ bool next(int i, Unit& u) const { if (i >= n) return false; u.pm = __builtin_amdgcn_readfirstlane(list[2 * i]); u.pn = __builtin_amdgcn_readfirstlane(list[2 * i + 1]); return true; }
    __device__ __forceinline__ void a_ready(const Unit&) const {}
    __device__ __forceinline__ void done(const Unit&) const {}
};
__device__ __forceinline__ int grouped_units(PG8_LAS int* list, const int* tile, int ncol, int G, int c) {
#define TLD(i) ((int)__hip_atomic_load((const unsigned*)tile + (i), __ATOMIC_RELAXED, __HIP_MEMORY_SCOPE_AGENT))
    const int nrt = TLD(0); int n = 0;
    for (int i = 0; i < 16; ++i) { const int L = i * G + c, rt = L / ncol; if (rt >= nrt) break; if (threadIdx.x == 0) { list[2 * i] = TLD(17 + 2 * rt); list[2 * i + 1] = TLD(16 + 2 * rt) * ncol + (L % ncol); } ++n; }
#undef TLD
    __syncthreads();
    return n;
}
__device__ __forceinline__ u32x4 pack8(const f32x4& v0, const f32x4& v1) { u32x4 w; w.x = cvt_pk_bf16(v0[0], v0[1]); w.y = cvt_pk_bf16(v0[2], v0[3]); w.z = cvt_pk_bf16(v1[0], v1[1]); w.w = cvt_pk_bf16(v1[2], v1[3]); return w; }
#define EPI_ROWS_BEGIN _Pragma("unroll") for (int ai = 0; ai < 2; ++ai) _Pragma("unroll") for (int m = 0; m < 4; ++m) { const int row = u.pm * BM + ai * HALF + wr * 64 + m * 16 + fr; \
    _Pragma("unroll") for (int bj = 0; bj < 2; ++bj) { const f32x4 v0 = acc[ai][bj][m][0], v1 = acc[ai][bj][m][1];
#define EPI_ROWS_END } }
struct EpiP { static constexpr bool PERM = true, AFTER_DRAIN = false; bf16_t* O; int ldc;
    __device__ __forceinline__ void operator()(const f32x4 (&acc)[2][2][4][2], const Unit& u, int wr, int wc, int fr, int fq) const {
        EPI_ROWS_BEGIN const int col = u.pn * BM + bj * HALF + wc * 32 + 8 * fq; *(u32x4*)(O + (size_t)row * ldc + col) = pack8(v0, v1); EPI_ROWS_END } };
struct EpiUQ { static constexpr bool PERM = true, AFTER_DRAIN = false; bf16_t* Q;
    __device__ __forceinline__ void operator()(const f32x4 (&acc)[2][2][4][2], const Unit& u, int wr, int wc, int fr, int fq) const {
        EPI_ROWS_BEGIN const int col = u.pn * BM + bj * HALF + wc * 32 + 8 * fq; if (col < 384) *(u32x4*)(Q + (size_t)row * 384 + col) = pack8(v0, v1); EPI_ROWS_END } };
struct EpiUKV { static constexpr bool PERM = true, AFTER_DRAIN = false; bf16_t* Kn; bf16_t* Vn;
    __device__ __forceinline__ void operator()(const f32x4 (&acc)[2][2][4][2], const Unit& u, int wr, int wc, int fr, int fq) const {
        bf16_t* base = wc < 2 ? Kn + wc * 32 + 8 * fq : Vn + (wc - 2) * 32 + 8 * fq; const int rp = wc < 2 ? 384 : 256, hp = wc < 2 ? 96 : 64;
        EPI_ROWS_BEGIN const int hd = u.pn * 2 + bj; *(u32x4*)(base + (size_t)row * rp + hd * hp) = pack8(v0, v1); EPI_ROWS_END } };
struct EpiOut { static constexpr bool PERM = true, AFTER_DRAIN = false; float* hl; float* hc; const float* gate;
    __device__ __forceinline__ void operator()(const f32x4 (&acc)[2][2][4][2], const Unit& u, int wr, int wc, int fr, int fq) const {
        EPI_ROWS_BEGIN const int col = u.pn * BM + bj * HALF + wc * 32 + 8 * fq;
            float* h = (row < 32768 ? hl + (size_t)row * 1024 : hc + (size_t)(row - 32768) * 1024) + col; const float* g = gate + (row < 32768 ? (row >> 13) : 4) * 6144 + col;
            const f32x4 g0 = *(const f32x4*)g, g1 = *(const f32x4*)(g + 4); f32x4 h0 = *(f32x4*)h, h1 = *(f32x4*)(h + 4);
            h0 = h0 + g0 * v0; h1 = h1 + g1 * v1; *(f32x4*)h = h0; *(f32x4*)(h + 4) = h1; EPI_ROWS_END } };
__device__ __forceinline__ float silu_fast(float x) { return x / (1.f + __expf(-x)); }
struct EpiMoe1 { static constexpr bool PERM = true, AFTER_DRAIN = false; bf16_t* Hd;
    __device__ __forceinline__ void operator()(const f32x4 (&acc)[2][2][4][2], const Unit& u, int wr, int wc, int fr, int fq) const {
        EPI_ROWS_BEGIN const int col = (u.pn & 1) * BM + bj * HALF + wc * 32 + 8 * fq;
            uint2 w; w.x = cvt_pk_bf16(silu_fast(v0[0]) * v0[1], silu_fast(v0[2]) * v0[3]); w.y = cvt_pk_bf16(silu_fast(v1[0]) * v1[1], silu_fast(v1[2]) * v1[3]);
            *(uint2*)(Hd + (size_t)row * 256 + (col >> 1)) = w; EPI_ROWS_END } };
struct EpiMoe2 { static constexpr bool PERM = true, AFTER_DRAIN = false; bf16_t* Y;
    __device__ __forceinline__ void operator()(const f32x4 (&acc)[2][2][4][2], const Unit& u, int wr, int wc, int fr, int fq) const {
        EPI_ROWS_BEGIN const int col = (u.pn & 3) * BM + bj * HALF + wc * 32 + 8 * fq; *(u32x4*)(Y + (size_t)row * 1024 + col) = pack8(v0, v1); EPI_ROWS_END } };
}

__device__ __forceinline__ void transpose_tile(float* tl, const float* W, int K, int N, bf16_t* dst, int rs, int ro, int tile, int ntn) {
    const int t = tid_(), k0 = (tile / ntn) * 64, n0 = (tile % ntn) * 64;
    __syncthreads();
    { const int k = t >> 3, n8 = (t & 7) * 8;
#pragma unroll
      for (int i = 0; i < 8; ++i) { const int n = n0 + n8 + i; tl[k * 65 + n8 + i] = n < N ? W[(size_t)(k0 + k) * N + n] : 0.f; } }
    __syncthreads();
    { const int n = t >> 3, k8 = (t & 7) * 8; uint4 o;
      o.x = (unsigned)f2bf(tl[(k8 + 0) * 65 + n]) | ((unsigned)f2bf(tl[(k8 + 1) * 65 + n]) << 16); o.y = (unsigned)f2bf(tl[(k8 + 2) * 65 + n]) | ((unsigned)f2bf(tl[(k8 + 3) * 65 + n]) << 16);
      o.z = (unsigned)f2bf(tl[(k8 + 4) * 65 + n]) | ((unsigned)f2bf(tl[(k8 + 5) * 65 + n]) << 16); o.w = (unsigned)f2bf(tl[(k8 + 6) * 65 + n]) | ((unsigned)f2bf(tl[(k8 + 7) * 65 + n]) << 16);
      *(uint4*)(dst + (size_t)((n0 + n) * rs + ro) * K + k0 + k8) = o; }
}
__device__ __forceinline__ void transpose_mat(float* tl, const float* W, int K, int N, int Npad, bf16_t* dst, int rs, int ro, int& base) {
    const int ntn = Npad / 64, nt = (K / 64) * ntn, G = gridDim.x;
    const int first = (((int)blockIdx.x - base) % G + G) % G;
    for (int tile = first; tile < nt; tile += G) transpose_tile(tl, W, K, N, dst, rs, ro, tile, ntn);
    base = (base + nt) % G;
}


namespace fa {
typedef short bf16x8 __attribute__((ext_vector_type(8)));
typedef float f32x16 __attribute__((ext_vector_type(16)));
typedef unsigned u32x4 __attribute__((ext_vector_type(4)));
__device__ __forceinline__ int crow(int r, int hi) { return (r & 3) + 8 * (r >> 2) + 4 * hi; }
__device__ __forceinline__ unsigned cvtpk(float lo, float hi) { unsigned r; asm volatile("v_cvt_pk_bf16_f32 %0, %1, %2" : "=v"(r) : "v"(lo), "v"(hi)); return r; }
__device__ __forceinline__ float xhalf_max(float m) { auto rr = __builtin_amdgcn_permlane32_swap(__float_as_uint(m), __float_as_uint(m), false, false); return fmaxf(__uint_as_float(rr[0]), __uint_as_float(rr[1])); }
__device__ __forceinline__ float xhalf_sum(float m) { auto rr = __builtin_amdgcn_permlane32_swap(__float_as_uint(m), __float_as_uint(m), false, false); return __uint_as_float(rr[0]) + __uint_as_float(rr[1]); }
template <int DQK> struct Lds { static constexpr int KP = DQK * 2 + 16, VP = 144, KB = 64 * KP, VB = 64 * VP, K0 = 0, V0 = 2 * KB, WSF = V0 + 2 * VB, OST = WSF + 8 * 64 * 4, BYTES = OST + 8 * 4096; };
template <int DQK>
__device__ __forceinline__ void attn_unit(char* smem, const bf16_t* Q, int ldq, const bf16_t* K0, int nt0, const bf16_t* K1, int nt1, int ldk, const bf16_t* VT, bf16_t* O, int ldo) {
    typedef Lds<DQK> L; constexpr int KC = DQK / 8, NKC = 64 * KC, NKS = DQK / 16; constexpr float THR = 8.f;
    const int tid = tid_(), lane = tid & 63, r32 = lane & 31, hi = lane >> 5; const int wid = __builtin_amdgcn_readfirstlane(tid >> 6);
    float* wsf = (float*)(smem + L::WSF) + wid * 64;
    bf16x8 qf[NKS];
#pragma unroll
    for (int ks = 0; ks < NKS; ++ks) qf[ks] = *(const bf16x8*)(Q + (size_t)(wid * 32 + r32) * ldq + ks * 16 + hi * 8);
    f32x16 o0, o1, negm;
#pragma unroll
    for (int r = 0; r < 16; ++r) { o0[r] = 0.f; o1[r] = 0.f; negm[r] = 0.f; }
    float mhat = 0.f, lsum = 0.f;
    const int NT = nt0 + nt1;
    const int kr0 = tid / KC, kc0 = tid % KC, kr1 = (tid + 512) / KC, kc1 = (tid + 512) % KC; const bool has1 = (tid + 512) < NKC;
    const int vdv = tid >> 3, vg = tid & 7;
    uint4 sk0, sk1 = make_uint4(0u, 0u, 0u, 0u), sv;
#define FA_GLOAD(t) do { const bf16_t* kt = ((t) < nt0) ? K0 + (size_t)(t) * 64 * ldk : K1 + (size_t)((t) - nt0) * 64 * ldk; \
        sk0 = *(const uint4*)(kt + (size_t)kr0 * ldk + kc0 * 8); if (has1) sk1 = *(const uint4*)(kt + (size_t)kr1 * ldk + kc1 * 8); \
        sv = *(const uint4*)(VT + (size_t)(t) * 4096 + tid * 8); } while (0)
#define FA_SWRITE(buf) do { *(uint4*)(smem + L::K0 + (buf) * L::KB + kr0 * L::KP + kc0 * 16) = sk0; if (has1) *(uint4*)(smem + L::K0 + (buf) * L::KB + kr1 * L::KP + kc1 * 16) = sk1; \
        *(uint4*)(smem + L::V0 + (buf) * L::VB + vdv * L::VP + vg * 16) = sv; } while (0)
    __syncthreads();
    FA_GLOAD(0); FA_SWRITE(0);
    __syncthreads();
    for (int t = 0; t < NT; ++t) {
        const int buf = t & 1;
        if (t + 1 < NT) FA_GLOAD(t + 1);
        const char* kb = smem + L::K0 + buf * L::KB + r32 * L::KP + hi * 16;
        f32x16 p0 = negm, p1 = negm;
#pragma unroll
        for (int ks = 0; ks < NKS; ++ks) {
            const bf16x8 a0 = *(const bf16x8*)(kb + ks * 32), a1 = *(const bf16x8*)(kb + 32 * L::KP + ks * 32);
            p0 = __builtin_amdgcn_mfma_f32_32x32x16_bf16(a0, qf[ks], p0, 0, 0, 0);
            p1 = __builtin_amdgcn_mfma_f32_32x32x16_bf16(a1, qf[ks], p1, 0, 0, 0);
        }
        float rm = fmaxf(p0[0], p1[0]);
#pragma unroll
        for (int r = 1; r < 16; ++r) rm = fmaxf(rm, fmaxf(p0[r], p1[r]));
        rm = xhalf_max(rm);
        const bool first = (t == 0);
        if (first || __any(rm > THR)) {
            const float dl = first ? rm : fmaxf(rm, 0.f);
            mhat += dl;
#pragma unroll
            for (int r = 0; r < 16; ++r) { p0[r] -= dl; p1[r] -= dl; negm[r] = -mhat; }
            if (!first) {
                const float f = __builtin_amdgcn_exp2f(-dl); lsum *= f;
                if (hi == 0) wsf[r32] = f;
                asm volatile("s_waitcnt lgkmcnt(0)" ::: "memory");
#pragma unroll
                for (int r = 0; r < 16; ++r) { const float fr = wsf[crow(r, hi)]; o0[r] *= fr; o1[r] *= fr; }
            }
        }
        float ps = 0.f;
#pragma unroll
        for (int r = 0; r < 16; ++r) { p0[r] = __builtin_amdgcn_exp2f(p0[r]); p1[r] = __builtin_amdgcn_exp2f(p1[r]); ps += p0[r] + p1[r]; }
        lsum += ps;
        u32x4 w0, w1, w2, w3;
        w0.x = cvtpk(p0[0], p0[1]); w0.y = cvtpk(p0[2], p0[3]); w0.z = cvtpk(p0[4], p0[5]); w0.w = cvtpk(p0[6], p0[7]);
        w1.x = cvtpk(p0[8], p0[9]); w1.y = cvtpk(p0[10], p0[11]); w1.z = cvtpk(p0[12], p0[13]); w1.w = cvtpk(p0[14], p0[15]);
        w2.x = cvtpk(p1[0], p1[1]); w2.y = cvtpk(p1[2], p1[3]); w2.z = cvtpk(p1[4], p1[5]); w2.w = cvtpk(p1[6], p1[7]);
        w3.x = cvtpk(p1[8], p1[9]); w3.y = cvtpk(p1[10], p1[11]); w3.z = cvtpk(p1[12], p1[13]); w3.w = cvtpk(p1[14], p1[15]);
        const char* vb = smem + L::V0 + buf * L::VB + r32 * L::VP + hi * 16;
#define FA_PV(W, s) do { const bf16x8 pa = __builtin_bit_cast(bf16x8, W); \
            const bf16x8 v0 = *(const bf16x8*)(vb + (s) * 32), v1 = *(const bf16x8*)(vb + 32 * L::VP + (s) * 32); \
            o0 = __builtin_amdgcn_mfma_f32_32x32x16_bf16(pa, v0, o0, 0, 0, 0); o1 = __builtin_amdgcn_mfma_f32_32x32x16_bf16(pa, v1, o1, 0, 0, 0); } while (0)
        FA_PV(w0, 0); FA_PV(w1, 1); FA_PV(w2, 2); FA_PV(w3, 3);
#undef FA_PV
        if (t + 1 < NT) FA_SWRITE(buf ^ 1);
        __syncthreads();
    }
#undef FA_GLOAD
#undef FA_SWRITE
    lsum = xhalf_sum(lsum);
    if (hi == 0) wsf[32 + r32] = lsum;
    asm volatile("s_waitcnt lgkmcnt(0)" ::: "memory");
    bf16_t* stg = (bf16_t*)(smem + L::OST) + wid * 2048;
#pragma unroll
    for (int r = 0; r < 16; ++r) { const int orow = crow(r, hi); const float rl = 1.f / wsf[32 + orow]; stg[orow * 64 + r32] = f2bf(o0[r] * rl); stg[orow * 64 + 32 + r32] = f2bf(o1[r] * rl); }
    asm volatile("s_waitcnt lgkmcnt(0)" ::: "memory");
#pragma unroll
    for (int i = 0; i < 4; ++i) { const int row = i * 8 + (lane >> 3), ch = lane & 7; const u32x4 v = *(const u32x4*)(stg + row * 64 + ch * 8); *(u32x4*)(O + (size_t)(wid * 32 + row) * ldo + ch * 8) = v; }
}
}


namespace na {
using fa::bf16x8; using fa::f32x16; using fa::u32x4; using fa::crow; using fa::cvtpk; using fa::xhalf_max; using fa::xhalf_sum;
constexpr int KP = 144, KB = 64 * KP, VP = 136, VB = 64 * VP, K0 = 0, V0 = 2 * KB, WSF = V0 + 2 * VB, OST = WSF + 2048, TBL = OST + 8 * 4096, BYTES = TBL + 17 * 64 * 4;
__device__ __forceinline__ int clampi(int v, int lo, int hi) { return v < lo ? lo : (v > hi ? hi : v); }
__device__ __forceinline__ void na_unit(char* smem, bool ctxu, int b, int h, int g, const bf16_t* P, const bf16_t* NVT, const float* rpb, bf16_t* MIX) {
    constexpr float THR = 8.f, NEG = -1e30f;
    const int tid = tid_(), lane = tid & 63, r32 = lane & 31, hi = lane >> 5; const int wid = __builtin_amdgcn_readfirstlane(tid >> 6);
    float* wsf = (float*)(smem + WSF) + wid * 64; float* tb = (float*)(smem + TBL);
    const int pr = wid >> 2, cbk = (wid & 3) * 16, kc0 = clampi(cbk - 8, 0, 32);
    const int qr = 4 * g + 2 * pr + (r32 >> 4), qc = cbk + (r32 & 15);
    const size_t qrow = ctxu ? (size_t)NLAT + b * CTXL + wid * 32 + r32 : (size_t)b * SEQ + qr * 64 + qc;
    bf16x8 qf[4];
#pragma unroll
    for (int ks = 0; ks < 4; ++ks) qf[ks] = *(const bf16x8*)(P + qrow * LDP + PC_NQ + h * 64 + ks * 16 + hi * 8);
    const int r0q = clampi(qr - 4, 0, 120), c0q = clampi(qc - 8, 0, 48);
    const int cbase = kc0 + 4 * hi - c0q, bidx = kc0 + 4 * hi - qc + 15 + 16;
    const int ra = 4 * g + 2 * pr, wlo = clampi(ra - 4, 0, 120), whi = clampi(ra - 3, 0, 120) + 8;
    const int krU = clampi(4 * g - 4, 0, 117);
    const int NL = ctxu ? 0 : 11, NT = NL + 4;
    f32x16 o0, o1, negm;
#pragma unroll
    for (int r = 0; r < 16; ++r) { o0[r] = 0.f; o1[r] = 0.f; negm[r] = 0.f; }
    float mhat = 0.f, lsum = 0.f; bool first = true;
    const size_t vt_base = (size_t)(b * 8 + h) * 132 * 4096;
    const int skr = tid >> 3, skc = tid & 7;
    uint4 sk, sv;
#define NA_GLOAD(t) do { const size_t krow = (t) < NL ? (size_t)b * SEQ + (size_t)(krU + (t)) * 64 : (size_t)NLAT + b * CTXL + ((t) - NL) * 64; const int vtile = (t) < NL ? krU + (t) : 128 + ((t) - NL); \
        sk = *(const uint4*)(P + (krow + skr) * LDP + PC_NK + h * 64 + skc * 8); sv = *(const uint4*)(NVT + vt_base + (size_t)vtile * 4096 + tid * 8); } while (0)
#define NA_SWRITE(buf) do { *(uint4*)(smem + K0 + (buf) * KB + skr * KP + skc * 16) = sk; uint2* vd = (uint2*)(smem + V0 + (buf) * VB + skr * VP + skc * 16); vd[0] = make_uint2(sv.x, sv.y); vd[1] = make_uint2(sv.z, sv.w); } while (0)
    __syncthreads();
    if (!ctxu) for (int idx = tid; idx < 17 * 64; idx += 512) { const int dr = (idx >> 6) - 8, dci = (idx & 63) - 16; tb[idx] = (dr >= -7 && dr <= 7 && dci >= 0 && dci <= 30) ? rpb[(dr + 7) * 31 + dci] * 1.4426950408889634f : 0.f; }
    NA_GLOAD(0); NA_SWRITE(0);
    __syncthreads();
#define NA_BLOCK(koff, MASKED, kr) do { \
        const char* kb = smem + K0 + buf * KB + ((koff) + r32) * KP + hi * 16; \
        f32x16 p = negm; \
        _Pragma("unroll") for (int ks = 0; ks < 4; ++ks) { const bf16x8 a = *(const bf16x8*)(kb + ks * 32); p = __builtin_amdgcn_mfma_f32_32x32x16_bf16(a, qf[ks], p, 0, 0, 0); } \
        if (MASKED) { const bool rowok = (unsigned)((kr) - r0q) < 8u; const float* tbr = tb + ((kr) - qr + 8) * 64 + bidx; \
            _Pragma("unroll") for (int r = 0; r < 16; ++r) { const int cst = (r & 3) + 8 * (r >> 2); const bool ok = rowok && (unsigned)(cbase + cst) < 16u; p[r] = ok ? p[r] + tbr[cst] : NEG; } } \
        float rm = p[0]; \
        _Pragma("unroll") for (int r = 1; r < 16; ++r) rm = fmaxf(rm, p[r]); \
        rm = xhalf_max(rm); \
        if (first || __any(rm > THR)) { \
            const float dl = first ? (rm > -1e29f ? rm : 0.f) : fmaxf(rm, 0.f); \
            mhat += dl; \
            _Pragma("unroll") for (int r = 0; r < 16; ++r) { p[r] -= dl; negm[r] = -mhat; } \
            if (!first) { const float f = __builtin_amdgcn_exp2f(-dl); lsum *= f; if (hi == 0) wsf[r32] = f; asm volatile("s_waitcnt lgkmcnt(0)" ::: "memory"); \
                _Pragma("unroll") for (int r = 0; r < 16; ++r) { const float fr = wsf[crow(r, hi)]; o0[r] *= fr; o1[r] *= fr; } } \
            first = false; } \
        float ps = 0.f; \
        _Pragma("unroll") for (int r = 0; r < 16; ++r) { p[r] = __builtin_amdgcn_exp2f(p[r]); ps += p[r]; } \
        lsum += ps; \
        u32x4 w0, w1; \
        w0.x = cvtpk(p[0], p[1]); w0.y = cvtpk(p[2], p[3]); w0.z = cvtpk(p[4], p[5]); w0.w = cvtpk(p[6], p[7]); \
        w1.x = cvtpk(p[8], p[9]); w1.y = cvtpk(p[10], p[11]); w1.z = cvtpk(p[12], p[13]); w1.w = cvtpk(p[14], p[15]); \
        const char* vb = smem + V0 + buf * VB + r32 * VP + ((koff) + 4 * hi) * 2; \
        { const bf16x8 pa = __builtin_bit_cast(bf16x8, w0); const uint2 a0 = *(const uint2*)(vb), a1 = *(const uint2*)(vb + 16), b0 = *(const uint2*)(vb + 32 * VP), b1 = *(const uint2*)(vb + 32 * VP + 16); \
          const bf16x8 v0 = __builtin_bit_cast(bf16x8, make_uint4(a0.x, a0.y, a1.x, a1.y)), v1 = __builtin_bit_cast(bf16x8, make_uint4(b0.x, b0.y, b1.x, b1.y)); \
          o0 = __builtin_amdgcn_mfma_f32_32x32x16_bf16(pa, v0, o0, 0, 0, 0); o1 = __builtin_amdgcn_mfma_f32_32x32x16_bf16(pa, v1, o1, 0, 0, 0); } \
        { const bf16x8 pa = __builtin_bit_cast(bf16x8, w1); const uint2 a0 = *(const uint2*)(vb + 32), a1 = *(const uint2*)(vb + 48), b0 = *(const uint2*)(vb + 32 * VP + 32), b1 = *(const uint2*)(vb + 32 * VP + 48); \
          const bf16x8 v0 = __builtin_bit_cast(bf16x8, make_uint4(a0.x, a0.y, a1.x, a1.y)), v1 = __builtin_bit_cast(bf16x8, make_uint4(b0.x, b0.y, b1.x, b1.y)); \
          o0 = __builtin_amdgcn_mfma_f32_32x32x16_bf16(pa, v0, o0, 0, 0, 0); o1 = __builtin_amdgcn_mfma_f32_32x32x16_bf16(pa, v1, o1, 0, 0, 0); } \
    } while (0)
    for (int t = 0; t < NT; ++t) {
        const int buf = t & 1;
        if (t + 1 < NT) NA_GLOAD(t + 1);
        if (t < NL) { const int kr = krU + t; if (kr >= wlo && kr < whi) NA_BLOCK(kc0, true, kr); }
        else { NA_BLOCK(0, false, 0); NA_BLOCK(32, false, 0); }
        if (t + 1 < NT) NA_SWRITE(buf ^ 1);
        __syncthreads();
    }
#undef NA_BLOCK
#undef NA_GLOAD
#undef NA_SWRITE
    lsum = xhalf_sum(lsum);
    if (hi == 0) wsf[32 + r32] = lsum;
    asm volatile("s_waitcnt lgkmcnt(0)" ::: "memory");
    bf16_t* stg = (bf16_t*)(smem + OST) + wid * 2048;
#pragma unroll
    for (int r = 0; r < 16; ++r) { const int orow = crow(r, hi); const float rl = 1.f / wsf[32 + orow]; stg[orow * 64 + r32] = f2bf(o0[r] * rl); stg[orow * 64 + 32 + r32] = f2bf(o1[r] * rl); }
    asm volatile("s_waitcnt lgkmcnt(0)" ::: "memory");
#pragma unroll
    for (int i = 0; i < 4; ++i) { const int q = i * 8 + (lane >> 3), ch = lane & 7; const u32x4 v = *(const u32x4*)(stg + q * 64 + ch * 8);
        const size_t orow = ctxu ? (size_t)NLAT + b * CTXL + wid * 32 + q : (size_t)b * SEQ + (size_t)(4 * g + 2 * pr + (q >> 4)) * 64 + cbk + (q & 15);
        *(u32x4*)(MIX + orow * DM + 256 + h * 64 + ch * 8) = v; }
}
}

#ifndef PHASE_INLINE
#define PHASE_INLINE __forceinline__
#endif
template <int KIND> __device__ PHASE_INLINE void phase(const Params& p, const int l, char* smem) {
    __syncthreads();
    const int tid = tid_(), lane = tid & 63, wid = tid >> 6;
    const int nblk = gridDim.x, bid = bid_();
    unsigned char* ws = p.ws; asm volatile("" : "+s"(ws));
    float* MOD = (float*)(ws + WS_MOD);
    bf16_t* U = (bf16_t*)(ws + WS_U);
    bf16_t* P = (bf16_t*)(ws + WS_P);
    bf16_t* QM = (bf16_t*)(ws + WS_QM);
    bf16_t* KM = (bf16_t*)(ws + WS_KM);
    bf16_t* VM = (bf16_t*)(ws + WS_VM);
    float* RKV = (float*)(ws + WS_RKV);
    bf16_t* XS = (bf16_t*)(ws + WS_XS);
    bf16_t* HDN = (bf16_t*)(ws + WS_HDN);
    int2* RTE = (int2*)(ws + WS_RT + RT_E);
    float2* RTW = (float2*)(ws + WS_RT + RT_W);
    float* RTR = (float*)(ws + WS_RT + RT_RSTD);
    int2* RTS = (int2*)(ws + WS_RT + RT_SLOT);
    int* CNT = (int*)(ws + WS_RT + RT_CNT);
    int* SEG = (int*)(ws + WS_RT + RT_SEG);
    int* TILE = (int*)(ws + WS_RT + RT_TILE);
    bf16_t* VT = (bf16_t*)(ws + WS_VT);
    bf16_t* NVT = (bf16_t*)(ws + WS_NVT);
    bf16_t* WT = (bf16_t*)(ws + WS_WT);
    PG8_LAS unsigned char* lds3 = (PG8_LAS unsigned char*)smem;
    float* const Hlat = p.out; float* const Hctx = (float*)(ws + WS_HC);

    if constexpr (KIND == 0) {
        float* sc = (float*)smem;
        for (int i = tid; i < 5 * DM; i += 512) { const int v = i / DM, k = i % DM; const float x = v < 4 ? p.in[I_C][v * DM + k] : p.in[I_CCTX][k]; sc[i] = silu_f(x); }
        __syncthreads();
        for (int idx = bid * 512 + tid; idx < 2 * 6144; idx += nblk * 512) {
            const int l = idx / 6144, j = idx % 6144;
            const float* wm = p.in[I_WMOD] + (size_t)l * DM * 6144 + j;
            float a0 = 0.f, a1 = 0.f, a2 = 0.f, a3 = 0.f, a4 = 0.f;
            for (int k = 0; k < DM; ++k) { const float w = wm[(size_t)k * 6144]; a0 = fmaf(sc[k], w, a0); a1 = fmaf(sc[DM + k], w, a1); a2 = fmaf(sc[2 * DM + k], w, a2); a3 = fmaf(sc[3 * DM + k], w, a3); a4 = fmaf(sc[4 * DM + k], w, a4); }
            const float bm = p.in[I_BMOD][l * 6144 + j];
            float* mo = MOD + (size_t)l * 5 * 6144 + j;
            mo[0] = a0 + bm; mo[6144] = a1 + bm; mo[2 * 6144] = a2 + bm; mo[3 * 6144] = a3 + bm; mo[4 * 6144] = a4 + bm;
        }
        const float4* xs = (const float4*)p.in[I_X]; float4* xo = (float4*)p.out;
        for (size_t i = (size_t)bid * 512 + tid; i < (size_t)NLAT * DM / 4; i += (size_t)nblk * 512) xo[i] = xs[i];
        const float4* cs = (const float4*)p.in[I_CTX]; float4* co = (float4*)(ws + WS_HC);
        for (size_t i = (size_t)bid * 512 + tid; i < (size_t)NCTX * DM / 4; i += (size_t)nblk * 512) co[i] = cs[i];
        {
            float* tl = (float*)smem; int base = 0;
            for (int ll = 0; ll < 2; ++ll) {
                transpose_mat(tl, p.in[I_WIN] + (size_t)ll * DM * DPROJ, DM, DPROJ, 3328, WT + WT_IN + ll * WT_IN_L, 1, 0, base);
                transpose_mat(tl, p.in[I_WUQ] + (size_t)ll * 384 * 384, 384, 384, 512, WT + WT_UQ + ll * WT_UQ_L, 1, 0, base);
                transpose_mat(tl, p.in[I_WUKV] + (size_t)ll * 256 * 512, 256, 512, 512, WT + WT_UKV + ll * WT_UKV_L, 1, 0, base);
                transpose_mat(tl, p.in[I_WOUT] + (size_t)ll * DM * DM, DM, DM, DM, WT + WT_OUT + ll * WT_OUT_L, 1, 0, base);
                for (int e = 0; e < NE; ++e) {
                    transpose_mat(tl, p.in[I_W1] + ((size_t)ll * NE + e) * DM * FF, DM, FF, FF, WT + WT_13 + ll * WT_13_L + (size_t)e * 512 * 1024, 2, 0, base);
                    transpose_mat(tl, p.in[I_W3] + ((size_t)ll * NE + e) * DM * FF, DM, FF, FF, WT + WT_13 + ll * WT_13_L + (size_t)e * 512 * 1024, 2, 1, base);
                    transpose_mat(tl, p.in[I_W2] + ((size_t)ll * NE + e) * FF * DM, FF, DM, DM, WT + WT_2 + ll * WT_2_L + (size_t)e * 1024 * 256, 1, 0, base);
                }
            }
        }
    }

    {
        const bool last = (l == 1);
        const float* modl = MOD + (size_t)l * 5 * 6144;
        const int rows_mix = last ? NLAT : NROW;

        if constexpr (KIND == 1) {
            const float* g = p.in[I_N1G] + l * DM;
            for (int row = bid * 8 + wid; row < NROW; row += nblk * 8) {
                const float* h = hrow2(Hlat, Hctx, row); const float* mv = modl + row_modv(row) * 6144;
                float4 x[4]; float ss = 0.f;
#pragma unroll
                for (int i = 0; i < 4; ++i) { x[i] = *(const float4*)(h + lane * 4 + 256 * i); ss += x[i].x * x[i].x + x[i].y * x[i].y + x[i].z * x[i].z + x[i].w * x[i].w; }
                ss = wave_sum(ss);
                const float rstd = rsqrtf(ss * (1.f / DM) + 1e-6f);
#pragma unroll
                for (int i = 0; i < 4; ++i) {
                    const int c = lane * 4 + 256 * i;
                    const float4 gg = *(const float4*)(g + c), sh = *(const float4*)(mv + c), sc = *(const float4*)(mv + 1024 + c);
                    const float y0 = x[i].x * rstd * gg.x * (1.f + sc.x) + sh.x, y1 = x[i].y * rstd * gg.y * (1.f + sc.y) + sh.y;
                    const float y2 = x[i].z * rstd * gg.z * (1.f + sc.z) + sh.z, y3 = x[i].w * rstd * gg.w * (1.f + sc.w) + sh.w;
                    uint2 o; o.x = (unsigned)f2bf(y0) | ((unsigned)f2bf(y1) << 16); o.y = (unsigned)f2bf(y2) | ((unsigned)f2bf(y3) << 16);
                    *(uint2*)(U + (size_t)row * DM + c) = o;
                }
            }
        }
        if constexpr (KIND == 2) {
            pg8::Gemm g{U, WT + WT_IN + l * WT_IN_L, DM, DM, DM}; pg8::StaticOrder S; S.init(NROW, 3328, nblk, bid);
            pg8::EpiP E{P, LDP};
            pg8::gemm_phase<pg8::EpiP, pg8::StaticOrder, true, true>(lds3, g, S, E);
        }
        if constexpr (KIND == 3) {
            const float* qn = p.in[I_QN] + l * 384; const float* kvn = p.in[I_KVN] + l * 256;
            for (int row = bid * 8 + wid; row < NROW; row += nblk * 8) {
                bf16_t* pr = P + (size_t)row * LDP;
                const bool lat = row < NLAT; const int tt = row & (SEQ - 1);
                const float posr = (float)(tt >> 6), posc = (float)(tt & 63);
#pragma unroll
                for (int i = 0; i < 4; ++i) {
                    const int pi = lane + 64 * i, arr = pi >> 7, hd = (pi >> 5) & 3, pp = pi & 31, sec = pp >> 4, ii = pp & 15;
                    bf16_t* b = pr + (arr ? PC_RK : PC_RQ) + hd * 64 + sec * 32 + ii;
                    float x1 = bf2f(b[0]), x2 = bf2f(b[16]);
                    if (lat) rope_pair(x1, x2, sec ? posc : posr, ii, 16);
                    if (!arr) { x1 *= 0.125f; x2 *= 0.125f; }
                    b[0] = f2bf(x1); b[16] = f2bf(x2);
                }
                if (lat && lane < 16) {
                    const int sec = lane >> 3, ii = lane & 7;
                    bf16_t* b = pr + PC_KPE + sec * 16 + ii;
                    float x1 = bf2f(b[0]), x2 = bf2f(b[8]);
                    rope_pair(x1, x2, sec ? posc : posr, ii, 8);
                    b[0] = f2bf(x1); b[8] = f2bf(x2);
                }
#pragma unroll
                for (int i = 0; i < 8; ++i) { bf16_t* b = pr + PC_NQ + lane + 64 * i; *b = f2bf(bf2f(*b) * (0.125f * 1.4426950408889634f)); }
                {
                    float v[6]; float ss = 0.f;
#pragma unroll
                    for (int i = 0; i < 6; ++i) { v[i] = bf2f(pr[PC_CQ + lane + 64 * i]); ss += v[i] * v[i]; }
                    ss = wave_sum(ss); const float rs = rsqrtf(ss * (1.f / 384.f) + 1e-6f);
#pragma unroll
                    for (int i = 0; i < 6; ++i) pr[PC_CQ + lane + 64 * i] = f2bf(v[i] * rs * qn[lane + 64 * i]);
                    float w[4]; float s2 = 0.f;
#pragma unroll
                    for (int i = 0; i < 4; ++i) { w[i] = bf2f(pr[PC_CKV + lane + 64 * i]); s2 += w[i] * w[i]; }
                    s2 = wave_sum(s2); const float rs2 = rsqrtf(s2 * (1.f / 256.f) + 1e-6f);
#pragma unroll
                    for (int i = 0; i < 4; ++i) pr[PC_CKV + lane + 64 * i] = f2bf(w[i] * rs2 * kvn[lane + 64 * i]);
                }
            }
            {
                bf16_t* tl = (bf16_t*)smem;
                for (int it = bid; it < 32 * 132; it += nblk) {
                    const int bh = it / 132, tile = it % 132, b = bh >> 3, hd = bh & 7;
                    const size_t row0 = tile < 128 ? (size_t)b * SEQ + tile * 64 : (size_t)NLAT + b * CTXL + (tile - 128) * 64;
                    __syncthreads();
                    { const int r = tid >> 3, d8 = (tid & 7) * 8; const uint4 v = *(const uint4*)(P + (row0 + r) * LDP + PC_NV + hd * 64 + d8);
                      unsigned* d = (unsigned*)(tl + r * 66 + d8); d[0] = v.x; d[1] = v.y; d[2] = v.z; d[3] = v.w; }
                    __syncthreads();
                    { const int dv = tid >> 3, g = tid & 7, s4 = g >> 1, hh = g & 1; unsigned short e[8];
#pragma unroll
                      for (int j = 0; j < 8; ++j) e[j] = tl[(8 * g + j) * 66 + dv];
                      uint4 o; o.x = e[0] | ((unsigned)e[1] << 16); o.y = e[2] | ((unsigned)e[3] << 16); o.z = e[4] | ((unsigned)e[5] << 16); o.w = e[6] | ((unsigned)e[7] << 16);
                      *(uint4*)(NVT + ((size_t)it * 64 + dv) * 64 + g * 8) = o; }
                }
                __syncthreads();
            }
        }
        if constexpr (KIND == 14) {
            pg8::Gemm g{P + PC_CKV, WT + WT_UKV + l * WT_UKV_L, LDP, 256, 256}; pg8::StaticOrder S; S.init(NROW, 512, nblk, bid);
            pg8::EpiUKV E{KM, VM};
            pg8::gemm_phase<pg8::EpiUKV, pg8::StaticOrder, true, true>(lds3, g, S, E);
        }
        if constexpr (KIND == 4) {
            {
                pg8::Gemm g{P + PC_CQ, WT + WT_UQ + l * WT_UQ_L, LDP, 384, 384}; pg8::StaticOrder S; S.init(NROW, 512, nblk, bid);
                pg8::EpiUQ E{QM};
                pg8::gemm_phase<pg8::EpiUQ, pg8::StaticOrder, true, true>(lds3, g, S, E);
            }
            __syncthreads();
            float* Ks = (float*)smem; float* Vs = Ks + 128 * 64; float* pwf = Vs + 128 * 64; float* pwb = pwf + 132;
            for (int it = bid; it < RET_ITEMS; it += nblk) {
                int b, hd, j, row0;
                if (it < 1024) { b = it >> 8; hd = (it >> 6) & 3; j = it & 63; row0 = b * SEQ + j * 128; } else { const int q = it - 1024; b = q >> 3; hd = (q >> 1) & 3; j = q & 1; row0 = NLAT + b * CTXL + j * 128; }
                const float lgf = log_sigmoid_f(p.in[I_RDF][l * 4 + hd]), lgb = log_sigmoid_f(p.in[I_RDB][l * 4 + hd]);
                __syncthreads();
                for (int idx = tid; idx < 128 * 64; idx += 512) { const int r = idx >> 6, c = idx & 63; const bf16_t* pr = P + (size_t)(row0 + r) * LDP + hd * 64 + c; Ks[idx] = bf2f(pr[PC_RK]); Vs[idx] = bf2f(pr[PC_RV]); }
                if (tid < 129) { pwf[tid] = expf(lgf * (float)tid); pwb[tid] = expf(lgb * (float)tid); }
                __syncthreads();
                const int d = tid >> 3, e0 = (tid & 7) * 8;
                float af[8], ab[8];
#pragma unroll
                for (int e = 0; e < 8; ++e) { af[e] = 0.f; ab[e] = 0.f; }
                for (int i = 0; i < 128; ++i) {
                    const float kd = Ks[i * 64 + d], wf = pwf[127 - i] * kd, wb = pwb[i] * kd;
#pragma unroll
                    for (int e = 0; e < 8; ++e) { const float v = Vs[i * 64 + e0 + e]; af[e] = fmaf(wf, v, af[e]); ab[e] = fmaf(wb, v, ab[e]); }
                }
                float* of = RKV + ((size_t)it * 2 + 0) * 4096 + d * 64 + e0; float* ob = RKV + ((size_t)it * 2 + 1) * 4096 + d * 64 + e0;
#pragma unroll
                for (int e = 0; e < 8; ++e) { of[e] = af[e]; ob[e] = ab[e]; }
            }
        }
        if constexpr (KIND == 5) {
            for (int row = bid * 8 + wid; row < NROW; row += nblk * 8) {
                const bool lat = row < NLAT; const int tt = row & (SEQ - 1);
                const float posr = (float)(tt >> 6), posc = (float)(tt & 63);
                const float scq = 0.10206207261596577f * 1.4426950408889634f;
                {
                    const int hd = lane >> 4, pp = lane & 15, sec = pp >> 3, ii = pp & 7;
                    bf16_t* b = QM + (size_t)row * 384 + hd * 96 + 64 + sec * 16 + ii;
                    float x1 = bf2f(b[0]), x2 = bf2f(b[8]);
                    if (lat) rope_pair(x1, x2, sec ? posc : posr, ii, 8);
                    b[0] = f2bf(x1 * scq); b[8] = f2bf(x2 * scq);
                }
#pragma unroll
                for (int i = 0; i < 4; ++i) { const int q = lane + 64 * i, hd = q >> 6, c = q & 63; bf16_t* b = QM + (size_t)row * 384 + hd * 96 + c; *b = f2bf(bf2f(*b) * scq); }
#pragma unroll
                for (int i = 0; i < 2; ++i) { const int q = lane + 64 * i, hd = q >> 5, c = q & 31; KM[(size_t)row * 384 + hd * 96 + 64 + c] = P[(size_t)row * LDP + PC_KPE + c]; }
            }
            {
                bf16_t* tl = (bf16_t*)smem;
                for (int it = bid; it < 16 * 132; it += nblk) {
                    const int bh = it / 132, tile = it % 132, b = bh >> 2, hd = bh & 3;
                    const size_t row0 = tile < 128 ? (size_t)b * SEQ + tile * 64 : (size_t)NLAT + b * CTXL + (tile - 128) * 64;
                    __syncthreads();
                    { const int r = tid >> 3, d8 = (tid & 7) * 8; const uint4 v = *(const uint4*)(VM + (row0 + r) * 256 + hd * 64 + d8);
                      unsigned* d = (unsigned*)(tl + r * 66 + d8); d[0] = v.x; d[1] = v.y; d[2] = v.z; d[3] = v.w; }
                    __syncthreads();
                    { const int dv = tid >> 3, g = tid & 7, s4 = g >> 1, hh = g & 1; unsigned short e[8];
#pragma unroll
                      for (int j = 0; j < 8; ++j) e[j] = tl[(16 * s4 + 8 * (j >> 2) + 4 * hh + (j & 3)) * 66 + dv];
                      uint4 o; o.x = e[0] | ((unsigned)e[1] << 16); o.y = e[2] | ((unsigned)e[3] << 16); o.z = e[4] | ((unsigned)e[5] << 16); o.w = e[6] | ((unsigned)e[7] << 16);
                      *(uint4*)(VT + ((size_t)it * 64 + dv) * 64 + g * 8) = o; }
                }
                __syncthreads();
            }
            for (int gid = bid * 512 + tid; gid < 2 * 16 * 4096; gid += nblk * 512) {
                const int el = gid & 4095, bh = (gid >> 12) & 15, dir = gid >> 16, hd = bh & 3;
                const float lg = log_sigmoid_f(dir ? p.in[I_RDB][l * 4 + hd] : p.in[I_RDF][l * 4 + hd]);
                const float g128 = expf(128.f * lg);
                float* c0p = RKV + ((size_t)(1024 + bh * 2 + 0) * 2 + dir) * 4096 + el;
                float* c1p = RKV + ((size_t)(1024 + bh * 2 + 1) * 2 + dir) * 4096 + el;
                const float c0 = *c0p, c1 = *c1p; float S;
                if (dir == 0) { *c0p = 0.f; *c1p = c0; S = g128 * c0 + c1; } else { *c1p = 0.f; *c0p = c1; S = g128 * c1 + c0; }
                for (int jj = 0; jj < 64; ++jj) {
                    const int j = dir ? 63 - jj : jj;
                    float* q = RKV + ((size_t)(bh * 64 + j) * 2 + dir) * 4096 + el;
                    const float tmp = *q; *q = S; S = fmaf(g128, S, tmp);
                }
            }
        }
        if constexpr (KIND == 6) {
            bf16_t* MIX = U;
            {
                const int n_mla = 512 + (last ? 0 : 16);
                for (int it = bid; it < n_mla; it += nblk) {
                    const bool cu = it >= 512; const int bh = cu ? it - 512 : it >> 5, qb = it & 31, b = bh >> 2, hd = bh & 3;
                    const size_t cr0 = (size_t)NLAT + b * CTXL, kr0 = (size_t)b * SEQ, r0 = cu ? cr0 : kr0 + qb * 256;
                    const bf16_t* k0 = KM + (cu ? cr0 : kr0) * 384 + hd * 96; const bf16_t* k1 = KM + cr0 * 384 + hd * 96;
                    fa::attn_unit<96>(smem, QM + r0 * 384 + hd * 96, 384, k0, cu ? 4 : 128, k1, cu ? 0 : 4, 384, VT + ((size_t)bh * 132 + (cu ? 128 : 0)) * 4096, MIX + r0 * DM + 768 + hd * 64, DM);
                }
            }
        }
        if constexpr (KIND == 15) {
            bf16_t* MIX = U;
            {
                const int n_na = 1024 + (last ? 0 : 32);
                for (int it = bid; it < n_na; it += nblk) {
                    const bool cu = it >= 1024; const int bh = cu ? it - 1024 : it >> 5, g = cu ? 0 : it & 31;
                    na::na_unit(smem, cu, bh >> 3, bh & 7, g, P, NVT, p.in[I_RPB] + ((size_t)l * 8 + (bh & 7)) * 465, MIX);
                }
                __syncthreads();
            }
        }
        if constexpr (KIND == 16) {
            bf16_t* MIX = U;
            {
                float* Ks = (float*)smem; float* Vs = Ks + 128 * 64; float* Sf = Vs + 128 * 64; float* Sb = Sf + 4096; float* pwf = Sb + 4096; float* pwb = pwf + 132; float* Qs = pwb + 132;
                const int n_it = last ? 1024 : RET_ITEMS;
                for (int it = bid; it < n_it; it += nblk) {
                    int b, hd, j, row0;
                    if (it < 1024) { b = it >> 8; hd = (it >> 6) & 3; j = it & 63; row0 = b * SEQ + j * 128; } else { const int q = it - 1024; b = q >> 3; hd = (q >> 1) & 3; j = q & 1; row0 = NLAT + b * CTXL + j * 128; }
                    const float lgf = log_sigmoid_f(p.in[I_RDF][l * 4 + hd]), lgb = log_sigmoid_f(p.in[I_RDB][l * 4 + hd]);
                    __syncthreads();
                    for (int idx = tid; idx < 128 * 64; idx += 512) { const int r = idx >> 6, c = idx & 63; const bf16_t* pr = P + (size_t)(row0 + r) * LDP + hd * 64 + c; Ks[idx] = bf2f(pr[PC_RK]); Vs[idx] = bf2f(pr[PC_RV]); Qs[r * 68 + c] = bf2f(pr[PC_RQ]); }
                    for (int idx = tid; idx < 4096; idx += 512) { Sf[idx] = RKV[((size_t)it * 2 + 0) * 4096 + idx]; Sb[idx] = RKV[((size_t)it * 2 + 1) * 4096 + idx]; }
                    if (tid < 129) { pwf[tid] = expf(lgf * (float)tid); pwb[tid] = expf(lgb * (float)tid); }
                    __syncthreads();
                    const int i = tid >> 2, part = tid & 3, row = row0 + i;
                    const float* qp = Qs + i * 68;
                    float acc[16];
#pragma unroll
                    for (int e = 0; e < 16; ++e) acc[e] = 0.f;
#pragma unroll 1
                    for (int m = 0; m < 128; ++m) {
                        float s = 0.f;
#pragma unroll 4
                        for (int d = 0; d < 64; d += 4) { const float4 kv = *(const float4*)&Ks[m * 64 + d]; const float4 qv = *(const float4*)&qp[d]; s = fmaf(qv.x, kv.x, s); s = fmaf(qv.y, kv.y, s); s = fmaf(qv.z, kv.z, s); s = fmaf(qv.w, kv.w, s); }
                        const float w = (m <= i) ? pwf[i - m] : pwb[m - i];
                        s *= w;
#pragma unroll
                        for (int e = 0; e < 16; e += 4) { const float4 vv = *(const float4*)&Vs[m * 64 + part * 16 + e]; acc[e] = fmaf(s, vv.x, acc[e]); acc[e + 1] = fmaf(s, vv.y, acc[e + 1]); acc[e + 2] = fmaf(s, vv.z, acc[e + 2]); acc[e + 3] = fmaf(s, vv.w, acc[e + 3]); }
                    }
                    const float cf = pwf[i + 1], cb = pwb[128 - i];
#pragma unroll 1
                    for (int d = 0; d < 64; ++d) {
                        const float qd = qp[d], qf = qd * cf, qb = qd * cb;
#pragma unroll
                        for (int e = 0; e < 16; e += 4) {
                            const float4 sf = *(const float4*)&Sf[d * 64 + part * 16 + e], sb = *(const float4*)&Sb[d * 64 + part * 16 + e];
                            acc[e] = fmaf(qf, sf.x, fmaf(qb, sb.x, acc[e])); acc[e + 1] = fmaf(qf, sf.y, fmaf(qb, sb.y, acc[e + 1]));
                            acc[e + 2] = fmaf(qf, sf.z, fmaf(qb, sb.z, acc[e + 2])); acc[e + 3] = fmaf(qf, sf.w, fmaf(qb, sb.w, acc[e + 3]));
                        }
                    }
                    float sm = 0.f;
#pragma unroll
                    for (int e = 0; e < 16; ++e) sm += acc[e];
                    sm += xor1_f(sm); sm += xor2_f(sm);
                    const float mu = sm * (1.f / 64.f);
                    float vr = 0.f;
#pragma unroll
                    for (int e = 0; e < 16; ++e) { const float dd = acc[e] - mu; vr += dd * dd; }
                    vr += xor1_f(vr); vr += xor2_f(vr);
                    const float rs = rsqrtf(vr * (1.f / 64.f) + 1e-6f);
#pragma unroll
                    for (int e = 0; e < 16; ++e) {
                        const float gg = bf2f(P[(size_t)row * LDP + PC_RG + hd * 64 + part * 16 + e]);
                        MIX[(size_t)row * DM + hd * 64 + part * 16 + e] = f2bf((acc[e] - mu) * rs * silu_f(gg));
                    }
                }
            }
        }
        if constexpr (KIND == 7) {
            pg8::Gemm g{U, WT + WT_OUT + l * WT_OUT_L, DM, DM, DM}; pg8::StaticOrder S; S.init(rows_mix, DM, nblk, bid);
            pg8::EpiOut E{Hlat, Hctx, modl + 2048};
            pg8::gemm_phase<pg8::EpiOut, pg8::StaticOrder, true, true>(lds3, g, S, E);
        }
        if constexpr (KIND == 8) {
            const float* g = p.in[I_N2G] + l * DM; const float* rw = p.in[I_RW]; const float* rb = p.in[I_RB];
            int* hist = (int*)smem;
            const int nch = rows_mix / NCHUNK_TOK;
            for (int ch = bid; ch < nch; ch += nblk) {
                __syncthreads();
                if (tid < 16) hist[tid] = 0;
                __syncthreads();
                for (int i = wid; i < NCHUNK_TOK; i += 8) {
                    const int row = ch * NCHUNK_TOK + i;
                    const float* h = hrow2(Hlat, Hctx, row); const float* mv = modl + row_modv(row) * 6144;
                    float4 x[4]; float ss = 0.f;
#pragma unroll
                    for (int k = 0; k < 4; ++k) { x[k] = *(const float4*)(h + lane * 4 + 256 * k); ss += x[k].x * x[k].x + x[k].y * x[k].y + x[k].z * x[k].z + x[k].w * x[k].w; }
                    ss = wave_sum(ss);
                    const float rstd = rsqrtf(ss * (1.f / DM) + 1e-6f);
                    float lg[16];
#pragma unroll
                    for (int e = 0; e < 16; ++e) lg[e] = 0.f;
#pragma unroll
                    for (int k = 0; k < 4; ++k) {
                        const int c = lane * 4 + 256 * k;
                        const float4 gg = *(const float4*)(g + c), sh = *(const float4*)(mv + 3072 + c), sc = *(const float4*)(mv + 4096 + c);
                        const float u0 = x[k].x * rstd * gg.x * (1.f + sc.x) + sh.x, u1 = x[k].y * rstd * gg.y * (1.f + sc.y) + sh.y;
                        const float u2 = x[k].z * rstd * gg.z * (1.f + sc.z) + sh.z, u3 = x[k].w * rstd * gg.w * (1.f + sc.w) + sh.w;
#pragma unroll
                        for (int e4 = 0; e4 < 4; ++e4) {
                            const float4 w0 = *(const float4*)(rw + (size_t)(c + 0) * 16 + e4 * 4), w1 = *(const float4*)(rw + (size_t)(c + 1) * 16 + e4 * 4);
                            const float4 w2 = *(const float4*)(rw + (size_t)(c + 2) * 16 + e4 * 4), w3 = *(const float4*)(rw + (size_t)(c + 3) * 16 + e4 * 4);
                            lg[e4 * 4 + 0] += u0 * w0.x + u1 * w1.x + u2 * w2.x + u3 * w3.x;
                            lg[e4 * 4 + 1] += u0 * w0.y + u1 * w1.y + u2 * w2.y + u3 * w3.y;
                            lg[e4 * 4 + 2] += u0 * w0.z + u1 * w1.z + u2 * w2.z + u3 * w3.z;
                            lg[e4 * 4 + 3] += u0 * w0.w + u1 * w1.w + u2 * w2.w + u3 * w3.w;
                        }
                    }
#pragma unroll
                    for (int e = 0; e < 16; ++e) lg[e] = wave_sum(lg[e]);
                    float scv[16], sel[16];
#pragma unroll
                    for (int e = 0; e < 16; ++e) { scv[e] = 1.f / (1.f + expf(-lg[e])); sel[e] = scv[e] + rb[e]; }
                    int best = 0; float bestv = -INFINITY;
#pragma unroll
                    for (int gI = 0; gI < 4; ++gI) {
                        float m1 = -INFINITY, m2 = -INFINITY;
#pragma unroll
                        for (int k = 0; k < 4; ++k) { const float v = sel[gI * 4 + k]; if (v > m1) { m2 = m1; m1 = v; } else if (v > m2) m2 = v; }
                        const float gs = m1 + m2; if (gs > bestv) { bestv = gs; best = gI; }
                    }
                    int ia = -1, ib = -1; float va = -INFINITY, vb = -INFINITY, wa = 0.f, wb = 0.f;
#pragma unroll
                    for (int e = 0; e < 16; ++e) {
                        if ((e >> 2) == best) { const float v = sel[e]; if (v > va) { vb = va; ib = ia; wb = wa; va = v; ia = e; wa = scv[e]; } else if (v > vb) { vb = v; ib = e; wb = scv[e]; } }
                    }
                    if (lane == 0) {
                        const float inv = 1.f / (wa + wb);
                        RTE[row] = make_int2(ia, ib); RTW[row] = make_float2(wa * inv, wb * inv); RTR[row] = rstd;
                        atomicAdd(&hist[ia], 1); atomicAdd(&hist[ib], 1);
                    }
                }
                __syncthreads();
                if (tid < 16) CNT[ch * 16 + tid] = hist[tid];
            }
        }
        if constexpr (KIND == 9) {
            const float* g = p.in[I_N2G] + l * DM;
            int* tots = (int*)smem; int* befo = tots + 16; int* offs = befo + 16; int* sla = offs + 32; int* slb = sla + 128; int* ea = slb + 128; int* eb = ea + 128;
            const int nch = rows_mix / NCHUNK_TOK;
            for (int ch = bid; ch < nch; ch += nblk) {
                __syncthreads();
                if (tid < 16) { int tot = 0, bef = 0; for (int c2 = 0; c2 < nch; ++c2) { const int v = CNT[c2 * 16 + tid]; if (c2 < ch) bef += v; tot += v; } tots[tid] = tot; befo[tid] = bef; }
                if (tid >= 64 && tid < 64 + 128) { const int2 e2 = RTE[ch * NCHUNK_TOK + tid - 64]; ea[tid - 64] = e2.x; eb[tid - 64] = e2.y; }
                __syncthreads();
                if (tid == 0) { int o = 0; for (int e = 0; e < 16; ++e) { offs[e] = o; o += (tots[e] + 255) & ~255; } offs[16] = o; }
                __syncthreads();
                if (tid < 16) { int pos = offs[tid] + befo[tid]; for (int i = 0; i < 128; ++i) { if (ea[i] == tid) sla[i] = pos++; else if (eb[i] == tid) slb[i] = pos++; } }
                if (ch == 0 && tid >= 64 && tid < 64 + 33) { const int q = tid - 64; SEG[q] = q < 17 ? offs[q] : tots[q - 17]; }
                if (ch == 0 && tid == 128) { int rt = 0; for (int e = 0; e < 16; ++e) { const int nte = (tots[e] + 255) >> 8; for (int k = 0; k < nte; ++k) { TILE[16 + 2 * rt] = e; TILE[17 + 2 * rt] = (offs[e] >> 8) + k; ++rt; } } TILE[0] = rt; }
                __syncthreads();
                for (int i = wid; i < NCHUNK_TOK; i += 8) {
                    const int row = ch * NCHUNK_TOK + i;
                    const float* h = hrow2(Hlat, Hctx, row); const float* mv = modl + row_modv(row) * 6144;
                    const float rstd = RTR[row]; const int sa = sla[i], sb = slb[i];
#pragma unroll
                    for (int k = 0; k < 4; ++k) {
                        const int c = lane * 4 + 256 * k;
                        const float4 x = *(const float4*)(h + c), gg = *(const float4*)(g + c), sh = *(const float4*)(mv + 3072 + c), sc = *(const float4*)(mv + 4096 + c);
                        const float u0 = x.x * rstd * gg.x * (1.f + sc.x) + sh.x, u1 = x.y * rstd * gg.y * (1.f + sc.y) + sh.y;
                        const float u2 = x.z * rstd * gg.z * (1.f + sc.z) + sh.z, u3 = x.w * rstd * gg.w * (1.f + sc.w) + sh.w;
                        uint2 o; o.x = (unsigned)f2bf(u0) | ((unsigned)f2bf(u1) << 16); o.y = (unsigned)f2bf(u2) | ((unsigned)f2bf(u3) << 16);
                        *(uint2*)(XS + (size_t)sa * DM + c) = o; *(uint2*)(XS + (size_t)sb * DM + c) = o;
                    }
                    if (lane == 0) RTS[row] = make_int2(sa, sb);
                }
            }
        }
        if constexpr (KIND == 10) {
            PG8_LAS int* ul = (PG8_LAS int*)(lds3 + 131072); const int nu = pg8::grouped_units(ul, TILE, 2, nblk, bid);
            pg8::Gemm g{XS, WT + WT_13 + l * WT_13_L, DM, DM, DM}; pg8::GroupedOrder S{ul, nu};
            pg8::EpiMoe1 E{HDN};
            pg8::gemm_phase<pg8::EpiMoe1, pg8::GroupedOrder, true, true>(lds3, g, S, E);
        }
        if constexpr (KIND == 11) {
            PG8_LAS int* ul = (PG8_LAS int*)(lds3 + 131072); const int nu = pg8::grouped_units(ul, TILE, 4, nblk, bid);
            pg8::Gemm g{HDN, WT + WT_2 + l * WT_2_L, FF, FF, FF}; pg8::GroupedOrder S{ul, nu};
            pg8::EpiMoe2 E{XS};
            pg8::gemm_phase<pg8::EpiMoe2, pg8::GroupedOrder, true, true>(lds3, g, S, E);
        }
        if constexpr (KIND == 12) {
            for (int row = bid * 8 + wid; row < rows_mix; row += nblk * 8) {
                float* h = hrow2(Hlat, Hctx, row); const float* mv = modl + row_modv(row) * 6144 + 5120;
                const int2 s2 = RTS[row]; const float2 w2 = RTW[row];
#pragma unroll
                for (int k = 0; k < 4; ++k) {
                    const int c = lane * 4 + 256 * k;
                    const uint2 ya = *(const uint2*)(XS + (size_t)s2.x * DM + c), yb = *(const uint2*)(XS + (size_t)s2.y * DM + c);
                    float4 x = *(float4*)(h + c); const float4 gg = *(const float4*)(mv + c);
                    x.x += gg.x * (w2.x * __uint_as_float(ya.x << 16) + w2.y * __uint_as_float(yb.x << 16));
                    x.y += gg.y * (w2.x * __uint_as_float(ya.x & 0xffff0000u) + w2.y * __uint_as_float(yb.x & 0xffff0000u));
                    x.z += gg.z * (w2.x * __uint_as_float(ya.y << 16) + w2.y * __uint_as_float(yb.y << 16));
                    x.w += gg.w * (w2.x * __uint_as_float(ya.y & 0xffff0000u) + w2.y * __uint_as_float(yb.y & 0xffff0000u));
                    *(float4*)(h + c) = x;
                }
            }
        }
    }
    if constexpr (KIND == 13) {
        const float* g = p.in[I_FNG];
        for (int row = bid * 8 + wid; row < NLAT; row += nblk * 8) {
            float* h = p.out + (size_t)row * DM;
            float4 x[4]; float ss = 0.f;
#pragma unroll
            for (int i = 0; i < 4; ++i) { x[i] = *(const float4*)(h + lane * 4 + 256 * i); ss += x[i].x * x[i].x + x[i].y * x[i].y + x[i].z * x[i].z + x[i].w * x[i].w; }
            ss = wave_sum(ss);
            const float rstd = rsqrtf(ss * (1.f / DM) + 1e-6f);
#pragma unroll
            for (int i = 0; i < 4; ++i) { const int c = lane * 4 + 256 * i; const float4 gg = *(const float4*)(g + c); float4 y; y.x = x[i].x * rstd * gg.x; y.y = x[i].y * rstd * gg.y; y.z = x[i].z * rstd * gg.z; y.w = x[i].w * rstd * gg.w; *(float4*)(h + c) = y; }
        }
    }
}

constexpr int LDS_BYTES = 136 * 1024;
template <int KIND> __global__ void __launch_bounds__(512, 2) k_ph(Params p, int l) {
    extern __shared__ __attribute__((aligned(16))) char smem[];
    phase<KIND>(p, l, smem);
}
__device__ __forceinline__ void grid_sync(unsigned char* wsp, char* smem) {
    unsigned* bw = (unsigned*)(wsp + WS_CTL); asm volatile("" : "+s"(bw));
    XcdBarrier b; b.bar = bw; b.x = xb_xcc_id(); b.st = (volatile LAS unsigned*)(smem + LDS_BYTES - 16);
    xcd_barrier(b);
}
__global__ void __launch_bounds__(512, 2) k_one(Params p) {
    extern __shared__ __attribute__((aligned(16))) char smem[];
    {
        volatile LAS unsigned* st = (volatile LAS unsigned*)(smem + LDS_BYTES - 16);
        if (threadIdx.x == 0) { st[0] = 0u; st[1] = 0u; st[2] = 0u; st[3] = 0u; }
        __syncthreads();
        (void)xcd_barrier_post((unsigned*)(p.ws + WS_CTL), st);
    }
#define SYNC() grid_sync(p.ws, smem)
    phase<0>(p, 0, smem); SYNC();
#define LAYER(l) \
        phase<1>(p, l, smem); SYNC(); \
        phase<2>(p, l, smem); SYNC(); \
        phase<3>(p, l, smem); SYNC(); \
        phase<4>(p, l, smem); phase<14>(p, l, smem); SYNC(); \
        phase<5>(p, l, smem); SYNC(); \
        phase<6>(p, l, smem); phase<15>(p, l, smem); phase<16>(p, l, smem); SYNC(); \
        phase<7>(p, l, smem); SYNC(); \
        phase<8>(p, l, smem); SYNC(); \
        phase<9>(p, l, smem); SYNC(); \
        phase<10>(p, l, smem); SYNC(); \
        phase<11>(p, l, smem); SYNC(); \
        phase<12>(p, l, smem); SYNC();
    LAYER(0)
    LAYER(1)
#undef LAYER
    phase<13>(p, 0, smem);
#undef SYNC
}
template <int KIND> static void launch_ph(const Params& p, int l, int grid, hipStream_t stream) {
    static bool attr_done = false;
    if (!attr_done) { (void)hipFuncSetAttribute((const void*)k_ph<KIND>, hipFuncAttributeMaxDynamicSharedMemorySize, LDS_BYTES); attr_done = true; }
    hipLaunchKernelGGL(k_ph<KIND>, dim3(grid), dim3(512), LDS_BYTES, stream, p, l);
}

extern "C" void kernel_launch(void* const* d_in, const int* in_sizes, int n_in, void* d_out, int out_size, void* d_ws, size_t ws_size, hipStream_t stream) {
    (void)in_sizes; (void)n_in; (void)out_size; (void)ws_size;
    static int grid = 0;
    if (!grid) {
        int dev = 0, cus = 0; (void)hipGetDevice(&dev); (void)hipDeviceGetAttribute(&cus, hipDeviceAttributeMultiprocessorCount, dev);
        grid = cus > 0 ? cus : 256;
        (void)hipFuncSetAttribute((const void*)k_one, hipFuncAttributeMaxDynamicSharedMemorySize, LDS_BYTES);
    }
    Params p{};
    for (int i = 0; i < 23; ++i) p.in[i] = (const float*)d_in[i];
    p.out = (float*)d_out; p.ws = (unsigned char*)d_ws;
#ifdef MULTI_LAUNCH
    launch_ph<0>(p, 0, grid, stream);
    for (int l = 0; l < 2; ++l) {
        launch_ph<1>(p, l, grid, stream); launch_ph<2>(p, l, grid, stream); launch_ph<3>(p, l, grid, stream); launch_ph<4>(p, l, grid, stream); launch_ph<14>(p, l, grid, stream);
        launch_ph<5>(p, l, grid, stream); launch_ph<6>(p, l, grid, stream); launch_ph<15>(p, l, grid, stream); launch_ph<16>(p, l, grid, stream); launch_ph<7>(p, l, grid, stream); launch_ph<8>(p, l, grid, stream);
        launch_ph<9>(p, l, grid, stream); launch_ph<10>(p, l, grid, stream); launch_ph<11>(p, l, grid, stream); launch_ph<12>(p, l, grid, stream);
    }
    launch_ph<13>(p, 0, grid, stream);
#else
    (void)hipMemsetAsync((char*)d_ws + WS_CTL, 0, XCD_BAR_WORDS * sizeof(unsigned), stream);
    hipLaunchKernelGGL(k_one, dim3(grid), dim3(512), LDS_BYTES, stream, p);
#endif
}
```

```cpp
#include <hip/hip_runtime.h>
#include <stdint.h>
#include <math.h>

typedef unsigned short bf16_t;
#define LAS __attribute__((address_space(3)))

constexpr int DM = 1024, NB = 4, SEQ = 8192, GW = 64, CTXL = 256;
constexpr int NLAT = NB * SEQ;
constexpr int NCTX = NB * CTXL;
constexpr int NROW = NLAT + NCTX;
constexpr int DPROJ = 3232, LDP = 3328;
constexpr int PC_RQ = 0, PC_RK = 256, PC_RV = 512, PC_RG = 768, PC_NQ = 1024, PC_NK = 1536, PC_NV = 2048, PC_CQ = 2560, PC_CKV = 2944, PC_KPE = 3200;
constexpr int NE = 16, FF = 256;
constexpr int MAXSLOT = 2 * NROW + NE * 256;
constexpr int NCHUNK_TOK = 128;
constexpr int RET_ITEMS = 16 * 64 + 16 * 2;

constexpr size_t MiB = 1u << 20;
constexpr size_t WS_CTL = 0;
constexpr size_t WS_MOD = 1 * MiB;
constexpr size_t WS_HC = 2 * MiB;
constexpr size_t WS_RT = 6 * MiB;
constexpr size_t WS_U = 8 * MiB;
constexpr size_t WS_QM = 74 * MiB;
constexpr size_t WS_KM = 99 * MiB;
constexpr size_t WS_VM = 124 * MiB;
constexpr size_t WS_RKV = 141 * MiB;
constexpr size_t WS_P = 174 * MiB;
constexpr size_t WS_XS = WS_P;
constexpr size_t WS_HDN = WS_P + 140 * MiB;
constexpr size_t WS_WT = 389 * MiB;
constexpr size_t WT_IN = 0, WT_IN_L = (size_t)3328 * 1024;
constexpr size_t WT_UQ = WT_IN + 2 * WT_IN_L, WT_UQ_L = (size_t)512 * 384;
constexpr size_t WT_UKV = WT_UQ + 2 * WT_UQ_L, WT_UKV_L = (size_t)512 * 256;
constexpr size_t WT_OUT = WT_UKV + 2 * WT_UKV_L, WT_OUT_L = (size_t)1024 * 1024;
constexpr size_t WT_13 = WT_OUT + 2 * WT_OUT_L, WT_13_L = (size_t)16 * 512 * 1024;
constexpr size_t WT_2 = WT_13 + 2 * WT_13_L, WT_2_L = (size_t)16 * 1024 * 256;
constexpr size_t WT_END = WT_2 + 2 * WT_2_L;
static_assert(WS_WT + WT_END * 2 <= 512 * MiB, "workspace");
constexpr size_t WS_VT = 456 * MiB;
constexpr size_t WS_NVT = 473 * MiB;
static_assert(WS_NVT + (size_t)32 * 132 * 4096 * 2 <= 512 * MiB, "workspace");
constexpr size_t RT_TILE = 1984 * 1024;
constexpr size_t RT_E = 0, RT_W = 512 * 1024, RT_RSTD = 1024 * 1024, RT_SLOT = 1280 * 1024, RT_CNT = 1792 * 1024, RT_SEG = 1920 * 1024;

struct Params { const float* in[23]; float* out; unsigned char* ws; int lo, hi; };
enum { I_X = 0, I_C, I_CTX, I_CCTX, I_WMOD, I_BMOD, I_N1G, I_N2G, I_WIN, I_RDF, I_RDB, I_RPB, I_QN, I_KVN, I_WUQ, I_WUKV, I_WOUT, I_RW, I_RB, I_W1, I_W3, I_W2, I_FNG };

__device__ __forceinline__ float bf2f(bf16_t v) { return __uint_as_float(((unsigned)v) << 16); }
__device__ __forceinline__ bf16_t f2bf(float f) { unsigned u = __float_as_uint(f); return (bf16_t)((u + 0x7fffu + ((u >> 16) & 1u)) >> 16); }
template <int CTRL> __device__ __forceinline__ float dpp_f(float v) { return __uint_as_float((unsigned)__builtin_amdgcn_mov_dpp((int)__float_as_uint(v), CTRL, 0xF, 0xF, true)); }
__device__ __forceinline__ float xor1_f(float v) { return dpp_f<0xB1>(v); }
__device__ __forceinline__ float xor2_f(float v) { return dpp_f<0x4E>(v); }
__device__ __forceinline__ float wave_sum(float v) {
    v += dpp_f<0xB1>(v); v += dpp_f<0x4E>(v); v += dpp_f<0x141>(v); v += dpp_f<0x140>(v);
    { auto r = __builtin_amdgcn_permlane16_swap(__float_as_uint(v), __float_as_uint(v), false, false); v = __uint_as_float(r[0]) + __uint_as_float(r[1]); }
    { auto r = __builtin_amdgcn_permlane32_swap(__float_as_uint(v), __float_as_uint(v), false, false); v = __uint_as_float(r[0]) + __uint_as_float(r[1]); }
    return v;
}
__device__ __forceinline__ float wave_max(float v) {
    v = fmaxf(v, dpp_f<0xB1>(v)); v = fmaxf(v, dpp_f<0x4E>(v)); v = fmaxf(v, dpp_f<0x141>(v)); v = fmaxf(v, dpp_f<0x140>(v));
    { auto r = __builtin_amdgcn_permlane16_swap(__float_as_uint(v), __float_as_uint(v), false, false); v = fmaxf(__uint_as_float(r[0]), __uint_as_float(r[1])); }
    { auto r = __builtin_amdgcn_permlane32_swap(__float_as_uint(v), __float_as_uint(v), false, false); v = fmaxf(__uint_as_float(r[0]), __uint_as_float(r[1])); }
    return v;
}
__device__ __forceinline__ int tid_() { int t = threadIdx.x; asm volatile("" : "+v"(t)); return t; }
__device__ __forceinline__ int bid_() { int b = blockIdx.x; asm volatile("" : "+s"(b)); return b; }
__device__ __forceinline__ float silu_f(float x) { return x / (1.f + expf(-x)); }
__device__ __forceinline__ int row_modv(int row) { return row < NLAT ? (row >> 13) : 4; }
__device__ __forceinline__ float* hrow2(float* hl, float* hc, int row) { return row < NLAT ? hl + (size_t)row * DM : hc + (size_t)(row - NLAT) * DM; }

#define XB_TMO      128
#define XB_XCNT(j)  (256  + 64 * (j))
#define XB_XSUB(j)  (1280 + 64 * (j))
#define XB_XGEN(j)  (2304 + 64 * (j))
#define XB_TOP      3328
#define XB_TOPGEN   3392
#define XCD_BAR_WORDS 3456
#define XB_SPIN_CAP (1u << 18)
__device__ __forceinline__ unsigned xb_ld(unsigned* p)              { return __hip_atomic_load(p, __ATOMIC_RELAXED, __HIP_MEMORY_SCOPE_AGENT); }
__device__ __forceinline__ unsigned xb_add(unsigned* p, unsigned v) { return __hip_atomic_fetch_add(p, v, __ATOMIC_RELAXED, __HIP_MEMORY_SCOPE_AGENT); }
__device__ __forceinline__ unsigned xb_xcc_id() { return (unsigned)__builtin_amdgcn_s_getreg((3 << 11) | 20) & 0xFu; }
#define XB_SPIN(cond, bar) do { unsigned _sp = 0; while (cond) { __builtin_amdgcn_s_sleep(1); \
    if ((++_sp & 255u) == 0u) { if (xb_ld(&(bar)[XB_TMO])) break; if (_sp > XB_SPIN_CAP) { atomicAdd(&(bar)[XB_TMO], 1u); break; } } } } while (0)
struct XcdBarrier { unsigned* bar; unsigned x; volatile LAS unsigned* st; };
__device__ __forceinline__ XcdBarrier xcd_barrier_post(unsigned* bar, volatile LAS unsigned* st) {
    XcdBarrier b; b.bar = bar; b.x = xb_xcc_id(); b.st = st;
    if (threadIdx.x == 0) (void)xb_add(&bar[XB_XCNT(b.x)], 1u);
    return b;
}
__device__ __forceinline__ void xcd_barrier_complete(unsigned* bar, unsigned x, unsigned& nloc, unsigned& nx) {
    const unsigned G = gridDim.x * gridDim.y * gridDim.z;
    unsigned sum, cnt, mine, sp = 0u;
    for (;;) {
        sum = 0u; cnt = 0u; mine = 0u;
#pragma unroll
        for (unsigned j = 0; j < 16; ++j) { const unsigned c = xb_ld(&bar[XB_XCNT(j)]); sum += c; cnt += (c > 0u) ? 1u : 0u; mine = (j == x) ? c : mine; }
        if (sum == G) break;
        __builtin_amdgcn_s_sleep(1);
        if ((++sp & 255u) == 0u) { if (xb_ld(&bar[XB_TMO])) break; if (sp > XB_SPIN_CAP) { atomicAdd(&bar[XB_TMO], 1u); break; } }
    }
    nloc = mine > 0u ? mine : 1u; nx = cnt > 0u ? cnt : 1u;
}
__device__ __forceinline__ void xcd_barrier(const XcdBarrier& b) {
    asm volatile("s_waitcnt vmcnt(0)" ::: "memory");
    __syncthreads();
    if (threadIdx.x == 0) {
        unsigned* bar = b.bar;
        __builtin_amdgcn_s_waitcnt(0);
        unsigned nloc = b.st[0], nx = b.st[1];
        if (nloc == 0u) { xcd_barrier_complete(bar, b.x, nloc, nx); b.st[0] = nloc; b.st[1] = nx; }
        const unsigned old = xb_add(&bar[XB_XSUB(b.x)], 1u);
        const unsigned gen = old / nloc;
        if (old + 1u == (gen + 1u) * nloc) {
            __builtin_amdgcn_fence(__ATOMIC_RELEASE, "agent");
            asm volatile("s_waitcnt vmcnt(0)" ::: "memory");
            const unsigned og = xb_add(&bar[XB_TOP], 1u);
            const unsigned tg = og / nx;
            if (og + 1u == (tg + 1u) * nx) xb_add(&bar[XB_TOPGEN], 1u);
            else XB_SPIN(xb_ld(&bar[XB_TOPGEN]) == tg, bar);
            __builtin_amdgcn_fence(__ATOMIC_ACQUIRE, "agent");
            xb_add(&bar[XB_XGEN(b.x)], 1u);
            asm volatile("s_waitcnt vmcnt(0)" ::: "memory");
        } else {
            XB_SPIN(xb_ld(&bar[XB_XGEN(b.x)]) == gen, bar);
            __builtin_amdgcn_fence(__ATOMIC_ACQUIRE, "agent");
            asm volatile("s_waitcnt vmcnt(0)" ::: "memory");
        }
    }
    __syncthreads();
}

struct SegInfo { const int* seg; size_t wstride; };
template <bool DUAL, class Epi>
__device__ __forceinline__ void gemm_simple(char* smem, const bf16_t* A, int lda, int M, const float* W, const float* W2, int ldw, int N, int K, SegInfo sg, const Epi& epi) {
    float* As = (float*)smem;
    float* Ws = As + 16 * 132;
    float* Ws2 = Ws + 16 * 68;
    const int t = tid_(), ty = t >> 4, tx = t & 15;
    const int ntm = (M + 127) / 128, ntn = (N + 63) / 64;
    for (int tile = blockIdx.x; tile < ntm * ntn; tile += gridDim.x) {
        const int tm = tile / ntn, tn = tile % ntn, m0 = tm * 128, n0 = tn * 64;
        const float* Wt = W; const float* Wt2 = W2; int mvalid = M;
        if (sg.seg) {
            int e = 0;
#pragma unroll
            for (int i = 1; i < 16; ++i) if (m0 >= sg.seg[i]) e = i;
            mvalid = sg.seg[e] + sg.seg[17 + e];
            if (m0 >= sg.seg[16] || m0 >= mvalid) continue;
            Wt = W + (size_t)e * sg.wstride; if (DUAL) Wt2 = W2 + (size_t)e * sg.wstride;
        }
        float acc[4][4], acc2[4][4];
#pragma unroll
        for (int i = 0; i < 4; ++i)
#pragma unroll
            for (int j = 0; j < 4; ++j) { acc[i][j] = 0.f; acc2[i][j] = 0.f; }
        for (int k0 = 0; k0 < K; k0 += 16) {
            {
                const int r = t >> 2, kq = (t & 3) * 4, row = m0 + r;
                uint2 v = make_uint2(0u, 0u);
                if (row < M) v = *(const uint2*)(A + (size_t)row * lda + k0 + kq);
                As[(kq + 0) * 132 + r] = __uint_as_float(v.x << 16);
                As[(kq + 1) * 132 + r] = __uint_as_float(v.x & 0xffff0000u);
                As[(kq + 2) * 132 + r] = __uint_as_float(v.y << 16);
                As[(kq + 3) * 132 + r] = __uint_as_float(v.y & 0xffff0000u);
            }
            {
                const int k = t >> 5, n = (t & 31) * 2, col = n0 + n;
                float2 w = make_float2(0.f, 0.f), w2 = make_float2(0.f, 0.f);
                if (col < N) { w = *(const float2*)(Wt + (size_t)(k0 + k) * ldw + col); if (DUAL) w2 = *(const float2*)(Wt2 + (size_t)(k0 + k) * ldw + col); }
                Ws[k * 68 + n] = w.x; Ws[k * 68 + n + 1] = w.y;
                if (DUAL) { Ws2[k * 68 + n] = w2.x; Ws2[k * 68 + n + 1] = w2.y; }
            }
            __syncthreads();
#pragma unroll
            for (int kk = 0; kk < 16; ++kk) {
                const float4 a = *(const float4*)&As[kk * 132 + ty * 4];
                const float4 w = *(const float4*)&Ws[kk * 68 + tx * 4];
                const float av[4] = {a.x, a.y, a.z, a.w}, wv[4] = {w.x, w.y, w.z, w.w};
#pragma unroll
                for (int i = 0; i < 4; ++i)
#pragma unroll
                    for (int j = 0; j < 4; ++j) acc[i][j] = fmaf(av[i], wv[j], acc[i][j]);
                if (DUAL) {
                    const float4 w2 = *(const float4*)&Ws2[kk * 68 + tx * 4];
                    const float wv2[4] = {w2.x, w2.y, w2.z, w2.w};
#pragma unroll
                    for (int i = 0; i < 4; ++i)
#pragma unroll
                        for (int j = 0; j < 4; ++j) acc2[i][j] = fmaf(av[i], wv2[j], acc2[i][j]);
                }
            }
            __syncthreads();
        }
#pragma unroll
        for (int i = 0; i < 4; ++i) {
            const int row = m0 + ty * 4 + i;
            if (row < M && row < mvalid) {
#pragma unroll
                for (int j = 0; j < 4; ++j) { const int col = n0 + tx * 4 + j; if (col < N) epi(row, col, acc[i][j], acc2[i][j]); }
            }
        }
    }
}

template <int DQK, int DV>
__device__ __forceinline__ void attn_simple(char* smem, const bf16_t* Q, int ldq, int nq, const bf16_t* K0, const bf16_t* V0, int n0, const bf16_t* K1, const bf16_t* V1, int n1,
                                            int ldk, int ldv, float qscale_log2, bf16_t* O, int ldo) {
    float* Ks = (float*)smem;
    float* Vs = Ks + 32 * DQK;
    const int t = tid_();
    const bool act = t < nq;
    float q[DQK];
#pragma unroll
    for (int c = 0; c < DQK; ++c) q[c] = act ? bf2f(Q[(size_t)t * ldq + c]) * qscale_log2 : 0.f;
    float o[DV];
#pragma unroll
    for (int e = 0; e < DV; ++e) o[e] = 0.f;
    float mrun = -INFINITY, lrun = 0.f;
    const int ntile = (n0 + n1) / 32;
    for (int tl = 0; tl < ntile; ++tl) {
        const int j0 = tl * 32;
        const bf16_t* Kp; const bf16_t* Vp;
        if (j0 < n0) { Kp = K0 + (size_t)j0 * ldk; Vp = V0 + (size_t)j0 * ldv; } else { Kp = K1 + (size_t)(j0 - n0) * ldk; Vp = V1 + (size_t)(j0 - n0) * ldv; }
        __syncthreads();
        for (int idx = t; idx < 32 * DQK; idx += 512) { const int r = idx / DQK, c = idx % DQK; Ks[idx] = bf2f(Kp[(size_t)r * ldk + c]); }
        for (int idx = t; idx < 32 * DV; idx += 512) { const int r = idx / DV, c = idx % DV; Vs[idx] = bf2f(Vp[(size_t)r * ldv + c]); }
        __syncthreads();
#pragma unroll 1
        for (int r = 0; r < 32; ++r) {
            float a = 0.f;
#pragma unroll
            for (int c = 0; c < DQK; c += 4) { const float4 kv = *(const float4*)&Ks[r * DQK + c]; a = fmaf(q[c], kv.x, a); a = fmaf(q[c + 1], kv.y, a); a = fmaf(q[c + 2], kv.z, a); a = fmaf(q[c + 3], kv.w, a); }
            if (a > mrun) {
                const float alpha = exp2f(mrun - a);
                mrun = a; lrun *= alpha;
#pragma unroll
                for (int e = 0; e < DV; ++e) o[e] *= alpha;
            }
            const float pr = exp2f(a - mrun);
            lrun += pr;
#pragma unroll
            for (int e = 0; e < DV; e += 4) { const float4 vv = *(const float4*)&Vs[r * DV + e]; o[e] = fmaf(pr, vv.x, o[e]); o[e + 1] = fmaf(pr, vv.y, o[e + 1]); o[e + 2] = fmaf(pr, vv.z, o[e + 2]); o[e + 3] = fmaf(pr, vv.w, o[e + 3]); }
        }
    }
    if (act) {
        const float inv = 1.f / lrun;
#pragma unroll
        for (int e = 0; e < DV; ++e) O[(size_t)t * ldo + e] = f2bf(o[e] * inv);
    }
    __syncthreads();
}

__device__ __forceinline__ void rope_pair(float& x1, float& x2, float pos, int i, int half) {
    const float inv = powf(10000.0f, -(float)i / (float)half);
    float sn, cs; sincosf(pos * inv, &sn, &cs);
    const float a = x1 * cs - x2 * sn, b = x2 * cs + x1 * sn; x1 = a; x2 = b;
}
__device__ __forceinline__ float log_sigmoid_f(float x) { return -log1pf(expf(-x)); }

namespace pg8 {
#define PG8_LAS __attribute__((address_space(3)))
typedef unsigned short bf16_t;
typedef short bf16x8 __attribute__((ext_vector_type(8)));
typedef float f32x4 __attribute__((ext_vector_type(4)));
typedef unsigned u32x4 __attribute__((ext_vector_type(4)));
constexpr int BM = 256, BK = 64, HALF = 128, HTB = HALF * BK * 2  , STAGE_BYTES = 8 * HTB, NXCD = 8, WGM = 8;

__host__ __device__ __forceinline__ int lds_byte(int r, int c) { const int st = (r >> 4) * 2 + (c >> 5), rr = r & 15, cc = c & 31, ob = rr * 64 + cc * 2; return st * 1024 + (ob ^ (((ob >> 9) & 1) << 5)); }
__host__ __device__ __forceinline__ void stage_rc(int b, int& R, int& C) { const int st = b / 1024, sb = b % 1024, swz = sb ^ (((sb >> 9) & 1) << 5); R = (st >> 1) * 16 + swz / 64; C = (st & 1) * 32 + (swz % 64) / 2; }
__host__ __device__ __forceinline__ int perm32(int rho) { const int n = rho >> 4, i = rho & 15; return 8 * (i >> 2) + 4 * n + (i & 3); }

struct Unit { int pm, pn; };
struct Gemm { const bf16_t* A; const bf16_t* Bt; int lda, ldb, K; };

__device__ __forceinline__ unsigned cvt_pk_bf16(float lo, float hi) { unsigned r; asm volatile("v_cvt_pk_bf16_f32 %0, %1, %2" : "=v"(r) : "v"(lo), "v"(hi)); return r; }
template <class Epi, class Sched, bool ALIGN_EPI = false, bool SP2 = false>
__device__ __forceinline__ void gemm_phase(PG8_LAS unsigned char* lds, const Gemm g, const Sched& S, const Epi& E) {
    const int tid = tid_(), wid = __builtin_amdgcn_readfirstlane(tid >> 6), lane = tid & 63, wr = wid >> 2, wc = wid & 3, fr = lane & 15, fq = lane >> 4;
    int K = g.K; asm volatile("" : "+s"(K));
    const int nt = K / BK;
    unsigned voffA[2], voffB[2];
#pragma unroll
    for (int i = 0; i < 2; ++i) { int R, C; stage_rc(tid * 16 + i * 8192, R, C); const int Rb = Epi::PERM ? ((R & ~31) + perm32(R & 31)) : R;
        voffA[i] = (unsigned)(R * g.lda + C) * 2u; voffB[i] = (unsigned)(Rb * g.ldb + C) * 2u; }
    const size_t kstep = (size_t)(BK * 2);
    const size_t hstepA = (size_t)HALF * g.lda * 2, hstepB = (size_t)HALF * g.ldb * 2;
    const size_t tstepA = 2 * hstepA, tstepB = 2 * hstepB;
    const unsigned ldsw = (unsigned)wid * 1024u;
    const int aoff = lds_byte(wr * 64 + fr, fq * 8), boff = lds_byte(wc * 32 + fr, fq * 8);
#define PG8_SA(b, h) (((b) * 2 + (h)) * HTB)
#define PG8_SB(b, h) ((4 + (b) * 2 + (h)) * HTB)
#define PG8_STAGE(bufoff, gbase, voff) do { _Pragma("unroll") for (int _i = 0; _i < 2; ++_i) \
        __builtin_amdgcn_global_load_lds((const unsigned*)((const char*)(gbase) + (voff)[_i]), (PG8_LAS unsigned*)(lds + (bufoff) + ldsw + _i * 8192), 16, 0, 0); } while (0)
#define PG8_LDA(dst, b, h) do { _Pragma("unroll") for (int m = 0; m < 4; ++m) _Pragma("unroll") for (int k = 0; k < 2; ++k) dst[m][k] = *(const PG8_LAS bf16x8*)(lds + PG8_SA(b, h) + aoff + m * 2048 + k * 1024); } while (0)
#define PG8_LDB(dst, b, h) do { _Pragma("unroll") for (int n = 0; n < 2; ++n) _Pragma("unroll") for (int k = 0; k < 2; ++k) dst[n][k] = *(const PG8_LAS bf16x8*)(lds + PG8_SB(b, h) + boff + n * 2048 + k * 1024); } while (0)
#define PG8_MMA(ai, bj, At, Bt) do { __builtin_amdgcn_s_setprio(1); _Pragma("unroll") for (int m = 0; m < 4; ++m) _Pragma("unroll") for (int n = 0; n < 2; ++n) _Pragma("unroll") for (int k = 0; k < 2; ++k) \
        acc[ai][bj][m][n] = __builtin_amdgcn_mfma_f32_16x16x32_bf16(Bt[n][k], At[m][k], acc[ai][bj][m][n], 0, 0, 0); __builtin_amdgcn_s_setprio(0); } while (0)
#define PG8_WAIT_V(n) asm volatile("s_waitcnt vmcnt(" #n ")" ::: "memory")
#define PG8_WAIT_L(n) asm volatile("s_waitcnt lgkmcnt(" #n ")" ::: "memory")
#define PG8_BAR __builtin_amdgcn_s_barrier()
#define PG8_SCHED __builtin_amdgcn_sched_barrier(0)
    Unit cur, nxt; int ui = 0;
    if (!S.next(0, cur)) return;
    f32x4 acc[2][2][4][2];
#pragma unroll
    for (int a = 0; a < 2; ++a)
#pragma unroll
        for (int b = 0; b < 2; ++b)
#pragma unroll
            for (int m = 0; m < 4; ++m)
#pragma unroll
                for (int n = 0; n < 2; ++n) acc[a][b][m][n] = (f32x4){0.f, 0.f, 0.f, 0.f};
    bf16x8 At[4][2], B0[2][2], B1[2][2];
    const char* cA = (const char*)g.A + (size_t)cur.pm * tstepA; const char* cB = (const char*)g.Bt + (size_t)cur.pn * tstepB;
    S.a_ready(cur);
    if constexpr (SP2) {
        PG8_STAGE(PG8_SB(0, 0), cB, voffB); PG8_STAGE(PG8_SB(0, 1), cB + hstepB, voffB); PG8_STAGE(PG8_SA(0, 0), cA, voffA); PG8_STAGE(PG8_SA(0, 1), cA + hstepA, voffA);
        if (wr == 1) PG8_BAR;
        PG8_WAIT_V(2); PG8_BAR;
        PG8_STAGE(PG8_SB(1, 0), cB + kstep, voffB); PG8_STAGE(PG8_SA(1, 0), cA + kstep, voffA); PG8_STAGE(PG8_SB(1, 1), cB + hstepB + kstep, voffB);
        PG8_WAIT_V(6); PG8_BAR;
    } else {
        PG8_STAGE(PG8_SB(0, 0), cB, voffB); PG8_STAGE(PG8_SA(0, 0), cA, voffA); PG8_STAGE(PG8_SB(0, 1), cB + hstepB, voffB); PG8_STAGE(PG8_SA(0, 1), cA + hstepA, voffA);
        if (wr == 1) PG8_BAR;
        PG8_WAIT_V(4); PG8_BAR;
        PG8_STAGE(PG8_SB(1, 0), cB + kstep, voffB); PG8_STAGE(PG8_SA(1, 0), cA + kstep, voffA); PG8_STAGE(PG8_SB(1, 1), cB + hstepB + kstep, voffB);
        PG8_WAIT_V(6); PG8_BAR;
    }
    for (;;) {
        const bool has_next = S.next(ui + 1, nxt);
        const char* nA = has_next ? (const char*)g.A + (size_t)nxt.pm * tstepA : cA; const char* nB = has_next ? (const char*)g.Bt + (size_t)nxt.pn * tstepB : cB;
        for (int t = 0; t < nt; t += 2) {
            const bool last = (t == nt - 2);
            const char* a1 = cA + (size_t)(t + 1) * kstep;
            const char* a2 = last ? nA : cA + (size_t)(t + 2) * kstep; const char* b2 = last ? nB : cB + (size_t)(t + 2) * kstep;
            const char* a3 = a2 + kstep; const char* b3 = b2 + kstep;
            if (last && has_next) S.a_ready(nxt);
            if constexpr (SP2) {
            PG8_LDB(B0, 0, 0); PG8_LDB(B1, 0, 1); PG8_SCHED; PG8_LDA(At, 0, 0); PG8_STAGE(PG8_SA(1, 1), a1 + hstepA, voffA);
            PG8_WAIT_V(8); PG8_WAIT_L(0); PG8_BAR; PG8_MMA(0, 0, At, B0); PG8_MMA(0, 1, At, B1); PG8_BAR; PG8_SCHED;
            PG8_LDA(At, 0, 1); PG8_STAGE(PG8_SB(0, 0), b2, voffB); PG8_STAGE(PG8_SB(0, 1), b2 + hstepB, voffB); PG8_STAGE(PG8_SA(0, 0), a2, voffA);
            PG8_WAIT_V(8); PG8_WAIT_L(0); PG8_BAR; PG8_MMA(1, 0, At, B0); PG8_MMA(1, 1, At, B1); PG8_BAR; PG8_SCHED;
            PG8_LDB(B0, 1, 0); PG8_LDB(B1, 1, 1); PG8_SCHED; PG8_LDA(At, 1, 0); PG8_STAGE(PG8_SA(0, 1), a2 + hstepA, voffA);
            PG8_WAIT_V(8); PG8_WAIT_L(0); PG8_BAR; PG8_MMA(0, 0, At, B0); PG8_MMA(0, 1, At, B1); PG8_BAR; PG8_SCHED;
            PG8_LDA(At, 1, 1); PG8_STAGE(PG8_SB(1, 0), b3, voffB); PG8_STAGE(PG8_SB(1, 1), b3 + hstepB, voffB); PG8_STAGE(PG8_SA(1, 0), a3, voffA);
            PG8_WAIT_V(8); PG8_WAIT_L(0); PG8_BAR; PG8_MMA(1, 0, At, B0); PG8_MMA(1, 1, At, B1); PG8_BAR; PG8_SCHED;
            } else {
            PG8_LDB(B0, 0, 0); PG8_SCHED; PG8_LDA(At, 0, 0); PG8_STAGE(PG8_SA(1, 1), a1 + hstepA, voffA);
            PG8_WAIT_L(8); PG8_BAR; PG8_WAIT_L(0); PG8_MMA(0, 0, At, B0); PG8_BAR; PG8_SCHED;
            PG8_LDB(B1, 0, 1); PG8_STAGE(PG8_SB(0, 0), b2, voffB);
            PG8_BAR; PG8_WAIT_L(0); PG8_MMA(0, 1, At, B1); PG8_BAR;
            PG8_LDA(At, 0, 1); PG8_STAGE(PG8_SA(0, 0), a2, voffA);
            PG8_BAR; PG8_WAIT_L(0); PG8_MMA(1, 0, At, B0); PG8_BAR; PG8_SCHED;
            PG8_STAGE(PG8_SB(0, 1), b2 + hstepB, voffB);
            PG8_WAIT_V(6); PG8_BAR; PG8_MMA(1, 1, At, B1); PG8_BAR;
            PG8_LDB(B0, 1, 0); PG8_SCHED; PG8_LDA(At, 1, 0); PG8_STAGE(PG8_SA(0, 1), a2 + hstepA, voffA);
            PG8_WAIT_L(8); PG8_BAR; PG8_WAIT_L(0); PG8_MMA(0, 0, At, B0); PG8_BAR; PG8_SCHED;
            PG8_LDB(B1, 1, 1); PG8_STAGE(PG8_SB(1, 0), b3, voffB);
            PG8_BAR; PG8_WAIT_L(0); PG8_MMA(0, 1, At, B1); PG8_BAR;
            PG8_LDA(At, 1, 1); PG8_STAGE(PG8_SA(1, 0), a3, voffA);
            PG8_BAR; PG8_WAIT_L(0); PG8_MMA(1, 0, At, B0); PG8_BAR; PG8_SCHED;
            PG8_STAGE(PG8_SB(1, 1), b3 + hstepB, voffB);
            PG8_WAIT_V(6); PG8_BAR; PG8_MMA(1, 1, At, B1); PG8_BAR;
            }
        }
        if constexpr (ALIGN_EPI) { if (wr == 0) PG8_BAR; }
        if constexpr (!Epi::AFTER_DRAIN) { E(acc, cur, wr, wc, fr, fq); S.done(cur); }
        if (!has_next) break;
#pragma unroll
        for (int a = 0; a < 2; ++a)
#pragma unroll
            for (int b = 0; b < 2; ++b)
#pragma unroll
                for (int m = 0; m < 4; ++m)
#pragma unroll
                    for (int n = 0; n < 2; ++n) acc[a][b][m][n] = (f32x4){0.f, 0.f, 0.f, 0.f};
        cur = nxt; cA = nA; cB = nB; ++ui;
        if constexpr (ALIGN_EPI) { if (wr == 1) PG8_BAR; }
    }
    PG8_WAIT_V(0);
    if constexpr (!ALIGN_EPI) { if (wr == 0) PG8_BAR; }
    PG8_BAR;
    if constexpr (Epi::AFTER_DRAIN) { E.fused(acc, cur, wr, wc, fr, fq, lds, wid, lane); S.done(cur); }
#undef PG8_SA
#undef PG8_SB
#undef PG8_STAGE
#undef PG8_LDA
#undef PG8_LDB
#undef PG8_MMA
#undef PG8_WAIT_V
#undef PG8_WAIT_L
#undef PG8_BAR
#undef PG8_SCHED
}


struct StaticOrder {
    int nM, nN, nwg, G, c;
    __device__ void init(int M, int N, int G_, int c_) { nM = M / BM; nN = N / BM; nwg = nM * nN; G = G_; c = c_; }
    __device__ bool next(int i, Unit& u) const {
        const long L = (long)i * G + c; if (L >= nwg) return false;
        int wgid = (int)L; { const int q = nwg / NXCD, r = nwg % NXCD, xcd = wgid % NXCD, off = wgid / NXCD; wgid = (xcd < r ? xcd * (q + 1) : r * (q + 1) + (xcd - r) * q) + off; }
        const int nig = WGM * nN, gid = wgid / nig, fm = gid * WGM, gsz = (nM - fm) < WGM ? (nM - fm) : WGM;
        u.pm = fm + ((wgid % nig) % gsz); u.pn = (wgid % nig) / gsz; return true;
    }
    __device__ __forceinline__ void a_ready(const Unit&) const {}
    __device__ __forceinline__ void done(const Unit&) const {}
};
struct GroupedOrder {
    const PG8_LAS int* list; int n;
    __device__ __forceinline__ bool next(int i, Unit& u) const { if (i >= n) return false; u.pm = __builtin_amdgcn_readfirstlane(list[2 * i]); u.pn = __builtin_amdgcn_readfirstlane(list[2 * i + 1]); return true; }
    __device__ __forceinline__ void a_ready(const Unit&) const {}
    __device__ __forceinline__ void done(const Unit&) const {}
};
__device__ __forceinline__ int grouped_units(PG8_LAS int* list, const int* tile, int ncol, int G, int c) {
#define TLD(i) ((int)__hip_atomic_load((const unsigned*)tile + (i), __ATOMIC_RELAXED, __HIP_MEMORY_SCOPE_AGENT))
    const int nrt = TLD(0); int n = 0;
    for (int i = 0; i < 16; ++i) { const int L = i * G + c, rt = L / ncol; if (rt >= nrt) break; if (threadIdx.x == 0) { list[2 * i] = TLD(17 + 2 * rt); list[2 * i + 1] = TLD(16 + 2 * rt) * ncol + (L % ncol); } ++n; }
#undef TLD
    __syncthreads();
    return n;
}
__device__ __forceinline__ u32x4 pack8(const f32x4& v0, const f32x4& v1) { u32x4 w; w.x = cvt_pk_bf16(v0[0], v0[1]); w.y = cvt_pk_bf16(v0[2], v0[3]); w.z = cvt_pk_bf16(v1[0], v1[1]); w.w = cvt_pk_bf16(v1[2], v1[3]); return w; }
#define EPI_ROWS_BEGIN _Pragma("unroll") for (int ai = 0; ai < 2; ++ai) _Pragma("unroll") for (int m = 0; m < 4; ++m) { const int row = u.pm * BM + ai * HALF + wr * 64 + m * 16 + fr; \
    _Pragma("unroll") for (int bj = 0; bj < 2; ++bj) { const f32x4 v0 = acc[ai][bj][m][0], v1 = acc[ai][bj][m][1];
#define EPI_ROWS_END } }
struct EpiP { static constexpr bool PERM = true, AFTER_DRAIN = false; bf16_t* O; int ldc;
    __device__ __forceinline__ void operator()(const f32x4 (&acc)[2][2][4][2], const Unit& u, int wr, int wc, int fr, int fq) const {
        EPI_ROWS_BEGIN const int col = u.pn * BM + bj * HALF + wc * 32 + 8 * fq; *(u32x4*)(O + (size_t)row * ldc + col) = pack8(v0, v1); EPI_ROWS_END } };
struct EpiUQ { static constexpr bool PERM = true, AFTER_DRAIN = false; bf16_t* Q;
    __device__ __forceinline__ void operator()(const f32x4 (&acc)[2][2][4][2], const Unit& u, int wr, int wc, int fr, int fq) const {
        EPI_ROWS_BEGIN const int col = u.pn * BM + bj * HALF + wc * 32 + 8 * fq; if (col < 384) *(u32x4*)(Q + (size_t)row * 384 + col) = pack8(v0, v1); EPI_ROWS_END } };
struct EpiUKV { static constexpr bool PERM = true, AFTER_DRAIN = false; bf16_t* Kn; bf16_t* Vn;
    __device__ __forceinline__ void operator()(const f32x4 (&acc)[2][2][4][2], const Unit& u, int wr, int wc, int fr, int fq) const {
        bf16_t* base = wc < 2 ? Kn + wc * 32 + 8 * fq : Vn + (wc - 2) * 32 + 8 * fq; const int rp = wc < 2 ? 384 : 256, hp = wc < 2 ? 96 : 64;
        EPI_ROWS_BEGIN const int hd = u.pn * 2 + bj; *(u32x4*)(base + (size_t)row * rp + hd * hp) = pack8(v0, v1); EPI_ROWS_END } };
struct EpiOut { static constexpr bool PERM = true, AFTER_DRAIN = false; float* hl; float* hc; const float* rl; const float* rc; const float* gate;
    __device__ __forceinline__ void operator()(const f32x4 (&acc)[2][2][4][2], const Unit& u, int wr, int wc, int fr, int fq) const {
        EPI_ROWS_BEGIN const int col = u.pn * BM + bj * HALF + wc * 32 + 8 * fq;
            const size_t off = (row < 32768 ? (size_t)row * 1024 : (size_t)(row - 32768) * 1024) + col;
            float* h = (row < 32768 ? hl : hc) + off; const float* r = (row < 32768 ? rl : rc) + off; const float* g = gate + (row < 32768 ? (row >> 13) : 4) * 6144 + col;
            const f32x4 g0 = *(const f32x4*)g, g1 = *(const f32x4*)(g + 4); f32x4 h0 = *(const f32x4*)r, h1 = *(const f32x4*)(r + 4);
            h0 = h0 + g0 * v0; h1 = h1 + g1 * v1; *(f32x4*)h = h0; *(f32x4*)(h + 4) = h1; EPI_ROWS_END } };
__device__ __forceinline__ float silu_fast(float x) { return x / (1.f + __expf(-x)); }
struct EpiMoe1 { static constexpr bool PERM = true, AFTER_DRAIN = false; bf16_t* Hd;
    __device__ __forceinline__ void operator()(const f32x4 (&acc)[2][2][4][2], const Unit& u, int wr, int wc, int fr, int fq) const {
        EPI_ROWS_BEGIN const int col = (u.pn & 1) * BM + bj * HALF + wc * 32 + 8 * fq;
            uint2 w; w.x = cvt_pk_bf16(silu_fast(v0[0]) * v0[1], silu_fast(v0[2]) * v0[3]); w.y = cvt_pk_bf16(silu_fast(v1[0]) * v1[1], silu_fast(v1[2]) * v1[3]);
            *(uint2*)(Hd + (size_t)row * 256 + (col >> 1)) = w; EPI_ROWS_END } };
struct EpiMoe2 { static constexpr bool PERM = true, AFTER_DRAIN = false; bf16_t* Y;
    __device__ __forceinline__ void operator()(const f32x4 (&acc)[2][2][4][2], const Unit& u, int wr, int wc, int fr, int fq) const {
        EPI_ROWS_BEGIN const int col = (u.pn & 3) * BM + bj * HALF + wc * 32 + 8 * fq; *(u32x4*)(Y + (size_t)row * 1024 + col) = pack8(v0, v1); EPI_ROWS_END } };
}

__device__ __forceinline__ void transpose_tile(float* tl, const float* W, int K, int N, bf16_t* dst, int rs, int ro, int tile, int ntn) {
    const int t = tid_(), k0 = (tile / ntn) * 64, n0 = (tile % ntn) * 64;
    __syncthreads();
    { const int k = t >> 3, n8 = (t & 7) * 8;
#pragma unroll
      for (int i = 0; i < 8; ++i) { const int n = n0 + n8 + i; tl[k * 65 + n8 + i] = n < N ? W[(size_t)(k0 + k) * N + n] : 0.f; } }
    __syncthreads();
    { const int n = t >> 3, k8 = (t & 7) * 8; uint4 o;
      o.x = (unsigned)f2bf(tl[(k8 + 0) * 65 + n]) | ((unsigned)f2bf(tl[(k8 + 1) * 65 + n]) << 16); o.y = (unsigned)f2bf(tl[(k8 + 2) * 65 + n]) | ((unsigned)f2bf(tl[(k8 + 3) * 65 + n]) << 16);
      o.z = (unsigned)f2bf(tl[(k8 + 4) * 65 + n]) | ((unsigned)f2bf(tl[(k8 + 5) * 65 + n]) << 16); o.w = (unsigned)f2bf(tl[(k8 + 6) * 65 + n]) | ((unsigned)f2bf(tl[(k8 + 7) * 65 + n]) << 16);
      *(uint4*)(dst + (size_t)((n0 + n) * rs + ro) * K + k0 + k8) = o; }
}
__device__ __forceinline__ void transpose_mat(float* tl, const float* W, int K, int N, int Npad, bf16_t* dst, int rs, int ro, int& base) {
    const int ntn = Npad / 64, nt = (K / 64) * ntn, G = gridDim.x;
    const int first = (((int)blockIdx.x - base) % G + G) % G;
    for (int tile = first; tile < nt; tile += G) transpose_tile(tl, W, K, N, dst, rs, ro, tile, ntn);
    base = (base + nt) % G;
}


namespace fa {
typedef short bf16x8 __attribute__((ext_vector_type(8)));
typedef float f32x16 __attribute__((ext_vector_type(16)));
typedef unsigned u32x4 __attribute__((ext_vector_type(4)));
__device__ __forceinline__ int crow(int r, int hi) { return (r & 3) + 8 * (r >> 2) + 4 * hi; }
__device__ __forceinline__ unsigned cvtpk(float lo, float hi) { unsigned r; asm volatile("v_cvt_pk_bf16_f32 %0, %1, %2" : "=v"(r) : "v"(lo), "v"(hi)); return r; }
__device__ __forceinline__ float max3f(float a, float b, float c) { return __builtin_fmaxf(__builtin_fmaxf(a, b), c); }
__device__ __forceinline__ float xhalf_max(float m) { auto rr = __builtin_amdgcn_permlane32_swap(__float_as_uint(m), __float_as_uint(m), false, false); return fmaxf(__uint_as_float(rr[0]), __uint_as_float(rr[1])); }
__device__ __forceinline__ float xhalf_sum(float m) { auto rr = __builtin_amdgcn_permlane32_swap(__float_as_uint(m), __float_as_uint(m), false, false); return __uint_as_float(rr[0]) + __uint_as_float(rr[1]); }
template <int DQK> struct Lds { static constexpr int KP = DQK * 2 + 16, VP = 144, KB = 64 * KP, VB = 64 * VP, K0 = 0, V0 = 3 * KB, WSF = V0 + 3 * VB, OST = WSF + 8 * 64 * 4, BYTES = OST + 8 * 4096; };
template <int DQK>
__device__ __forceinline__ void attn_unit(char* smem, const bf16_t* Q, int ldq, const bf16_t* K0, int nt0, const bf16_t* K1, int nt1, int ldk, const bf16_t* VT, bf16_t* O, int ldo) {
    typedef Lds<DQK> L; constexpr int KC = DQK / 8, NKC = 64 * KC, NKS = DQK / 16; constexpr float THR = 8.f;
    const int tid = tid_(), lane = tid & 63, r32 = lane & 31, hi = lane >> 5; const int wid = __builtin_amdgcn_readfirstlane(tid >> 6);
    float* wsf = (float*)(smem + L::WSF) + wid * 64;
    bf16x8 qf[NKS];
#pragma unroll
    for (int ks = 0; ks < NKS; ++ks) qf[ks] = *(const bf16x8*)(Q + (size_t)(wid * 32 + r32) * ldq + ks * 16 + hi * 8);
    f32x16 o0, o1, negm;
#pragma unroll
    for (int r = 0; r < 16; ++r) { o0[r] = 0.f; o1[r] = 0.f; negm[r] = 0.f; }
    float mhat = 0.f, lsum = 0.f; bool resc = false;
    const int NT = nt0 + nt1;
    const int kr0 = tid / KC, kc0 = tid % KC, kr1 = (tid + 512) / KC, kc1 = (tid + 512) % KC; const bool has1 = (tid + 512) < NKC;
    const int vdv = tid >> 3, vg = tid & 7;
    uint4 sk0, sk1 = make_uint4(0u, 0u, 0u, 0u), sv;
    u32x4 w0, w1, w2, w3;
    f32x16 pA0, pA1, pB0, pB1;
#define FA_SB() __builtin_amdgcn_sched_barrier(0)
#define FA_GLOAD(t) do { const bf16_t* kt = ((t) < nt0) ? K0 + (size_t)(t) * 64 * ldk : K1 + (size_t)((t) - nt0) * 64 * ldk; \
        sk0 = *(const uint4*)(kt + (size_t)kr0 * ldk + kc0 * 8); if (has1) sk1 = *(const uint4*)(kt + (size_t)kr1 * ldk + kc1 * 8); \
        sv = *(const uint4*)(VT + (size_t)(t) * 4096 + tid * 8); } while (0)
#define FA_SWRITE(bo) do { *(uint4*)(smem + L::K0 + (bo) * L::KB + kr0 * L::KP + kc0 * 16) = sk0; if (has1) *(uint4*)(smem + L::K0 + (bo) * L::KB + kr1 * L::KP + kc1 * 16) = sk1; \
        *(uint4*)(smem + L::V0 + (bo) * L::VB + vdv * L::VP + vg * 16) = sv; } while (0)
#define FA_QK(P0, P1, bo) do { const char* kb = smem + L::K0 + (bo) * L::KB + r32 * L::KP + hi * 16; P0 = negm; P1 = negm; \
        _Pragma("unroll") for (int ks = 0; ks < NKS; ++ks) { const bf16x8 a0 = *(const bf16x8*)(kb + ks * 32), a1 = *(const bf16x8*)(kb + 32 * L::KP + ks * 32); \
            P0 = __builtin_amdgcn_mfma_f32_32x32x16_bf16(a0, qf[ks], P0, 0, 0, 0); P1 = __builtin_amdgcn_mfma_f32_32x32x16_bf16(a1, qf[ks], P1, 0, 0, 0); } } while (0)
#define FA_PARTIAL(P0, P1, FIRST) do { float rm = max3f(P0[0], P1[0], P0[1]); rm = max3f(rm, P1[1], P0[2]); rm = max3f(rm, P1[2], P0[3]); rm = max3f(rm, P1[3], P0[4]); \
        _Pragma("unroll") for (int r = 4; r < 15; ++r) rm = max3f(rm, P1[r], P0[r + 1]); \
        rm = fmaxf(rm, P1[15]); \
        rm = xhalf_max(rm); resc = false; \
        if ((FIRST) || __any(rm > THR)) { const float dl = (FIRST) ? rm : fmaxf(rm, 0.f); mhat += dl; \
            _Pragma("unroll") for (int r = 0; r < 16; ++r) { P0[r] -= dl; P1[r] -= dl; negm[r] = -mhat; } \
            if (!(FIRST)) { const float f = __builtin_amdgcn_exp2f(-dl); lsum *= f; if (hi == 0) wsf[r32] = f; resc = true; } } \
        _Pragma("unroll") for (int r = 0; r < 16; ++r) P0[r] = __builtin_amdgcn_exp2f(P0[r]); } while (0)
#define FA_FINISH(P0, P1) do { float ps = 0.f; \
        _Pragma("unroll") for (int r = 0; r < 16; ++r) { P1[r] = __builtin_amdgcn_exp2f(P1[r]); ps += P0[r] + P1[r]; } \
        lsum += ps; \
        w0.x = cvtpk(P0[0], P0[1]); w0.y = cvtpk(P0[2], P0[3]); w0.z = cvtpk(P0[4], P0[5]); w0.w = cvtpk(P0[6], P0[7]); \
        w1.x = cvtpk(P0[8], P0[9]); w1.y = cvtpk(P0[10], P0[11]); w1.z = cvtpk(P0[12], P0[13]); w1.w = cvtpk(P0[14], P0[15]); \
        w2.x = cvtpk(P1[0], P1[1]); w2.y = cvtpk(P1[2], P1[3]); w2.z = cvtpk(P1[4], P1[5]); w2.w = cvtpk(P1[6], P1[7]); \
        w3.x = cvtpk(P1[8], P1[9]); w3.y = cvtpk(P1[10], P1[11]); w3.z = cvtpk(P1[12], P1[13]); w3.w = cvtpk(P1[14], P1[15]); } while (0)
#define FA_PV1(W, s, vb) do { const bf16x8 pa = __builtin_bit_cast(bf16x8, W); \
        const bf16x8 v0 = *(const bf16x8*)((vb) + (s) * 32), v1 = *(const bf16x8*)((vb) + 32 * L::VP + (s) * 32); \
        o0 = __builtin_amdgcn_mfma_f32_32x32x16_bf16(pa, v0, o0, 0, 0, 0); o1 = __builtin_amdgcn_mfma_f32_32x32x16_bf16(pa, v1, o1, 0, 0, 0); } while (0)
#define FA_PV(bo) do { const char* vb_ = smem + L::V0 + (bo) * L::VB + r32 * L::VP + hi * 16; FA_PV1(w0, 0, vb_); FA_PV1(w1, 1, vb_); FA_PV1(w2, 2, vb_); FA_PV1(w3, 3, vb_); } while (0)
#define FA_RESC() do { if (resc) { asm volatile("s_waitcnt lgkmcnt(0)" ::: "memory"); \
        _Pragma("unroll") for (int r = 0; r < 16; ++r) { const float fr = wsf[crow(r, hi)]; o0[r] *= fr; o1[r] *= fr; } } } while (0)
#define FA_STEP(C0, C1, P0, P1, t, LOADNEXT) do { \
        FA_SB(); FA_QK(C0, C1, bc); FA_FINISH(P0, P1); FA_SB(); \
        if (LOADNEXT) FA_GLOAD((t) + 1); FA_SB(); \
        FA_PV(bp); FA_PARTIAL(C0, C1, false); \
        if (LOADNEXT) FA_SWRITE(bn); \
        FA_RESC(); \
        __syncthreads(); \
        { const int nb = bp; bp = bc; bc = bn; bn = nb; } } while (0)
    __syncthreads();
    FA_GLOAD(0); FA_SWRITE(0);
    __syncthreads();
    FA_QK(pA0, pA1, 0); FA_PARTIAL(pA0, pA1, true);
    FA_GLOAD(1); FA_SWRITE(1);
    __syncthreads();
    int bp = 0, bc = 1, bn = 2;
    for (int t = 1; t + 1 < NT; t += 2) {
        FA_STEP(pB0, pB1, pA0, pA1, t, true);
        FA_STEP(pA0, pA1, pB0, pB1, t + 1, true);
    }
    FA_STEP(pB0, pB1, pA0, pA1, NT - 1, false);
    FA_FINISH(pB0, pB1); FA_PV(bp);
#undef FA_STEP
#undef FA_RESC
#undef FA_PV
#undef FA_PV1
#undef FA_FINISH
#undef FA_PARTIAL
#undef FA_QK
#undef FA_GLOAD
#undef FA_SWRITE
#undef FA_SB
    lsum = xhalf_sum(lsum);
    if (hi == 0) wsf[32 + r32] = lsum;
    asm volatile("s_waitcnt lgkmcnt(0)" ::: "memory");
    bf16_t* stg = (bf16_t*)(smem + L::OST) + wid * 2048;
#pragma unroll
    for (int r = 0; r < 16; ++r) { const int orow = crow(r, hi); const float rl = 1.f / wsf[32 + orow]; stg[orow * 64 + r32] = f2bf(o0[r] * rl); stg[orow * 64 + 32 + r32] = f2bf(o1[r] * rl); }
    asm volatile("s_waitcnt lgkmcnt(0)" ::: "memory");
#pragma unroll
    for (int i = 0; i < 4; ++i) { const int row = i * 8 + (lane >> 3), ch = lane & 7; const u32x4 v = *(const u32x4*)(stg + row * 64 + ch * 8); *(u32x4*)(O + (size_t)(wid * 32 + row) * ldo + ch * 8) = v; }
}
}


namespace na {
using fa::bf16x8; using fa::f32x16; using fa::u32x4; using fa::crow; using fa::cvtpk; using fa::xhalf_max; using fa::xhalf_sum;
constexpr int KP = 144, KB = 64 * KP, VP = 136, VB = 64 * VP, K0 = 0, V0 = 2 * KB, WSF = V0 + 2 * VB, OST = WSF + 2048, TBL = OST + 8 * 4096, BYTES = TBL + 17 * 64 * 4;
__device__ __forceinline__ int clampi(int v, int lo, int hi) { return v < lo ? lo : (v > hi ? hi : v); }
__device__ __forceinline__ void na_unit(char* smem, bool ctxu, int b, int h, int g, const bf16_t* P, const bf16_t* NVT, const float* rpb, bf16_t* MIX) {
    constexpr float THR = 8.f, NEG = -1e30f;
    const int tid = tid_(), lane = tid & 63, r32 = lane & 31, hi = lane >> 5; const int wid = __builtin_amdgcn_readfirstlane(tid >> 6);
    float* wsf = (float*)(smem + WSF) + wid * 64; float* tb = (float*)(smem + TBL);
    const int pr = wid >> 2, cbk = (wid & 3) * 16, kc0 = clampi(cbk - 8, 0, 32);
    const int qr = 4 * g + 2 * pr + (r32 >> 4), qc = cbk + (r32 & 15);
    const size_t qrow = ctxu ? (size_t)NLAT + b * CTXL + wid * 32 + r32 : (size_t)b * SEQ + qr * 64 + qc;
    bf16x8 qf[4];
#pragma unroll
    for (int ks = 0; ks < 4; ++ks) qf[ks] = *(const bf16x8*)(P + qrow * LDP + PC_NQ + h * 64 + ks * 16 + hi * 8);
    const int r0q = clampi(qr - 4, 0, 120), c0q = clampi(qc - 8, 0, 48);
    const int cbase = kc0 + 4 * hi - c0q, bidx = kc0 + 4 * hi - qc + 15 + 16;
    const int ra = 4 * g + 2 * pr, wlo = clampi(ra - 4, 0, 120), whi = clampi(ra - 3, 0, 120) + 8;
    const int krU = clampi(4 * g - 4, 0, 117);
    const int NL = ctxu ? 0 : 11, NT = NL + 4;
    f32x16 o0, o1, negm;
#pragma unroll
    for (int r = 0; r < 16; ++r) { o0[r] = 0.f; o1[r] = 0.f; negm[r] = 0.f; }
    float mhat = 0.f, lsum = 0.f; bool first = true;
    const size_t vt_base = (size_t)(b * 8 + h) * 132 * 4096;
    const int skr = tid >> 3, skc = tid & 7;
    uint4 sk, sv;
#define NA_GLOAD(t) do { const size_t krow = (t) < NL ? (size_t)b * SEQ + (size_t)(krU + (t)) * 64 : (size_t)NLAT + b * CTXL + ((t) - NL) * 64; const int vtile = (t) < NL ? krU + (t) : 128 + ((t) - NL); \
        sk = *(const uint4*)(P + (krow + skr) * LDP + PC_NK + h * 64 + skc * 8); sv = *(const uint4*)(NVT + vt_base + (size_t)vtile * 4096 + tid * 8); } while (0)
#define NA_SWRITE(buf) do { *(uint4*)(smem + K0 + (buf) * KB + skr * KP + skc * 16) = sk; uint2* vd = (uint2*)(smem + V0 + (buf) * VB + skr * VP + skc * 16); vd[0] = make_uint2(sv.x, sv.y); vd[1] = make_uint2(sv.z, sv.w); } while (0)
    __syncthreads();
    if (!ctxu) for (int idx = tid; idx < 17 * 64; idx += 512) { const int dr = (idx >> 6) - 8, dci = (idx & 63) - 16; tb[idx] = (dr >= -7 && dr <= 7 && dci >= 0 && dci <= 30) ? rpb[(dr + 7) * 31 + dci] * 1.4426950408889634f : 0.f; }
    NA_GLOAD(0); NA_SWRITE(0);
    __syncthreads();
#define NA_BLOCK(koff, MASKED, kr) do { \
        const char* kb = smem + K0 + buf * KB + ((koff) + r32) * KP + hi * 16; \
        f32x16 p = negm; \
        _Pragma("unroll") for (int ks = 0; ks < 4; ++ks) { const bf16x8 a = *(const bf16x8*)(kb + ks * 32); p = __builtin_amdgcn_mfma_f32_32x32x16_bf16(a, qf[ks], p, 0, 0, 0); } \
        if (MASKED) { const bool rowok = (unsigned)((kr) - r0q) < 8u; const float* tbr = tb + ((kr) - qr + 8) * 64 + bidx; \
            _Pragma("unroll") for (int r = 0; r < 16; ++r) { const int cst = (r & 3) + 8 * (r >> 2); const bool ok = rowok && (unsigned)(cbase + cst) < 16u; p[r] = ok ? p[r] + tbr[cst] : NEG; } } \
        float rm = fa::max3f(p[0], p[1], p[2]); \
        _Pragma("unroll") for (int r = 3; r < 15; r += 2) rm = fa::max3f(rm, p[r], p[r + 1]); \
        rm = fmaxf(rm, p[15]); \
        rm = xhalf_max(rm); \
        if (first || __any(rm > THR)) { \
            const float dl = first ? (rm > -1e29f ? rm : 0.f) : fmaxf(rm, 0.f); \
            mhat += dl; \
            _Pragma("unroll") for (int r = 0; r < 16; ++r) { p[r] -= dl; negm[r] = -mhat; } \
            if (!first) { const float f = __builtin_amdgcn_exp2f(-dl); lsum *= f; if (hi == 0) wsf[r32] = f; asm volatile("s_waitcnt lgkmcnt(0)" ::: "memory"); \
                _Pragma("unroll") for (int r = 0; r < 16; ++r) { const float fr = wsf[crow(r, hi)]; o0[r] *= fr; o1[r] *= fr; } } \
            first = false; } \
        float ps = 0.f; \
        _Pragma("unroll") for (int r = 0; r < 16; ++r) { p[r] = __builtin_amdgcn_exp2f(p[r]); ps += p[r]; } \
        lsum += ps; \
        u32x4 w0, w1; \
        w0.x = cvtpk(p[0], p[1]); w0.y = cvtpk(p[2], p[3]); w0.z = cvtpk(p[4], p[5]); w0.w = cvtpk(p[6], p[7]); \
        w1.x = cvtpk(p[8], p[9]); w1.y = cvtpk(p[10], p[11]); w1.z = cvtpk(p[12], p[13]); w1.w = cvtpk(p[14], p[15]); \
        const char* vb = smem + V0 + buf * VB + r32 * VP + ((koff) + 4 * hi) * 2; \
        { const bf16x8 pa = __builtin_bit_cast(bf16x8, w0); const uint2 a0 = *(const uint2*)(vb), a1 = *(const uint2*)(vb + 16), b0 = *(const uint2*)(vb + 32 * VP), b1 = *(const uint2*)(vb + 32 * VP + 16); \
          const bf16x8 v0 = __builtin_bit_cast(bf16x8, make_uint4(a0.x, a0.y, a1.x, a1.y)), v1 = __builtin_bit_cast(bf16x8, make_uint4(b0.x, b0.y, b1.x, b1.y)); \
          o0 = __builtin_amdgcn_mfma_f32_32x32x16_bf16(pa, v0, o0, 0, 0, 0); o1 = __builtin_amdgcn_mfma_f32_32x32x16_bf16(pa, v1, o1, 0, 0, 0); } \
        { const bf16x8 pa = __builtin_bit_cast(bf16x8, w1); const uint2 a0 = *(const uint2*)(vb + 32), a1 = *(const uint2*)(vb + 48), b0 = *(const uint2*)(vb + 32 * VP + 32), b1 = *(const uint2*)(vb + 32 * VP + 48); \
          const bf16x8 v0 = __builtin_bit_cast(bf16x8, make_uint4(a0.x, a0.y, a1.x, a1.y)), v1 = __builtin_bit_cast(bf16x8, make_uint4(b0.x, b0.y, b1.x, b1.y)); \
          o0 = __builtin_amdgcn_mfma_f32_32x32x16_bf16(pa, v0, o0, 0, 0, 0); o1 = __builtin_amdgcn_mfma_f32_32x32x16_bf16(pa, v1, o1, 0, 0, 0); } \
    } while (0)
    for (int t = 0; t < NT; ++t) {
        const int buf = t & 1;
        if (t + 1 < NT) NA_GLOAD(t + 1);
        if (t < NL) { const int kr = krU + t; if (kr >= wlo && kr < whi) NA_BLOCK(kc0, true, kr); }
        else { NA_BLOCK(0, false, 0); NA_BLOCK(32, false, 0); }
        if (t + 1 < NT) NA_SWRITE(buf ^ 1);
        __syncthreads();
    }
#undef NA_BLOCK
#undef NA_GLOAD
#undef NA_SWRITE
    lsum = xhalf_sum(lsum);
    if (hi == 0) wsf[32 + r32] = lsum;
    asm volatile("s_waitcnt lgkmcnt(0)" ::: "memory");
    bf16_t* stg = (bf16_t*)(smem + OST) + wid * 2048;
#pragma unroll
    for (int r = 0; r < 16; ++r) { const int orow = crow(r, hi); const float rl = 1.f / wsf[32 + orow]; stg[orow * 64 + r32] = f2bf(o0[r] * rl); stg[orow * 64 + 32 + r32] = f2bf(o1[r] * rl); }
    asm volatile("s_waitcnt lgkmcnt(0)" ::: "memory");
#pragma unroll
    for (int i = 0; i < 4; ++i) { const int q = i * 8 + (lane >> 3), ch = lane & 7; const u32x4 v = *(const u32x4*)(stg + q * 64 + ch * 8);
        const size_t orow = ctxu ? (size_t)NLAT + b * CTXL + wid * 32 + q : (size_t)b * SEQ + (size_t)(4 * g + 2 * pr + (q >> 4)) * 64 + cbk + (q & 15);
        *(u32x4*)(MIX + orow * DM + 256 + h * 64 + ch * 8) = v; }
}
}


__device__ __forceinline__ float reduce64(float (&v)[64], int lane) {
#pragma unroll
    for (int i = 0; i < 32; ++i) { auto r = __builtin_amdgcn_permlane32_swap(__float_as_uint(v[i]), __float_as_uint(v[i + 32]), false, false); v[i] = __uint_as_float(r[0]) + __uint_as_float(r[1]); }
#pragma unroll
    for (int i = 0; i < 16; ++i) { auto r = __builtin_amdgcn_permlane16_swap(__float_as_uint(v[i]), __float_as_uint(v[i + 16]), false, false); v[i] = __uint_as_float(r[0]) + __uint_as_float(r[1]); }
    const bool b3 = lane & 8, b2 = lane & 4, b1 = lane & 2, b0 = lane & 1;
#pragma unroll
    for (int i = 0; i < 8; ++i) { const float keep = b3 ? v[i + 8] : v[i], send = b3 ? v[i] : v[i + 8]; v[i] = keep + dpp_f<0x140>(send); }
#pragma unroll
    for (int i = 0; i < 4; ++i) { const float keep = b2 ? v[i + 4] : v[i], send = b2 ? v[i] : v[i + 4]; v[i] = keep + dpp_f<0x141>(send); }
#pragma unroll
    for (int i = 0; i < 2; ++i) { const float keep = b1 ? v[i + 2] : v[i], send = b1 ? v[i] : v[i + 2]; v[i] = keep + dpp_f<0x4E>(send); }
    { const float keep = b0 ? v[1] : v[0], send = b0 ? v[0] : v[1]; v[0] = keep + dpp_f<0xB1>(send); }
    return v[0];
}
#define PROBE_SET 0
#ifndef PHASE_INLINE
#define PHASE_INLINE __forceinline__
#endif

namespace rt {
using fa::bf16x8; using fa::f32x16; using fa::u32x4; using fa::crow; using fa::cvtpk;
constexpr int KP = 144, KBY = 128 * KP, VP = 264, VBY = 64 * VP, SP = 144, SBY = 64 * SP;
constexpr int OK_ = 0, OV = KBY, OSF = OV + VBY, OSB = OSF + SBY, UNIT = OSB + SBY, STG = 2 * UNIT, BYTES = STG + 8 * 4096;
static_assert(UNIT % 16 == 0 && BYTES <= 144 * 1024 - 64, "retention LDS map");
template <int CTRL> __device__ __forceinline__ float dppf(float v) { return __uint_as_float((unsigned)__builtin_amdgcn_mov_dpp((int)__float_as_uint(v), CTRL, 0xF, 0xF, true)); }
__device__ __forceinline__ float half_sum(float v) {
    v += dppf<0xB1>(v); v += dppf<0x4E>(v); v += dppf<0x141>(v); v += dppf<0x140>(v);
    auto r = __builtin_amdgcn_permlane16_swap(__float_as_uint(v), __float_as_uint(v), false, false); return __uint_as_float(r[0]) + __uint_as_float(r[1]);
}
__device__ __forceinline__ void ret_pair(char* smem, int it0, int n_it, const bf16_t* P, const float* RKV, const float* dec_f, const float* dec_b, bf16_t* MIX) {
    const int tid = tid_(), lane = tid & 63, r32 = lane & 31, hi = lane >> 5; const int wid = __builtin_amdgcn_readfirstlane(tid >> 6);
    const int hw = wid >> 2, w4 = wid & 3, t4 = tid & 255;
    const int it = it0 + hw; const bool valid = it < n_it;
    int b, hd, j, row0;
    if (it < 1024) { b = it >> 8; hd = (it >> 6) & 3; j = it & 63; row0 = b * SEQ + j * 128; } else { const int q = it - 1024; b = q >> 3; hd = (q >> 1) & 3; j = q & 1; row0 = NLAT + b * CTXL + j * 128; }
    char* un = smem + hw * UNIT;
    __syncthreads();
    if (valid) {
#pragma unroll
        for (int c = 0; c < 4; ++c) { const int ch = t4 + 256 * c, r = ch >> 3, cc = ch & 7; const bf16_t* src = P + (size_t)(row0 + r) * LDP + hd * 64 + cc * 8;
            *(uint4*)(un + OK_ + r * KP + cc * 16) = *(const uint4*)(src + PC_RK);
            const uint4 v = *(const uint4*)(src + PC_RV); bf16_t* vt = (bf16_t*)(un + OV) + (cc * 8) * (VP / 2) + r;
            vt[0 * (VP / 2)] = (bf16_t)(v.x & 0xffff); vt[1 * (VP / 2)] = (bf16_t)(v.x >> 16); vt[2 * (VP / 2)] = (bf16_t)(v.y & 0xffff); vt[3 * (VP / 2)] = (bf16_t)(v.y >> 16);
            vt[4 * (VP / 2)] = (bf16_t)(v.z & 0xffff); vt[5 * (VP / 2)] = (bf16_t)(v.z >> 16); vt[6 * (VP / 2)] = (bf16_t)(v.w & 0xffff); vt[7 * (VP / 2)] = (bf16_t)(v.w >> 16); }
#pragma unroll
        for (int c = 0; c < 16; ++c) { const int idx = t4 + 256 * c, d = idx >> 6, e = idx & 63;
            ((bf16_t*)(un + OSF))[e * (SP / 2) + d] = f2bf(RKV[((size_t)it * 2 + 0) * 4096 + idx]); ((bf16_t*)(un + OSB))[e * (SP / 2) + d] = f2bf(RKV[((size_t)it * 2 + 1) * 4096 + idx]); }
    }
    __syncthreads();
    if (valid) {
        const float lgf2 = log_sigmoid_f(dec_f[hd]) * 1.4426950408889634f, lgb2 = log_sigmoid_f(dec_b[hd]) * 1.4426950408889634f;
        const int qi = w4 * 32 + r32;
        bf16x8 qf[4];
#pragma unroll
        for (int ks = 0; ks < 4; ++ks) qf[ks] = *(const bf16x8*)(P + (size_t)(row0 + qi) * LDP + PC_RQ + hd * 64 + ks * 16 + hi * 8);
        f32x16 o0, o1;
#pragma unroll
        for (int r = 0; r < 16; ++r) { o0[r] = 0.f; o1[r] = 0.f; }
#pragma unroll
        for (int kb = 0; kb < 4; ++kb) {
            f32x16 pz;
#pragma unroll
            for (int r = 0; r < 16; ++r) pz[r] = 0.f;
            const char* kp = un + OK_ + (kb * 32 + r32) * KP + hi * 16;
#pragma unroll
            for (int ks = 0; ks < 4; ++ks) { const bf16x8 a = *(const bf16x8*)(kp + ks * 32); pz = __builtin_amdgcn_mfma_f32_32x32x16_bf16(a, qf[ks], pz, 0, 0, 0); }
#pragma unroll
            for (int r = 0; r < 16; ++r) { const int dI = qi - (kb * 32 + crow(r, hi)); const float arg = dI >= 0 ? lgf2 * (float)dI : -lgb2 * (float)dI; pz[r] *= __builtin_amdgcn_exp2f(arg); }
            u32x4 w0, w1;
            w0.x = cvtpk(pz[0], pz[1]); w0.y = cvtpk(pz[2], pz[3]); w0.z = cvtpk(pz[4], pz[5]); w0.w = cvtpk(pz[6], pz[7]);
            w1.x = cvtpk(pz[8], pz[9]); w1.y = cvtpk(pz[10], pz[11]); w1.z = cvtpk(pz[12], pz[13]); w1.w = cvtpk(pz[14], pz[15]);
            const char* vb = un + OV + r32 * VP + (kb * 32 + 4 * hi) * 2;
            { const bf16x8 pa = __builtin_bit_cast(bf16x8, w0); const uint2 a0 = *(const uint2*)(vb), a1 = *(const uint2*)(vb + 16), b0 = *(const uint2*)(vb + 32 * VP), b1 = *(const uint2*)(vb + 32 * VP + 16);
              o0 = __builtin_amdgcn_mfma_f32_32x32x16_bf16(pa, __builtin_bit_cast(bf16x8, make_uint4(a0.x, a0.y, a1.x, a1.y)), o0, 0, 0, 0);
              o1 = __builtin_amdgcn_mfma_f32_32x32x16_bf16(pa, __builtin_bit_cast(bf16x8, make_uint4(b0.x, b0.y, b1.x, b1.y)), o1, 0, 0, 0); }
            { const bf16x8 pa = __builtin_bit_cast(bf16x8, w1); const uint2 a0 = *(const uint2*)(vb + 32), a1 = *(const uint2*)(vb + 48), b0 = *(const uint2*)(vb + 32 * VP + 32), b1 = *(const uint2*)(vb + 32 * VP + 48);
              o0 = __builtin_amdgcn_mfma_f32_32x32x16_bf16(pa, __builtin_bit_cast(bf16x8, make_uint4(a0.x, a0.y, a1.x, a1.y)), o0, 0, 0, 0);
              o1 = __builtin_amdgcn_mfma_f32_32x32x16_bf16(pa, __builtin_bit_cast(bf16x8, make_uint4(b0.x, b0.y, b1.x, b1.y)), o1, 0, 0, 0); }
        }
        {
            f32x16 tf0, tf1, tb0, tb1;
#pragma unroll
            for (int r = 0; r < 16; ++r) { tf0[r] = 0.f; tf1[r] = 0.f; tb0[r] = 0.f; tb1[r] = 0.f; }
            const char* sf = un + OSF + r32 * SP + hi * 16; const char* sb = un + OSB + r32 * SP + hi * 16;
#pragma unroll
            for (int ks = 0; ks < 4; ++ks) {
                tf0 = __builtin_amdgcn_mfma_f32_32x32x16_bf16(qf[ks], *(const bf16x8*)(sf + ks * 32), tf0, 0, 0, 0); tf1 = __builtin_amdgcn_mfma_f32_32x32x16_bf16(qf[ks], *(const bf16x8*)(sf + 32 * SP + ks * 32), tf1, 0, 0, 0);
                tb0 = __builtin_amdgcn_mfma_f32_32x32x16_bf16(qf[ks], *(const bf16x8*)(sb + ks * 32), tb0, 0, 0, 0); tb1 = __builtin_amdgcn_mfma_f32_32x32x16_bf16(qf[ks], *(const bf16x8*)(sb + 32 * SP + ks * 32), tb1, 0, 0, 0);
            }
#pragma unroll
            for (int r = 0; r < 16; ++r) { const int i = w4 * 32 + crow(r, hi); const float cf = __builtin_amdgcn_exp2f(lgf2 * (float)(i + 1)), cb = __builtin_amdgcn_exp2f(lgb2 * (float)(128 - i));
                o0[r] += cf * tf0[r] + cb * tb0[r]; o1[r] += cf * tf1[r] + cb * tb1[r]; }
        }
        bf16_t* stg = (bf16_t*)(smem + STG) + wid * 2048;
#pragma unroll
        for (int r = 0; r < 16; ++r) {
            const float mu = half_sum(o0[r] + o1[r]) * (1.f / 64.f); const float d0 = o0[r] - mu, d1 = o1[r] - mu;
            const float rs = rsqrtf(half_sum(d0 * d0 + d1 * d1) * (1.f / 64.f) + 1e-6f);
            const int q = crow(r, hi); stg[q * 64 + r32] = f2bf(d0 * rs); stg[q * 64 + 32 + r32] = f2bf(d1 * rs);
        }
        asm volatile("s_waitcnt lgkmcnt(0)" ::: "memory");
#pragma unroll
        for (int i = 0; i < 4; ++i) { const int q = i * 8 + (lane >> 3), ch = lane & 7; const size_t row = (size_t)row0 + w4 * 32 + q;
            const u32x4 y = *(const u32x4*)(stg + q * 64 + ch * 8), gg = *(const u32x4*)(P + row * LDP + PC_RG + hd * 64 + ch * 8); u32x4 o;
#define RT_G(yv, gv) cvtpk(__uint_as_float((yv) << 16) * silu_f(__uint_as_float((gv) << 16)), __uint_as_float((yv) & 0xffff0000u) * silu_f(__uint_as_float((gv) & 0xffff0000u)))
            o.x = RT_G(y.x, gg.x); o.y = RT_G(y.y, gg.y); o.z = RT_G(y.z, gg.z); o.w = RT_G(y.w, gg.w);
#undef RT_G
            *(u32x4*)(MIX + row * DM + hd * 64 + ch * 8) = o; }
    }
}
}

template <int KIND> __device__ PHASE_INLINE void phase(const Params& p, const int l, char* smem) {
    __syncthreads();
    const int tid = tid_(), lane = tid & 63, wid = tid >> 6;
    const int nblk = gridDim.x, bid = bid_();
    size_t zoff = 0; asm volatile("" : "+s"(zoff));
    unsigned char* ws = p.ws + zoff;
    float* MOD = (float*)(ws + WS_MOD);
    bf16_t* U = (bf16_t*)(ws + WS_U);
    bf16_t* P = (bf16_t*)(ws + WS_P);
    bf16_t* QM = (bf16_t*)(ws + WS_QM);
    bf16_t* KM = (bf16_t*)(ws + WS_KM);
    bf16_t* VM = (bf16_t*)(ws + WS_VM);
    float* RKV = (float*)(ws + WS_RKV);
    bf16_t* XS = (bf16_t*)(ws + WS_XS);
    bf16_t* HDN = (bf16_t*)(ws + WS_HDN);
    int2* RTE = (int2*)(ws + WS_RT + RT_E);
    float2* RTW = (float2*)(ws + WS_RT + RT_W);
    float* RTR = (float*)(ws + WS_RT + RT_RSTD);
    int2* RTS = (int2*)(ws + WS_RT + RT_SLOT);
    int* CNT = (int*)(ws + WS_RT + RT_CNT);
    int* SEG = (int*)(ws + WS_RT + RT_SEG);
    int* TILE = (int*)(ws + WS_RT + RT_TILE);
    bf16_t* VT = (bf16_t*)(ws + WS_VT);
    bf16_t* NVT = (bf16_t*)(ws + WS_NVT);
    bf16_t* WT = (bf16_t*)(ws + WS_WT);
    PG8_LAS unsigned char* lds3 = (PG8_LAS unsigned char*)smem;
    float* const Hlat = p.out; float* const Hctx = (float*)(ws + WS_HC);

    if constexpr (KIND == 0) {
        {
            float* sc = (float*)smem;
            float* red = sc + 5 * DM;
            for (int i = tid; i < 5 * DM; i += 512) { const int v = i / DM, k = i % DM; const float x = v < 4 ? p.in[I_C][v * DM + k] : p.in[I_CCTX][k]; sc[i] = silu_f(x); }
            __syncthreads();
            for (int it = bid; it < 2 * 96; it += nblk) {
                const int ll = it / 96, j = (it % 96) * 64 + lane;
                const float* wm = p.in[I_WMOD] + (size_t)ll * DM * 6144 + (size_t)(wid * 128) * 6144 + j;
                float a0 = 0.f, a1 = 0.f, a2 = 0.f, a3 = 0.f, a4 = 0.f;
#pragma unroll 8
                for (int k = 0; k < 128; ++k) { const float w = wm[(size_t)k * 6144]; const int kk = wid * 128 + k; a0 = fmaf(sc[kk], w, a0); a1 = fmaf(sc[DM + kk], w, a1); a2 = fmaf(sc[2 * DM + kk], w, a2); a3 = fmaf(sc[3 * DM + kk], w, a3); a4 = fmaf(sc[4 * DM + kk], w, a4); }
                __syncthreads();
                red[(wid * 5 + 0) * 64 + lane] = a0; red[(wid * 5 + 1) * 64 + lane] = a1; red[(wid * 5 + 2) * 64 + lane] = a2; red[(wid * 5 + 3) * 64 + lane] = a3; red[(wid * 5 + 4) * 64 + lane] = a4;
                __syncthreads();
                if (tid < 320) { const int v = tid >> 6, c = tid & 63; float t = p.in[I_BMOD][ll * 6144 + (it % 96) * 64 + c];
#pragma unroll
                    for (int w8 = 0; w8 < 8; ++w8) t += red[(w8 * 5 + v) * 64 + c];
                    MOD[((size_t)ll * 5 + v) * 6144 + (it % 96) * 64 + c] = t; }
            }
            __syncthreads();
        }
        {
            float* tl = (float*)smem; int base = 0;
            for (int ll = 0; ll < 2; ++ll) {
                transpose_mat(tl, p.in[I_WIN] + (size_t)ll * DM * DPROJ, DM, DPROJ, 3328, WT + WT_IN + ll * WT_IN_L, 1, 0, base);
                transpose_mat(tl, p.in[I_WUQ] + (size_t)ll * 384 * 384, 384, 384, 512, WT + WT_UQ + ll * WT_UQ_L, 1, 0, base);
                transpose_mat(tl, p.in[I_WUKV] + (size_t)ll * 256 * 512, 256, 512, 512, WT + WT_UKV + ll * WT_UKV_L, 1, 0, base);
                transpose_mat(tl, p.in[I_WOUT] + (size_t)ll * DM * DM, DM, DM, DM, WT + WT_OUT + ll * WT_OUT_L, 1, 0, base);
                for (int e = 0; e < NE; ++e) {
                    transpose_mat(tl, p.in[I_W1] + ((size_t)ll * NE + e) * DM * FF, DM, FF, FF, WT + WT_13 + ll * WT_13_L + (size_t)e * 512 * 1024, 2, 0, base);
                    transpose_mat(tl, p.in[I_W3] + ((size_t)ll * NE + e) * DM * FF, DM, FF, FF, WT + WT_13 + ll * WT_13_L + (size_t)e * 512 * 1024, 2, 1, base);
                    transpose_mat(tl, p.in[I_W2] + ((size_t)ll * NE + e) * FF * DM, FF, DM, DM, WT + WT_2 + ll * WT_2_L + (size_t)e * 1024 * 256, 1, 0, base);
                }
            }
        }
    }

    {
        const bool last = (l == 1);
        const float* modl = MOD + (size_t)l * 5 * 6144;
        const int rows_mix = last ? NLAT : NROW;

        if constexpr (KIND == 1) {
            const float* g = p.in[I_N1G] + l * DM; const float* modp = MOD + (size_t)(l - 1) * 5 * 6144;
            for (int row = bid * 8 + wid; row < NROW; row += nblk * 8) {
                const float* mv = modl + row_modv(row) * 6144;
                float4 x[4]; float ss = 0.f;
                if (l == 0) {
                    const float* h = row < NLAT ? p.in[I_X] + (size_t)row * DM : p.in[I_CTX] + (size_t)(row - NLAT) * DM;
#pragma unroll
                    for (int i = 0; i < 4; ++i) x[i] = *(const float4*)(h + lane * 4 + 256 * i);
                } else {
                    float* h = hrow2(Hlat, Hctx, row); const float* mg = modp + row_modv(row) * 6144 + 5120;
                    const int2 s2 = RTS[row]; const float2 w2 = RTW[row];
#pragma unroll
                    for (int i = 0; i < 4; ++i) {
                        const int c = lane * 4 + 256 * i;
                        const uint2 ya = *(const uint2*)(XS + (size_t)s2.x * DM + c), yb = *(const uint2*)(XS + (size_t)s2.y * DM + c);
                        float4 xx = *(const float4*)(h + c); const float4 gg = *(const float4*)(mg + c);
                        xx.x += gg.x * (w2.x * __uint_as_float(ya.x << 16) + w2.y * __uint_as_float(yb.x << 16));
                        xx.y += gg.y * (w2.x * __uint_as_float(ya.x & 0xffff0000u) + w2.y * __uint_as_float(yb.x & 0xffff0000u));
                        xx.z += gg.z * (w2.x * __uint_as_float(ya.y << 16) + w2.y * __uint_as_float(yb.y << 16));
                        xx.w += gg.w * (w2.x * __uint_as_float(ya.y & 0xffff0000u) + w2.y * __uint_as_float(yb.y & 0xffff0000u));
                        *(float4*)(h + c) = xx; x[i] = xx;
                    }
                }
#pragma unroll
                for (int i = 0; i < 4; ++i) ss += x[i].x * x[i].x + x[i].y * x[i].y + x[i].z * x[i].z + x[i].w * x[i].w;
                ss = wave_sum(ss);
                const float rstd = rsqrtf(ss * (1.f / DM) + 1e-6f);
#pragma unroll
                for (int i = 0; i < 4; ++i) {
                    const int c = lane * 4 + 256 * i;
                    const float4 gg = *(const float4*)(g + c), sh = *(const float4*)(mv + c), sc = *(const float4*)(mv + 1024 + c);
                    const float y0 = x[i].x * rstd * gg.x * (1.f + sc.x) + sh.x, y1 = x[i].y * rstd * gg.y * (1.f + sc.y) + sh.y;
                    const float y2 = x[i].z * rstd * gg.z * (1.f + sc.z) + sh.z, y3 = x[i].w * rstd * gg.w * (1.f + sc.w) + sh.w;
                    uint2 o; o.x = (unsigned)f2bf(y0) | ((unsigned)f2bf(y1) << 16); o.y = (unsigned)f2bf(y2) | ((unsigned)f2bf(y3) << 16);
                    *(uint2*)(U + (size_t)row * DM + c) = o;
                }
            }
        }
        if constexpr (KIND == 2) {
            pg8::Gemm g{U, WT + WT_IN + l * WT_IN_L, DM, DM, DM}; pg8::StaticOrder S; S.init(NROW, 3328, nblk, bid);
            pg8::EpiP E{P, LDP};
            pg8::gemm_phase<pg8::EpiP, pg8::StaticOrder, true, true>(lds3, g, S, E);
        }
        if constexpr (KIND == 3) {
            const float* qn = p.in[I_QN] + l * 384; const float* kvn = p.in[I_KVN] + l * 256;
            for (int row = bid * 8 + wid; row < NROW; row += nblk * 8) {
                bf16_t* pr = P + (size_t)row * LDP;
                const bool lat = row < NLAT; const int tt = row & (SEQ - 1);
                const float posr = (float)(tt >> 6), posc = (float)(tt & 63);
#pragma unroll
                for (int i = 0; i < 4; ++i) {
                    const int pi = lane + 64 * i, arr = pi >> 7, hd = (pi >> 5) & 3, pp = pi & 31, sec = pp >> 4, ii = pp & 15;
                    bf16_t* b = pr + (arr ? PC_RK : PC_RQ) + hd * 64 + sec * 32 + ii;
                    float x1 = bf2f(b[0]), x2 = bf2f(b[16]);
                    if (lat) rope_pair(x1, x2, sec ? posc : posr, ii, 16);
                    if (!arr) { x1 *= 0.125f; x2 *= 0.125f; }
                    b[0] = f2bf(x1); b[16] = f2bf(x2);
                }
                if (lat && lane < 16) {
                    const int sec = lane >> 3, ii = lane & 7;
                    bf16_t* b = pr + PC_KPE + sec * 16 + ii;
                    float x1 = bf2f(b[0]), x2 = bf2f(b[8]);
                    rope_pair(x1, x2, sec ? posc : posr, ii, 8);
                    b[0] = f2bf(x1); b[8] = f2bf(x2);
                }
#pragma unroll
                for (int i = 0; i < 8; ++i) { bf16_t* b = pr + PC_NQ + lane + 64 * i; *b = f2bf(bf2f(*b) * (0.125f * 1.4426950408889634f)); }
                {
                    float v[6]; float ss = 0.f;
#pragma unroll
                    for (int i = 0; i < 6; ++i) { v[i] = bf2f(pr[PC_CQ + lane + 64 * i]); ss += v[i] * v[i]; }
                    ss = wave_sum(ss); const float rs = rsqrtf(ss * (1.f / 384.f) + 1e-6f);
#pragma unroll
                    for (int i = 0; i < 6; ++i) pr[PC_CQ + lane + 64 * i] = f2bf(v[i] * rs * qn[lane + 64 * i]);
                    float w[4]; float s2 = 0.f;
#pragma unroll
                    for (int i = 0; i < 4; ++i) { w[i] = bf2f(pr[PC_CKV + lane + 64 * i]); s2 += w[i] * w[i]; }
                    s2 = wave_sum(s2); const float rs2 = rsqrtf(s2 * (1.f / 256.f) + 1e-6f);
#pragma unroll
                    for (int i = 0; i < 4; ++i) pr[PC_CKV + lane + 64 * i] = f2bf(w[i] * rs2 * kvn[lane + 64 * i]);
                }
            }
            {
                bf16_t* tl = (bf16_t*)smem;
                for (int it = bid; it < 32 * 132; it += nblk) {
                    const int bh = it / 132, tile = it % 132, b = bh >> 3, hd = bh & 7;
                    const size_t row0 = tile < 128 ? (size_t)b * SEQ + tile * 64 : (size_t)NLAT + b * CTXL + (tile - 128) * 64;
                    __syncthreads();
                    { const int r = tid >> 3, d8 = (tid & 7) * 8; const uint4 v = *(const uint4*)(P + (row0 + r) * LDP + PC_NV + hd * 64 + d8);
                      unsigned* d = (unsigned*)(tl + r * 66 + d8); d[0] = v.x; d[1] = v.y; d[2] = v.z; d[3] = v.w; }
                    __syncthreads();
                    { const int dv = tid >> 3, g = tid & 7, s4 = g >> 1, hh = g & 1; unsigned short e[8];
#pragma unroll
                      for (int j = 0; j < 8; ++j) e[j] = tl[(8 * g + j) * 66 + dv];
                      uint4 o; o.x = e[0] | ((unsigned)e[1] << 16); o.y = e[2] | ((unsigned)e[3] << 16); o.z = e[4] | ((unsigned)e[5] << 16); o.w = e[6] | ((unsigned)e[7] << 16);
                      *(uint4*)(NVT + ((size_t)it * 64 + dv) * 64 + g * 8) = o; }
                }
                __syncthreads();
            }
        }
        if constexpr (KIND == 14) {
            pg8::Gemm g{P + PC_CKV, WT + WT_UKV + l * WT_UKV_L, LDP, 256, 256}; pg8::StaticOrder S; S.init(NROW, 512, nblk, bid);
            pg8::EpiUKV E{KM, VM};
            pg8::gemm_phase<pg8::EpiUKV, pg8::StaticOrder, true, true>(lds3, g, S, E);
        }
        if constexpr (KIND == 4) {
            {
                pg8::Gemm g{P + PC_CQ, WT + WT_UQ + l * WT_UQ_L, LDP, 384, 384}; pg8::StaticOrder S; S.init(NROW, 512, nblk, bid);
                pg8::EpiUQ E{QM};
                pg8::gemm_phase<pg8::EpiUQ, pg8::StaticOrder, true, true>(lds3, g, S, E);
            }
            __syncthreads();
            float* Ks = (float*)smem; float* Vs = Ks + 128 * 64; float* pwf = Vs + 128 * 64; float* pwb = pwf + 132;
            for (int it = bid; it < RET_ITEMS; it += nblk) {
                int b, hd, j, row0;
                if (it < 1024) { b = it >> 8; hd = (it >> 6) & 3; j = it & 63; row0 = b * SEQ + j * 128; } else { const int q = it - 1024; b = q >> 3; hd = (q >> 1) & 3; j = q & 1; row0 = NLAT + b * CTXL + j * 128; }
                const float lgf = log_sigmoid_f(p.in[I_RDF][l * 4 + hd]), lgb = log_sigmoid_f(p.in[I_RDB][l * 4 + hd]);
                __syncthreads();
                for (int idx = tid; idx < 128 * 64; idx += 512) { const int r = idx >> 6, c = idx & 63; const bf16_t* pr = P + (size_t)(row0 + r) * LDP + hd * 64 + c; Ks[idx] = bf2f(pr[PC_RK]); Vs[idx] = bf2f(pr[PC_RV]); }
                if (tid < 129) { pwf[tid] = expf(lgf * (float)tid); pwb[tid] = expf(lgb * (float)tid); }
                __syncthreads();
                const int d = tid >> 3, e0 = (tid & 7) * 8;
                float af[8], ab[8];
#pragma unroll
                for (int e = 0; e < 8; ++e) { af[e] = 0.f; ab[e] = 0.f; }
                for (int i = 0; i < 128; ++i) {
                    const float kd = Ks[i * 64 + d], wf = pwf[127 - i] * kd, wb = pwb[i] * kd;
#pragma unroll
                    for (int e = 0; e < 8; ++e) { const float v = Vs[i * 64 + e0 + e]; af[e] = fmaf(wf, v, af[e]); ab[e] = fmaf(wb, v, ab[e]); }
                }
                float* of = RKV + ((size_t)it * 2 + 0) * 4096 + d * 64 + e0; float* ob = RKV + ((size_t)it * 2 + 1) * 4096 + d * 64 + e0;
#pragma unroll
                for (int e = 0; e < 8; ++e) { of[e] = af[e]; ob[e] = ab[e]; }
            }
        }
        if constexpr (KIND == 5) {
            for (int row = bid * 8 + wid; row < NROW; row += nblk * 8) {
                const bool lat = row < NLAT; const int tt = row & (SEQ - 1);
                const float posr = (float)(tt >> 6), posc = (float)(tt & 63);
                const float scq = 0.10206207261596577f * 1.4426950408889634f;
                {
                    const int hd = lane >> 4, pp = lane & 15, sec = pp >> 3, ii = pp & 7;
                    bf16_t* b = QM + (size_t)row * 384 + hd * 96 + 64 + sec * 16 + ii;
                    float x1 = bf2f(b[0]), x2 = bf2f(b[8]);
                    if (lat) rope_pair(x1, x2, sec ? posc : posr, ii, 8);
                    b[0] = f2bf(x1 * scq); b[8] = f2bf(x2 * scq);
                }
#pragma unroll
                for (int i = 0; i < 4; ++i) { const int q = lane + 64 * i, hd = q >> 6, c = q & 63; bf16_t* b = QM + (size_t)row * 384 + hd * 96 + c; *b = f2bf(bf2f(*b) * scq); }
#pragma unroll
                for (int i = 0; i < 2; ++i) { const int q = lane + 64 * i, hd = q >> 5, c = q & 31; KM[(size_t)row * 384 + hd * 96 + 64 + c] = P[(size_t)row * LDP + PC_KPE + c]; }
            }
            {
                bf16_t* tl = (bf16_t*)smem;
                for (int it = bid; it < 16 * 132; it += nblk) {
                    const int bh = it / 132, tile = it % 132, b = bh >> 2, hd = bh & 3;
                    const size_t row0 = tile < 128 ? (size_t)b * SEQ + tile * 64 : (size_t)NLAT + b * CTXL + (tile - 128) * 64;
                    __syncthreads();
                    { const int r = tid >> 3, d8 = (tid & 7) * 8; const uint4 v = *(const uint4*)(VM + (row0 + r) * 256 + hd * 64 + d8);
                      unsigned* d = (unsigned*)(tl + r * 66 + d8); d[0] = v.x; d[1] = v.y; d[2] = v.z; d[3] = v.w; }
                    __syncthreads();
                    { const int dv = tid >> 3, g = tid & 7, s4 = g >> 1, hh = g & 1; unsigned short e[8];
#pragma unroll
                      for (int j = 0; j < 8; ++j) e[j] = tl[(16 * s4 + 8 * (j >> 2) + 4 * hh + (j & 3)) * 66 + dv];
                      uint4 o; o.x = e[0] | ((unsigned)e[1] << 16); o.y = e[2] | ((unsigned)e[3] << 16); o.z = e[4] | ((unsigned)e[5] << 16); o.w = e[6] | ((unsigned)e[7] << 16);
                      *(uint4*)(VT + ((size_t)it * 64 + dv) * 64 + g * 8) = o; }
                }
                __syncthreads();
            }
            for (int gid = bid * 512 + tid; gid < 2 * 16 * 4096; gid += nblk * 512) {
                const int el = gid & 4095, bh = (gid >> 12) & 15, dir = gid >> 16, hd = bh & 3;
                const float lg = log_sigmoid_f(dir ? p.in[I_RDB][l * 4 + hd] : p.in[I_RDF][l * 4 + hd]);
                const float g128 = expf(128.f * lg);
                float* c0p = RKV + ((size_t)(1024 + bh * 2 + 0) * 2 + dir) * 4096 + el;
                float* c1p = RKV + ((size_t)(1024 + bh * 2 + 1) * 2 + dir) * 4096 + el;
                const float c0 = *c0p, c1 = *c1p; float S;
                if (dir == 0) { *c0p = 0.f; *c1p = c0; S = g128 * c0 + c1; } else { *c1p = 0.f; *c0p = c1; S = g128 * c1 + c0; }
                for (int jj = 0; jj < 64; ++jj) {
                    const int j = dir ? 63 - jj : jj;
                    float* q = RKV + ((size_t)(bh * 64 + j) * 2 + dir) * 4096 + el;
                    const float tmp = *q; *q = S; S = fmaf(g128, S, tmp);
                }
            }
        }
        if constexpr (KIND == 6) {
            bf16_t* MIX = U;
            {
                const int n_mla = 512 + (last ? 0 : 16);
                for (int it = bid; it < n_mla; it += nblk) {
                    const bool cu = it >= 512; const int bh = cu ? it - 512 : it >> 5, qb = it & 31, b = bh >> 2, hd = bh & 3;
                    const size_t cr0 = (size_t)NLAT + b * CTXL, kr0 = (size_t)b * SEQ, r0 = cu ? cr0 : kr0 + qb * 256;
                    const bf16_t* k0 = KM + (cu ? cr0 : kr0) * 384 + hd * 96; const bf16_t* k1 = KM + cr0 * 384 + hd * 96;
                    fa::attn_unit<96>(smem, QM + r0 * 384 + hd * 96, 384, k0, cu ? 4 : 128, k1, cu ? 0 : 4, 384, VT + ((size_t)bh * 132 + (cu ? 128 : 0)) * 4096, MIX + r0 * DM + 768 + hd * 64, DM);
                }
            }
        }
        if constexpr (KIND == 15) {
            bf16_t* MIX = U;
            {
                const int n_na = 1024 + (last ? 0 : 32);
                for (int it = bid; it < n_na; it += nblk) {
                    const bool cu = it >= 1024; const int bh = cu ? it - 1024 : it >> 5, g = cu ? 0 : it & 31;
                    na::na_unit(smem, cu, bh >> 3, bh & 7, g, P, NVT, p.in[I_RPB] + ((size_t)l * 8 + (bh & 7)) * 465, MIX);
                }
                __syncthreads();
            }
        }
        if constexpr (KIND == 16) {
            bf16_t* MIX = U;
            const int n_it = last ? 1024 : RET_ITEMS;
            for (int pi = bid; pi * 2 < n_it; pi += nblk) rt::ret_pair(smem, pi * 2, n_it, P, RKV, p.in[I_RDF] + l * 4, p.in[I_RDB] + l * 4, MIX);
        }
        if constexpr (KIND == 7) {
            pg8::Gemm g{U, WT + WT_OUT + l * WT_OUT_L, DM, DM, DM}; pg8::StaticOrder S; S.init(rows_mix, DM, nblk, bid);
            pg8::EpiOut E{Hlat, Hctx, l == 0 ? p.in[I_X] : Hlat, l == 0 ? p.in[I_CTX] : Hctx, modl + 2048};
            pg8::gemm_phase<pg8::EpiOut, pg8::StaticOrder, true, true>(lds3, g, S, E);
        }
        if constexpr (KIND == 8) {
            const float* g = p.in[I_N2G] + l * DM; const float* rb = p.in[I_RB];
            float* rwl = (float*)smem;
            int* hist = (int*)(smem + 69632); float* wl = (float*)(smem + 69632 + 64) + wid * 64;
            for (int idx = tid; idx < 1024 * 4; idx += 512) { const int c = idx >> 2, q = idx & 3; const float4 v = *(const float4*)(p.in[I_RW] + (size_t)c * 16 + q * 4); *(float4*)(rwl + (c >> 2) * 68 + (c & 3) * 16 + q * 4) = v; }
            for (int ch = bid; ch < 256; ch += nblk) {
                __syncthreads();
                if (tid < 16) hist[tid] = 0;
                __syncthreads();
                const int ngrp = 4 + ((!last && wid == 0) ? 1 : 0);
                for (int gi = 0; gi < ngrp; ++gi) {
                    const int row0 = gi < 4 ? ch * 128 + wid * 16 + gi * 4 : NLAT + ch * 4;
                    const float* mv = modl + row_modv(row0) * 6144;
                    float4 u[4][4]; float rstd[4];
#pragma unroll
                    for (int t = 0; t < 4; ++t) { const float* h = hrow2(Hlat, Hctx, row0 + t); float ss = 0.f;
#pragma unroll
                        for (int k = 0; k < 4; ++k) { u[t][k] = *(const float4*)(h + lane * 4 + 256 * k); ss += u[t][k].x * u[t][k].x + u[t][k].y * u[t][k].y + u[t][k].z * u[t][k].z + u[t][k].w * u[t][k].w; }
                        rstd[t] = rsqrtf(wave_sum(ss) * (1.f / DM) + 1e-6f); }
#pragma unroll
                    for (int k = 0; k < 4; ++k) { const int c = lane * 4 + 256 * k;
                        const float4 gg = *(const float4*)(g + c), sh = *(const float4*)(mv + 3072 + c), sc = *(const float4*)(mv + 4096 + c);
                        const float4 a = make_float4(gg.x * (1.f + sc.x), gg.y * (1.f + sc.y), gg.z * (1.f + sc.z), gg.w * (1.f + sc.w));
#pragma unroll
                        for (int t = 0; t < 4; ++t) { u[t][k].x = u[t][k].x * rstd[t] * a.x + sh.x; u[t][k].y = u[t][k].y * rstd[t] * a.y + sh.y; u[t][k].z = u[t][k].z * rstd[t] * a.z + sh.z; u[t][k].w = u[t][k].w * rstd[t] * a.w + sh.w; } }
                    float lg[64];
#pragma unroll
                    for (int i = 0; i < 64; ++i) lg[i] = 0.f;
#pragma unroll
                    for (int k = 0; k < 4; ++k) {
                        const float* wb = rwl + (lane + 64 * k) * 68;
#pragma unroll
                        for (int r = 0; r < 4; ++r) {
                            const float4 w0 = *(const float4*)(wb + r * 16), w1 = *(const float4*)(wb + r * 16 + 4), w2 = *(const float4*)(wb + r * 16 + 8), w3 = *(const float4*)(wb + r * 16 + 12);
#pragma unroll
                            for (int t = 0; t < 4; ++t) { const float us = r == 0 ? u[t][k].x : (r == 1 ? u[t][k].y : (r == 2 ? u[t][k].z : u[t][k].w));
                                lg[t * 16 + 0] = fmaf(us, w0.x, lg[t * 16 + 0]); lg[t * 16 + 1] = fmaf(us, w0.y, lg[t * 16 + 1]); lg[t * 16 + 2] = fmaf(us, w0.z, lg[t * 16 + 2]); lg[t * 16 + 3] = fmaf(us, w0.w, lg[t * 16 + 3]);
                                lg[t * 16 + 4] = fmaf(us, w1.x, lg[t * 16 + 4]); lg[t * 16 + 5] = fmaf(us, w1.y, lg[t * 16 + 5]); lg[t * 16 + 6] = fmaf(us, w1.z, lg[t * 16 + 6]); lg[t * 16 + 7] = fmaf(us, w1.w, lg[t * 16 + 7]);
                                lg[t * 16 + 8] = fmaf(us, w2.x, lg[t * 16 + 8]); lg[t * 16 + 9] = fmaf(us, w2.y, lg[t * 16 + 9]); lg[t * 16 + 10] = fmaf(us, w2.z, lg[t * 16 + 10]); lg[t * 16 + 11] = fmaf(us, w2.w, lg[t * 16 + 11]);
                                lg[t * 16 + 12] = fmaf(us, w3.x, lg[t * 16 + 12]); lg[t * 16 + 13] = fmaf(us, w3.y, lg[t * 16 + 13]); lg[t * 16 + 14] = fmaf(us, w3.z, lg[t * 16 + 14]); lg[t * 16 + 15] = fmaf(us, w3.w, lg[t * 16 + 15]); }
                        }
                    }
                    wl[lane] = reduce64(lg, lane);
                    asm volatile("s_waitcnt lgkmcnt(0)" ::: "memory");
                    if (lane < 4) {
                        float scv[16], sel[16];
#pragma unroll
                        for (int e = 0; e < 16; ++e) { scv[e] = 1.f / (1.f + expf(-wl[lane * 16 + e])); sel[e] = scv[e] + rb[e]; }
                        int best = 0; float bestv = -INFINITY;
#pragma unroll
                        for (int gI = 0; gI < 4; ++gI) {
                            float m1 = -INFINITY, m2 = -INFINITY;
#pragma unroll
                            for (int k = 0; k < 4; ++k) { const float v = sel[gI * 4 + k]; if (v > m1) { m2 = m1; m1 = v; } else if (v > m2) m2 = v; }
                            const float gs = m1 + m2; if (gs > bestv) { bestv = gs; best = gI; }
                        }
                        int ia = -1, ib = -1; float va = -INFINITY, vb = -INFINITY, wa = 0.f, wb2 = 0.f;
#pragma unroll
                        for (int e = 0; e < 16; ++e) {
                            if ((e >> 2) == best) { const float v = sel[e]; if (v > va) { vb = va; ib = ia; wb2 = wa; va = v; ia = e; wa = scv[e]; } else if (v > vb) { vb = v; ib = e; wb2 = scv[e]; } }
                        }
                        const float inv = 1.f / (wa + wb2); const int row = row0 + lane;
                        RTE[row] = make_int2(ia, ib); RTW[row] = make_float2(wa * inv, wb2 * inv); RTR[row] = lane == 0 ? rstd[0] : (lane == 1 ? rstd[1] : (lane == 2 ? rstd[2] : rstd[3]));
                        atomicAdd(&hist[ia], 1); atomicAdd(&hist[ib], 1);
                    }
                }
                __syncthreads();
                if (tid < 16) CNT[ch * 16 + tid] = hist[tid];
            }
        }
        if constexpr (KIND == 9) {
            const float* g = p.in[I_N2G] + l * DM;
            int* cnts = (int*)smem;
            int* tots = cnts + 4096; int* befo = tots + 16; int* offs = befo + 16; int* sla = offs + 32; int* slb = sla + 136; int* ea = slb + 136; int* eb = ea + 136;
            const int ntok = last ? 128 : 132;
            for (int ch = bid; ch < 256; ch += nblk) {
                __syncthreads();
                for (int i = tid; i < 4096; i += 512) cnts[i] = CNT[i];
                if (tid < ntok) { const int row = tid < 128 ? ch * 128 + tid : NLAT + ch * 4 + (tid - 128); const int2 e2 = RTE[row]; ea[tid] = e2.x; eb[tid] = e2.y; }
                __syncthreads();
                if (tid < 16) { int tot = 0, bef = 0; for (int c2 = 0; c2 < 256; ++c2) { const int v = cnts[c2 * 16 + tid]; bef += c2 < ch ? v : 0; tot += v; } tots[tid] = tot; befo[tid] = bef; }
                __syncthreads();
                if (tid == 0) { int o = 0; for (int e = 0; e < 16; ++e) { offs[e] = o; o += (tots[e] + 255) & ~255; } offs[16] = o; }
                __syncthreads();
                if (tid < 16) { int pos = offs[tid] + befo[tid]; for (int i = 0; i < ntok; ++i) { if (ea[i] == tid) sla[i] = pos++; else if (eb[i] == tid) slb[i] = pos++; } }
                if (ch == 0 && tid == 128) { int rt = 0; for (int e = 0; e < 16; ++e) { const int nte = (tots[e] + 255) >> 8; for (int k = 0; k < nte; ++k) { TILE[16 + 2 * rt] = e; TILE[17 + 2 * rt] = (offs[e] >> 8) + k; ++rt; } } TILE[0] = rt; }
                __syncthreads();
                for (int i = wid; i < ntok; i += 8) {
                    const int row = i < 128 ? ch * 128 + i : NLAT + ch * 4 + (i - 128);
                    const float* h = hrow2(Hlat, Hctx, row); const float* mv = modl + row_modv(row) * 6144;
                    const float rstd = RTR[row]; const int sa = sla[i], sb = slb[i];
#pragma unroll
                    for (int k = 0; k < 4; ++k) {
                        const int c = lane * 4 + 256 * k;
                        const float4 x = *(const float4*)(h + c), gg = *(const float4*)(g + c), sh = *(const float4*)(mv + 3072 + c), sc = *(const float4*)(mv + 4096 + c);
                        const float u0 = x.x * rstd * gg.x * (1.f + sc.x) + sh.x, u1 = x.y * rstd * gg.y * (1.f + sc.y) + sh.y;
                        const float u2 = x.z * rstd * gg.z * (1.f + sc.z) + sh.z, u3 = x.w * rstd * gg.w * (1.f + sc.w) + sh.w;
                        uint2 o; o.x = (unsigned)f2bf(u0) | ((unsigned)f2bf(u1) << 16); o.y = (unsigned)f2bf(u2) | ((unsigned)f2bf(u3) << 16);
                        *(uint2*)(XS + (size_t)sa * DM + c) = o; *(uint2*)(XS + (size_t)sb * DM + c) = o;
                    }
                    if (lane == 0) RTS[row] = make_int2(sa, sb);
                }
            }
        }
        if constexpr (KIND == 10) {
            PG8_LAS int* ul = (PG8_LAS int*)(lds3 + 131072); const int nu = pg8::grouped_units(ul, TILE, 2, nblk, bid);
            pg8::Gemm g{XS, WT + WT_13 + l * WT_13_L, DM, DM, DM}; pg8::GroupedOrder S{ul, nu};
            pg8::EpiMoe1 E{HDN};
            pg8::gemm_phase<pg8::EpiMoe1, pg8::GroupedOrder, true, true>(lds3, g, S, E);
        }
        if constexpr (KIND == 11) {
            PG8_LAS int* ul = (PG8_LAS int*)(lds3 + 131072); const int nu = pg8::grouped_units(ul, TILE, 4, nblk, bid);
            pg8::Gemm g{HDN, WT + WT_2 + l * WT_2_L, FF, FF, FF}; pg8::GroupedOrder S{ul, nu};
            pg8::EpiMoe2 E{XS};
            pg8::gemm_phase<pg8::EpiMoe2, pg8::GroupedOrder, true, true>(lds3, g, S, E);
        }
    }
    if constexpr (KIND == 13) {
        const float* g = p.in[I_FNG]; const float* modp = MOD + (size_t)1 * 5 * 6144;
        for (int row = bid * 8 + wid; row < NLAT; row += nblk * 8) {
            float* h = p.out + (size_t)row * DM; const float* mg = modp + row_modv(row) * 6144 + 5120;
            const int2 s2 = RTS[row]; const float2 w2 = RTW[row];
            float4 x[4]; float ss = 0.f;
#pragma unroll
            for (int i = 0; i < 4; ++i) {
                const int c = lane * 4 + 256 * i;
                const uint2 ya = *(const uint2*)(XS + (size_t)s2.x * DM + c), yb = *(const uint2*)(XS + (size_t)s2.y * DM + c);
                float4 xx = *(const float4*)(h + c); const float4 gg = *(const float4*)(mg + c);
                xx.x += gg.x * (w2.x * __uint_as_float(ya.x << 16) + w2.y * __uint_as_float(yb.x << 16));
                xx.y += gg.y * (w2.x * __uint_as_float(ya.x & 0xffff0000u) + w2.y * __uint_as_float(yb.x & 0xffff0000u));
                xx.z += gg.z * (w2.x * __uint_as_float(ya.y << 16) + w2.y * __uint_as_float(yb.y << 16));
                xx.w += gg.w * (w2.x * __uint_as_float(ya.y & 0xffff0000u) + w2.y * __uint_as_float(yb.y & 0xffff0000u));
                x[i] = xx; ss += xx.x * xx.x + xx.y * xx.y + xx.z * xx.z + xx.w * xx.w;
            }
            ss = wave_sum(ss);
            const float rstd = rsqrtf(ss * (1.f / DM) + 1e-6f);
#pragma unroll
            for (int i = 0; i < 4; ++i) { const int c = lane * 4 + 256 * i; const float4 gg = *(const float4*)(g + c); float4 y; y.x = x[i].x * rstd * gg.x; y.y = x[i].y * rstd * gg.y; y.z = x[i].z * rstd * gg.z; y.w = x[i].w * rstd * gg.w; *(float4*)(h + c) = y; }
        }
    }
}

constexpr int LDS_BYTES = 144 * 1024;
template <int KIND> __global__ void __launch_bounds__(512, 2) k_ph(Params p, int l) {
    extern __shared__ __attribute__((aligned(16))) char smem[];
    phase<KIND>(p, l, smem);
}
__device__ __forceinline__ void grid_sync(unsigned char* wsp, char* smem) {
    unsigned* bw = (unsigned*)(wsp + WS_CTL); asm volatile("" : "+s"(bw));
    XcdBarrier b; b.bar = bw; b.x = xb_xcc_id(); b.st = (volatile LAS unsigned*)(smem + LDS_BYTES - 16);
    xcd_barrier(b);
}
__global__ void __launch_bounds__(512, 2) k_one(Params p) {
    extern __shared__ __attribute__((aligned(16))) char smem[];
    {
        volatile LAS unsigned* st = (volatile LAS unsigned*)(smem + LDS_BYTES - 16);
        if (threadIdx.x == 0) { st[0] = 0u; st[1] = 0u; st[2] = 0u; st[3] = 0u; }
        __syncthreads();
        (void)xcd_barrier_post((unsigned*)(p.ws + WS_CTL), st);
    }
#define SYNC() grid_sync(p.ws, smem)
    phase<0>(p, 0, smem); SYNC();
    if (PROBE_SET == 1) { phase<0>(p, 0, smem); SYNC(); }
#define DUP(k, stmt) do { stmt; if (PROBE_SET == (k)) { SYNC(); stmt; } } while (0)
#define LAYER(l) \
        phase<1>(p, l, smem); SYNC(); \
        DUP(2, phase<2>(p, l, smem)); SYNC(); \
        phase<3>(p, l, smem); SYNC(); \
        DUP(8, phase<4>(p, l, smem); phase<14>(p, l, smem)); SYNC(); \
        phase<5>(p, l, smem); SYNC(); \
        DUP(3, phase<6>(p, l, smem)); DUP(4, phase<15>(p, l, smem)); DUP(5, phase<16>(p, l, smem)); SYNC(); \
        phase<7>(p, l, smem); SYNC(); \
        DUP(7, phase<8>(p, l, smem)); SYNC(); \
        DUP(9, phase<9>(p, l, smem)); SYNC(); \
        DUP(6, phase<10>(p, l, smem)); SYNC(); \
        DUP(6, phase<11>(p, l, smem)); SYNC();
    LAYER(0)
    LAYER(1)
#undef LAYER
    phase<13>(p, 0, smem);
#undef SYNC
}
template <int KIND> static void launch_ph(const Params& p, int l, int grid, hipStream_t stream) {
    static bool attr_done = false;
    if (!attr_done) { (void)hipFuncSetAttribute((const void*)k_ph<KIND>, hipFuncAttributeMaxDynamicSharedMemorySize, LDS_BYTES); attr_done = true; }
    hipLaunchKernelGGL(k_ph<KIND>, dim3(grid), dim3(512), LDS_BYTES, stream, p, l);
}

extern "C" void kernel_launch(void* const* d_in, const int* in_sizes, int n_in, void* d_out, int out_size, void* d_ws, size_t ws_size, hipStream_t stream) {
    (void)in_sizes; (void)n_in; (void)out_size; (void)ws_size;
    static int grid = 0;
    if (!grid) {
        int dev = 0, cus = 0; (void)hipGetDevice(&dev); (void)hipDeviceGetAttribute(&cus, hipDeviceAttributeMultiprocessorCount, dev);
        grid = cus > 0 ? cus : 256;
        (void)hipFuncSetAttribute((const void*)k_one, hipFuncAttributeMaxDynamicSharedMemorySize, LDS_BYTES);
    }
    Params p{};
    for (int i = 0; i < 23; ++i) p.in[i] = (const float*)d_in[i];
    p.out = (float*)d_out; p.ws = (unsigned char*)d_ws;
#ifdef MULTI_LAUNCH
    launch_ph<0>(p, 0, grid, stream);
    for (int l = 0; l < 2; ++l) {
        launch_ph<1>(p, l, grid, stream); launch_ph<2>(p, l, grid, stream); launch_ph<3>(p, l, grid, stream); launch_ph<4>(p, l, grid, stream); launch_ph<14>(p, l, grid, stream);
        launch_ph<5>(p, l, grid, stream); launch_ph<6>(p, l, grid, stream); launch_ph<15>(p, l, grid, stream); launch_ph<16>(p, l, grid, stream); launch_ph<7>(p, l, grid, stream); launch_ph<8>(p, l, grid, stream);
        launch_ph<9>(p, l, grid, stream); launch_ph<10>(p, l, grid, stream); launch_ph<11>(p, l, grid, stream);
    }
    launch_ph<13>(p, 0, grid, stream);
#else
    (void)hipMemsetAsync((char*)d_ws + WS_CTL, 0, XCD_BAR_WORDS * sizeof(unsigned), stream);
    hipLaunchKernelGGL(k_one, dim3(grid), dim3(512), LDS_BYTES, stream, p);
#endif
}
```

```cpp
#include <hip/hip_runtime.h>
#include <stdint.h>
#include <math.h>

typedef unsigned short bf16_t;
#define LAS __attribute__((address_space(3)))

constexpr int DM = 1024, NB = 4, SEQ = 8192, GW = 64, CTXL = 256;
constexpr int NLAT = NB * SEQ;
constexpr int NCTX = NB * CTXL;
constexpr int NROW = NLAT + NCTX;
constexpr int DPROJ = 3232, LDP = 3328;
constexpr int PC_RQ = 0, PC_RK = 256, PC_RV = 512, PC_RG = 768, PC_NQ = 1024, PC_NK = 1536, PC_NV = 2048, PC_CQ = 2560, PC_CKV = 2944, PC_KPE = 3200;
constexpr int NE = 16, FF = 256;
constexpr int MAXSLOT = 2 * NROW + NE * 256;
constexpr int NCHUNK_TOK = 128;
constexpr int RET_ITEMS = 16 * 64 + 16 * 2;

constexpr size_t MiB = 1u << 20;
constexpr size_t WS_CTL = 0;
constexpr size_t WS_MOD = 1 * MiB;
constexpr size_t WS_HC = 2 * MiB;
constexpr size_t WS_RT = 6 * MiB;
constexpr size_t WS_U = 8 * MiB;
constexpr size_t WS_QM = 74 * MiB;
constexpr size_t WS_KM = 99 * MiB;
constexpr size_t WS_VM = 124 * MiB;
constexpr size_t WS_RKV = 141 * MiB;
constexpr size_t WS_P = 174 * MiB;
constexpr size_t WS_XS = WS_P;
constexpr size_t WS_HDN = WS_P + 140 * MiB;
constexpr size_t WS_WT = 389 * MiB;
constexpr size_t WT_IN = 0, WT_IN_L = (size_t)3328 * 1024;
constexpr size_t WT_UQ = WT_IN + 2 * WT_IN_L, WT_UQ_L = (size_t)512 * 384;
constexpr size_t WT_UKV = WT_UQ + 2 * WT_UQ_L, WT_UKV_L = (size_t)512 * 256;
constexpr size_t WT_OUT = WT_UKV + 2 * WT_UKV_L, WT_OUT_L = (size_t)1024 * 1024;
constexpr size_t WT_13 = WT_OUT + 2 * WT_OUT_L, WT_13_L = (size_t)16 * 512 * 1024;
constexpr size_t WT_2 = WT_13 + 2 * WT_13_L, WT_2_L = (size_t)16 * 1024 * 256;
constexpr size_t WT_END = WT_2 + 2 * WT_2_L;
static_assert(WS_WT + WT_END * 2 <= 512 * MiB, "workspace");
constexpr size_t WS_VT = 456 * MiB;
constexpr size_t WS_NVT = 473 * MiB;
static_assert(WS_NVT + (size_t)32 * 132 * 4096 * 2 <= 512 * MiB, "workspace");
constexpr size_t WS_PS = 506 * MiB;
constexpr size_t WS_TAB = 510 * MiB;
constexpr size_t RT_TILE = 1984 * 1024;
constexpr size_t RT_E = 0, RT_W = 512 * 1024, RT_RSTD = 1024 * 1024, RT_SLOT = 1280 * 1024, RT_CNT = 1792 * 1024, RT_SEG = 1920 * 1024;

struct Params { const float* in[23]; float* out; unsigned char* ws; int lo, hi; };
enum { I_X = 0, I_C, I_CTX, I_CCTX, I_WMOD, I_BMOD, I_N1G, I_N2G, I_WIN, I_RDF, I_RDB, I_RPB, I_QN, I_KVN, I_WUQ, I_WUKV, I_WOUT, I_RW, I_RB, I_W1, I_W3, I_W2, I_FNG };

__device__ __forceinline__ float bf2f(bf16_t v) { return __uint_as_float(((unsigned)v) << 16); }
__device__ __forceinline__ bf16_t f2bf(float f) { unsigned u = __float_as_uint(f); return (bf16_t)((u + 0x7fffu + ((u >> 16) & 1u)) >> 16); }
template <int CTRL> __device__ __forceinline__ float dpp_f(float v) { return __uint_as_float((unsigned)__builtin_amdgcn_mov_dpp((int)__float_as_uint(v), CTRL, 0xF, 0xF, true)); }
__device__ __forceinline__ float xor1_f(float v) { return dpp_f<0xB1>(v); }
__device__ __forceinline__ float xor2_f(float v) { return dpp_f<0x4E>(v); }
__device__ __forceinline__ float wave_sum(float v) {
    v += dpp_f<0xB1>(v); v += dpp_f<0x4E>(v); v += dpp_f<0x141>(v); v += dpp_f<0x140>(v);
    { auto r = __builtin_amdgcn_permlane16_swap(__float_as_uint(v), __float_as_uint(v), false, false); v = __uint_as_float(r[0]) + __uint_as_float(r[1]); }
    { auto r = __builtin_amdgcn_permlane32_swap(__float_as_uint(v), __float_as_uint(v), false, false); v = __uint_as_float(r[0]) + __uint_as_float(r[1]); }
    return v;
}
__device__ __forceinline__ float wave_max(float v) {
    v = fmaxf(v, dpp_f<0xB1>(v)); v = fmaxf(v, dpp_f<0x4E>(v)); v = fmaxf(v, dpp_f<0x141>(v)); v = fmaxf(v, dpp_f<0x140>(v));
    { auto r = __builtin_amdgcn_permlane16_swap(__float_as_uint(v), __float_as_uint(v), false, false); v = fmaxf(__uint_as_float(r[0]), __uint_as_float(r[1])); }
    { auto r = __builtin_amdgcn_permlane32_swap(__float_as_uint(v), __float_as_uint(v), false, false); v = fmaxf(__uint_as_float(r[0]), __uint_as_float(r[1])); }
    return v;
}
__device__ __forceinline__ int tid_() { int t = threadIdx.x; asm volatile("" : "+v"(t)); return t; }
__device__ __forceinline__ int bid_() { int b = blockIdx.x; asm volatile("" : "+s"(b)); return b; }
__device__ __forceinline__ float silu_f(float x) { return x / (1.f + expf(-x)); }
__device__ __forceinline__ int row_modv(int row) { return row < NLAT ? (row >> 13) : 4; }
__device__ __forceinline__ float* hrow2(float* hl, float* hc, int row) { return row < NLAT ? hl + (size_t)row * DM : hc + (size_t)(row - NLAT) * DM; }

#define XB_TMO      128
#define XB_XCNT(j)  (256  + 64 * (j))
#define XB_XSUB(j)  (1280 + 64 * (j))
#define XB_XGEN(j)  (2304 + 64 * (j))
#define XB_TOP      3328
#define XB_TOPGEN   3392
#define XCD_BAR_WORDS 3456
#define XB_SPIN_CAP (1u << 18)
__device__ __forceinline__ unsigned xb_ld(unsigned* p)              { return __hip_atomic_load(p, __ATOMIC_RELAXED, __HIP_MEMORY_SCOPE_AGENT); }
__device__ __forceinline__ unsigned xb_add(unsigned* p, unsigned v) { return __hip_atomic_fetch_add(p, v, __ATOMIC_RELAXED, __HIP_MEMORY_SCOPE_AGENT); }
__device__ __forceinline__ unsigned xb_xcc_id() { return (unsigned)__builtin_amdgcn_s_getreg((3 << 11) | 20) & 0xFu; }
#define XB_SPIN(cond, bar) do { unsigned _sp = 0; while (cond) { __builtin_amdgcn_s_sleep(1); \
    if ((++_sp & 255u) == 0u) { if (xb_ld(&(bar)[XB_TMO])) break; if (_sp > XB_SPIN_CAP) { atomicAdd(&(bar)[XB_TMO], 1u); break; } } } } while (0)
struct XcdBarrier { unsigned* bar; unsigned x; volatile LAS unsigned* st; };
__device__ __forceinline__ XcdBarrier xcd_barrier_post(unsigned* bar, volatile LAS unsigned* st) {
    XcdBarrier b; b.bar = bar; b.x = xb_xcc_id(); b.st = st;
    if (threadIdx.x == 0) (void)xb_add(&bar[XB_XCNT(b.x)], 1u);
    return b;
}
__device__ __forceinline__ void xcd_barrier_complete(unsigned* bar, unsigned x, unsigned& nloc, unsigned& nx) {
    const unsigned G = gridDim.x * gridDim.y * gridDim.z;
    unsigned sum, cnt, mine, sp = 0u;
    for (;;) {
        sum = 0u; cnt = 0u; mine = 0u;
#pragma unroll
        for (unsigned j = 0; j < 16; ++j) { const unsigned c = xb_ld(&bar[XB_XCNT(j)]); sum += c; cnt += (c > 0u) ? 1u : 0u; mine = (j == x) ? c : mine; }
        if (sum == G) break;
        __builtin_amdgcn_s_sleep(1);
        if ((++sp & 255u) == 0u) { if (xb_ld(&bar[XB_TMO])) break; if (sp > XB_SPIN_CAP) { atomicAdd(&bar[XB_TMO], 1u); break; } }
    }
    nloc = mine > 0u ? mine : 1u; nx = cnt > 0u ? cnt : 1u;
}
__device__ __forceinline__ void xcd_barrier(const XcdBarrier& b) {
    asm volatile("s_waitcnt vmcnt(0)" ::: "memory");
    __syncthreads();
    if (threadIdx.x == 0) {
        unsigned* bar = b.bar;
        __builtin_amdgcn_s_waitcnt(0);
        unsigned nloc = b.st[0], nx = b.st[1];
        if (nloc == 0u) { xcd_barrier_complete(bar, b.x, nloc, nx); b.st[0] = nloc; b.st[1] = nx; }
        const unsigned old = xb_add(&bar[XB_XSUB(b.x)], 1u);
        const unsigned gen = old / nloc;
        if (old + 1u == (gen + 1u) * nloc) {
            __builtin_amdgcn_fence(__ATOMIC_RELEASE, "agent");
            asm volatile("s_waitcnt vmcnt(0)" ::: "memory");
            const unsigned og = xb_add(&bar[XB_TOP], 1u);
            const unsigned tg = og / nx;
            if (og + 1u == (tg + 1u) * nx) xb_add(&bar[XB_TOPGEN], 1u);
            else XB_SPIN(xb_ld(&bar[XB_TOPGEN]) == tg, bar);
            __builtin_amdgcn_fence(__ATOMIC_ACQUIRE, "agent");
            xb_add(&bar[XB_XGEN(b.x)], 1u);
            asm volatile("s_waitcnt vmcnt(0)" ::: "memory");
        } else {
            XB_SPIN(xb_ld(&bar[XB_XGEN(b.x)]) == gen, bar);
            __builtin_amdgcn_fence(__ATOMIC_ACQUIRE, "agent");
            asm volatile("s_waitcnt vmcnt(0)" ::: "memory");
        }
    }
    __syncthreads();
}

struct SegInfo { const int* seg; size_t wstride; };
template <bool DUAL, class Epi>
__device__ __forceinline__ void gemm_simple(char* smem, const bf16_t* A, int lda, int M, const float* W, const float* W2, int ldw, int N, int K, SegInfo sg, const Epi& epi) {
    float* As = (float*)smem;
    float* Ws = As + 16 * 132;
    float* Ws2 = Ws + 16 * 68;
    const int t = tid_(), ty = t >> 4, tx = t & 15;
    const int ntm = (M + 127) / 128, ntn = (N + 63) / 64;
    for (int tile = blockIdx.x; tile < ntm * ntn; tile += gridDim.x) {
        const int tm = tile / ntn, tn = tile % ntn, m0 = tm * 128, n0 = tn * 64;
        const float* Wt = W; const float* Wt2 = W2; int mvalid = M;
        if (sg.seg) {
            int e = 0;
#pragma unroll
            for (int i = 1; i < 16; ++i) if (m0 >= sg.seg[i]) e = i;
            mvalid = sg.seg[e] + sg.seg[17 + e];
            if (m0 >= sg.seg[16] || m0 >= mvalid) continue;
            Wt = W + (size_t)e * sg.wstride; if (DUAL) Wt2 = W2 + (size_t)e * sg.wstride;
        }
        float acc[4][4], acc2[4][4];
#pragma unroll
        for (int i = 0; i < 4; ++i)
#pragma unroll
            for (int j = 0; j < 4; ++j) { acc[i][j] = 0.f; acc2[i][j] = 0.f; }
        for (int k0 = 0; k0 < K; k0 += 16) {
            {
                const int r = t >> 2, kq = (t & 3) * 4, row = m0 + r;
                uint2 v = make_uint2(0u, 0u);
                if (row < M) v = *(const uint2*)(A + (size_t)row * lda + k0 + kq);
                As[(kq + 0) * 132 + r] = __uint_as_float(v.x << 16);
                As[(kq + 1) * 132 + r] = __uint_as_float(v.x & 0xffff0000u);
                As[(kq + 2) * 132 + r] = __uint_as_float(v.y << 16);
                As[(kq + 3) * 132 + r] = __uint_as_float(v.y & 0xffff0000u);
            }
            {
                const int k = t >> 5, n = (t & 31) * 2, col = n0 + n;
                float2 w = make_float2(0.f, 0.f), w2 = make_float2(0.f, 0.f);
                if (col < N) { w = *(const float2*)(Wt + (size_t)(k0 + k) * ldw + col); if (DUAL) w2 = *(const float2*)(Wt2 + (size_t)(k0 + k) * ldw + col); }
                Ws[k * 68 + n] = w.x; Ws[k * 68 + n + 1] = w.y;
                if (DUAL) { Ws2[k * 68 + n] = w2.x; Ws2[k * 68 + n + 1] = w2.y; }
            }
            __syncthreads();
#pragma unroll
            for (int kk = 0; kk < 16; ++kk) {
                const float4 a = *(const float4*)&As[kk * 132 + ty * 4];
                const float4 w = *(const float4*)&Ws[kk * 68 + tx * 4];
                const float av[4] = {a.x, a.y, a.z, a.w}, wv[4] = {w.x, w.y, w.z, w.w};
#pragma unroll
                for (int i = 0; i < 4; ++i)
#pragma unroll
                    for (int j = 0; j < 4; ++j) acc[i][j] = fmaf(av[i], wv[j], acc[i][j]);
                if (DUAL) {
                    const float4 w2 = *(const float4*)&Ws2[kk * 68 + tx * 4];
                    const float wv2[4] = {w2.x, w2.y, w2.z, w2.w};
#pragma unroll
                    for (int i = 0; i < 4; ++i)
#pragma unroll
                        for (int j = 0; j < 4; ++j) acc2[i][j] = fmaf(av[i], wv2[j], acc2[i][j]);
                }
            }
            __syncthreads();
        }
#pragma unroll
        for (int i = 0; i < 4; ++i) {
            const int row = m0 + ty * 4 + i;
            if (row < M && row < mvalid) {
#pragma unroll
                for (int j = 0; j < 4; ++j) { const int col = n0 + tx * 4 + j; if (col < N) epi(row, col, acc[i][j], acc2[i][j]); }
            }
        }
    }
}

template <int DQK, int DV>
__device__ __forceinline__ void attn_simple(char* smem, const bf16_t* Q, int ldq, int nq, const bf16_t* K0, const bf16_t* V0, int n0, const bf16_t* K1, const bf16_t* V1, int n1,
                                            int ldk, int ldv, float qscale_log2, bf16_t* O, int ldo) {
    float* Ks = (float*)smem;
    float* Vs = Ks + 32 * DQK;
    const int t = tid_();
    const bool act = t < nq;
    float q[DQK];
#pragma unroll
    for (int c = 0; c < DQK; ++c) q[c] = act ? bf2f(Q[(size_t)t * ldq + c]) * qscale_log2 : 0.f;
    float o[DV];
#pragma unroll
    for (int e = 0; e < DV; ++e) o[e] = 0.f;
    float mrun = -INFINITY, lrun = 0.f;
    const int ntile = (n0 + n1) / 32;
    for (int tl = 0; tl < ntile; ++tl) {
        const int j0 = tl * 32;
        const bf16_t* Kp; const bf16_t* Vp;
        if (j0 < n0) { Kp = K0 + (size_t)j0 * ldk; Vp = V0 + (size_t)j0 * ldv; } else { Kp = K1 + (size_t)(j0 - n0) * ldk; Vp = V1 + (size_t)(j0 - n0) * ldv; }
        __syncthreads();
        for (int idx = t; idx < 32 * DQK; idx += 512) { const int r = idx / DQK, c = idx % DQK; Ks[idx] = bf2f(Kp[(size_t)r * ldk + c]); }
        for (int idx = t; idx < 32 * DV; idx += 512) { const int r = idx / DV, c = idx % DV; Vs[idx] = bf2f(Vp[(size_t)r * ldv + c]); }
        __syncthreads();
#pragma unroll 1
        for (int r = 0; r < 32; ++r) {
            float a = 0.f;
#pragma unroll
            for (int c = 0; c < DQK; c += 4) { const float4 kv = *(const float4*)&Ks[r * DQK + c]; a = fmaf(q[c], kv.x, a); a = fmaf(q[c + 1], kv.y, a); a = fmaf(q[c + 2], kv.z, a); a = fmaf(q[c + 3], kv.w, a); }
            if (a > mrun) {
                const float alpha = exp2f(mrun - a);
                mrun = a; lrun *= alpha;
#pragma unroll
                for (int e = 0; e < DV; ++e) o[e] *= alpha;
            }
            const float pr = exp2f(a - mrun);
            lrun += pr;
#pragma unroll
            for (int e = 0; e < DV; e += 4) { const float4 vv = *(const float4*)&Vs[r * DV + e]; o[e] = fmaf(pr, vv.x, o[e]); o[e + 1] = fmaf(pr, vv.y, o[e + 1]); o[e + 2] = fmaf(pr, vv.z, o[e + 2]); o[e + 3] = fmaf(pr, vv.w, o[e + 3]); }
        }
    }
    if (act) {
        const float inv = 1.f / lrun;
#pragma unroll
        for (int e = 0; e < DV; ++e) O[(size_t)t * ldo + e] = f2bf(o[e] * inv);
    }
    __syncthreads();
}

__device__ __forceinline__ void rope_pair(float& x1, float& x2, float pos, int i, int half) {
    const float inv = powf(10000.0f, -(float)i / (float)half);
    float sn, cs; sincosf(pos * inv, &sn, &cs);
    const float a = x1 * cs - x2 * sn, b = x2 * cs + x1 * sn; x1 = a; x2 = b;
}
__device__ __forceinline__ float log_sigmoid_f(float x) { return -log1pf(expf(-x)); }

namespace pg8 {
#define PG8_LAS __attribute__((address_space(3)))
typedef unsigned short bf16_t;
typedef short bf16x8 __attribute__((ext_vector_type(8)));
typedef float f32x4 __attribute__((ext_vector_type(4)));
typedef unsigned u32x4 __attribute__((ext_vector_type(4)));
constexpr int BM = 256, BK = 64, HALF = 128, HTB = HALF * BK * 2  , STAGE_BYTES = 8 * HTB, NXCD = 8, WGM = 8;

__host__ __device__ __forceinline__ int lds_byte(int r, int c) { const int st = (r >> 4) * 2 + (c >> 5), rr = r & 15, cc = c & 31, ob = rr * 64 + cc * 2; return st * 1024 + (ob ^ (((ob >> 9) & 1) << 5)); }
__host__ __device__ __forceinline__ void stage_rc(int b, int& R, int& C) { const int st = b / 1024, sb = b % 1024, swz = sb ^ (((sb >> 9) & 1) << 5); R = (st >> 1) * 16 + swz / 64; C = (st & 1) * 32 + (swz % 64) / 2; }
__host__ __device__ __forceinline__ int perm32(int rho) { const int n = rho >> 4, i = rho & 15; return 8 * (i >> 2) + 4 * n + (i & 3); }

struct Unit { int pm, pn; };
struct Gemm { const bf16_t* A; const bf16_t* Bt; int lda, ldb, K; };

typedef float f32x2c __attribute__((ext_vector_type(2))); typedef __bf16 bf16x2c __attribute__((ext_vector_type(2)));
__device__ __forceinline__ unsigned cvt_pk_bf16(float lo, float hi) { const f32x2c v = {lo, hi}; const bf16x2c b = __builtin_convertvector(v, bf16x2c); return __builtin_bit_cast(unsigned, b); }
template <class Epi, class Sched, bool ALIGN_EPI = false, bool SP2 = false>
__device__ __forceinline__ void gemm_phase(PG8_LAS unsigned char* lds, const Gemm g, const Sched& S, const Epi& E) {
    const int tid = tid_(), wid = __builtin_amdgcn_readfirstlane(tid >> 6), lane = tid & 63, wr = wid >> 2, wc = wid & 3, fr = lane & 15, fq = lane >> 4;
    int K = g.K; asm volatile("" : "+s"(K));
    const int nt = K / BK;
    unsigned voffA[2], voffB[2];
#pragma unroll
    for (int i = 0; i < 2; ++i) { int R, C; stage_rc(tid * 16 + i * 8192, R, C); const int Rb = Epi::PERM ? ((R & ~31) + perm32(R & 31)) : R;
        voffA[i] = (unsigned)(R * g.lda + C) * 2u; voffB[i] = (unsigned)(Rb * g.ldb + C) * 2u; }
    const size_t kstep = (size_t)(BK * 2);
    const size_t hstepA = (size_t)HALF * g.lda * 2, hstepB = (size_t)HALF * g.ldb * 2;
    const size_t tstepA = 2 * hstepA, tstepB = 2 * hstepB;
    const unsigned ldsw = (unsigned)wid * 1024u;
    const int aoff = lds_byte(wr * 64 + fr, fq * 8), boff = lds_byte(wc * 32 + fr, fq * 8);
#define PG8_SA(b, h) (((b) * 2 + (h)) * HTB)
#define PG8_SB(b, h) ((4 + (b) * 2 + (h)) * HTB)
#define PG8_STAGE(bufoff, gbase, voff) do { _Pragma("unroll") for (int _i = 0; _i < 2; ++_i) \
        __builtin_amdgcn_global_load_lds((const unsigned*)((const char*)(gbase) + (voff)[_i]), (PG8_LAS unsigned*)(lds + (bufoff) + ldsw + _i * 8192), 16, 0, 0); } while (0)
#define PG8_LDA(dst, b, h) do { _Pragma("unroll") for (int m = 0; m < 4; ++m) _Pragma("unroll") for (int k = 0; k < 2; ++k) dst[m][k] = *(const PG8_LAS bf16x8*)(lds + PG8_SA(b, h) + aoff + m * 2048 + k * 1024); } while (0)
#define PG8_LDB(dst, b, h) do { _Pragma("unroll") for (int n = 0; n < 2; ++n) _Pragma("unroll") for (int k = 0; k < 2; ++k) dst[n][k] = *(const PG8_LAS bf16x8*)(lds + PG8_SB(b, h) + boff + n * 2048 + k * 1024); } while (0)
#define PG8_MMA(ai, bj, At, Bt) do { __builtin_amdgcn_s_setprio(1); _Pragma("unroll") for (int m = 0; m < 4; ++m) _Pragma("unroll") for (int n = 0; n < 2; ++n) _Pragma("unroll") for (int k = 0; k < 2; ++k) \
        acc[ai][bj][m][n] = __builtin_amdgcn_mfma_f32_16x16x32_bf16(Bt[n][k], At[m][k], acc[ai][bj][m][n], 0, 0, 0); __builtin_amdgcn_s_setprio(0); } while (0)
#define PG8_WAIT_V(n) asm volatile("s_waitcnt vmcnt(" #n ")" ::: "memory")
#define PG8_WAIT_L(n) asm volatile("s_waitcnt lgkmcnt(" #n ")" ::: "memory")
#define PG8_BAR __builtin_amdgcn_s_barrier()
#define PG8_SCHED __builtin_amdgcn_sched_barrier(0)
    Unit cur, nxt; int ui = 0;
    if (!S.next(0, cur)) return;
    f32x4 acc[2][2][4][2];
#pragma unroll
    for (int a = 0; a < 2; ++a)
#pragma unroll
        for (int b = 0; b < 2; ++b)
#pragma unroll
            for (int m = 0; m < 4; ++m)
#pragma unroll
                for (int n = 0; n < 2; ++n) acc[a][b][m][n] = (f32x4){0.f, 0.f, 0.f, 0.f};
    bf16x8 At[4][2], B0[2][2], B1[2][2];
    const char* cA = (const char*)g.A + (size_t)cur.pm * tstepA; const char* cB = (const char*)g.Bt + (size_t)cur.pn * tstepB;
    S.a_ready(cur);
    if constexpr (SP2) {
        PG8_STAGE(PG8_SB(0, 0), cB, voffB); PG8_STAGE(PG8_SB(0, 1), cB + hstepB, voffB); PG8_STAGE(PG8_SA(0, 0), cA, voffA); PG8_STAGE(PG8_SA(0, 1), cA + hstepA, voffA);
        if (wr == 1) PG8_BAR;
        PG8_WAIT_V(2); PG8_BAR;
        PG8_STAGE(PG8_SB(1, 0), cB + kstep, voffB); PG8_STAGE(PG8_SA(1, 0), cA + kstep, voffA); PG8_STAGE(PG8_SB(1, 1), cB + hstepB + kstep, voffB);
        PG8_WAIT_V(6); PG8_BAR;
    } else {
        PG8_STAGE(PG8_SB(0, 0), cB, voffB); PG8_STAGE(PG8_SA(0, 0), cA, voffA); PG8_STAGE(PG8_SB(0, 1), cB + hstepB, voffB); PG8_STAGE(PG8_SA(0, 1), cA + hstepA, voffA);
        if (wr == 1) PG8_BAR;
        PG8_WAIT_V(4); PG8_BAR;
        PG8_STAGE(PG8_SB(1, 0), cB + kstep, voffB); PG8_STAGE(PG8_SA(1, 0), cA + kstep, voffA); PG8_STAGE(PG8_SB(1, 1), cB + hstepB + kstep, voffB);
        PG8_WAIT_V(6); PG8_BAR;
    }
    for (;;) {
        const bool has_next = S.next(ui + 1, nxt);
        const char* nA = has_next ? (const char*)g.A + (size_t)nxt.pm * tstepA : cA; const char* nB = has_next ? (const char*)g.Bt + (size_t)nxt.pn * tstepB : cB;
        for (int t = 0; t < nt; t += 2) {
            const bool last = (t == nt - 2);
            const char* a1 = cA + (size_t)(t + 1) * kstep;
            const char* a2 = last ? nA : cA + (size_t)(t + 2) * kstep; const char* b2 = last ? nB : cB + (size_t)(t + 2) * kstep;
            const char* a3 = a2 + kstep; const char* b3 = b2 + kstep;
            if (last && has_next) S.a_ready(nxt);
            if constexpr (SP2) {
            PG8_LDB(B0, 0, 0); PG8_LDB(B1, 0, 1); PG8_SCHED; PG8_LDA(At, 0, 0); PG8_STAGE(PG8_SA(1, 1), a1 + hstepA, voffA);
            PG8_WAIT_V(8); PG8_WAIT_L(0); PG8_BAR; PG8_MMA(0, 0, At, B0); PG8_MMA(0, 1, At, B1); PG8_BAR; PG8_SCHED;
            PG8_LDA(At, 0, 1); PG8_STAGE(PG8_SB(0, 0), b2, voffB); PG8_STAGE(PG8_SB(0, 1), b2 + hstepB, voffB); PG8_STAGE(PG8_SA(0, 0), a2, voffA);
            PG8_WAIT_V(8); PG8_WAIT_L(0); PG8_BAR; PG8_MMA(1, 0, At, B0); PG8_MMA(1, 1, At, B1); PG8_BAR; PG8_SCHED;
            PG8_LDB(B0, 1, 0); PG8_LDB(B1, 1, 1); PG8_SCHED; PG8_LDA(At, 1, 0); PG8_STAGE(PG8_SA(0, 1), a2 + hstepA, voffA);
            PG8_WAIT_V(8); PG8_WAIT_L(0); PG8_BAR; PG8_MMA(0, 0, At, B0); PG8_MMA(0, 1, At, B1); PG8_BAR; PG8_SCHED;
            PG8_LDA(At, 1, 1); PG8_STAGE(PG8_SB(1, 0), b3, voffB); PG8_STAGE(PG8_SB(1, 1), b3 + hstepB, voffB); PG8_STAGE(PG8_SA(1, 0), a3, voffA);
            PG8_WAIT_V(8); PG8_WAIT_L(0); PG8_BAR; PG8_MMA(1, 0, At, B0); PG8_MMA(1, 1, At, B1); PG8_BAR; PG8_SCHED;
            } else {
            PG8_LDB(B0, 0, 0); PG8_SCHED; PG8_LDA(At, 0, 0); PG8_STAGE(PG8_SA(1, 1), a1 + hstepA, voffA);
            PG8_WAIT_L(8); PG8_BAR; PG8_WAIT_L(0); PG8_MMA(0, 0, At, B0); PG8_BAR; PG8_SCHED;
            PG8_LDB(B1, 0, 1); PG8_STAGE(PG8_SB(0, 0), b2, voffB);
            PG8_BAR; PG8_WAIT_L(0); PG8_MMA(0, 1, At, B1); PG8_BAR;
            PG8_LDA(At, 0, 1); PG8_STAGE(PG8_SA(0, 0), a2, voffA);
            PG8_BAR; PG8_WAIT_L(0); PG8_MMA(1, 0, At, B0); PG8_BAR; PG8_SCHED;
            PG8_STAGE(PG8_SB(0, 1), b2 + hstepB, voffB);
            PG8_WAIT_V(6); PG8_BAR; PG8_MMA(1, 1, At, B1); PG8_BAR;
            PG8_LDB(B0, 1, 0); PG8_SCHED; PG8_LDA(At, 1, 0); PG8_STAGE(PG8_SA(0, 1), a2 + hstepA, voffA);
            PG8_WAIT_L(8); PG8_BAR; PG8_WAIT_L(0); PG8_MMA(0, 0, At, B0); PG8_BAR; PG8_SCHED;
            PG8_LDB(B1, 1, 1); PG8_STAGE(PG8_SB(1, 0), b3, voffB);
            PG8_BAR; PG8_WAIT_L(0); PG8_MMA(0, 1, At, B1); PG8_BAR;
            PG8_LDA(At, 1, 1); PG8_STAGE(PG8_SA(1, 0), a3, voffA);
            PG8_BAR; PG8_WAIT_L(0); PG8_MMA(1, 0, At, B0); PG8_BAR; PG8_SCHED;
            PG8_STAGE(PG8_SB(1, 1), b3 + hstepB, voffB);
            PG8_WAIT_V(6); PG8_BAR; PG8_MMA(1, 1, At, B1); PG8_BAR;
            }
        }
        if constexpr (ALIGN_EPI) { if (wr == 0) PG8_BAR; }
        if constexpr (!Epi::AFTER_DRAIN) { E(acc, cur, wr, wc, fr, fq); S.done(cur); }
        if (!has_next) break;
#pragma unroll
        for (int a = 0; a < 2; ++a)
#pragma unroll
            for (int b = 0; b < 2; ++b)
#pragma unroll
                for (int m = 0; m < 4; ++m)
#pragma unroll
                    for (int n = 0; n < 2; ++n) acc[a][b][m][n] = (f32x4){0.f, 0.f, 0.f, 0.f};
        cur = nxt; cA = nA; cB = nB; ++ui;
        if constexpr (ALIGN_EPI) { if (wr == 1) PG8_BAR; }
    }
    PG8_WAIT_V(0);
    if constexpr (!ALIGN_EPI) { if (wr == 0) PG8_BAR; }
    PG8_BAR;
    if constexpr (Epi::AFTER_DRAIN) { E.fused(acc, cur, wr, wc, fr, fq, lds, wid, lane); S.done(cur); }
#undef PG8_SA
#undef PG8_SB
#undef PG8_STAGE
#undef PG8_LDA
#undef PG8_LDB
#undef PG8_MMA
#undef PG8_WAIT_V
#undef PG8_WAIT_L
#undef PG8_BAR
#undef PG8_SCHED
}


struct StaticOrder {
    int nM, nN, nwg, G, c;
    __device__ void init(int M, int N, int G_, int c_) { nM = M / BM; nN = N / BM; nwg = nM * nN; G = G_; c = c_; }
    __device__ bool next(int i, Unit& u) const {
        const long L = (long)i * G + c; if (L >= nwg) return false;
        int wgid = (int)L; { const int q = nwg / NXCD, r = nwg % NXCD, xcd = wgid % NXCD, off = wgid / NXCD; wgid = (xcd < r ? xcd * (q + 1) : r * (q + 1) + (xcd - r) * q) + off; }
        const int nig = WGM * nN, gid = wgid / nig, fm = gid * WGM, gsz = (nM - fm) < WGM ? (nM - fm) : WGM;
        u.pm = fm + ((wgid % nig) % gsz); u.pn = (wgid % nig) / gsz; return true;
    }
    __device__ __forceinline__ void a_ready(const Unit&) const {}
    __device__ __forceinline__ void done(const Unit&) const {}
};
struct GroupedOrder {
    const PG8_LAS int* list; int n;
    __device__ __forceinline__ bool next(int i, Unit& u) const { if (i >= n) return false; u.pm = __builtin_amdgcn_readfirstlane(list[2 * i]); u.pn = __builtin_amdgcn_readfirstlane(list[2 * i + 1]); return true; }
    __device__ __forceinline__ void a_ready(const Unit&) const {}
    __device__ __forceinline__ void done(const Unit&) const {}
};
__device__ __forceinline__ int grouped_units(PG8_LAS int* list, const int* tile, int ncol, int G, int c) {
#define TLD(i) ((int)__hip_atomic_load((const unsigned*)tile + (i), __ATOMIC_RELAXED, __HIP_MEMORY_SCOPE_AGENT))
    const int nrt = TLD(0); int n = 0;
    for (int i = 0; i < 16; ++i) { const int L = i * G + c, rt = L / ncol; if (rt >= nrt) break; if (threadIdx.x == 0) { list[2 * i] = TLD(17 + 2 * rt); list[2 * i + 1] = TLD(16 + 2 * rt) * ncol + (L % ncol); } ++n; }
#undef TLD
    __syncthreads();
    return n;
}
__device__ __forceinline__ u32x4 pack8(const f32x4& v0, const f32x4& v1) { u32x4 w; w.x = cvt_pk_bf16(v0[0], v0[1]); w.y = cvt_pk_bf16(v0[2], v0[3]); w.z = cvt_pk_bf16(v1[0], v1[1]); w.w = cvt_pk_bf16(v1[2], v1[3]); return w; }
#define EPI_ROWS_BEGIN _Pragma("unroll") for (int ai = 0; ai < 2; ++ai) _Pragma("unroll") for (int m = 0; m < 4; ++m) { const int row = u.pm * BM + ai * HALF + wr * 64 + m * 16 + fr; \
    _Pragma("unroll") for (int bj = 0; bj < 2; ++bj) { const f32x4 v0 = acc[ai][bj][m][0], v1 = acc[ai][bj][m][1];
#define EPI_ROWS_END } }
__device__ __forceinline__ float ssq32(const f32x4& v0, const f32x4& v1) {
    float q = (v0[0] * v0[0] + v0[1] * v0[1]) + (v0[2] * v0[2] + v0[3] * v0[3]) + (v1[0] * v1[0] + v1[1] * v1[1]) + (v1[2] * v1[2] + v1[3] * v1[3]);
    { auto r = __builtin_amdgcn_permlane16_swap(__float_as_uint(q), __float_as_uint(q), false, false); q = __uint_as_float(r[0]) + __uint_as_float(r[1]); }
    { auto r = __builtin_amdgcn_permlane32_swap(__float_as_uint(q), __float_as_uint(q), false, false); q = __uint_as_float(r[0]) + __uint_as_float(r[1]); }
    return q;
}
struct EpiP { static constexpr bool PERM = true, AFTER_DRAIN = false; bf16_t* O; int ldc; float* PS;
    __device__ __forceinline__ void operator()(const f32x4 (&acc)[2][2][4][2], const Unit& u, int wr, int wc, int fr, int fq) const {
        EPI_ROWS_BEGIN const int col = u.pn * BM + bj * HALF + wc * 32 + 8 * fq; *(u32x4*)(O + (size_t)row * ldc + col) = pack8(v0, v1);
            if (u.pn >= 10) { const float q = ssq32(v0, v1); if (fq == 0) PS[(size_t)row * 24 + (u.pn - 10) * 8 + bj * 4 + wc] = q; } EPI_ROWS_END } };
struct EpiUQ { static constexpr bool PERM = true, AFTER_DRAIN = false; bf16_t* Q; const float* PS;
    __device__ __forceinline__ void operator()(const f32x4 (&acc)[2][2][4][2], const Unit& u, int wr, int wc, int fr, int fq) const {
        _Pragma("unroll") for (int ai = 0; ai < 2; ++ai) _Pragma("unroll") for (int m = 0; m < 4; ++m) { const int row = u.pm * BM + ai * HALF + wr * 64 + m * 16 + fr;
            const f32x4 s0 = *(const f32x4*)(PS + (size_t)row * 24), s1 = *(const f32x4*)(PS + (size_t)row * 24 + 4), s2 = *(const f32x4*)(PS + (size_t)row * 24 + 8);
            const float rstd = rsqrtf(((s0[0] + s0[1]) + (s0[2] + s0[3]) + (s1[0] + s1[1]) + (s1[2] + s1[3]) + (s2[0] + s2[1]) + (s2[2] + s2[3])) * (1.f / 384.f) + 1e-6f);
            _Pragma("unroll") for (int bj = 0; bj < 2; ++bj) { const int col = u.pn * BM + bj * HALF + wc * 32 + 8 * fq;
                if (col < 384) *(u32x4*)(Q + (size_t)row * 384 + col) = pack8(acc[ai][bj][m][0] * rstd, acc[ai][bj][m][1] * rstd); } } } };
struct EpiUKV { static constexpr bool PERM = true, AFTER_DRAIN = false; bf16_t* Kn; bf16_t* Vn; const float* PS;
    __device__ __forceinline__ void operator()(const f32x4 (&acc)[2][2][4][2], const Unit& u, int wr, int wc, int fr, int fq) const {
        bf16_t* base = wc < 2 ? Kn + wc * 32 + 8 * fq : Vn + (wc - 2) * 32 + 8 * fq; const int rp = wc < 2 ? 384 : 256, hp = wc < 2 ? 96 : 64;
        _Pragma("unroll") for (int ai = 0; ai < 2; ++ai) _Pragma("unroll") for (int m = 0; m < 4; ++m) { const int row = u.pm * BM + ai * HALF + wr * 64 + m * 16 + fr;
            const f32x4 s0 = *(const f32x4*)(PS + (size_t)row * 24 + 12), s1 = *(const f32x4*)(PS + (size_t)row * 24 + 16);
            const float rstd = rsqrtf(((s0[0] + s0[1]) + (s0[2] + s0[3]) + (s1[0] + s1[1]) + (s1[2] + s1[3])) * (1.f / 256.f) + 1e-6f);
            _Pragma("unroll") for (int bj = 0; bj < 2; ++bj) { const int hd = u.pn * 2 + bj; *(u32x4*)(base + (size_t)row * rp + hd * hp) = pack8(acc[ai][bj][m][0] * rstd, acc[ai][bj][m][1] * rstd); } } } };
struct EpiOut { static constexpr bool PERM = true, AFTER_DRAIN = false; float* hl; float* hc; const float* rl; const float* rc; const float* gate;
    __device__ __forceinline__ void operator()(const f32x4 (&acc)[2][2][4][2], const Unit& u, int wr, int wc, int fr, int fq) const {
        EPI_ROWS_BEGIN const int col = u.pn * BM + bj * HALF + wc * 32 + 8 * fq;
            const size_t off = (row < 32768 ? (size_t)row * 1024 : (size_t)(row - 32768) * 1024) + col;
            float* h = (row < 32768 ? hl : hc) + off; const float* r = (row < 32768 ? rl : rc) + off; const float* g = gate + (row < 32768 ? (row >> 13) : 4) * 6144 + col;
            const f32x4 g0 = *(const f32x4*)g, g1 = *(const f32x4*)(g + 4); f32x4 h0 = *(const f32x4*)r, h1 = *(const f32x4*)(r + 4);
            h0 = h0 + g0 * v0; h1 = h1 + g1 * v1; *(f32x4*)h = h0; *(f32x4*)(h + 4) = h1; EPI_ROWS_END } };
__device__ __forceinline__ float silu_fast(float x) { return x / (1.f + __expf(-x)); }
struct EpiMoe1 { static constexpr bool PERM = true, AFTER_DRAIN = false; bf16_t* Hd;
    __device__ __forceinline__ void operator()(const f32x4 (&acc)[2][2][4][2], const Unit& u, int wr, int wc, int fr, int fq) const {
        EPI_ROWS_BEGIN const int col = (u.pn & 1) * BM + bj * HALF + wc * 32 + 8 * fq;
            uint2 w; w.x = cvt_pk_bf16(silu_fast(v0[0]) * v0[1], silu_fast(v0[2]) * v0[3]); w.y = cvt_pk_bf16(silu_fast(v1[0]) * v1[1], silu_fast(v1[2]) * v1[3]);
            *(uint2*)(Hd + (size_t)row * 256 + (col >> 1)) = w; EPI_ROWS_END } };
struct EpiMoe2 { static constexpr bool PERM = true, AFTER_DRAIN = false; bf16_t* Y;
    __device__ __forceinline__ void operator()(const f32x4 (&acc)[2][2][4][2], const Unit& u, int wr, int wc, int fr, int fq) const {
        EPI_ROWS_BEGIN const int col = (u.pn & 3) * BM + bj * HALF + wc * 32 + 8 * fq; *(u32x4*)(Y + (size_t)row * 1024 + col) = pack8(v0, v1); EPI_ROWS_END } };
}

struct WScale { const float* rowgain; int c0lo, c0hi; float s0; int c1lo, c1hi; float s1; };
__device__ __forceinline__ void transpose_tile(float* tl, const float* W, int K, int N, bf16_t* dst, int rs, int ro, int tile, int ntn, const WScale& ws_) {
    const int t = tid_(), k0 = (tile / ntn) * 64, n0 = (tile % ntn) * 64;
    __syncthreads();
    { const int k = t >> 3, n8 = (t & 7) * 8; const float rg = ws_.rowgain ? ws_.rowgain[k0 + k] : 1.f;
#pragma unroll
      for (int i = 0; i < 8; ++i) { const int n = n0 + n8 + i; const float cs = (n >= ws_.c0lo && n < ws_.c0hi) ? ws_.s0 : ((n >= ws_.c1lo && n < ws_.c1hi) ? ws_.s1 : 1.f);
          tl[k * 65 + n8 + i] = n < N ? W[(size_t)(k0 + k) * N + n] * rg * cs : 0.f; } }
    __syncthreads();
    { const int n = t >> 3, k8 = (t & 7) * 8; uint4 o;
      o.x = (unsigned)f2bf(tl[(k8 + 0) * 65 + n]) | ((unsigned)f2bf(tl[(k8 + 1) * 65 + n]) << 16); o.y = (unsigned)f2bf(tl[(k8 + 2) * 65 + n]) | ((unsigned)f2bf(tl[(k8 + 3) * 65 + n]) << 16);
      o.z = (unsigned)f2bf(tl[(k8 + 4) * 65 + n]) | ((unsigned)f2bf(tl[(k8 + 5) * 65 + n]) << 16); o.w = (unsigned)f2bf(tl[(k8 + 6) * 65 + n]) | ((unsigned)f2bf(tl[(k8 + 7) * 65 + n]) << 16);
      *(uint4*)(dst + (size_t)((n0 + n) * rs + ro) * K + k0 + k8) = o; }
}
__device__ __forceinline__ void transpose_mat(float* tl, const float* W, int K, int N, int Npad, bf16_t* dst, int rs, int ro, int& base, const WScale& ws_) {
    const int ntn = Npad / 64, nt = (K / 64) * ntn, G = gridDim.x;
    const int first = (((int)blockIdx.x - base) % G + G) % G;
    for (int tile = first; tile < nt; tile += G) transpose_tile(tl, W, K, N, dst, rs, ro, tile, ntn, ws_);
    base = (base + nt) % G;
}


namespace fa {
typedef short bf16x8 __attribute__((ext_vector_type(8)));
typedef float f32x16 __attribute__((ext_vector_type(16)));
typedef unsigned u32x4 __attribute__((ext_vector_type(4)));
__device__ __forceinline__ int crow(int r, int hi) { return (r & 3) + 8 * (r >> 2) + 4 * hi; }
__device__ __forceinline__ unsigned cvtpk(float lo, float hi) { return pg8::cvt_pk_bf16(lo, hi); }
__device__ __forceinline__ float max3f(float a, float b, float c) { return __builtin_fmaxf(__builtin_fmaxf(a, b), c); }
__device__ __forceinline__ float xhalf_max(float m) { auto rr = __builtin_amdgcn_permlane32_swap(__float_as_uint(m), __float_as_uint(m), false, false); return fmaxf(__uint_as_float(rr[0]), __uint_as_float(rr[1])); }
__device__ __forceinline__ float xhalf_sum(float m) { auto rr = __builtin_amdgcn_permlane32_swap(__float_as_uint(m), __float_as_uint(m), false, false); return __uint_as_float(rr[0]) + __uint_as_float(rr[1]); }
template <int DQK> struct Lds { static constexpr int KP = DQK * 2 + 16, VP = 144, KB = 64 * KP, VB = 64 * VP, K0 = 0, V0 = 3 * KB, WSF = V0 + 3 * VB, OST = WSF + 8 * 64 * 4, BYTES = OST + 8 * 4096; };
template <int DQK>
__device__ __forceinline__ void attn_unit(char* smem, const bf16_t* Q, int ldq, const bf16_t* K0, int nt0, const bf16_t* K1, int nt1, int ldk, const bf16_t* VT, bf16_t* O, int ldo) {
    typedef Lds<DQK> L; constexpr int KC = DQK / 8, NKC = 64 * KC, NKS = DQK / 16; constexpr float THR = 8.f;
    const int tid = tid_(), lane = tid & 63, r32 = lane & 31, hi = lane >> 5; const int wid = __builtin_amdgcn_readfirstlane(tid >> 6);
    float* wsf = (float*)(smem + L::WSF) + wid * 64;
    bf16x8 qf[NKS];
#pragma unroll
    for (int ks = 0; ks < NKS; ++ks) qf[ks] = *(const bf16x8*)(Q + (size_t)(wid * 32 + r32) * ldq + ks * 16 + hi * 8);
    f32x16 o0, o1, negm;
#pragma unroll
    for (int r = 0; r < 16; ++r) { o0[r] = 0.f; o1[r] = 0.f; negm[r] = 0.f; }
    float mhat = 0.f, lsum = 0.f; bool resc = false;
    const int NT = nt0 + nt1;
    const int kr0 = tid / KC, kc0 = tid % KC, kr1 = (tid + 512) / KC, kc1 = (tid + 512) % KC; const bool has1 = (tid + 512) < NKC;
    const int vdv = tid >> 3, vg = tid & 7;
    uint4 sk0, sk1 = make_uint4(0u, 0u, 0u, 0u), sv;
    u32x4 w0, w1, w2, w3;
    f32x16 pA0, pA1, pB0, pB1;
#define FA_SB() __builtin_amdgcn_sched_barrier(0)
#define FA_GLOAD(t) do { const bf16_t* kt = ((t) < nt0) ? K0 + (size_t)(t) * 64 * ldk : K1 + (size_t)((t) - nt0) * 64 * ldk; \
        sk0 = *(const uint4*)(kt + (size_t)kr0 * ldk + kc0 * 8); if (has1) sk1 = *(const uint4*)(kt + (size_t)kr1 * ldk + kc1 * 8); \
        sv = *(const uint4*)(VT + (size_t)(t) * 4096 + tid * 8); } while (0)
#define FA_SWRITE(bo) do { *(uint4*)(smem + L::K0 + (bo) * L::KB + kr0 * L::KP + kc0 * 16) = sk0; if (has1) *(uint4*)(smem + L::K0 + (bo) * L::KB + kr1 * L::KP + kc1 * 16) = sk1; \
        *(uint4*)(smem + L::V0 + (bo) * L::VB + vdv * L::VP + vg * 16) = sv; } while (0)
#define FA_QK(P0, P1, bo) do { const char* kb = smem + L::K0 + (bo) * L::KB + r32 * L::KP + hi * 16; P0 = negm; P1 = negm; \
        _Pragma("unroll") for (int ks = 0; ks < NKS; ++ks) { const bf16x8 a0 = *(const bf16x8*)(kb + ks * 32), a1 = *(const bf16x8*)(kb + 32 * L::KP + ks * 32); \
            P0 = __builtin_amdgcn_mfma_f32_32x32x16_bf16(a0, qf[ks], P0, 0, 0, 0); P1 = __builtin_amdgcn_mfma_f32_32x32x16_bf16(a1, qf[ks], P1, 0, 0, 0); } } while (0)
#define FA_PARTIAL(P0, P1, FIRST) do { float rm = max3f(P0[0], P1[0], P0[1]); rm = max3f(rm, P1[1], P0[2]); rm = max3f(rm, P1[2], P0[3]); rm = max3f(rm, P1[3], P0[4]); \
        _Pragma("unroll") for (int r = 4; r < 15; ++r) rm = max3f(rm, P1[r], P0[r + 1]); \
        rm = fmaxf(rm, P1[15]); \
        rm = xhalf_max(rm); resc = false; \
        if ((FIRST) || __any(rm > THR)) { const float dl = (FIRST) ? rm : fmaxf(rm, 0.f); mhat += dl; \
            _Pragma("unroll") for (int r = 0; r < 16; ++r) { P0[r] -= dl; P1[r] -= dl; negm[r] = -mhat; } \
            if (!(FIRST)) { const float f = __builtin_amdgcn_exp2f(-dl); lsum *= f; if (hi == 0) wsf[r32] = f; resc = true; } } \
        _Pragma("unroll") for (int r = 0; r < 16; ++r) P0[r] = __builtin_amdgcn_exp2f(P0[r]); } while (0)
#define FA_FINISH(P0, P1) do { float ps = 0.f; \
        _Pragma("unroll") for (int r = 0; r < 16; ++r) { P1[r] = __builtin_amdgcn_exp2f(P1[r]); ps += P0[r] + P1[r]; } \
        lsum += ps; \
        w0.x = cvtpk(P0[0], P0[1]); w0.y = cvtpk(P0[2], P0[3]); w0.z = cvtpk(P0[4], P0[5]); w0.w = cvtpk(P0[6], P0[7]); \
        w1.x = cvtpk(P0[8], P0[9]); w1.y = cvtpk(P0[10], P0[11]); w1.z = cvtpk(P0[12], P0[13]); w1.w = cvtpk(P0[14], P0[15]); \
        w2.x = cvtpk(P1[0], P1[1]); w2.y = cvtpk(P1[2], P1[3]); w2.z = cvtpk(P1[4], P1[5]); w2.w = cvtpk(P1[6], P1[7]); \
        w3.x = cvtpk(P1[8], P1[9]); w3.y = cvtpk(P1[10], P1[11]); w3.z = cvtpk(P1[12], P1[13]); w3.w = cvtpk(P1[14], P1[15]); } while (0)
#define FA_PV1(W, s, vb) do { const bf16x8 pa = __builtin_bit_cast(bf16x8, W); \
        const bf16x8 v0 = *(const bf16x8*)((vb) + (s) * 32), v1 = *(const bf16x8*)((vb) + 32 * L::VP + (s) * 32); \
        o0 = __builtin_amdgcn_mfma_f32_32x32x16_bf16(pa, v0, o0, 0, 0, 0); o1 = __builtin_amdgcn_mfma_f32_32x32x16_bf16(pa, v1, o1, 0, 0, 0); } while (0)
#define FA_PV(bo) do { const char* vb_ = smem + L::V0 + (bo) * L::VB + r32 * L::VP + hi * 16; FA_PV1(w0, 0, vb_); FA_PV1(w1, 1, vb_); FA_PV1(w2, 2, vb_); FA_PV1(w3, 3, vb_); } while (0)
#define FA_RESC() do { if (resc) { asm volatile("s_waitcnt lgkmcnt(0)" ::: "memory"); \
        _Pragma("unroll") for (int r = 0; r < 16; ++r) { const float fr = wsf[crow(r, hi)]; o0[r] *= fr; o1[r] *= fr; } } } while (0)
#define FA_STEP(C0, C1, P0, P1, t, LOADNEXT) do { \
        FA_SB(); FA_QK(C0, C1, bc); FA_FINISH(P0, P1); FA_SB(); \
        if (LOADNEXT) FA_GLOAD((t) + 1); FA_SB(); \
        FA_PV(bp); FA_PARTIAL(C0, C1, false); \
        if (LOADNEXT) FA_SWRITE(bn); \
        FA_RESC(); \
        __syncthreads(); \
        { const int nb = bp; bp = bc; bc = bn; bn = nb; } } while (0)
    __syncthreads();
    FA_GLOAD(0); FA_SWRITE(0);
    __syncthreads();
    FA_QK(pA0, pA1, 0); FA_PARTIAL(pA0, pA1, true);
    FA_GLOAD(1); FA_SWRITE(1);
    __syncthreads();
    int bp = 0, bc = 1, bn = 2;
    for (int t = 1; t + 1 < NT; t += 2) {
        FA_STEP(pB0, pB1, pA0, pA1, t, true);
        FA_STEP(pA0, pA1, pB0, pB1, t + 1, true);
    }
    FA_STEP(pB0, pB1, pA0, pA1, NT - 1, false);
    FA_FINISH(pB0, pB1); FA_PV(bp);
#undef FA_STEP
#undef FA_RESC
#undef FA_PV
#undef FA_PV1
#undef FA_FINISH
#undef FA_PARTIAL
#undef FA_QK
#undef FA_GLOAD
#undef FA_SWRITE
#undef FA_SB
    lsum = xhalf_sum(lsum);
    if (hi == 0) wsf[32 + r32] = lsum;
    asm volatile("s_waitcnt lgkmcnt(0)" ::: "memory");
    bf16_t* stg = (bf16_t*)(smem + L::OST) + wid * 2048;
#pragma unroll
    for (int r = 0; r < 16; ++r) { const int orow = crow(r, hi); const float rl = 1.f / wsf[32 + orow]; stg[orow * 64 + r32] = f2bf(o0[r] * rl); stg[orow * 64 + 32 + r32] = f2bf(o1[r] * rl); }
    asm volatile("s_waitcnt lgkmcnt(0)" ::: "memory");
#pragma unroll
    for (int i = 0; i < 4; ++i) { const int row = i * 8 + (lane >> 3), ch = lane & 7; const u32x4 v = *(const u32x4*)(stg + row * 64 + ch * 8); *(u32x4*)(O + (size_t)(wid * 32 + row) * ldo + ch * 8) = v; }
}
}


namespace na {
using fa::bf16x8; using fa::f32x16; using fa::u32x4; using fa::crow; using fa::cvtpk; using fa::xhalf_max; using fa::xhalf_sum;
constexpr int KP = 144, KB = 64 * KP, VP = 136, VB = 64 * VP, K0 = 0, V0 = 2 * KB, WSF = V0 + 2 * VB, OST = WSF + 2048, TBL = OST + 8 * 4096, BYTES = TBL + 17 * 64 * 4;
__device__ __forceinline__ int clampi(int v, int lo, int hi) { return v < lo ? lo : (v > hi ? hi : v); }
__device__ __forceinline__ void na_unit(char* smem, bool ctxu, int b, int h, int g, const bf16_t* P, const bf16_t* NVT, const float* rpb, bf16_t* MIX) {
    constexpr float THR = 8.f, NEG = -1e30f;
    const int tid = tid_(), lane = tid & 63, r32 = lane & 31, hi = lane >> 5; const int wid = __builtin_amdgcn_readfirstlane(tid >> 6);
    float* wsf = (float*)(smem + WSF) + wid * 64; float* tb = (float*)(smem + TBL);
    const int pr = wid >> 2, cbk = (wid & 3) * 16, kc0 = clampi(cbk - 8, 0, 32);
    const int qr = 4 * g + 2 * pr + (r32 >> 4), qc = cbk + (r32 & 15);
    const size_t qrow = ctxu ? (size_t)NLAT + b * CTXL + wid * 32 + r32 : (size_t)b * SEQ + qr * 64 + qc;
    bf16x8 qf[4];
#pragma unroll
    for (int ks = 0; ks < 4; ++ks) qf[ks] = *(const bf16x8*)(P + qrow * LDP + PC_NQ + h * 64 + ks * 16 + hi * 8);
    const int r0q = clampi(qr - 4, 0, 120), c0q = clampi(qc - 8, 0, 48);
    const int cbase = kc0 + 4 * hi - c0q, bidx = kc0 + 4 * hi - qc + 15 + 16;
    const int ra = 4 * g + 2 * pr, wlo = clampi(ra - 4, 0, 120), whi = clampi(ra - 3, 0, 120) + 8;
    const int krU = clampi(4 * g - 4, 0, 117);
    const int NL = ctxu ? 0 : 11, NT = NL + 4;
    f32x16 o0, o1, negm;
#pragma unroll
    for (int r = 0; r < 16; ++r) { o0[r] = 0.f; o1[r] = 0.f; negm[r] = 0.f; }
    float mhat = 0.f, lsum = 0.f; bool first = true;
    const size_t vt_base = (size_t)(b * 8 + h) * 132 * 4096;
    const int skr = tid >> 3, skc = tid & 7;
    uint4 sk, sv;
#define NA_GLOAD(t) do { const size_t krow = (t) < NL ? (size_t)b * SEQ + (size_t)(krU + (t)) * 64 : (size_t)NLAT + b * CTXL + ((t) - NL) * 64; const int vtile = (t) < NL ? krU + (t) : 128 + ((t) - NL); \
        sk = *(const uint4*)(P + (krow + skr) * LDP + PC_NK + h * 64 + skc * 8); sv = *(const uint4*)(NVT + vt_base + (size_t)vtile * 4096 + tid * 8); } while (0)
#define NA_SWRITE(buf) do { *(uint4*)(smem + K0 + (buf) * KB + skr * KP + skc * 16) = sk; uint2* vd = (uint2*)(smem + V0 + (buf) * VB + skr * VP + skc * 16); vd[0] = make_uint2(sv.x, sv.y); vd[1] = make_uint2(sv.z, sv.w); } while (0)
    __syncthreads();
    if (!ctxu) for (int idx = tid; idx < 17 * 64; idx += 512) { const int dr = (idx >> 6) - 8, dci = (idx & 63) - 16; tb[idx] = (dr >= -7 && dr <= 7 && dci >= 0 && dci <= 30) ? rpb[(dr + 7) * 31 + dci] * 1.4426950408889634f : 0.f; }
    NA_GLOAD(0); NA_SWRITE(0);
    __syncthreads();
#define NA_BLOCK(koff, MASKED, kr) do { \
        const char* kb = smem + K0 + buf * KB + ((koff) + r32) * KP + hi * 16; \
        f32x16 p = negm; \
        _Pragma("unroll") for (int ks = 0; ks < 4; ++ks) { const bf16x8 a = *(const bf16x8*)(kb + ks * 32); p = __builtin_amdgcn_mfma_f32_32x32x16_bf16(a, qf[ks], p, 0, 0, 0); } \
        if (MASKED) { const bool rowok = (unsigned)((kr) - r0q) < 8u; const float* tbr = tb + ((kr) - qr + 8) * 64 + bidx; \
            _Pragma("unroll") for (int r = 0; r < 16; ++r) { const int cst = (r & 3) + 8 * (r >> 2); const bool ok = rowok && (unsigned)(cbase + cst) < 16u; p[r] = ok ? p[r] + tbr[cst] : NEG; } } \
        float rm = fa::max3f(p[0], p[1], p[2]); \
        _Pragma("unroll") for (int r = 3; r < 15; r += 2) rm = fa::max3f(rm, p[r], p[r + 1]); \
        rm = fmaxf(rm, p[15]); \
        rm = xhalf_max(rm); \
        if (first || __any(rm > THR)) { \
            const float dl = first ? (rm > -1e29f ? rm : 0.f) : fmaxf(rm, 0.f); \
            mhat += dl; \
            _Pragma("unroll") for (int r = 0; r < 16; ++r) { p[r] -= dl; negm[r] = -mhat; } \
            if (!first) { const float f = __builtin_amdgcn_exp2f(-dl); lsum *= f; if (hi == 0) wsf[r32] = f; asm volatile("s_waitcnt lgkmcnt(0)" ::: "memory"); \
                _Pragma("unroll") for (int r = 0; r < 16; ++r) { const float fr = wsf[crow(r, hi)]; o0[r] *= fr; o1[r] *= fr; } } \
            first = false; } \
        float ps = 0.f; \
        _Pragma("unroll") for (int r = 0; r < 16; ++r) { p[r] = __builtin_amdgcn_exp2f(p[r]); ps += p[r]; } \
        lsum += ps; \
        u32x4 w0, w1; \
        w0.x = cvtpk(p[0], p[1]); w0.y = cvtpk(p[2], p[3]); w0.z = cvtpk(p[4], p[5]); w0.w = cvtpk(p[6], p[7]); \
        w1.x = cvtpk(p[8], p[9]); w1.y = cvtpk(p[10], p[11]); w1.z = cvtpk(p[12], p[13]); w1.w = cvtpk(p[14], p[15]); \
        const char* vb = smem + V0 + buf * VB + r32 * VP + ((koff) + 4 * hi) * 2; \
        { const bf16x8 pa = __builtin_bit_cast(bf16x8, w0); const uint2 a0 = *(const uint2*)(vb), a1 = *(const uint2*)(vb + 16), b0 = *(const uint2*)(vb + 32 * VP), b1 = *(const uint2*)(vb + 32 * VP + 16); \
          const bf16x8 v0 = __builtin_bit_cast(bf16x8, make_uint4(a0.x, a0.y, a1.x, a1.y)), v1 = __builtin_bit_cast(bf16x8, make_uint4(b0.x, b0.y, b1.x, b1.y)); \
          o0 = __builtin_amdgcn_mfma_f32_32x32x16_bf16(pa, v0, o0, 0, 0, 0); o1 = __builtin_amdgcn_mfma_f32_32x32x16_bf16(pa, v1, o1, 0, 0, 0); } \
        { const bf16x8 pa = __builtin_bit_cast(bf16x8, w1); const uint2 a0 = *(const uint2*)(vb + 32), a1 = *(const uint2*)(vb + 48), b0 = *(const uint2*)(vb + 32 * VP + 32), b1 = *(const uint2*)(vb + 32 * VP + 48); \
          const bf16x8 v0 = __builtin_bit_cast(bf16x8, make_uint4(a0.x, a0.y, a1.x, a1.y)), v1 = __builtin_bit_cast(bf16x8, make_uint4(b0.x, b0.y, b1.x, b1.y)); \
          o0 = __builtin_amdgcn_mfma_f32_32x32x16_bf16(pa, v0, o0, 0, 0, 0); o1 = __builtin_amdgcn_mfma_f32_32x32x16_bf16(pa, v1, o1, 0, 0, 0); } \
    } while (0)
    for (int t = 0; t < NT; ++t) {
        const int buf = t & 1;
        if (t + 1 < NT) NA_GLOAD(t + 1);
        if (t < NL) { const int kr = krU + t; if (kr >= wlo && kr < whi) NA_BLOCK(kc0, true, kr); }
        else { NA_BLOCK(0, false, 0); NA_BLOCK(32, false, 0); }
        if (t + 1 < NT) NA_SWRITE(buf ^ 1);
        __syncthreads();
    }
#undef NA_BLOCK
#undef NA_GLOAD
#undef NA_SWRITE
    lsum = xhalf_sum(lsum);
    if (hi == 0) wsf[32 + r32] = lsum;
    asm volatile("s_waitcnt lgkmcnt(0)" ::: "memory");
    bf16_t* stg = (bf16_t*)(smem + OST) + wid * 2048;
#pragma unroll
    for (int r = 0; r < 16; ++r) { const int orow = crow(r, hi); const float rl = 1.f / wsf[32 + orow]; stg[orow * 64 + r32] = f2bf(o0[r] * rl); stg[orow * 64 + 32 + r32] = f2bf(o1[r] * rl); }
    asm volatile("s_waitcnt lgkmcnt(0)" ::: "memory");
#pragma unroll
    for (int i = 0; i < 4; ++i) { const int q = i * 8 + (lane >> 3), ch = lane & 7; const u32x4 v = *(const u32x4*)(stg + q * 64 + ch * 8);
        const size_t orow = ctxu ? (size_t)NLAT + b * CTXL + wid * 32 + q : (size_t)b * SEQ + (size_t)(4 * g + 2 * pr + (q >> 4)) * 64 + cbk + (q & 15);
        *(u32x4*)(MIX + orow * DM + 256 + h * 64 + ch * 8) = v; }
}
}


__device__ __forceinline__ float reduce64(float (&v)[64], int lane) {
#pragma unroll
    for (int i = 0; i < 32; ++i) { auto r = __builtin_amdgcn_permlane32_swap(__float_as_uint(v[i]), __float_as_uint(v[i + 32]), false, false); v[i] = __uint_as_float(r[0]) + __uint_as_float(r[1]); }
#pragma unroll
    for (int i = 0; i < 16; ++i) { auto r = __builtin_amdgcn_permlane16_swap(__float_as_uint(v[i]), __float_as_uint(v[i + 16]), false, false); v[i] = __uint_as_float(r[0]) + __uint_as_float(r[1]); }
    const bool b3 = lane & 8, b2 = lane & 4, b1 = lane & 2, b0 = lane & 1;
#pragma unroll
    for (int i = 0; i < 8; ++i) { const float keep = b3 ? v[i + 8] : v[i], send = b3 ? v[i] : v[i + 8]; v[i] = keep + dpp_f<0x140>(send); }
#pragma unroll
    for (int i = 0; i < 4; ++i) { const float keep = b2 ? v[i + 4] : v[i], send = b2 ? v[i] : v[i + 4]; v[i] = keep + dpp_f<0x141>(send); }
#pragma unroll
    for (int i = 0; i < 2; ++i) { const float keep = b1 ? v[i + 2] : v[i], send = b1 ? v[i] : v[i + 2]; v[i] = keep + dpp_f<0x4E>(send); }
    { const float keep = b0 ? v[1] : v[0], send = b0 ? v[0] : v[1]; v[0] = keep + dpp_f<0xB1>(send); }
    return v[0];
}
#define PROBE_SET 0
#ifndef PHASE_INLINE
#define PHASE_INLINE __forceinline__
#endif

namespace rt {
using fa::bf16x8; using fa::f32x16; using fa::u32x4; using fa::crow; using fa::cvtpk;
constexpr int KP = 144, KBY = 128 * KP, VP = 264, VBY = 64 * VP, SP = 144, SBY = 64 * SP;
constexpr int OK_ = 0, OV = KBY, OSF = OV + VBY, OSB = OSF + SBY, UNIT = OSB + SBY, STG = 2 * UNIT, BYTES = STG + 8 * 4096;
static_assert(UNIT % 16 == 0 && BYTES <= 144 * 1024 - 64, "retention LDS map");
template <int CTRL> __device__ __forceinline__ float dppf(float v) { return __uint_as_float((unsigned)__builtin_amdgcn_mov_dpp((int)__float_as_uint(v), CTRL, 0xF, 0xF, true)); }
__device__ __forceinline__ float half_sum(float v) {
    v += dppf<0xB1>(v); v += dppf<0x4E>(v); v += dppf<0x141>(v); v += dppf<0x140>(v);
    auto r = __builtin_amdgcn_permlane16_swap(__float_as_uint(v), __float_as_uint(v), false, false); return __uint_as_float(r[0]) + __uint_as_float(r[1]);
}
__device__ __forceinline__ void rope8(uint4& a, uint4& b, const float2* tab) {
    unsigned* pa = (unsigned*)&a; unsigned* pb = (unsigned*)&b;
#pragma unroll
    for (int w = 0; w < 4; ++w) {
        const float4 t = *(const float4*)(tab + 2 * w);
        const float x1l = __uint_as_float(pa[w] << 16), x1h = __uint_as_float(pa[w] & 0xffff0000u), x2l = __uint_as_float(pb[w] << 16), x2h = __uint_as_float(pb[w] & 0xffff0000u);
        pa[w] = cvtpk(x1l * t.x - x2l * t.y, x1h * t.z - x2h * t.w); pb[w] = cvtpk(x2l * t.x + x1l * t.y, x2h * t.z + x1h * t.w);
    }
}
#define RT_KITEM(item, A, B, R, CC) const int R = (item) >> 2, pc_ = (item) & 3, CC = (pc_ & 1) + 4 * (pc_ >> 1); \
        const bf16_t* ksrc_ = P + (size_t)(row0 + R) * LDP + PC_RK + hd * 64; uint4 A = *(const uint4*)(ksrc_ + CC * 8), B = *(const uint4*)(ksrc_ + (CC + 2) * 8); \
        if (lat) { const int tok_ = j * 128 + R, pos_ = pc_ < 2 ? tok_ >> 6 : tok_ & 63; rope8(A, B, TAB + pos_ * 16 + 8 * (pc_ & 1)); }
__device__ __forceinline__ void ret_pair(char* smem, int it0, int n_it, const bf16_t* P, const float* RKV, const float2* TAB, const float* dec_f, const float* dec_b, bf16_t* MIX) {
    const int tid = tid_(), lane = tid & 63, r32 = lane & 31, hi = lane >> 5; const int wid = __builtin_amdgcn_readfirstlane(tid >> 6);
    const int hw = wid >> 2, w4 = wid & 3, t4 = tid & 255;
    const int it = it0 + hw; const bool valid = it < n_it;
    int b, hd, j, row0;
    if (it < 1024) { b = it >> 8; hd = (it >> 6) & 3; j = it & 63; row0 = b * SEQ + j * 128; } else { const int q = it - 1024; b = q >> 3; hd = (q >> 1) & 3; j = q & 1; row0 = NLAT + b * CTXL + j * 128; }
    char* un = smem + hw * UNIT; const bool lat = it < 1024;
    __syncthreads();
    if (valid) {
#pragma unroll
        for (int c = 0; c < 2; ++c) { RT_KITEM(t4 + 256 * c, ka, kb2, r, cc) *(uint4*)(un + OK_ + r * KP + cc * 16) = ka; *(uint4*)(un + OK_ + r * KP + (cc + 2) * 16) = kb2; }
#pragma unroll
        for (int c = 0; c < 4; ++c) { const int ch = t4 + 256 * c, r = ch >> 3, cc = ch & 7; const bf16_t* src = P + (size_t)(row0 + r) * LDP + hd * 64 + cc * 8;
            const uint4 v = *(const uint4*)(src + PC_RV); bf16_t* vt = (bf16_t*)(un + OV) + (cc * 8) * (VP / 2) + r;
            vt[0 * (VP / 2)] = (bf16_t)(v.x & 0xffff); vt[1 * (VP / 2)] = (bf16_t)(v.x >> 16); vt[2 * (VP / 2)] = (bf16_t)(v.y & 0xffff); vt[3 * (VP / 2)] = (bf16_t)(v.y >> 16);
            vt[4 * (VP / 2)] = (bf16_t)(v.z & 0xffff); vt[5 * (VP / 2)] = (bf16_t)(v.z >> 16); vt[6 * (VP / 2)] = (bf16_t)(v.w & 0xffff); vt[7 * (VP / 2)] = (bf16_t)(v.w >> 16); }
#pragma unroll
        for (int c = 0; c < 16; ++c) { const int idx = t4 + 256 * c, d = idx >> 6, e = idx & 63;
            ((bf16_t*)(un + OSF))[e * (SP / 2) + d] = f2bf(RKV[((size_t)it * 2 + 0) * 4096 + idx]); ((bf16_t*)(un + OSB))[e * (SP / 2) + d] = f2bf(RKV[((size_t)it * 2 + 1) * 4096 + idx]); }
    }
    __syncthreads();
    if (valid) {
        const float lgf2 = log_sigmoid_f(dec_f[hd]) * 1.4426950408889634f, lgb2 = log_sigmoid_f(dec_b[hd]) * 1.4426950408889634f;
        const int qi = w4 * 32 + r32;
        bf16x8 qf[4];
#pragma unroll
        for (int ks = 0; ks < 4; ++ks) qf[ks] = *(const bf16x8*)(P + (size_t)(row0 + qi) * LDP + PC_RQ + hd * 64 + ks * 16 + hi * 8);
        if (lat) { const int tq = j * 128 + qi; uint4 a = __builtin_bit_cast(uint4, qf[0]), b2 = __builtin_bit_cast(uint4, qf[1]), c2 = __builtin_bit_cast(uint4, qf[2]), d2 = __builtin_bit_cast(uint4, qf[3]);
            rope8(a, b2, TAB + (tq >> 6) * 16 + 8 * hi); rope8(c2, d2, TAB + (tq & 63) * 16 + 8 * hi);
            qf[0] = __builtin_bit_cast(bf16x8, a); qf[1] = __builtin_bit_cast(bf16x8, b2); qf[2] = __builtin_bit_cast(bf16x8, c2); qf[3] = __builtin_bit_cast(bf16x8, d2); }
        f32x16 o0, o1;
#pragma unroll
        for (int r = 0; r < 16; ++r) { o0[r] = 0.f; o1[r] = 0.f; }
#pragma unroll
        for (int kb = 0; kb < 4; ++kb) {
            f32x16 pz;
#pragma unroll
            for (int r = 0; r < 16; ++r) pz[r] = 0.f;
            const char* kp = un + OK_ + (kb * 32 + r32) * KP + hi * 16;
#pragma unroll
            for (int ks = 0; ks < 4; ++ks) { const bf16x8 a = *(const bf16x8*)(kp + ks * 32); pz = __builtin_amdgcn_mfma_f32_32x32x16_bf16(a, qf[ks], pz, 0, 0, 0); }
#pragma unroll
            for (int r = 0; r < 16; ++r) { const int dI = qi - (kb * 32 + crow(r, hi)); const float arg = dI >= 0 ? lgf2 * (float)dI : -lgb2 * (float)dI; pz[r] *= __builtin_amdgcn_exp2f(arg); }
            u32x4 w0, w1;
            w0.x = cvtpk(pz[0], pz[1]); w0.y = cvtpk(pz[2], pz[3]); w0.z = cvtpk(pz[4], pz[5]); w0.w = cvtpk(pz[6], pz[7]);
            w1.x = cvtpk(pz[8], pz[9]); w1.y = cvtpk(pz[10], pz[11]); w1.z = cvtpk(pz[12], pz[13]); w1.w = cvtpk(pz[14], pz[15]);
            const char* vb = un + OV + r32 * VP + (kb * 32 + 4 * hi) * 2;
            { const bf16x8 pa = __builtin_bit_cast(bf16x8, w0); const uint2 a0 = *(const uint2*)(vb), a1 = *(const uint2*)(vb + 16), b0 = *(const uint2*)(vb + 32 * VP), b1 = *(const uint2*)(vb + 32 * VP + 16);
              o0 = __builtin_amdgcn_mfma_f32_32x32x16_bf16(pa, __builtin_bit_cast(bf16x8, make_uint4(a0.x, a0.y, a1.x, a1.y)), o0, 0, 0, 0);
              o1 = __builtin_amdgcn_mfma_f32_32x32x16_bf16(pa, __builtin_bit_cast(bf16x8, make_uint4(b0.x, b0.y, b1.x, b1.y)), o1, 0, 0, 0); }
            { const bf16x8 pa = __builtin_bit_cast(bf16x8, w1); const uint2 a0 = *(const uint2*)(vb + 32), a1 = *(const uint2*)(vb + 48), b0 = *(const uint2*)(vb + 32 * VP + 32), b1 = *(const uint2*)(vb + 32 * VP + 48);
              o0 = __builtin_amdgcn_mfma_f32_32x32x16_bf16(pa, __builtin_bit_cast(bf16x8, make_uint4(a0.x, a0.y, a1.x, a1.y)), o0, 0, 0, 0);
              o1 = __builtin_amdgcn_mfma_f32_32x32x16_bf16(pa, __builtin_bit_cast(bf16x8, make_uint4(b0.x, b0.y, b1.x, b1.y)), o1, 0, 0, 0); }
        }
        {
            f32x16 tf0, tf1, tb0, tb1;
#pragma unroll
            for (int r = 0; r < 16; ++r) { tf0[r] = 0.f; tf1[r] = 0.f; tb0[r] = 0.f; tb1[r] = 0.f; }
            const char* sf = un + OSF + r32 * SP + hi * 16; const char* sb = un + OSB + r32 * SP + hi * 16;
#pragma unroll
            for (int ks = 0; ks < 4; ++ks) {
                tf0 = __builtin_amdgcn_mfma_f32_32x32x16_bf16(qf[ks], *(const bf16x8*)(sf + ks * 32), tf0, 0, 0, 0); tf1 = __builtin_amdgcn_mfma_f32_32x32x16_bf16(qf[ks], *(const bf16x8*)(sf + 32 * SP + ks * 32), tf1, 0, 0, 0);
                tb0 = __builtin_amdgcn_mfma_f32_32x32x16_bf16(qf[ks], *(const bf16x8*)(sb + ks * 32), tb0, 0, 0, 0); tb1 = __builtin_amdgcn_mfma_f32_32x32x16_bf16(qf[ks], *(const bf16x8*)(sb + 32 * SP + ks * 32), tb1, 0, 0, 0);
            }
#pragma unroll
            for (int r = 0; r < 16; ++r) { const int i = w4 * 32 + crow(r, hi); const float cf = __builtin_amdgcn_exp2f(lgf2 * (float)(i + 1)), cb = __builtin_amdgcn_exp2f(lgb2 * (float)(128 - i));
                o0[r] += cf * tf0[r] + cb * tb0[r]; o1[r] += cf * tf1[r] + cb * tb1[r]; }
        }
        bf16_t* stg = (bf16_t*)(smem + STG) + wid * 2048;
#pragma unroll
        for (int r = 0; r < 16; ++r) {
            const float mu = half_sum(o0[r] + o1[r]) * (1.f / 64.f); const float d0 = o0[r] - mu, d1 = o1[r] - mu;
            const float rs = rsqrtf(half_sum(d0 * d0 + d1 * d1) * (1.f / 64.f) + 1e-6f);
            const int q = crow(r, hi); stg[q * 64 + r32] = f2bf(d0 * rs); stg[q * 64 + 32 + r32] = f2bf(d1 * rs);
        }
        asm volatile("s_waitcnt lgkmcnt(0)" ::: "memory");
#pragma unroll
        for (int i = 0; i < 4; ++i) { const int q = i * 8 + (lane >> 3), ch = lane & 7; const size_t row = (size_t)row0 + w4 * 32 + q;
            const u32x4 y = *(const u32x4*)(stg + q * 64 + ch * 8), gg = *(const u32x4*)(P + row * LDP + PC_RG + hd * 64 + ch * 8); u32x4 o;
#define RT_G(yv, gv) cvtpk(__uint_as_float((yv) << 16) * silu_f(__uint_as_float((gv) << 16)), __uint_as_float((yv) & 0xffff0000u) * silu_f(__uint_as_float((gv) & 0xffff0000u)))
            o.x = RT_G(y.x, gg.x); o.y = RT_G(y.y, gg.y); o.z = RT_G(y.z, gg.z); o.w = RT_G(y.w, gg.w);
#undef RT_G
            *(u32x4*)(MIX + row * DM + hd * 64 + ch * 8) = o; }
    }
}
constexpr int TP = 272, TBY = 64 * TP, SUNIT = 3 * TBY;
static_assert(2 * SUNIT <= BYTES, "summary LDS map");
__device__ __forceinline__ void sum_pair(char* smem, int it0, int n_it, const bf16_t* P, float* RKV, const float2* TAB, const float* dec_f, const float* dec_b) {
    const int tid = tid_(), lane = tid & 63, r32 = lane & 31, hi = lane >> 5; const int wid = __builtin_amdgcn_readfirstlane(tid >> 6);
    const int hw = wid >> 2, w4 = wid & 3, t4 = tid & 255;
    const int it = it0 + hw; const bool valid = it < n_it, lat = it < 1024;
    int b, hd, j, row0;
    if (it < 1024) { b = it >> 8; hd = (it >> 6) & 3; j = it & 63; row0 = b * SEQ + j * 128; } else { const int q = it - 1024; b = q >> 3; hd = (q >> 1) & 3; j = q & 1; row0 = NLAT + b * CTXL + j * 128; }
    bf16_t* kt = (bf16_t*)(smem + hw * SUNIT); bf16_t* vf = kt + TBY / 2; bf16_t* vb = vf + TBY / 2;
    __syncthreads();
    if (valid) {
        const float lgf2 = log_sigmoid_f(dec_f[hd]) * 1.4426950408889634f, lgb2 = log_sigmoid_f(dec_b[hd]) * 1.4426950408889634f;
#pragma unroll
        for (int c = 0; c < 2; ++c) { RT_KITEM(t4 + 256 * c, ka, kb2, r, cc) const unsigned* pa = (const unsigned*)&ka; const unsigned* pb = (const unsigned*)&kb2;
#pragma unroll
            for (int w = 0; w < 4; ++w) { kt[(cc * 8 + 2 * w) * (TP / 2) + r] = (bf16_t)(pa[w] & 0xffff); kt[(cc * 8 + 2 * w + 1) * (TP / 2) + r] = (bf16_t)(pa[w] >> 16);
                kt[((cc + 2) * 8 + 2 * w) * (TP / 2) + r] = (bf16_t)(pb[w] & 0xffff); kt[((cc + 2) * 8 + 2 * w + 1) * (TP / 2) + r] = (bf16_t)(pb[w] >> 16); } }
#pragma unroll
        for (int c = 0; c < 4; ++c) { const int ch = t4 + 256 * c, r = ch >> 3, cc = ch & 7; const uint4 v = *(const uint4*)(P + (size_t)(row0 + r) * LDP + PC_RV + hd * 64 + cc * 8); const unsigned* pv = (const unsigned*)&v;
            const float wf = __builtin_amdgcn_exp2f(lgf2 * (float)(127 - r)), wb = __builtin_amdgcn_exp2f(lgb2 * (float)r);
#pragma unroll
            for (int w = 0; w < 4; ++w) { const float lo = __uint_as_float(pv[w] << 16), hh = __uint_as_float(pv[w] & 0xffff0000u);
                vf[(cc * 8 + 2 * w) * (TP / 2) + r] = f2bf(lo * wf); vf[(cc * 8 + 2 * w + 1) * (TP / 2) + r] = f2bf(hh * wf);
                vb[(cc * 8 + 2 * w) * (TP / 2) + r] = f2bf(lo * wb); vb[(cc * 8 + 2 * w + 1) * (TP / 2) + r] = f2bf(hh * wb); } }
    }
    __syncthreads();
    if (valid) {
        const int dblk = w4 >> 1, eblk = w4 & 1;
        f32x16 af, ab;
#pragma unroll
        for (int r = 0; r < 16; ++r) { af[r] = 0.f; ab[r] = 0.f; }
        const char* ka = (const char*)kt + (dblk * 32 + r32) * TP + hi * 16; const char* fa_ = (const char*)vf + (eblk * 32 + r32) * TP + hi * 16; const char* ba_ = (const char*)vb + (eblk * 32 + r32) * TP + hi * 16;
#pragma unroll
        for (int ks = 0; ks < 8; ++ks) { const bf16x8 a = *(const bf16x8*)(ka + ks * 32);
            af = __builtin_amdgcn_mfma_f32_32x32x16_bf16(a, *(const bf16x8*)(fa_ + ks * 32), af, 0, 0, 0); ab = __builtin_amdgcn_mfma_f32_32x32x16_bf16(a, *(const bf16x8*)(ba_ + ks * 32), ab, 0, 0, 0); }
        float* of = RKV + ((size_t)it * 2 + 0) * 4096 + eblk * 32 + r32; float* ob = RKV + ((size_t)it * 2 + 1) * 4096 + eblk * 32 + r32;
#pragma unroll
        for (int r = 0; r < 16; ++r) { const int d = dblk * 32 + crow(r, hi); of[d * 64] = af[r]; ob[d * 64] = ab[r]; }
    }
}
}

template <int KIND> __device__ PHASE_INLINE void phase(const Params& p, const int l, char* smem) {
    __syncthreads();
    const int tid = tid_(), lane = tid & 63, wid = tid >> 6;
    const int nblk = gridDim.x, bid = bid_();
    size_t zoff = 0; asm volatile("" : "+s"(zoff));
    unsigned char* ws = p.ws + zoff;
    float* MOD = (float*)(ws + WS_MOD);
    bf16_t* U = (bf16_t*)(ws + WS_U);
    bf16_t* P = (bf16_t*)(ws + WS_P);
    bf16_t* QM = (bf16_t*)(ws + WS_QM);
    bf16_t* KM = (bf16_t*)(ws + WS_KM);
    bf16_t* VM = (bf16_t*)(ws + WS_VM);
    float* RKV = (float*)(ws + WS_RKV);
    bf16_t* XS = (bf16_t*)(ws + WS_XS);
    bf16_t* HDN = (bf16_t*)(ws + WS_HDN);
    int2* RTE = (int2*)(ws + WS_RT + RT_E);
    float2* RTW = (float2*)(ws + WS_RT + RT_W);
    float* RTR = (float*)(ws + WS_RT + RT_RSTD);
    int2* RTS = (int2*)(ws + WS_RT + RT_SLOT);
    int* CNT = (int*)(ws + WS_RT + RT_CNT);
    int* SEG = (int*)(ws + WS_RT + RT_SEG);
    int* TILE = (int*)(ws + WS_RT + RT_TILE);
    bf16_t* VT = (bf16_t*)(ws + WS_VT);
    bf16_t* NVT = (bf16_t*)(ws + WS_NVT);
    bf16_t* WT = (bf16_t*)(ws + WS_WT);
    PG8_LAS unsigned char* lds3 = (PG8_LAS unsigned char*)smem;
    float* const Hlat = p.out; float* const Hctx = (float*)(ws + WS_HC);

    if constexpr (KIND == 0) {
        {
            float* sc = (float*)smem;
            float* red = sc + 5 * DM;
            for (int i = tid; i < 5 * DM; i += 512) { const int v = i / DM, k = i % DM; const float x = v < 4 ? p.in[I_C][v * DM + k] : p.in[I_CCTX][k]; sc[i] = silu_f(x); }
            __syncthreads();
            for (int it = bid; it < 2 * 96; it += nblk) {
                const int ll = it / 96, j = (it % 96) * 64 + lane;
                const float* wm = p.in[I_WMOD] + (size_t)ll * DM * 6144 + (size_t)(wid * 128) * 6144 + j;
                float a0 = 0.f, a1 = 0.f, a2 = 0.f, a3 = 0.f, a4 = 0.f;
#pragma unroll 8
                for (int k = 0; k < 128; ++k) { const float w = wm[(size_t)k * 6144]; const int kk = wid * 128 + k; a0 = fmaf(sc[kk], w, a0); a1 = fmaf(sc[DM + kk], w, a1); a2 = fmaf(sc[2 * DM + kk], w, a2); a3 = fmaf(sc[3 * DM + kk], w, a3); a4 = fmaf(sc[4 * DM + kk], w, a4); }
                __syncthreads();
                red[(wid * 5 + 0) * 64 + lane] = a0; red[(wid * 5 + 1) * 64 + lane] = a1; red[(wid * 5 + 2) * 64 + lane] = a2; red[(wid * 5 + 3) * 64 + lane] = a3; red[(wid * 5 + 4) * 64 + lane] = a4;
                __syncthreads();
                if (tid < 320) { const int v = tid >> 6, c = tid & 63; float t = p.in[I_BMOD][ll * 6144 + (it % 96) * 64 + c];
#pragma unroll
                    for (int w8 = 0; w8 < 8; ++w8) t += red[(w8 * 5 + v) * 64 + c];
                    MOD[((size_t)ll * 5 + v) * 6144 + (it % 96) * 64 + c] = t; }
            }
            __syncthreads();
        }
        for (int idx = bid * 512 + tid; idx < 128 * 16; idx += nblk * 512) { const int pos = idx >> 4, i = idx & 15; float sn, cs; sincosf((float)pos * powf(10000.0f, -(float)i / 16.0f), &sn, &cs); ((float2*)(ws + WS_TAB))[idx] = make_float2(cs, sn); }
        {
            float* tl = (float*)smem; int base = 0;
            for (int ll = 0; ll < 2; ++ll) {
                transpose_mat(tl, p.in[I_WIN] + (size_t)ll * DM * DPROJ, DM, DPROJ, 3328, WT + WT_IN + ll * WT_IN_L, 1, 0, base, WScale{nullptr, PC_RQ, PC_RQ + 256, 0.125f, PC_NQ, PC_NQ + 512, 0.125f * 1.4426950408889634f});
                transpose_mat(tl, p.in[I_WUQ] + (size_t)ll * 384 * 384, 384, 384, 512, WT + WT_UQ + ll * WT_UQ_L, 1, 0, base, WScale{p.in[I_QN] + ll * 384, 0, 384, 0.10206207261596577f * 1.4426950408889634f, 0, 0, 1.f});
                transpose_mat(tl, p.in[I_WUKV] + (size_t)ll * 256 * 512, 256, 512, 512, WT + WT_UKV + ll * WT_UKV_L, 1, 0, base, WScale{p.in[I_KVN] + ll * 256, 0, 0, 1.f, 0, 0, 1.f});
                transpose_mat(tl, p.in[I_WOUT] + (size_t)ll * DM * DM, DM, DM, DM, WT + WT_OUT + ll * WT_OUT_L, 1, 0, base, WScale{nullptr, 0, 0, 1.f, 0, 0, 1.f});
                for (int e = 0; e < NE; ++e) {
                    transpose_mat(tl, p.in[I_W1] + ((size_t)ll * NE + e) * DM * FF, DM, FF, FF, WT + WT_13 + ll * WT_13_L + (size_t)e * 512 * 1024, 2, 0, base, WScale{nullptr, 0, 0, 1.f, 0, 0, 1.f});
                    transpose_mat(tl, p.in[I_W3] + ((size_t)ll * NE + e) * DM * FF, DM, FF, FF, WT + WT_13 + ll * WT_13_L + (size_t)e * 512 * 1024, 2, 1, base, WScale{nullptr, 0, 0, 1.f, 0, 0, 1.f});
                    transpose_mat(tl, p.in[I_W2] + ((size_t)ll * NE + e) * FF * DM, FF, DM, DM, WT + WT_2 + ll * WT_2_L + (size_t)e * 1024 * 256, 1, 0, base, WScale{nullptr, 0, 0, 1.f, 0, 0, 1.f});
                }
            }
        }
    }

    {
        const bool last = (l == 1);
        const float* modl = MOD + (size_t)l * 5 * 6144;
        const int rows_mix = last ? NLAT : NROW;

        if constexpr (KIND == 1) {
            const float* g = p.in[I_N1G] + l * DM; const float* modp = MOD + (size_t)(l - 1) * 5 * 6144;
            for (int row = bid * 8 + wid; row < NROW; row += nblk * 8) {
                const float* mv = modl + row_modv(row) * 6144;
                float4 x[4]; float ss = 0.f;
                if (l == 0) {
                    const float* h = row < NLAT ? p.in[I_X] + (size_t)row * DM : p.in[I_CTX] + (size_t)(row - NLAT) * DM;
#pragma unroll
                    for (int i = 0; i < 4; ++i) x[i] = *(const float4*)(h + lane * 4 + 256 * i);
                } else {
                    float* h = hrow2(Hlat, Hctx, row); const float* mg = modp + row_modv(row) * 6144 + 5120;
                    const int2 s2 = RTS[row]; const float2 w2 = RTW[row];
#pragma unroll
                    for (int i = 0; i < 4; ++i) {
                        const int c = lane * 4 + 256 * i;
                        const uint2 ya = *(const uint2*)(XS + (size_t)s2.x * DM + c), yb = *(const uint2*)(XS + (size_t)s2.y * DM + c);
                        float4 xx = *(const float4*)(h + c); const float4 gg = *(const float4*)(mg + c);
                        xx.x += gg.x * (w2.x * __uint_as_float(ya.x << 16) + w2.y * __uint_as_float(yb.x << 16));
                        xx.y += gg.y * (w2.x * __uint_as_float(ya.x & 0xffff0000u) + w2.y * __uint_as_float(yb.x & 0xffff0000u));
                        xx.z += gg.z * (w2.x * __uint_as_float(ya.y << 16) + w2.y * __uint_as_float(yb.y << 16));
                        xx.w += gg.w * (w2.x * __uint_as_float(ya.y & 0xffff0000u) + w2.y * __uint_as_float(yb.y & 0xffff0000u));
                        *(float4*)(h + c) = xx; x[i] = xx;
                    }
                }
#pragma unroll
                for (int i = 0; i < 4; ++i) ss += x[i].x * x[i].x + x[i].y * x[i].y + x[i].z * x[i].z + x[i].w * x[i].w;
                ss = wave_sum(ss);
                const float rstd = rsqrtf(ss * (1.f / DM) + 1e-6f);
#pragma unroll
                for (int i = 0; i < 4; ++i) {
                    const int c = lane * 4 + 256 * i;
                    const float4 gg = *(const float4*)(g + c), sh = *(const float4*)(mv + c), sc = *(const float4*)(mv + 1024 + c);
                    const float y0 = x[i].x * rstd * gg.x * (1.f + sc.x) + sh.x, y1 = x[i].y * rstd * gg.y * (1.f + sc.y) + sh.y;
                    const float y2 = x[i].z * rstd * gg.z * (1.f + sc.z) + sh.z, y3 = x[i].w * rstd * gg.w * (1.f + sc.w) + sh.w;
                    uint2 o; o.x = (unsigned)f2bf(y0) | ((unsigned)f2bf(y1) << 16); o.y = (unsigned)f2bf(y2) | ((unsigned)f2bf(y3) << 16);
                    *(uint2*)(U + (size_t)row * DM + c) = o;
                }
            }
        }
        if constexpr (KIND == 2) {
            pg8::Gemm g{U, WT + WT_IN + l * WT_IN_L, DM, DM, DM}; pg8::StaticOrder S; S.init(NROW, 3328, nblk, bid);
            pg8::EpiP E{P, LDP, (float*)(ws + WS_PS)};
            pg8::gemm_phase<pg8::EpiP, pg8::StaticOrder, true, true>(lds3, g, S, E);
        }
        if constexpr (KIND == 14) {
            pg8::Gemm g{P + PC_CKV, WT + WT_UKV + l * WT_UKV_L, LDP, 256, 256}; pg8::StaticOrder S; S.init(NROW, 512, nblk, bid);
            pg8::EpiUKV E{KM, VM, (const float*)(ws + WS_PS)};
            pg8::gemm_phase<pg8::EpiUKV, pg8::StaticOrder, true, true>(lds3, g, S, E);
        }
        if constexpr (KIND == 4) {
            {
                pg8::Gemm g{P + PC_CQ, WT + WT_UQ + l * WT_UQ_L, LDP, 384, 384}; pg8::StaticOrder S; S.init(NROW, 512, nblk, bid);
                pg8::EpiUQ E{QM, (const float*)(ws + WS_PS)};
                pg8::gemm_phase<pg8::EpiUQ, pg8::StaticOrder, true, true>(lds3, g, S, E);
            }
            __syncthreads();
            for (int pi = bid; pi * 2 < RET_ITEMS; pi += nblk) rt::sum_pair(smem, pi * 2, RET_ITEMS, P, RKV, (const float2*)(ws + WS_TAB), p.in[I_RDF] + l * 4, p.in[I_RDB] + l * 4);
        }
        if constexpr (KIND == 5) {
            for (int row = bid * 8 + wid; row < NROW; row += nblk * 8) {
                const bool lat = row < NLAT; const int tt = row & (SEQ - 1);
                const float posr = (float)(tt >> 6), posc = (float)(tt & 63);
                if (lat) {
                    const int hd = lane >> 4, pp = lane & 15, sec = pp >> 3, ii = pp & 7;
                    bf16_t* b = QM + (size_t)row * 384 + hd * 96 + 64 + sec * 16 + ii;
                    float x1 = bf2f(b[0]), x2 = bf2f(b[8]);
                    rope_pair(x1, x2, sec ? posc : posr, ii, 8);
                    b[0] = f2bf(x1); b[8] = f2bf(x2);
                }
                if (lane < 16) {
                    const int sec = lane >> 3, ii = lane & 7;
                    const bf16_t* b = P + (size_t)row * LDP + PC_KPE + sec * 16 + ii;
                    float x1 = bf2f(b[0]), x2 = bf2f(b[8]);
                    if (lat) rope_pair(x1, x2, sec ? posc : posr, ii, 8);
                    const bf16_t y1 = f2bf(x1), y2 = f2bf(x2);
#pragma unroll
                    for (int hd = 0; hd < 4; ++hd) { bf16_t* k = KM + (size_t)row * 384 + hd * 96 + 64 + sec * 16 + ii; k[0] = y1; k[8] = y2; }
                }
            }
            {
                bf16_t* tl = (bf16_t*)smem;
                for (int it = bid; it < 16 * 132; it += nblk) {
                    const int bh = it / 132, tile = it % 132, b = bh >> 2, hd = bh & 3;
                    const size_t row0 = tile < 128 ? (size_t)b * SEQ + tile * 64 : (size_t)NLAT + b * CTXL + (tile - 128) * 64;
                    __syncthreads();
                    { const int r = tid >> 3, d8 = (tid & 7) * 8; const uint4 v = *(const uint4*)(VM + (row0 + r) * 256 + hd * 64 + d8);
                      unsigned* d = (unsigned*)(tl + r * 66 + d8); d[0] = v.x; d[1] = v.y; d[2] = v.z; d[3] = v.w; }
                    __syncthreads();
                    { const int dv = tid >> 3, g = tid & 7, s4 = g >> 1, hh = g & 1; unsigned short e[8];
#pragma unroll
                      for (int j = 0; j < 8; ++j) e[j] = tl[(16 * s4 + 8 * (j >> 2) + 4 * hh + (j & 3)) * 66 + dv];
                      uint4 o; o.x = e[0] | ((unsigned)e[1] << 16); o.y = e[2] | ((unsigned)e[3] << 16); o.z = e[4] | ((unsigned)e[5] << 16); o.w = e[6] | ((unsigned)e[7] << 16);
                      *(uint4*)(VT + ((size_t)it * 64 + dv) * 64 + g * 8) = o; }
                }
                __syncthreads();
            }
            {
                bf16_t* tl = (bf16_t*)smem;
                for (int it = bid; it < 32 * 132; it += nblk) {
                    const int bh = it / 132, tile = it % 132, b = bh >> 3, hd = bh & 7;
                    const size_t row0 = tile < 128 ? (size_t)b * SEQ + tile * 64 : (size_t)NLAT + b * CTXL + (tile - 128) * 64;
                    __syncthreads();
                    { const int r = tid >> 3, d8 = (tid & 7) * 8; const uint4 v = *(const uint4*)(P + (row0 + r) * LDP + PC_NV + hd * 64 + d8);
                      unsigned* d = (unsigned*)(tl + r * 66 + d8); d[0] = v.x; d[1] = v.y; d[2] = v.z; d[3] = v.w; }
                    __syncthreads();
                    { const int dv = tid >> 3, g = tid & 7, s4 = g >> 1, hh = g & 1; unsigned short e[8];
#pragma unroll
                      for (int j = 0; j < 8; ++j) e[j] = tl[(8 * g + j) * 66 + dv];
                      uint4 o; o.x = e[0] | ((unsigned)e[1] << 16); o.y = e[2] | ((unsigned)e[3] << 16); o.z = e[4] | ((unsigned)e[5] << 16); o.w = e[6] | ((unsigned)e[7] << 16);
                      *(uint4*)(NVT + ((size_t)it * 64 + dv) * 64 + g * 8) = o; }
                }
                __syncthreads();
            }
            for (int gid = bid * 512 + tid; gid < 2 * 16 * 4096; gid += nblk * 512) {
                const int el = gid & 4095, bh = (gid >> 12) & 15, dir = gid >> 16, hd = bh & 3;
                const float lg = log_sigmoid_f(dir ? p.in[I_RDB][l * 4 + hd] : p.in[I_RDF][l * 4 + hd]);
                const float g128 = expf(128.f * lg);
                float* c0p = RKV + ((size_t)(1024 + bh * 2 + 0) * 2 + dir) * 4096 + el;
                float* c1p = RKV + ((size_t)(1024 + bh * 2 + 1) * 2 + dir) * 4096 + el;
                const float c0 = *c0p, c1 = *c1p; float S;
                if (dir == 0) { *c0p = 0.f; *c1p = c0; S = g128 * c0 + c1; } else { *c1p = 0.f; *c0p = c1; S = g128 * c1 + c0; }
                for (int jj = 0; jj < 64; ++jj) {
                    const int j = dir ? 63 - jj : jj;
                    float* q = RKV + ((size_t)(bh * 64 + j) * 2 + dir) * 4096 + el;
                    const float tmp = *q; *q = S; S = fmaf(g128, S, tmp);
                }
            }
        }
        if constexpr (KIND == 6) {
            bf16_t* MIX = U;
            {
                const int n_mla = 512 + (last ? 0 : 16);
                for (int it = bid; it < n_mla; it += nblk) {
                    const bool cu = it >= 512; const int bh = cu ? it - 512 : it >> 5, qb = it & 31, b = bh >> 2, hd = bh & 3;
                    const size_t cr0 = (size_t)NLAT + b * CTXL, kr0 = (size_t)b * SEQ, r0 = cu ? cr0 : kr0 + qb * 256;
                    const bf16_t* k0 = KM + (cu ? cr0 : kr0) * 384 + hd * 96; const bf16_t* k1 = KM + cr0 * 384 + hd * 96;
                    fa::attn_unit<96>(smem, QM + r0 * 384 + hd * 96, 384, k0, cu ? 4 : 128, k1, cu ? 0 : 4, 384, VT + ((size_t)bh * 132 + (cu ? 128 : 0)) * 4096, MIX + r0 * DM + 768 + hd * 64, DM);
                }
            }
        }
        if constexpr (KIND == 15) {
            bf16_t* MIX = U;
            {
                const int n_na = 1024 + (last ? 0 : 32);
                for (int it = bid; it < n_na; it += nblk) {
                    const bool cu = it >= 1024; const int bh = cu ? it - 1024 : it >> 5, g = cu ? 0 : it & 31;
                    na::na_unit(smem, cu, bh >> 3, bh & 7, g, P, NVT, p.in[I_RPB] + ((size_t)l * 8 + (bh & 7)) * 465, MIX);
                }
                __syncthreads();
            }
        }
        if constexpr (KIND == 16) {
            bf16_t* MIX = U;
            const int n_it = last ? 1024 : RET_ITEMS;
            for (int pi = bid; pi * 2 < n_it; pi += nblk) rt::ret_pair(smem, pi * 2, n_it, P, RKV, (const float2*)(ws + WS_TAB), p.in[I_RDF] + l * 4, p.in[I_RDB] + l * 4, MIX);
        }
        if constexpr (KIND == 7) {
            pg8::Gemm g{U, WT + WT_OUT + l * WT_OUT_L, DM, DM, DM}; pg8::StaticOrder S; S.init(rows_mix, DM, nblk, bid);
            pg8::EpiOut E{Hlat, Hctx, l == 0 ? p.in[I_X] : Hlat, l == 0 ? p.in[I_CTX] : Hctx, modl + 2048};
            pg8::gemm_phase<pg8::EpiOut, pg8::StaticOrder, true, true>(lds3, g, S, E);
        }
        if constexpr (KIND == 8) {
            const float* g = p.in[I_N2G] + l * DM; const float* rb = p.in[I_RB];
            float* rwl = (float*)smem;
            int* hist = (int*)(smem + 69632); float* wl = (float*)(smem + 69632 + 64) + wid * 64;
            for (int idx = tid; idx < 1024 * 4; idx += 512) { const int c = idx >> 2, q = idx & 3; const float4 v = *(const float4*)(p.in[I_RW] + (size_t)c * 16 + q * 4); *(float4*)(rwl + (c >> 2) * 68 + (c & 3) * 16 + q * 4) = v; }
            for (int ch = bid; ch < 256; ch += nblk) {
                __syncthreads();
                if (tid < 16) hist[tid] = 0;
                __syncthreads();
                const int ngrp = 4 + ((!last && wid == 0) ? 1 : 0);
                for (int gi = 0; gi < ngrp; ++gi) {
                    const int row0 = gi < 4 ? ch * 128 + wid * 16 + gi * 4 : NLAT + ch * 4;
                    const float* mv = modl + row_modv(row0) * 6144;
                    float4 u[4][4]; float rstd[4];
#pragma unroll
                    for (int t = 0; t < 4; ++t) { const float* h = hrow2(Hlat, Hctx, row0 + t); float ss = 0.f;
#pragma unroll
                        for (int k = 0; k < 4; ++k) { u[t][k] = *(const float4*)(h + lane * 4 + 256 * k); ss += u[t][k].x * u[t][k].x + u[t][k].y * u[t][k].y + u[t][k].z * u[t][k].z + u[t][k].w * u[t][k].w; }
                        rstd[t] = rsqrtf(wave_sum(ss) * (1.f / DM) + 1e-6f); }
#pragma unroll
                    for (int k = 0; k < 4; ++k) { const int c = lane * 4 + 256 * k;
                        const float4 gg = *(const float4*)(g + c), sh = *(const float4*)(mv + 3072 + c), sc = *(const float4*)(mv + 4096 + c);
                        const float4 a = make_float4(gg.x * (1.f + sc.x), gg.y * (1.f + sc.y), gg.z * (1.f + sc.z), gg.w * (1.f + sc.w));
#pragma unroll
                        for (int t = 0; t < 4; ++t) { u[t][k].x = u[t][k].x * rstd[t] * a.x + sh.x; u[t][k].y = u[t][k].y * rstd[t] * a.y + sh.y; u[t][k].z = u[t][k].z * rstd[t] * a.z + sh.z; u[t][k].w = u[t][k].w * rstd[t] * a.w + sh.w; } }
                    float lg[64];
#pragma unroll
                    for (int i = 0; i < 64; ++i) lg[i] = 0.f;
#pragma unroll
                    for (int k = 0; k < 4; ++k) {
                        const float* wb = rwl + (lane + 64 * k) * 68;
#pragma unroll
                        for (int r = 0; r < 4; ++r) {
                            const float4 w0 = *(const float4*)(wb + r * 16), w1 = *(const float4*)(wb + r * 16 + 4), w2 = *(const float4*)(wb + r * 16 + 8), w3 = *(const float4*)(wb + r * 16 + 12);
#pragma unroll
                            for (int t = 0; t < 4; ++t) { const float us = r == 0 ? u[t][k].x : (r == 1 ? u[t][k].y : (r == 2 ? u[t][k].z : u[t][k].w));
                                lg[t * 16 + 0] = fmaf(us, w0.x, lg[t * 16 + 0]); lg[t * 16 + 1] = fmaf(us, w0.y, lg[t * 16 + 1]); lg[t * 16 + 2] = fmaf(us, w0.z, lg[t * 16 + 2]); lg[t * 16 + 3] = fmaf(us, w0.w, lg[t * 16 + 3]);
                                lg[t * 16 + 4] = fmaf(us, w1.x, lg[t * 16 + 4]); lg[t * 16 + 5] = fmaf(us, w1.y, lg[t * 16 + 5]); lg[t * 16 + 6] = fmaf(us, w1.z, lg[t * 16 + 6]); lg[t * 16 + 7] = fmaf(us, w1.w, lg[t * 16 + 7]);
                                lg[t * 16 + 8] = fmaf(us, w2.x, lg[t * 16 + 8]); lg[t * 16 + 9] = fmaf(us, w2.y, lg[t * 16 + 9]); lg[t * 16 + 10] = fmaf(us, w2.z, lg[t * 16 + 10]); lg[t * 16 + 11] = fmaf(us, w2.w, lg[t * 16 + 11]);
                                lg[t * 16 + 12] = fmaf(us, w3.x, lg[t * 16 + 12]); lg[t * 16 + 13] = fmaf(us, w3.y, lg[t * 16 + 13]); lg[t * 16 + 14] = fmaf(us, w3.z, lg[t * 16 + 14]); lg[t * 16 + 15] = fmaf(us, w3.w, lg[t * 16 + 15]); }
                        }
                    }
                    wl[lane] = reduce64(lg, lane);
                    asm volatile("s_waitcnt lgkmcnt(0)" ::: "memory");
                    if (lane < 4) {
                        float scv[16], sel[16];
#pragma unroll
                        for (int e = 0; e < 16; ++e) { scv[e] = 1.f / (1.f + expf(-wl[lane * 16 + e])); sel[e] = scv[e] + rb[e]; }
                        int best = 0; float bestv = -INFINITY;
#pragma unroll
                        for (int gI = 0; gI < 4; ++gI) {
                            float m1 = -INFINITY, m2 = -INFINITY;
#pragma unroll
                            for (int k = 0; k < 4; ++k) { const float v = sel[gI * 4 + k]; if (v > m1) { m2 = m1; m1 = v; } else if (v > m2) m2 = v; }
                            const float gs = m1 + m2; if (gs > bestv) { bestv = gs; best = gI; }
                        }
                        int ia = -1, ib = -1; float va = -INFINITY, vb = -INFINITY, wa = 0.f, wb2 = 0.f;
#pragma unroll
                        for (int e = 0; e < 16; ++e) {
                            if ((e >> 2) == best) { const float v = sel[e]; if (v > va) { vb = va; ib = ia; wb2 = wa; va = v; ia = e; wa = scv[e]; } else if (v > vb) { vb = v; ib = e; wb2 = scv[e]; } }
                        }
                        const float inv = 1.f / (wa + wb2); const int row = row0 + lane;
                        RTE[row] = make_int2(ia, ib); RTW[row] = make_float2(wa * inv, wb2 * inv); RTR[row] = lane == 0 ? rstd[0] : (lane == 1 ? rstd[1] : (lane == 2 ? rstd[2] : rstd[3]));
                        atomicAdd(&hist[ia], 1); atomicAdd(&hist[ib], 1);
                    }
                }
                __syncthreads();
                if (tid < 16) CNT[ch * 16 + tid] = hist[tid];
            }
        }
        if constexpr (KIND == 9) {
            const float* g = p.in[I_N2G] + l * DM;
            int* cnts = (int*)smem;
            int* tots = cnts + 4096; int* befo = tots + 16; int* offs = befo + 16; int* sla = offs + 32; int* slb = sla + 136; int* ea = slb + 136; int* eb = ea + 136;
            const int ntok = last ? 128 : 132;
            for (int ch = bid; ch < 256; ch += nblk) {
                __syncthreads();
                for (int i = tid; i < 4096; i += 512) cnts[i] = CNT[i];
                if (tid < ntok) { const int row = tid < 128 ? ch * 128 + tid : NLAT + ch * 4 + (tid - 128); const int2 e2 = RTE[row]; ea[tid] = e2.x; eb[tid] = e2.y; }
                __syncthreads();
                if (tid < 16) { int tot = 0, bef = 0; for (int c2 = 0; c2 < 256; ++c2) { const int v = cnts[c2 * 16 + tid]; bef += c2 < ch ? v : 0; tot += v; } tots[tid] = tot; befo[tid] = bef; }
                __syncthreads();
                if (tid == 0) { int o = 0; for (int e = 0; e < 16; ++e) { offs[e] = o; o += (tots[e] + 255) & ~255; } offs[16] = o; }
                __syncthreads();
                if (tid < 16) { int pos = offs[tid] + befo[tid]; for (int i = 0; i < ntok; ++i) { if (ea[i] == tid) sla[i] = pos++; else if (eb[i] == tid) slb[i] = pos++; } }
                if (ch == 0 && tid == 128) { int rt = 0; for (int e = 0; e < 16; ++e) { const int nte = (tots[e] + 255) >> 8; for (int k = 0; k < nte; ++k) { TILE[16 + 2 * rt] = e; TILE[17 + 2 * rt] = (offs[e] >> 8) + k; ++rt; } } TILE[0] = rt; }
                __syncthreads();
                for (int i = wid; i < ntok; i += 8) {
                    const int row = i < 128 ? ch * 128 + i : NLAT + ch * 4 + (i - 128);
                    const float* h = hrow2(Hlat, Hctx, row); const float* mv = modl + row_modv(row) * 6144;
                    const float rstd = RTR[row]; const int sa = sla[i], sb = slb[i];
#pragma unroll
                    for (int k = 0; k < 4; ++k) {
                        const int c = lane * 4 + 256 * k;
                        const float4 x = *(const float4*)(h + c), gg = *(const float4*)(g + c), sh = *(const float4*)(mv + 3072 + c), sc = *(const float4*)(mv + 4096 + c);
                        const float u0 = x.x * rstd * gg.x * (1.f + sc.x) + sh.x, u1 = x.y * rstd * gg.y * (1.f + sc.y) + sh.y;
                        const float u2 = x.z * rstd * gg.z * (1.f + sc.z) + sh.z, u3 = x.w * rstd * gg.w * (1.f + sc.w) + sh.w;
                        uint2 o; o.x = (unsigned)f2bf(u0) | ((unsigned)f2bf(u1) << 16); o.y = (unsigned)f2bf(u2) | ((unsigned)f2bf(u3) << 16);
                        *(uint2*)(XS + (size_t)sa * DM + c) = o; *(uint2*)(XS + (size_t)sb * DM + c) = o;
                    }
                    if (lane == 0) RTS[row] = make_int2(sa, sb);
                }
            }
        }
        if constexpr (KIND == 10) {
            PG8_LAS int* ul = (PG8_LAS int*)(lds3 + 131072); const int nu = pg8::grouped_units(ul, TILE, 2, nblk, bid);
            pg8::Gemm g{XS, WT + WT_13 + l * WT_13_L, DM, DM, DM}; pg8::GroupedOrder S{ul, nu};
            pg8::EpiMoe1 E{HDN};
            pg8::gemm_phase<pg8::EpiMoe1, pg8::GroupedOrder, true, true>(lds3, g, S, E);
        }
        if constexpr (KIND == 11) {
            PG8_LAS int* ul = (PG8_LAS int*)(lds3 + 131072); const int nu = pg8::grouped_units(ul, TILE, 4, nblk, bid);
            pg8::Gemm g{HDN, WT + WT_2 + l * WT_2_L, FF, FF, FF}; pg8::GroupedOrder S{ul, nu};
            pg8::EpiMoe2 E{XS};
            pg8::gemm_phase<pg8::EpiMoe2, pg8::GroupedOrder, true, true>(lds3, g, S, E);
        }
    }
    if constexpr (KIND == 13) {
        const float* g = p.in[I_FNG]; const float* modp = MOD + (size_t)1 * 5 * 6144;
        for (int row = bid * 8 + wid; row < NLAT; row += nblk * 8) {
            float* h = p.out + (size_t)row * DM; const float* mg = modp + row_modv(row) * 6144 + 5120;
            const int2 s2 = RTS[row]; const float2 w2 = RTW[row];
            float4 x[4]; float ss = 0.f;
#pragma unroll
            for (int i = 0; i < 4; ++i) {
                const int c = lane * 4 + 256 * i;
                const uint2 ya = *(const uint2*)(XS + (size_t)s2.x * DM + c), yb = *(const uint2*)(XS + (size_t)s2.y * DM + c);
                float4 xx = *(const float4*)(h + c); const float4 gg = *(const float4*)(mg + c);
                xx.x += gg.x * (w2.x * __uint_as_float(ya.x << 16) + w2.y * __uint_as_float(yb.x << 16));
                xx.y += gg.y * (w2.x * __uint_as_float(ya.x & 0xffff0000u) + w2.y * __uint_as_float(yb.x & 0xffff0000u));
                xx.z += gg.z * (w2.x * __uint_as_float(ya.y << 16) + w2.y * __uint_as_float(yb.y << 16));
                xx.w += gg.w * (w2.x * __uint_as_float(ya.y & 0xffff0000u) + w2.y * __uint_as_float(yb.y & 0xffff0000u));
                x[i] = xx; ss += xx.x * xx.x + xx.y * xx.y + xx.z * xx.z + xx.w * xx.w;
            }
            ss = wave_sum(ss);
            const float rstd = rsqrtf(ss * (1.f / DM) + 1e-6f);
#pragma unroll
            for (int i = 0; i < 4; ++i) { const int c = lane * 4 + 256 * i; const float4 gg = *(const float4*)(g + c); float4 y; y.x = x[i].x * rstd * gg.x; y.y = x[i].y * rstd * gg.y; y.z = x[i].z * rstd * gg.z; y.w = x[i].w * rstd * gg.w; *(float4*)(h + c) = y; }
        }
    }
}

constexpr int LDS_BYTES = 144 * 1024;
template <int KIND> __global__ void __launch_bounds__(512, 2) k_ph(Params p, int l) {
    extern __shared__ __attribute__((aligned(16))) char smem[];
    phase<KIND>(p, l, smem);
}
__device__ __forceinline__ void grid_sync(unsigned char* wsp, char* smem) {
    unsigned* bw = (unsigned*)(wsp + WS_CTL); asm volatile("" : "+s"(bw));
    XcdBarrier b; b.bar = bw; b.x = xb_xcc_id(); b.st = (volatile LAS unsigned*)(smem + LDS_BYTES - 16);
    xcd_barrier(b);
}
__global__ void __launch_bounds__(512, 2) k_one(Params p) {
    extern __shared__ __attribute__((aligned(16))) char smem[];
    {
        volatile LAS unsigned* st = (volatile LAS unsigned*)(smem + LDS_BYTES - 16);
        if (threadIdx.x == 0) { st[0] = 0u; st[1] = 0u; st[2] = 0u; st[3] = 0u; }
        __syncthreads();
        (void)xcd_barrier_post((unsigned*)(p.ws + WS_CTL), st);
    }
#define SYNC() grid_sync(p.ws, smem)
    phase<0>(p, 0, smem); SYNC();
    if (PROBE_SET == 1) { phase<0>(p, 0, smem); SYNC(); }
#define DUP(k, stmt) do { stmt; if (PROBE_SET == (k)) { SYNC(); stmt; } } while (0)
#define LAYER(l) \
        phase<1>(p, l, smem); SYNC(); \
        DUP(2, phase<2>(p, l, smem)); SYNC(); \
        DUP(8, phase<4>(p, l, smem); phase<14>(p, l, smem)); SYNC(); \
        phase<5>(p, l, smem); SYNC(); \
        DUP(3, phase<6>(p, l, smem)); DUP(4, phase<15>(p, l, smem)); DUP(5, phase<16>(p, l, smem)); SYNC(); \
        phase<7>(p, l, smem); SYNC(); \
        DUP(7, phase<8>(p, l, smem)); SYNC(); \
        DUP(9, phase<9>(p, l, smem)); SYNC(); \
        DUP(6, phase<10>(p, l, smem)); SYNC(); \
        DUP(6, phase<11>(p, l, smem)); SYNC();
    LAYER(0)
    LAYER(1)
#undef LAYER
    phase<13>(p, 0, smem);
#undef SYNC
}
template <int KIND> static void launch_ph(const Params& p, int l, int grid, hipStream_t stream) {
    static bool attr_done = false;
    if (!attr_done) { (void)hipFuncSetAttribute((const void*)k_ph<KIND>, hipFuncAttributeMaxDynamicSharedMemorySize, LDS_BYTES); attr_done = true; }
    hipLaunchKernelGGL(k_ph<KIND>, dim3(grid), dim3(512), LDS_BYTES, stream, p, l);
}

extern "C" void kernel_launch(void* const* d_in, const int* in_sizes, int n_in, void* d_out, int out_size, void* d_ws, size_t ws_size, hipStream_t stream) {
    (void)in_sizes; (void)n_in; (void)out_size; (void)ws_size;
    static int grid = 0;
    if (!grid) {
        int dev = 0, cus = 0; (void)hipGetDevice(&dev); (void)hipDeviceGetAttribute(&cus, hipDeviceAttributeMultiprocessorCount, dev);
        grid = cus > 0 ? cus : 256;
        (void)hipFuncSetAttribute((const void*)k_one, hipFuncAttributeMaxDynamicSharedMemorySize, LDS_BYTES);
    }
    Params p{};
    for (int i = 0; i < 23; ++i) p.in[i] = (const float*)d_in[i];
    p.out = (float*)d_out; p.ws = (unsigned char*)d_ws;
#ifdef MULTI_LAUNCH
    launch_ph<0>(p, 0, grid, stream);
    for (int l = 0; l < 2; ++l) {
        launch_ph<1>(p, l, grid, stream); launch_ph<2>(p, l, grid, stream); launch_ph<4>(p, l, grid, stream); launch_ph<14>(p, l, grid, stream);
        launch_ph<5>(p, l, grid, stream); launch_ph<6>(p, l, grid, stream); launch_ph<15>(p, l, grid, stream); launch_ph<16>(p, l, grid, stream); launch_ph<7>(p, l, grid, stream); launch_ph<8>(p, l, grid, stream);
        launch_ph<9>(p, l, grid, stream); launch_ph<10>(p, l, grid, stream); launch_ph<11>(p, l, grid, stream);
    }
    launch_ph<13>(p, 0, grid, stream);
#else
    (void)hipMemsetAsync((char*)d_ws + WS_CTL, 0, XCD_BAR_WORDS * sizeof(unsigned), stream);
    hipLaunchKernelGGL(k_one, dim3(grid), dim3(512), LDS_BYTES, stream, p);
#endif
}
```

```cpp
#include <hip/hip_runtime.h>
#include <stdint.h>
#include <math.h>

typedef unsigned short bf16_t;
#define LAS __attribute__((address_space(3)))

constexpr int DM = 1024, NB = 4, SEQ = 8192, GW = 64, CTXL = 256;
constexpr int NLAT = NB * SEQ;
constexpr int NCTX = NB * CTXL;
constexpr int NROW = NLAT + NCTX;
constexpr int DPROJ = 3232, LDP = 3328;
constexpr int PC_RQ = 0, PC_RK = 256, PC_RV = 512, PC_RG = 768, PC_NQ = 1024, PC_NK = 1536, PC_NV = 2048, PC_CQ = 2560, PC_CKV = 2944, PC_KPE = 3200;
constexpr int NE = 16, FF = 256;
constexpr int MAXSLOT = 2 * NROW + NE * 256;
constexpr int NCHUNK_TOK = 128;
constexpr int RET_ITEMS = 16 * 64 + 16 * 2;

constexpr size_t MiB = 1u << 20;
constexpr size_t WS_CTL = 0;
constexpr size_t WS_MOD = 1 * MiB;
constexpr size_t WS_HC = 2 * MiB;
constexpr size_t WS_RT = 6 * MiB;
constexpr size_t WS_U = 8 * MiB;
constexpr size_t WS_QM = 74 * MiB;
constexpr size_t WS_KM = 99 * MiB;
constexpr size_t WS_VM = 124 * MiB;
constexpr size_t WS_RKV = 141 * MiB;
constexpr size_t WS_P = 174 * MiB;
constexpr size_t WS_XS = WS_P;
constexpr size_t WS_HDN = WS_P + 140 * MiB;
constexpr size_t WS_WT = 389 * MiB;
constexpr size_t WT_IN = 0, WT_IN_L = (size_t)3328 * 1024;
constexpr size_t WT_UQ = WT_IN + 2 * WT_IN_L, WT_UQ_L = (size_t)512 * 384;
constexpr size_t WT_UKV = WT_UQ + 2 * WT_UQ_L, WT_UKV_L = (size_t)512 * 256;
constexpr size_t WT_OUT = WT_UKV + 2 * WT_UKV_L, WT_OUT_L = (size_t)1024 * 1024;
constexpr size_t WT_13 = WT_OUT + 2 * WT_OUT_L, WT_13_L = (size_t)16 * 512 * 1024;
constexpr size_t WT_2 = WT_13 + 2 * WT_13_L, WT_2_L = (size_t)16 * 1024 * 256;
constexpr size_t WT_END = WT_2 + 2 * WT_2_L;
static_assert(WS_WT + WT_END * 2 <= 512 * MiB, "workspace");
constexpr size_t WS_VT = 456 * MiB;
constexpr size_t WS_NVT = 473 * MiB;
static_assert(WS_NVT + (size_t)32 * 132 * 4096 * 2 <= 512 * MiB, "workspace");
constexpr size_t WS_PS = 506 * MiB;
constexpr size_t WS_TAB = 510 * MiB;
constexpr size_t WS_TOK = 1536 * 1024;
constexpr size_t RT_TILE = 1984 * 1024;
constexpr size_t RT_E = 0, RT_W = 512 * 1024, RT_RSTD = 1024 * 1024, RT_SLOT = 1280 * 1024, RT_CNT = 1792 * 1024, RT_SEG = 1920 * 1024;

struct Params { const float* in[23]; float* out; unsigned char* ws; int lo, hi; };
enum { I_X = 0, I_C, I_CTX, I_CCTX, I_WMOD, I_BMOD, I_N1G, I_N2G, I_WIN, I_RDF, I_RDB, I_RPB, I_QN, I_KVN, I_WUQ, I_WUKV, I_WOUT, I_RW, I_RB, I_W1, I_W3, I_W2, I_FNG };

__device__ __forceinline__ float bf2f(bf16_t v) { return __uint_as_float(((unsigned)v) << 16); }
__device__ __forceinline__ bf16_t f2bf(float f) { unsigned u = __float_as_uint(f); return (bf16_t)((u + 0x7fffu + ((u >> 16) & 1u)) >> 16); }
template <int CTRL> __device__ __forceinline__ float dpp_f(float v) { return __uint_as_float((unsigned)__builtin_amdgcn_mov_dpp((int)__float_as_uint(v), CTRL, 0xF, 0xF, true)); }
__device__ __forceinline__ float xor1_f(float v) { return dpp_f<0xB1>(v); }
__device__ __forceinline__ float xor2_f(float v) { return dpp_f<0x4E>(v); }
__device__ __forceinline__ float wave_sum(float v) {
    v += dpp_f<0xB1>(v); v += dpp_f<0x4E>(v); v += dpp_f<0x141>(v); v += dpp_f<0x140>(v);
    { auto r = __builtin_amdgcn_permlane16_swap(__float_as_uint(v), __float_as_uint(v), false, false); v = __uint_as_float(r[0]) + __uint_as_float(r[1]); }
    { auto r = __builtin_amdgcn_permlane32_swap(__float_as_uint(v), __float_as_uint(v), false, false); v = __uint_as_float(r[0]) + __uint_as_float(r[1]); }
    return v;
}
__device__ __forceinline__ float wave_max(float v) {
    v = fmaxf(v, dpp_f<0xB1>(v)); v = fmaxf(v, dpp_f<0x4E>(v)); v = fmaxf(v, dpp_f<0x141>(v)); v = fmaxf(v, dpp_f<0x140>(v));
    { auto r = __builtin_amdgcn_permlane16_swap(__float_as_uint(v), __float_as_uint(v), false, false); v = fmaxf(__uint_as_float(r[0]), __uint_as_float(r[1])); }
    { auto r = __builtin_amdgcn_permlane32_swap(__float_as_uint(v), __float_as_uint(v), false, false); v = fmaxf(__uint_as_float(r[0]), __uint_as_float(r[1])); }
    return v;
}
__device__ __forceinline__ int tid_() { int t = threadIdx.x; asm volatile("" : "+v"(t)); return t; }
__device__ __forceinline__ int bid_() { int b = blockIdx.x; asm volatile("" : "+s"(b)); return b; }
__device__ __forceinline__ float silu_f(float x) { return x / (1.f + expf(-x)); }
__device__ __forceinline__ int row_modv(int row) { return row < NLAT ? (row >> 13) : 4; }
__device__ __forceinline__ float* hrow2(float* hl, float* hc, int row) { return row < NLAT ? hl + (size_t)row * DM : hc + (size_t)(row - NLAT) * DM; }

#define XB_TMO      128
#define XB_XCNT(j)  (256  + 64 * (j))
#define XB_XSUB(j)  (1280 + 64 * (j))
#define XB_XGEN(j)  (2304 + 64 * (j))
#define XB_TOP      3328
#define XB_TOPGEN   3392
#define XCD_BAR_WORDS 3456
#define XB_SPIN_CAP (1u << 18)
__device__ __forceinline__ unsigned xb_ld(unsigned* p)              { return __hip_atomic_load(p, __ATOMIC_RELAXED, __HIP_MEMORY_SCOPE_AGENT); }
__device__ __forceinline__ unsigned xb_add(unsigned* p, unsigned v) { return __hip_atomic_fetch_add(p, v, __ATOMIC_RELAXED, __HIP_MEMORY_SCOPE_AGENT); }
__device__ __forceinline__ unsigned xb_xcc_id() { return (unsigned)__builtin_amdgcn_s_getreg((3 << 11) | 20) & 0xFu; }
#define XB_SPIN(cond, bar) do { unsigned _sp = 0; while (cond) { __builtin_amdgcn_s_sleep(1); \
    if ((++_sp & 255u) == 0u) { if (xb_ld(&(bar)[XB_TMO])) break; if (_sp > XB_SPIN_CAP) { atomicAdd(&(bar)[XB_TMO], 1u); break; } } } } while (0)
struct XcdBarrier { unsigned* bar; unsigned x; volatile LAS unsigned* st; };
__device__ __forceinline__ XcdBarrier xcd_barrier_post(unsigned* bar, volatile LAS unsigned* st) {
    XcdBarrier b; b.bar = bar; b.x = xb_xcc_id(); b.st = st;
    if (threadIdx.x == 0) (void)xb_add(&bar[XB_XCNT(b.x)], 1u);
    return b;
}
__device__ __forceinline__ void xcd_barrier_complete(unsigned* bar, unsigned x, unsigned& nloc, unsigned& nx) {
    const unsigned G = gridDim.x * gridDim.y * gridDim.z;
    unsigned sum, cnt, mine, sp = 0u;
    for (;;) {
        sum = 0u; cnt = 0u; mine = 0u;
#pragma unroll
        for (unsigned j = 0; j < 16; ++j) { const unsigned c = xb_ld(&bar[XB_XCNT(j)]); sum += c; cnt += (c > 0u) ? 1u : 0u; mine = (j == x) ? c : mine; }
        if (sum == G) break;
        __builtin_amdgcn_s_sleep(1);
        if ((++sp & 255u) == 0u) { if (xb_ld(&bar[XB_TMO])) break; if (sp > XB_SPIN_CAP) { atomicAdd(&bar[XB_TMO], 1u); break; } }
    }
    nloc = mine > 0u ? mine : 1u; nx = cnt > 0u ? cnt : 1u;
}
__device__ __forceinline__ void xcd_barrier(const XcdBarrier& b) {
    asm volatile("s_waitcnt vmcnt(0)" ::: "memory");
    __syncthreads();
    if (threadIdx.x == 0) {
        unsigned* bar = b.bar;
        __builtin_amdgcn_s_waitcnt(0);
        unsigned nloc = b.st[0], nx = b.st[1];
        if (nloc == 0u) { xcd_barrier_complete(bar, b.x, nloc, nx); b.st[0] = nloc; b.st[1] = nx; }
        const unsigned old = xb_add(&bar[XB_XSUB(b.x)], 1u);
        const unsigned gen = old / nloc;
        if (old + 1u == (gen + 1u) * nloc) {
            __builtin_amdgcn_fence(__ATOMIC_RELEASE, "agent");
            asm volatile("s_waitcnt vmcnt(0)" ::: "memory");
            const unsigned og = xb_add(&bar[XB_TOP], 1u);
            const unsigned tg = og / nx;
            if (og + 1u == (tg + 1u) * nx) xb_add(&bar[XB_TOPGEN], 1u);
            else XB_SPIN(xb_ld(&bar[XB_TOPGEN]) == tg, bar);
            __builtin_amdgcn_fence(__ATOMIC_ACQUIRE, "agent");
            xb_add(&bar[XB_XGEN(b.x)], 1u);
            asm volatile("s_waitcnt vmcnt(0)" ::: "memory");
        } else {
            XB_SPIN(xb_ld(&bar[XB_XGEN(b.x)]) == gen, bar);
            __builtin_amdgcn_fence(__ATOMIC_ACQUIRE, "agent");
            asm volatile("s_waitcnt vmcnt(0)" ::: "memory");
        }
    }
    __syncthreads();
}

struct SegInfo { const int* seg; size_t wstride; };
template <bool DUAL, class Epi>
__device__ __forceinline__ void gemm_simple(char* smem, const bf16_t* A, int lda, int M, const float* W, const float* W2, int ldw, int N, int K, SegInfo sg, const Epi& epi) {
    float* As = (float*)smem;
    float* Ws = As + 16 * 132;
    float* Ws2 = Ws + 16 * 68;
    const int t = tid_(), ty = t >> 4, tx = t & 15;
    const int ntm = (M + 127) / 128, ntn = (N + 63) / 64;
    for (int tile = blockIdx.x; tile < ntm * ntn; tile += gridDim.x) {
        const int tm = tile / ntn, tn = tile % ntn, m0 = tm * 128, n0 = tn * 64;
        const float* Wt = W; const float* Wt2 = W2; int mvalid = M;
        if (sg.seg) {
            int e = 0;
#pragma unroll
            for (int i = 1; i < 16; ++i) if (m0 >= sg.seg[i]) e = i;
            mvalid = sg.seg[e] + sg.seg[17 + e];
            if (m0 >= sg.seg[16] || m0 >= mvalid) continue;
            Wt = W + (size_t)e * sg.wstride; if (DUAL) Wt2 = W2 + (size_t)e * sg.wstride;
        }
        float acc[4][4], acc2[4][4];
#pragma unroll
        for (int i = 0; i < 4; ++i)
#pragma unroll
            for (int j = 0; j < 4; ++j) { acc[i][j] = 0.f; acc2[i][j] = 0.f; }
        for (int k0 = 0; k0 < K; k0 += 16) {
            {
                const int r = t >> 2, kq = (t & 3) * 4, row = m0 + r;
                uint2 v = make_uint2(0u, 0u);
                if (row < M) v = *(const uint2*)(A + (size_t)row * lda + k0 + kq);
                As[(kq + 0) * 132 + r] = __uint_as_float(v.x << 16);
                As[(kq + 1) * 132 + r] = __uint_as_float(v.x & 0xffff0000u);
                As[(kq + 2) * 132 + r] = __uint_as_float(v.y << 16);
                As[(kq + 3) * 132 + r] = __uint_as_float(v.y & 0xffff0000u);
            }
            {
                const int k = t >> 5, n = (t & 31) * 2, col = n0 + n;
                float2 w = make_float2(0.f, 0.f), w2 = make_float2(0.f, 0.f);
                if (col < N) { w = *(const float2*)(Wt + (size_t)(k0 + k) * ldw + col); if (DUAL) w2 = *(const float2*)(Wt2 + (size_t)(k0 + k) * ldw + col); }
                Ws[k * 68 + n] = w.x; Ws[k * 68 + n + 1] = w.y;
                if (DUAL) { Ws2[k * 68 + n] = w2.x; Ws2[k * 68 + n + 1] = w2.y; }
            }
            __syncthreads();
#pragma unroll
            for (int kk = 0; kk < 16; ++kk) {
                const float4 a = *(const float4*)&As[kk * 132 + ty * 4];
                const float4 w = *(const float4*)&Ws[kk * 68 + tx * 4];
                const float av[4] = {a.x, a.y, a.z, a.w}, wv[4] = {w.x, w.y, w.z, w.w};
#pragma unroll
                for (int i = 0; i < 4; ++i)
#pragma unroll
                    for (int j = 0; j < 4; ++j) acc[i][j] = fmaf(av[i], wv[j], acc[i][j]);
                if (DUAL) {
                    const float4 w2 = *(const float4*)&Ws2[kk * 68 + tx * 4];
                    const float wv2[4] = {w2.x, w2.y, w2.z, w2.w};
#pragma unroll
                    for (int i = 0; i < 4; ++i)
#pragma unroll
                        for (int j = 0; j < 4; ++j) acc2[i][j] = fmaf(av[i], wv2[j], acc2[i][j]);
                }
            }
            __syncthreads();
        }
#pragma unroll
        for (int i = 0; i < 4; ++i) {
            const int row = m0 + ty * 4 + i;
            if (row < M && row < mvalid) {
#pragma unroll
                for (int j = 0; j < 4; ++j) { const int col = n0 + tx * 4 + j; if (col < N) epi(row, col, acc[i][j], acc2[i][j]); }
            }
        }
    }
}

template <int DQK, int DV>
__device__ __forceinline__ void attn_simple(char* smem, const bf16_t* Q, int ldq, int nq, const bf16_t* K0, const bf16_t* V0, int n0, const bf16_t* K1, const bf16_t* V1, int n1,
                                            int ldk, int ldv, float qscale_log2, bf16_t* O, int ldo) {
    float* Ks = (float*)smem;
    float* Vs = Ks + 32 * DQK;
    const int t = tid_();
    const bool act = t < nq;
    float q[DQK];
#pragma unroll
    for (int c = 0; c < DQK; ++c) q[c] = act ? bf2f(Q[(size_t)t * ldq + c]) * qscale_log2 : 0.f;
    float o[DV];
#pragma unroll
    for (int e = 0; e < DV; ++e) o[e] = 0.f;
    float mrun = -INFINITY, lrun = 0.f;
    const int ntile = (n0 + n1) / 32;
    for (int tl = 0; tl < ntile; ++tl) {
        const int j0 = tl * 32;
        const bf16_t* Kp; const bf16_t* Vp;
        if (j0 < n0) { Kp = K0 + (size_t)j0 * ldk; Vp = V0 + (size_t)j0 * ldv; } else { Kp = K1 + (size_t)(j0 - n0) * ldk; Vp = V1 + (size_t)(j0 - n0) * ldv; }
        __syncthreads();
        for (int idx = t; idx < 32 * DQK; idx += 512) { const int r = idx / DQK, c = idx % DQK; Ks[idx] = bf2f(Kp[(size_t)r * ldk + c]); }
        for (int idx = t; idx < 32 * DV; idx += 512) { const int r = idx / DV, c = idx % DV; Vs[idx] = bf2f(Vp[(size_t)r * ldv + c]); }
        __syncthreads();
#pragma unroll 1
        for (int r = 0; r < 32; ++r) {
            float a = 0.f;
#pragma unroll
            for (int c = 0; c < DQK; c += 4) { const float4 kv = *(const float4*)&Ks[r * DQK + c]; a = fmaf(q[c], kv.x, a); a = fmaf(q[c + 1], kv.y, a); a = fmaf(q[c + 2], kv.z, a); a = fmaf(q[c + 3], kv.w, a); }
            if (a > mrun) {
                const float alpha = exp2f(mrun - a);
                mrun = a; lrun *= alpha;
#pragma unroll
                for (int e = 0; e < DV; ++e) o[e] *= alpha;
            }
            const float pr = exp2f(a - mrun);
            lrun += pr;
#pragma unroll
            for (int e = 0; e < DV; e += 4) { const float4 vv = *(const float4*)&Vs[r * DV + e]; o[e] = fmaf(pr, vv.x, o[e]); o[e + 1] = fmaf(pr, vv.y, o[e + 1]); o[e + 2] = fmaf(pr, vv.z, o[e + 2]); o[e + 3] = fmaf(pr, vv.w, o[e + 3]); }
        }
    }
    if (act) {
        const float inv = 1.f / lrun;
#pragma unroll
        for (int e = 0; e < DV; ++e) O[(size_t)t * ldo + e] = f2bf(o[e] * inv);
    }
    __syncthreads();
}

__device__ __forceinline__ void rope_pair(float& x1, float& x2, float pos, int i, int half) {
    const float inv = powf(10000.0f, -(float)i / (float)half);
    float sn, cs; sincosf(pos * inv, &sn, &cs);
    const float a = x1 * cs - x2 * sn, b = x2 * cs + x1 * sn; x1 = a; x2 = b;
}
__device__ __forceinline__ float log_sigmoid_f(float x) { return -log1pf(expf(-x)); }

namespace pg8 {
#define PG8_LAS __attribute__((address_space(3)))
typedef unsigned short bf16_t;
typedef short bf16x8 __attribute__((ext_vector_type(8)));
typedef float f32x4 __attribute__((ext_vector_type(4)));
typedef unsigned u32x4 __attribute__((ext_vector_type(4)));
constexpr int BM = 256, BK = 64, HALF = 128, HTB = HALF * BK * 2  , STAGE_BYTES = 8 * HTB, NXCD = 8, WGM = 8;

__host__ __device__ __forceinline__ int lds_byte(int r, int c) { const int st = (r >> 4) * 2 + (c >> 5), rr = r & 15, cc = c & 31, ob = rr * 64 + cc * 2; return st * 1024 + (ob ^ (((ob >> 9) & 1) << 5)); }
__host__ __device__ __forceinline__ void stage_rc(int b, int& R, int& C) { const int st = b / 1024, sb = b % 1024, swz = sb ^ (((sb >> 9) & 1) << 5); R = (st >> 1) * 16 + swz / 64; C = (st & 1) * 32 + (swz % 64) / 2; }
__host__ __device__ __forceinline__ int perm32(int rho) { const int n = rho >> 4, i = rho & 15; return 8 * (i >> 2) + 4 * n + (i & 3); }

struct Unit { int pm, pn; };
struct Gemm { const bf16_t* A; const bf16_t* Bt; int lda, ldb, K; const int* tok; };

typedef float f32x2c __attribute__((ext_vector_type(2))); typedef __bf16 bf16x2c __attribute__((ext_vector_type(2)));
__device__ __forceinline__ unsigned cvt_pk_bf16(float lo, float hi) { const f32x2c v = {lo, hi}; const bf16x2c b = __builtin_convertvector(v, bf16x2c); return __builtin_bit_cast(unsigned, b); }
template <class Epi, class Sched, bool ALIGN_EPI = false, bool SP2 = false, bool GATHER = false>
__device__ __forceinline__ void gemm_phase(PG8_LAS unsigned char* lds, const Gemm g, const Sched& S, const Epi& E) {
    const int tid = tid_(), wid = __builtin_amdgcn_readfirstlane(tid >> 6), lane = tid & 63, wr = wid >> 2, wc = wid & 3, fr = lane & 15, fq = lane >> 4;
    int K = g.K; asm volatile("" : "+s"(K));
    const int nt = K / BK;
    unsigned voffA[2], voffB[2];
#pragma unroll
    for (int i = 0; i < 2; ++i) { int R, C; stage_rc(tid * 16 + i * 8192, R, C); const int Rb = Epi::PERM ? ((R & ~31) + perm32(R & 31)) : R;
        voffA[i] = (unsigned)(R * g.lda + C) * 2u; voffB[i] = (unsigned)(Rb * g.ldb + C) * 2u; }
    const size_t kstep = (size_t)(BK * 2);
    static_assert(!GATHER || SP2, "the gather variant is written for the two-super-phase loop");
    const size_t hstepA = GATHER ? 0 : (size_t)HALF * g.lda * 2, hstepB = (size_t)HALF * g.ldb * 2;
    const size_t tstepA = 2 * hstepA  , tstepB = 2 * hstepB;
    const unsigned ldsw = (unsigned)wid * 1024u;
    const int aoff = lds_byte(wr * 64 + fr, fq * 8), boff = lds_byte(wc * 32 + fr, fq * 8);
#define PG8_SA(b, h) (((b) * 2 + (h)) * HTB)
#define PG8_SB(b, h) ((4 + (b) * 2 + (h)) * HTB)
#define PG8_STAGE(bufoff, gbase, voff) do { _Pragma("unroll") for (int _i = 0; _i < 2; ++_i) \
        __builtin_amdgcn_global_load_lds((const unsigned*)((const char*)(gbase) + (voff)[_i]), (PG8_LAS unsigned*)(lds + (bufoff) + ldsw + _i * 8192), 16, 0, 0); } while (0)
    unsigned vA[2][2], vN[2][2];
#define PG8_GOFF(V, pm_) do { _Pragma("unroll") for (int h_ = 0; h_ < 2; ++h_) _Pragma("unroll") for (int i_ = 0; i_ < 2; ++i_) { int R_, C_; stage_rc(tid * 16 + i_ * 8192, R_, C_); \
        V[h_][i_] = (unsigned)(g.tok[(pm_) * BM + h_ * HALF + R_] * g.lda + C_) * 2u; } } while (0)
#define PG8_STAGE_A(bufoff, gbase, h, nx) do { if constexpr (GATHER) { const unsigned vv_[2] = {(nx) ? vN[h][0] : vA[h][0], (nx) ? vN[h][1] : vA[h][1]}; PG8_STAGE(bufoff, gbase, vv_); } else { PG8_STAGE(bufoff, gbase, voffA); } } while (0)
#define PG8_LDA(dst, b, h) do { _Pragma("unroll") for (int m = 0; m < 4; ++m) _Pragma("unroll") for (int k = 0; k < 2; ++k) dst[m][k] = *(const PG8_LAS bf16x8*)(lds + PG8_SA(b, h) + aoff + m * 2048 + k * 1024); } while (0)
#define PG8_LDB(dst, b, h) do { _Pragma("unroll") for (int n = 0; n < 2; ++n) _Pragma("unroll") for (int k = 0; k < 2; ++k) dst[n][k] = *(const PG8_LAS bf16x8*)(lds + PG8_SB(b, h) + boff + n * 2048 + k * 1024); } while (0)
#define PG8_MMA(ai, bj, At, Bt) do { __builtin_amdgcn_s_setprio(1); _Pragma("unroll") for (int m = 0; m < 4; ++m) _Pragma("unroll") for (int n = 0; n < 2; ++n) _Pragma("unroll") for (int k = 0; k < 2; ++k) \
        acc[ai][bj][m][n] = __builtin_amdgcn_mfma_f32_16x16x32_bf16(Bt[n][k], At[m][k], acc[ai][bj][m][n], 0, 0, 0); __builtin_amdgcn_s_setprio(0); } while (0)
#define PG8_WAIT_V(n) asm volatile("s_waitcnt vmcnt(" #n ")" ::: "memory")
#define PG8_WAIT_L(n) asm volatile("s_waitcnt lgkmcnt(" #n ")" ::: "memory")
#define PG8_BAR __builtin_amdgcn_s_barrier()
#define PG8_SCHED __builtin_amdgcn_sched_barrier(0)
    Unit cur, nxt; int ui = 0;
    if (!S.next(0, cur)) return;
    f32x4 acc[2][2][4][2];
#pragma unroll
    for (int a = 0; a < 2; ++a)
#pragma unroll
        for (int b = 0; b < 2; ++b)
#pragma unroll
            for (int m = 0; m < 4; ++m)
#pragma unroll
                for (int n = 0; n < 2; ++n) acc[a][b][m][n] = (f32x4){0.f, 0.f, 0.f, 0.f};
    bf16x8 At[4][2], B0[2][2], B1[2][2];
    const char* cA = (const char*)g.A + (size_t)cur.pm * tstepA; const char* cB = (const char*)g.Bt + (size_t)cur.pn * tstepB;
    if constexpr (GATHER) { PG8_GOFF(vA, cur.pm); }
    S.a_ready(cur);
    if constexpr (SP2) {
        PG8_STAGE(PG8_SB(0, 0), cB, voffB); PG8_STAGE(PG8_SB(0, 1), cB + hstepB, voffB); PG8_STAGE_A(PG8_SA(0, 0), cA, 0, false); PG8_STAGE_A(PG8_SA(0, 1), cA + hstepA, 1, false);
        if (wr == 1) PG8_BAR;
        PG8_WAIT_V(2); PG8_BAR;
        PG8_STAGE(PG8_SB(1, 0), cB + kstep, voffB); PG8_STAGE_A(PG8_SA(1, 0), cA + kstep, 0, false); PG8_STAGE(PG8_SB(1, 1), cB + hstepB + kstep, voffB);
        PG8_WAIT_V(6); PG8_BAR;
    } else {
        PG8_STAGE(PG8_SB(0, 0), cB, voffB); PG8_STAGE(PG8_SA(0, 0), cA, voffA); PG8_STAGE(PG8_SB(0, 1), cB + hstepB, voffB); PG8_STAGE(PG8_SA(0, 1), cA + hstepA, voffA);
        if (wr == 1) PG8_BAR;
        PG8_WAIT_V(4); PG8_BAR;
        PG8_STAGE(PG8_SB(1, 0), cB + kstep, voffB); PG8_STAGE(PG8_SA(1, 0), cA + kstep, voffA); PG8_STAGE(PG8_SB(1, 1), cB + hstepB + kstep, voffB);
        PG8_WAIT_V(6); PG8_BAR;
    }
    for (;;) {
        const bool has_next = S.next(ui + 1, nxt);
        if constexpr (GATHER) { if (has_next) { PG8_GOFF(vN, nxt.pm); } else { _Pragma("unroll") for (int h_ = 0; h_ < 2; ++h_) { vN[h_][0] = vA[h_][0]; vN[h_][1] = vA[h_][1]; } } }
        const char* nA = has_next ? (const char*)g.A + (size_t)nxt.pm * tstepA : cA; const char* nB = has_next ? (const char*)g.Bt + (size_t)nxt.pn * tstepB : cB;
        for (int t = 0; t < nt; t += 2) {
            const bool last = (t == nt - 2);
            const char* a1 = cA + (size_t)(t + 1) * kstep;
            const char* a2 = last ? nA : cA + (size_t)(t + 2) * kstep; const char* b2 = last ? nB : cB + (size_t)(t + 2) * kstep;
            const char* a3 = a2 + kstep; const char* b3 = b2 + kstep;
            if (last && has_next) S.a_ready(nxt);
            if constexpr (SP2) {
            PG8_LDB(B0, 0, 0); PG8_LDB(B1, 0, 1); PG8_SCHED; PG8_LDA(At, 0, 0); PG8_STAGE_A(PG8_SA(1, 1), a1 + hstepA, 1, false);
            PG8_WAIT_V(8); PG8_WAIT_L(0); PG8_BAR; PG8_MMA(0, 0, At, B0); PG8_MMA(0, 1, At, B1); PG8_BAR; PG8_SCHED;
            PG8_LDA(At, 0, 1); PG8_STAGE(PG8_SB(0, 0), b2, voffB); PG8_STAGE(PG8_SB(0, 1), b2 + hstepB, voffB); PG8_STAGE_A(PG8_SA(0, 0), a2, 0, last);
            PG8_WAIT_V(8); PG8_WAIT_L(0); PG8_BAR; PG8_MMA(1, 0, At, B0); PG8_MMA(1, 1, At, B1); PG8_BAR; PG8_SCHED;
            PG8_LDB(B0, 1, 0); PG8_LDB(B1, 1, 1); PG8_SCHED; PG8_LDA(At, 1, 0); PG8_STAGE_A(PG8_SA(0, 1), a2 + hstepA, 1, last);
            PG8_WAIT_V(8); PG8_WAIT_L(0); PG8_BAR; PG8_MMA(0, 0, At, B0); PG8_MMA(0, 1, At, B1); PG8_BAR; PG8_SCHED;
            PG8_LDA(At, 1, 1); PG8_STAGE(PG8_SB(1, 0), b3, voffB); PG8_STAGE(PG8_SB(1, 1), b3 + hstepB, voffB); PG8_STAGE_A(PG8_SA(1, 0), a3, 0, last);
            PG8_WAIT_V(8); PG8_WAIT_L(0); PG8_BAR; PG8_MMA(1, 0, At, B0); PG8_MMA(1, 1, At, B1); PG8_BAR; PG8_SCHED;
            } else {
            PG8_LDB(B0, 0, 0); PG8_SCHED; PG8_LDA(At, 0, 0); PG8_STAGE(PG8_SA(1, 1), a1 + hstepA, voffA);
            PG8_WAIT_L(8); PG8_BAR; PG8_WAIT_L(0); PG8_MMA(0, 0, At, B0); PG8_BAR; PG8_SCHED;
            PG8_LDB(B1, 0, 1); PG8_STAGE(PG8_SB(0, 0), b2, voffB);
            PG8_BAR; PG8_WAIT_L(0); PG8_MMA(0, 1, At, B1); PG8_BAR;
            PG8_LDA(At, 0, 1); PG8_STAGE(PG8_SA(0, 0), a2, voffA);
            PG8_BAR; PG8_WAIT_L(0); PG8_MMA(1, 0, At, B0); PG8_BAR; PG8_SCHED;
            PG8_STAGE(PG8_SB(0, 1), b2 + hstepB, voffB);
            PG8_WAIT_V(6); PG8_BAR; PG8_MMA(1, 1, At, B1); PG8_BAR;
            PG8_LDB(B0, 1, 0); PG8_SCHED; PG8_LDA(At, 1, 0); PG8_STAGE(PG8_SA(0, 1), a2 + hstepA, voffA);
            PG8_WAIT_L(8); PG8_BAR; PG8_WAIT_L(0); PG8_MMA(0, 0, At, B0); PG8_BAR; PG8_SCHED;
            PG8_LDB(B1, 1, 1); PG8_STAGE(PG8_SB(1, 0), b3, voffB);
            PG8_BAR; PG8_WAIT_L(0); PG8_MMA(0, 1, At, B1); PG8_BAR;
            PG8_LDA(At, 1, 1); PG8_STAGE(PG8_SA(1, 0), a3, voffA);
            PG8_BAR; PG8_WAIT_L(0); PG8_MMA(1, 0, At, B0); PG8_BAR; PG8_SCHED;
            PG8_STAGE(PG8_SB(1, 1), b3 + hstepB, voffB);
            PG8_WAIT_V(6); PG8_BAR; PG8_MMA(1, 1, At, B1); PG8_BAR;
            }
        }
        if constexpr (ALIGN_EPI) { if (wr == 0) PG8_BAR; }
        if constexpr (!Epi::AFTER_DRAIN) { E(acc, cur, wr, wc, fr, fq); S.done(cur); }
        if (!has_next) break;
#pragma unroll
        for (int a = 0; a < 2; ++a)
#pragma unroll
            for (int b = 0; b < 2; ++b)
#pragma unroll
                for (int m = 0; m < 4; ++m)
#pragma unroll
                    for (int n = 0; n < 2; ++n) acc[a][b][m][n] = (f32x4){0.f, 0.f, 0.f, 0.f};
        cur = nxt; cA = nA; cB = nB; ++ui;
        if constexpr (GATHER) { _Pragma("unroll") for (int h_ = 0; h_ < 2; ++h_) { vA[h_][0] = vN[h_][0]; vA[h_][1] = vN[h_][1]; } }
        if constexpr (ALIGN_EPI) { if (wr == 1) PG8_BAR; }
    }
    PG8_WAIT_V(0);
    if constexpr (!ALIGN_EPI) { if (wr == 0) PG8_BAR; }
    PG8_BAR;
    if constexpr (Epi::AFTER_DRAIN) { E.fused(acc, cur, wr, wc, fr, fq, lds, wid, lane); S.done(cur); }
#undef PG8_SA
#undef PG8_SB
#undef PG8_STAGE
#undef PG8_LDA
#undef PG8_GOFF
#undef PG8_STAGE_A
#undef PG8_LDB
#undef PG8_MMA
#undef PG8_WAIT_V
#undef PG8_WAIT_L
#undef PG8_BAR
#undef PG8_SCHED
}


struct StaticOrder {
    int nM, nN, nwg, G, c;
    __device__ void init(int M, int N, int G_, int c_) { nM = M / BM; nN = N / BM; nwg = nM * nN; G = G_; c = c_; }
    __device__ bool next(int i, Unit& u) const {
        const long L = (long)i * G + c; if (L >= nwg) return false;
        int wgid = (int)L; { const int q = nwg / NXCD, r = nwg % NXCD, xcd = wgid % NXCD, off = wgid / NXCD; wgid = (xcd < r ? xcd * (q + 1) : r * (q + 1) + (xcd - r) * q) + off; }
        const int nig = WGM * nN, gid = wgid / nig, fm = gid * WGM, gsz = (nM - fm) < WGM ? (nM - fm) : WGM;
        u.pm = fm + ((wgid % nig) % gsz); u.pn = (wgid % nig) / gsz; return true;
    }
    __device__ __forceinline__ void a_ready(const Unit&) const {}
    __device__ __forceinline__ void done(const Unit&) const {}
};
struct GroupedOrder {
    const PG8_LAS int* list; int n;
    __device__ __forceinline__ bool next(int i, Unit& u) const { if (i >= n) return false; u.pm = __builtin_amdgcn_readfirstlane(list[2 * i]); u.pn = __builtin_amdgcn_readfirstlane(list[2 * i + 1]); return true; }
    __device__ __forceinline__ void a_ready(const Unit&) const {}
    __device__ __forceinline__ void done(const Unit&) const {}
};
__device__ __forceinline__ int grouped_units(PG8_LAS int* list, const int* tile, int ncol, int G, int c) {
#define TLD(i) ((int)__hip_atomic_load((const unsigned*)tile + (i), __ATOMIC_RELAXED, __HIP_MEMORY_SCOPE_AGENT))
    const int nrt = TLD(0); int n = 0;
    for (int i = 0; i < 16; ++i) { const int L = i * G + c, rt = L / ncol; if (rt >= nrt) break; if (threadIdx.x == 0) { list[2 * i] = TLD(17 + 2 * rt); list[2 * i + 1] = TLD(16 + 2 * rt) * ncol + (L % ncol); } ++n; }
#undef TLD
    __syncthreads();
    return n;
}
__device__ __forceinline__ u32x4 pack8(const f32x4& v0, const f32x4& v1) { u32x4 w; w.x = cvt_pk_bf16(v0[0], v0[1]); w.y = cvt_pk_bf16(v0[2], v0[3]); w.z = cvt_pk_bf16(v1[0], v1[1]); w.w = cvt_pk_bf16(v1[2], v1[3]); return w; }
#define EPI_ROWS_BEGIN _Pragma("unroll") for (int ai = 0; ai < 2; ++ai) _Pragma("unroll") for (int m = 0; m < 4; ++m) { const int row = u.pm * BM + ai * HALF + wr * 64 + m * 16 + fr; \
    _Pragma("unroll") for (int bj = 0; bj < 2; ++bj) { const f32x4 v0 = acc[ai][bj][m][0], v1 = acc[ai][bj][m][1];
#define EPI_ROWS_END } }
__device__ __forceinline__ float ssq32(const f32x4& v0, const f32x4& v1) {
    float q = (v0[0] * v0[0] + v0[1] * v0[1]) + (v0[2] * v0[2] + v0[3] * v0[3]) + (v1[0] * v1[0] + v1[1] * v1[1]) + (v1[2] * v1[2] + v1[3] * v1[3]);
    { auto r = __builtin_amdgcn_permlane16_swap(__float_as_uint(q), __float_as_uint(q), false, false); q = __uint_as_float(r[0]) + __uint_as_float(r[1]); }
    { auto r = __builtin_amdgcn_permlane32_swap(__float_as_uint(q), __float_as_uint(q), false, false); q = __uint_as_float(r[0]) + __uint_as_float(r[1]); }
    return q;
}
struct EpiP { static constexpr bool PERM = true, AFTER_DRAIN = false; bf16_t* O; int ldc; float* PS;
    __device__ __forceinline__ void operator()(const f32x4 (&acc)[2][2][4][2], const Unit& u, int wr, int wc, int fr, int fq) const {
        EPI_ROWS_BEGIN const int col = u.pn * BM + bj * HALF + wc * 32 + 8 * fq; *(u32x4*)(O + (size_t)row * ldc + col) = pack8(v0, v1);
            if (u.pn >= 10) { const float q = ssq32(v0, v1); if (fq == 0) PS[(size_t)row * 24 + (u.pn - 10) * 8 + bj * 4 + wc] = q; } EPI_ROWS_END } };
struct EpiUQ { static constexpr bool PERM = true, AFTER_DRAIN = false; bf16_t* Q; const float* PS;
    __device__ __forceinline__ void operator()(const f32x4 (&acc)[2][2][4][2], const Unit& u, int wr, int wc, int fr, int fq) const {
        _Pragma("unroll") for (int ai = 0; ai < 2; ++ai) _Pragma("unroll") for (int m = 0; m < 4; ++m) { const int row = u.pm * BM + ai * HALF + wr * 64 + m * 16 + fr;
            const f32x4 s0 = *(const f32x4*)(PS + (size_t)row * 24), s1 = *(const f32x4*)(PS + (size_t)row * 24 + 4), s2 = *(const f32x4*)(PS + (size_t)row * 24 + 8);
            const float rstd = rsqrtf(((s0[0] + s0[1]) + (s0[2] + s0[3]) + (s1[0] + s1[1]) + (s1[2] + s1[3]) + (s2[0] + s2[1]) + (s2[2] + s2[3])) * (1.f / 384.f) + 1e-6f);
            _Pragma("unroll") for (int bj = 0; bj < 2; ++bj) { const int col = u.pn * BM + bj * HALF + wc * 32 + 8 * fq;
                if (col < 384) *(u32x4*)(Q + (size_t)row * 384 + col) = pack8(acc[ai][bj][m][0] * rstd, acc[ai][bj][m][1] * rstd); } } } };
struct EpiUKV { static constexpr bool PERM = true, AFTER_DRAIN = false; bf16_t* Kn; bf16_t* Vn; const float* PS;
    __device__ __forceinline__ void operator()(const f32x4 (&acc)[2][2][4][2], const Unit& u, int wr, int wc, int fr, int fq) const {
        bf16_t* base = wc < 2 ? Kn + wc * 32 + 8 * fq : Vn + (wc - 2) * 32 + 8 * fq; const int rp = wc < 2 ? 384 : 256, hp = wc < 2 ? 96 : 64;
        _Pragma("unroll") for (int ai = 0; ai < 2; ++ai) _Pragma("unroll") for (int m = 0; m < 4; ++m) { const int row = u.pm * BM + ai * HALF + wr * 64 + m * 16 + fr;
            const f32x4 s0 = *(const f32x4*)(PS + (size_t)row * 24 + 12), s1 = *(const f32x4*)(PS + (size_t)row * 24 + 16);
            const float rstd = rsqrtf(((s0[0] + s0[1]) + (s0[2] + s0[3]) + (s1[0] + s1[1]) + (s1[2] + s1[3])) * (1.f / 256.f) + 1e-6f);
            _Pragma("unroll") for (int bj = 0; bj < 2; ++bj) { const int hd = u.pn * 2 + bj; *(u32x4*)(base + (size_t)row * rp + hd * hp) = pack8(acc[ai][bj][m][0] * rstd, acc[ai][bj][m][1] * rstd); } } } };
struct EpiOut { static constexpr bool PERM = true, AFTER_DRAIN = false; float* hl; float* hc; const float* rl; const float* rc; const float* gate;
    __device__ __forceinline__ void operator()(const f32x4 (&acc)[2][2][4][2], const Unit& u, int wr, int wc, int fr, int fq) const {
        EPI_ROWS_BEGIN const int col = u.pn * BM + bj * HALF + wc * 32 + 8 * fq;
            const size_t off = (row < 32768 ? (size_t)row * 1024 : (size_t)(row - 32768) * 1024) + col;
            float* h = (row < 32768 ? hl : hc) + off; const float* r = (row < 32768 ? rl : rc) + off; const float* g = gate + (row < 32768 ? (row >> 13) : 4) * 6144 + col;
            const f32x4 g0 = *(const f32x4*)g, g1 = *(const f32x4*)(g + 4); f32x4 h0 = *(const f32x4*)r, h1 = *(const f32x4*)(r + 4);
            h0 = h0 + g0 * v0; h1 = h1 + g1 * v1; *(f32x4*)h = h0; *(f32x4*)(h + 4) = h1; EPI_ROWS_END } };
__device__ __forceinline__ float silu_fast(float x) { return x / (1.f + __expf(-x)); }
struct EpiMoe1 { static constexpr bool PERM = true, AFTER_DRAIN = false; bf16_t* Hd;
    __device__ __forceinline__ void operator()(const f32x4 (&acc)[2][2][4][2], const Unit& u, int wr, int wc, int fr, int fq) const {
        EPI_ROWS_BEGIN const int col = (u.pn & 1) * BM + bj * HALF + wc * 32 + 8 * fq;
            uint2 w; w.x = cvt_pk_bf16(silu_fast(v0[0]) * v0[1], silu_fast(v0[2]) * v0[3]); w.y = cvt_pk_bf16(silu_fast(v1[0]) * v1[1], silu_fast(v1[2]) * v1[3]);
            *(uint2*)(Hd + (size_t)row * 256 + (col >> 1)) = w; EPI_ROWS_END } };
struct EpiMoe2 { static constexpr bool PERM = true, AFTER_DRAIN = false; bf16_t* Y;
    __device__ __forceinline__ void operator()(const f32x4 (&acc)[2][2][4][2], const Unit& u, int wr, int wc, int fr, int fq) const {
        EPI_ROWS_BEGIN const int col = (u.pn & 3) * BM + bj * HALF + wc * 32 + 8 * fq; *(u32x4*)(Y + (size_t)row * 1024 + col) = pack8(v0, v1); EPI_ROWS_END } };
}

struct WScale { const float* rowgain; int c0lo, c0hi; float s0; int c1lo, c1hi; float s1; };
__device__ __forceinline__ void transpose_tile(float* tl, const float* W, int K, int N, bf16_t* dst, int rs, int ro, int tile, int ntn, const WScale& ws_) {
    const int t = tid_(), k0 = (tile / ntn) * 64, n0 = (tile % ntn) * 64;
    __syncthreads();
    { const int k = t >> 3, n8 = (t & 7) * 8; const float rg = ws_.rowgain ? ws_.rowgain[k0 + k] : 1.f;
      float wv[8];
      if (n0 + n8 + 8 <= N) { const float4 a = *(const float4*)(W + (size_t)(k0 + k) * N + n0 + n8), b = *(const float4*)(W + (size_t)(k0 + k) * N + n0 + n8 + 4);
          wv[0] = a.x; wv[1] = a.y; wv[2] = a.z; wv[3] = a.w; wv[4] = b.x; wv[5] = b.y; wv[6] = b.z; wv[7] = b.w; }
      else {
#pragma unroll
          for (int i = 0; i < 8; ++i) wv[i] = (n0 + n8 + i) < N ? W[(size_t)(k0 + k) * N + n0 + n8 + i] : 0.f; }
#pragma unroll
      for (int i = 0; i < 8; ++i) { const int n = n0 + n8 + i; const float cs = (n >= ws_.c0lo && n < ws_.c0hi) ? ws_.s0 : ((n >= ws_.c1lo && n < ws_.c1hi) ? ws_.s1 : 1.f);
          tl[k * 65 + n8 + i] = wv[i] * rg * cs; } }
    __syncthreads();
    { const int n = t >> 3, k8 = (t & 7) * 8; uint4 o;
      o.x = (unsigned)f2bf(tl[(k8 + 0) * 65 + n]) | ((unsigned)f2bf(tl[(k8 + 1) * 65 + n]) << 16); o.y = (unsigned)f2bf(tl[(k8 + 2) * 65 + n]) | ((unsigned)f2bf(tl[(k8 + 3) * 65 + n]) << 16);
      o.z = (unsigned)f2bf(tl[(k8 + 4) * 65 + n]) | ((unsigned)f2bf(tl[(k8 + 5) * 65 + n]) << 16); o.w = (unsigned)f2bf(tl[(k8 + 6) * 65 + n]) | ((unsigned)f2bf(tl[(k8 + 7) * 65 + n]) << 16);
      *(uint4*)(dst + (size_t)((n0 + n) * rs + ro) * K + k0 + k8) = o; }
}
__device__ __forceinline__ void transpose_mat(float* tl, const float* W, int K, int N, int Npad, bf16_t* dst, int rs, int ro, int& base, const WScale& ws_) {
    const int ntn = Npad / 64, nt = (K / 64) * ntn, G = gridDim.x;
    const int first = (((int)blockIdx.x - base) % G + G) % G;
    for (int tile = first; tile < nt; tile += G) transpose_tile(tl, W, K, N, dst, rs, ro, tile, ntn, ws_);
    base = (base + nt) % G;
}


namespace fa {
typedef short bf16x8 __attribute__((ext_vector_type(8)));
typedef float f32x16 __attribute__((ext_vector_type(16)));
typedef unsigned u32x4 __attribute__((ext_vector_type(4)));
__device__ __forceinline__ int crow(int r, int hi) { return (r & 3) + 8 * (r >> 2) + 4 * hi; }
__device__ __forceinline__ unsigned cvtpk(float lo, float hi) { return pg8::cvt_pk_bf16(lo, hi); }
__device__ __forceinline__ float max3f(float a, float b, float c) { return __builtin_fmaxf(__builtin_fmaxf(a, b), c); }
__device__ __forceinline__ float xhalf_max(float m) { auto rr = __builtin_amdgcn_permlane32_swap(__float_as_uint(m), __float_as_uint(m), false, false); return fmaxf(__uint_as_float(rr[0]), __uint_as_float(rr[1])); }
__device__ __forceinline__ float xhalf_sum(float m) { auto rr = __builtin_amdgcn_permlane32_swap(__float_as_uint(m), __float_as_uint(m), false, false); return __uint_as_float(rr[0]) + __uint_as_float(rr[1]); }
template <int DQK> struct Lds { static constexpr int KP = DQK * 2 + 16, VP = 144, KB = 64 * KP, VB = 64 * VP, K0 = 0, V0 = 3 * KB, WSF = V0 + 3 * VB, OST = WSF + 8 * 64 * 4, BYTES = OST + 8 * 4096; };
template <int DQK>
__device__ __forceinline__ void attn_unit(char* smem, const bf16_t* Q, int ldq, const bf16_t* K0, int nt0, const bf16_t* K1, int nt1, int ldk, const bf16_t* VT, bf16_t* O, int ldo) {
    typedef Lds<DQK> L; constexpr int KC = DQK / 8, NKC = 64 * KC, NKS = DQK / 16; constexpr float THR = 8.f;
    const int tid = tid_(), lane = tid & 63, r32 = lane & 31, hi = lane >> 5; const int wid = __builtin_amdgcn_readfirstlane(tid >> 6);
    float* wsf = (float*)(smem + L::WSF) + wid * 64;
    bf16x8 qf[NKS];
#pragma unroll
    for (int ks = 0; ks < NKS; ++ks) qf[ks] = *(const bf16x8*)(Q + (size_t)(wid * 32 + r32) * ldq + ks * 16 + hi * 8);
    f32x16 o0, o1, negm;
#pragma unroll
    for (int r = 0; r < 16; ++r) { o0[r] = 0.f; o1[r] = 0.f; negm[r] = 0.f; }
    float mhat = 0.f, lsum = 0.f; bool resc = false;
    const int NT = nt0 + nt1;
    const int kr0 = tid / KC, kc0 = tid % KC, kr1 = (tid + 512) / KC, kc1 = (tid + 512) % KC; const bool has1 = (tid + 512) < NKC;
    const int vdv = tid >> 3, vg = tid & 7;
    uint4 sk0, sk1 = make_uint4(0u, 0u, 0u, 0u), sv;
    u32x4 w0, w1, w2, w3;
    f32x16 pA0, pA1, pB0, pB1;
#define FA_SB() __builtin_amdgcn_sched_barrier(0)
#define FA_GLOAD(t) do { const bf16_t* kt = ((t) < nt0) ? K0 + (size_t)(t) * 64 * ldk : K1 + (size_t)((t) - nt0) * 64 * ldk; \
        sk0 = *(const uint4*)(kt + (size_t)kr0 * ldk + kc0 * 8); if (has1) sk1 = *(const uint4*)(kt + (size_t)kr1 * ldk + kc1 * 8); \
        sv = *(const uint4*)(VT + (size_t)(t) * 4096 + tid * 8); } while (0)
#define FA_SWRITE(bo) do { *(uint4*)(smem + L::K0 + (bo) * L::KB + kr0 * L::KP + kc0 * 16) = sk0; if (has1) *(uint4*)(smem + L::K0 + (bo) * L::KB + kr1 * L::KP + kc1 * 16) = sk1; \
        *(uint4*)(smem + L::V0 + (bo) * L::VB + vdv * L::VP + vg * 16) = sv; } while (0)
#define FA_QK(P0, P1, bo) do { const char* kb = smem + L::K0 + (bo) * L::KB + r32 * L::KP + hi * 16; P0 = negm; P1 = negm; \
        _Pragma("unroll") for (int ks = 0; ks < NKS; ++ks) { const bf16x8 a0 = *(const bf16x8*)(kb + ks * 32), a1 = *(const bf16x8*)(kb + 32 * L::KP + ks * 32); \
            P0 = __builtin_amdgcn_mfma_f32_32x32x16_bf16(a0, qf[ks], P0, 0, 0, 0); P1 = __builtin_amdgcn_mfma_f32_32x32x16_bf16(a1, qf[ks], P1, 0, 0, 0); } } while (0)
#define FA_PARTIAL(P0, P1, FIRST) do { float rm = max3f(P0[0], P1[0], P0[1]); rm = max3f(rm, P1[1], P0[2]); rm = max3f(rm, P1[2], P0[3]); rm = max3f(rm, P1[3], P0[4]); \
        _Pragma("unroll") for (int r = 4; r < 15; ++r) rm = max3f(rm, P1[r], P0[r + 1]); \
        rm = fmaxf(rm, P1[15]); \
        rm = xhalf_max(rm); resc = false; \
        if ((FIRST) || __any(rm > THR)) { const float dl = (FIRST) ? rm : fmaxf(rm, 0.f); mhat += dl; \
            _Pragma("unroll") for (int r = 0; r < 16; ++r) { P0[r] -= dl; P1[r] -= dl; negm[r] = -mhat; } \
            if (!(FIRST)) { const float f = __builtin_amdgcn_exp2f(-dl); lsum *= f; if (hi == 0) wsf[r32] = f; resc = true; } } \
        _Pragma("unroll") for (int r = 0; r < 16; ++r) P0[r] = __builtin_amdgcn_exp2f(P0[r]); } while (0)
#define FA_FINISH(P0, P1) do { float ps = 0.f; \
        _Pragma("unroll") for (int r = 0; r < 16; ++r) { P1[r] = __builtin_amdgcn_exp2f(P1[r]); ps += P0[r] + P1[r]; } \
        lsum += ps; \
        w0.x = cvtpk(P0[0], P0[1]); w0.y = cvtpk(P0[2], P0[3]); w0.z = cvtpk(P0[4], P0[5]); w0.w = cvtpk(P0[6], P0[7]); \
        w1.x = cvtpk(P0[8], P0[9]); w1.y = cvtpk(P0[10], P0[11]); w1.z = cvtpk(P0[12], P0[13]); w1.w = cvtpk(P0[14], P0[15]); \
        w2.x = cvtpk(P1[0], P1[1]); w2.y = cvtpk(P1[2], P1[3]); w2.z = cvtpk(P1[4], P1[5]); w2.w = cvtpk(P1[6], P1[7]); \
        w3.x = cvtpk(P1[8], P1[9]); w3.y = cvtpk(P1[10], P1[11]); w3.z = cvtpk(P1[12], P1[13]); w3.w = cvtpk(P1[14], P1[15]); } while (0)
#define FA_PV1(W, s, vb) do { const bf16x8 pa = __builtin_bit_cast(bf16x8, W); \
        const bf16x8 v0 = *(const bf16x8*)((vb) + (s) * 32), v1 = *(const bf16x8*)((vb) + 32 * L::VP + (s) * 32); \
        o0 = __builtin_amdgcn_mfma_f32_32x32x16_bf16(pa, v0, o0, 0, 0, 0); o1 = __builtin_amdgcn_mfma_f32_32x32x16_bf16(pa, v1, o1, 0, 0, 0); } while (0)
#define FA_PV(bo) do { const char* vb_ = smem + L::V0 + (bo) * L::VB + r32 * L::VP + hi * 16; FA_PV1(w0, 0, vb_); FA_PV1(w1, 1, vb_); FA_PV1(w2, 2, vb_); FA_PV1(w3, 3, vb_); } while (0)
#define FA_RESC() do { if (resc) { asm volatile("s_waitcnt lgkmcnt(0)" ::: "memory"); \
        _Pragma("unroll") for (int r = 0; r < 16; ++r) { const float fr = wsf[crow(r, hi)]; o0[r] *= fr; o1[r] *= fr; } } } while (0)
#define FA_STEP(C0, C1, P0, P1, t, LOADNEXT) do { \
        FA_SB(); FA_QK(C0, C1, bc); FA_FINISH(P0, P1); FA_SB(); \
        if (LOADNEXT) FA_GLOAD((t) + 1); FA_SB(); \
        FA_PV(bp); FA_PARTIAL(C0, C1, false); \
        if (LOADNEXT) FA_SWRITE(bn); \
        FA_RESC(); \
        __syncthreads(); \
        { const int nb = bp; bp = bc; bc = bn; bn = nb; } } while (0)
    __syncthreads();
    FA_GLOAD(0); FA_SWRITE(0);
    __syncthreads();
    FA_QK(pA0, pA1, 0); FA_PARTIAL(pA0, pA1, true);
    FA_GLOAD(1); FA_SWRITE(1);
    __syncthreads();
    int bp = 0, bc = 1, bn = 2;
    for (int t = 1; t + 1 < NT; t += 2) {
        FA_STEP(pB0, pB1, pA0, pA1, t, true);
        FA_STEP(pA0, pA1, pB0, pB1, t + 1, true);
    }
    FA_STEP(pB0, pB1, pA0, pA1, NT - 1, false);
    FA_FINISH(pB0, pB1); FA_PV(bp);
#undef FA_STEP
#undef FA_RESC
#undef FA_PV
#undef FA_PV1
#undef FA_FINISH
#undef FA_PARTIAL
#undef FA_QK
#undef FA_GLOAD
#undef FA_SWRITE
#undef FA_SB
    lsum = xhalf_sum(lsum);
    if (hi == 0) wsf[32 + r32] = lsum;
    asm volatile("s_waitcnt lgkmcnt(0)" ::: "memory");
    bf16_t* stg = (bf16_t*)(smem + L::OST) + wid * 2048;
#pragma unroll
    for (int r = 0; r < 16; ++r) { const int orow = crow(r, hi); const float rl = 1.f / wsf[32 + orow]; stg[orow * 64 + r32] = f2bf(o0[r] * rl); stg[orow * 64 + 32 + r32] = f2bf(o1[r] * rl); }
    asm volatile("s_waitcnt lgkmcnt(0)" ::: "memory");
#pragma unroll
    for (int i = 0; i < 4; ++i) { const int row = i * 8 + (lane >> 3), ch = lane & 7; const u32x4 v = *(const u32x4*)(stg + row * 64 + ch * 8); *(u32x4*)(O + (size_t)(wid * 32 + row) * ldo + ch * 8) = v; }
}
}


namespace na {
using fa::bf16x8; using fa::f32x16; using fa::u32x4; using fa::crow; using fa::cvtpk; using fa::xhalf_max; using fa::xhalf_sum;
constexpr int KP = 144, KB = 64 * KP, VP = 136, VB = 64 * VP, K0 = 0, V0 = 2 * KB, WSF = V0 + 2 * VB, OST = WSF + 2048, TBL = OST + 8 * 4096, BYTES = TBL + 17 * 64 * 4;
__device__ __forceinline__ int clampi(int v, int lo, int hi) { return v < lo ? lo : (v > hi ? hi : v); }
__device__ __forceinline__ void na_unit(char* smem, bool ctxu, int b, int h, int g, const bf16_t* P, const bf16_t* NVT, const float* rpb, bf16_t* MIX) {
    constexpr float THR = 8.f, NEG = -1e30f;
    const int tid = tid_(), lane = tid & 63, r32 = lane & 31, hi = lane >> 5; const int wid = __builtin_amdgcn_readfirstlane(tid >> 6);
    float* wsf = (float*)(smem + WSF) + wid * 64; float* tb = (float*)(smem + TBL);
    const int pr = wid >> 2, cbk = (wid & 3) * 16, kc0 = clampi(cbk - 8, 0, 32);
    const int qr = 4 * g + 2 * pr + (r32 >> 4), qc = cbk + (r32 & 15);
    const size_t qrow = ctxu ? (size_t)NLAT + b * CTXL + wid * 32 + r32 : (size_t)b * SEQ + qr * 64 + qc;
    bf16x8 qf[4];
#pragma unroll
    for (int ks = 0; ks < 4; ++ks) qf[ks] = *(const bf16x8*)(P + qrow * LDP + PC_NQ + h * 64 + ks * 16 + hi * 8);
    const int r0q = clampi(qr - 4, 0, 120), c0q = clampi(qc - 8, 0, 48);
    const int cbase = kc0 + 4 * hi - c0q, bidx = kc0 + 4 * hi - qc + 15 + 16;
    const int ra = 4 * g + 2 * pr, wlo = clampi(ra - 4, 0, 120), whi = clampi(ra - 3, 0, 120) + 8;
    const int krU = clampi(4 * g - 4, 0, 117);
    const int NL = ctxu ? 0 : 11, NT = NL + 4;
    f32x16 o0, o1, negm;
#pragma unroll
    for (int r = 0; r < 16; ++r) { o0[r] = 0.f; o1[r] = 0.f; negm[r] = 0.f; }
    float mhat = 0.f, lsum = 0.f; bool first = true;
    const size_t vt_base = (size_t)(b * 8 + h) * 132 * 4096;
    const int skr = tid >> 3, skc = tid & 7;
    uint4 sk, sv;
#define NA_GLOAD(t) do { const size_t krow = (t) < NL ? (size_t)b * SEQ + (size_t)(krU + (t)) * 64 : (size_t)NLAT + b * CTXL + ((t) - NL) * 64; const int vtile = (t) < NL ? krU + (t) : 128 + ((t) - NL); \
        sk = *(const uint4*)(P + (krow + skr) * LDP + PC_NK + h * 64 + skc * 8); sv = *(const uint4*)(NVT + vt_base + (size_t)vtile * 4096 + tid * 8); } while (0)
#define NA_SWRITE(buf) do { *(uint4*)(smem + K0 + (buf) * KB + skr * KP + skc * 16) = sk; uint2* vd = (uint2*)(smem + V0 + (buf) * VB + skr * VP + skc * 16); vd[0] = make_uint2(sv.x, sv.y); vd[1] = make_uint2(sv.z, sv.w); } while (0)
    __syncthreads();
    if (!ctxu) for (int idx = tid; idx < 17 * 64; idx += 512) { const int dr = (idx >> 6) - 8, dci = (idx & 63) - 16; tb[idx] = (dr >= -7 && dr <= 7 && dci >= 0 && dci <= 30) ? rpb[(dr + 7) * 31 + dci] * 1.4426950408889634f : 0.f; }
    NA_GLOAD(0); NA_SWRITE(0);
    __syncthreads();
#define NA_BLOCK(koff, MASKED, kr) do { \
        const char* kb = smem + K0 + buf * KB + ((koff) + r32) * KP + hi * 16; \
        f32x16 p = negm; \
        _Pragma("unroll") for (int ks = 0; ks < 4; ++ks) { const bf16x8 a = *(const bf16x8*)(kb + ks * 32); p = __builtin_amdgcn_mfma_f32_32x32x16_bf16(a, qf[ks], p, 0, 0, 0); } \
        if (MASKED) { const bool rowok = (unsigned)((kr) - r0q) < 8u; const float* tbr = tb + ((kr) - qr + 8) * 64 + bidx; \
            _Pragma("unroll") for (int r = 0; r < 16; ++r) { const int cst = (r & 3) + 8 * (r >> 2); const bool ok = rowok && (unsigned)(cbase + cst) < 16u; p[r] = ok ? p[r] + tbr[cst] : NEG; } } \
        float rm = fa::max3f(p[0], p[1], p[2]); \
        _Pragma("unroll") for (int r = 3; r < 15; r += 2) rm = fa::max3f(rm, p[r], p[r + 1]); \
        rm = fmaxf(rm, p[15]); \
        rm = xhalf_max(rm); \
        if (first || __any(rm > THR)) { \
            const float dl = first ? (rm > -1e29f ? rm : 0.f) : fmaxf(rm, 0.f); \
            mhat += dl; \
            _Pragma("unroll") for (int r = 0; r < 16; ++r) { p[r] -= dl; negm[r] = -mhat; } \
            if (!first) { const float f = __builtin_amdgcn_exp2f(-dl); lsum *= f; if (hi == 0) wsf[r32] = f; asm volatile("s_waitcnt lgkmcnt(0)" ::: "memory"); \
                _Pragma("unroll") for (int r = 0; r < 16; ++r) { const float fr = wsf[crow(r, hi)]; o0[r] *= fr; o1[r] *= fr; } } \
            first = false; } \
        float ps = 0.f; \
        _Pragma("unroll") for (int r = 0; r < 16; ++r) { p[r] = __builtin_amdgcn_exp2f(p[r]); ps += p[r]; } \
        lsum += ps; \
        u32x4 w0, w1; \
        w0.x = cvtpk(p[0], p[1]); w0.y = cvtpk(p[2], p[3]); w0.z = cvtpk(p[4], p[5]); w0.w = cvtpk(p[6], p[7]); \
        w1.x = cvtpk(p[8], p[9]); w1.y = cvtpk(p[10], p[11]); w1.z = cvtpk(p[12], p[13]); w1.w = cvtpk(p[14], p[15]); \
        const char* vb = smem + V0 + buf * VB + r32 * VP + ((koff) + 4 * hi) * 2; \
        { const bf16x8 pa = __builtin_bit_cast(bf16x8, w0); const uint2 a0 = *(const uint2*)(vb), a1 = *(const uint2*)(vb + 16), b0 = *(const uint2*)(vb + 32 * VP), b1 = *(const uint2*)(vb + 32 * VP + 16); \
          const bf16x8 v0 = __builtin_bit_cast(bf16x8, make_uint4(a0.x, a0.y, a1.x, a1.y)), v1 = __builtin_bit_cast(bf16x8, make_uint4(b0.x, b0.y, b1.x, b1.y)); \
          o0 = __builtin_amdgcn_mfma_f32_32x32x16_bf16(pa, v0, o0, 0, 0, 0); o1 = __builtin_amdgcn_mfma_f32_32x32x16_bf16(pa, v1, o1, 0, 0, 0); } \
        { const bf16x8 pa = __builtin_bit_cast(bf16x8, w1); const uint2 a0 = *(const uint2*)(vb + 32), a1 = *(const uint2*)(vb + 48), b0 = *(const uint2*)(vb + 32 * VP + 32), b1 = *(const uint2*)(vb + 32 * VP + 48); \
          const bf16x8 v0 = __builtin_bit_cast(bf16x8, make_uint4(a0.x, a0.y, a1.x, a1.y)), v1 = __builtin_bit_cast(bf16x8, make_uint4(b0.x, b0.y, b1.x, b1.y)); \
          o0 = __builtin_amdgcn_mfma_f32_32x32x16_bf16(pa, v0, o0, 0, 0, 0); o1 = __builtin_amdgcn_mfma_f32_32x32x16_bf16(pa, v1, o1, 0, 0, 0); } \
    } while (0)
    for (int t = 0; t < NT; ++t) {
        const int buf = t & 1;
        if (t + 1 < NT) NA_GLOAD(t + 1);
        if (t < NL) { const int kr = krU + t; if (kr >= wlo && kr < whi) NA_BLOCK(kc0, true, kr); }
        else { NA_BLOCK(0, false, 0); NA_BLOCK(32, false, 0); }
        if (t + 1 < NT) NA_SWRITE(buf ^ 1);
        __syncthreads();
    }
#undef NA_BLOCK
#undef NA_GLOAD
#undef NA_SWRITE
    lsum = xhalf_sum(lsum);
    if (hi == 0) wsf[32 + r32] = lsum;
    asm volatile("s_waitcnt lgkmcnt(0)" ::: "memory");
    bf16_t* stg = (bf16_t*)(smem + OST) + wid * 2048;
#pragma unroll
    for (int r = 0; r < 16; ++r) { const int orow = crow(r, hi); const float rl = 1.f / wsf[32 + orow]; stg[orow * 64 + r32] = f2bf(o0[r] * rl); stg[orow * 64 + 32 + r32] = f2bf(o1[r] * rl); }
    asm volatile("s_waitcnt lgkmcnt(0)" ::: "memory");
#pragma unroll
    for (int i = 0; i < 4; ++i) { const int q = i * 8 + (lane >> 3), ch = lane & 7; const u32x4 v = *(const u32x4*)(stg + q * 64 + ch * 8);
        const size_t orow = ctxu ? (size_t)NLAT + b * CTXL + wid * 32 + q : (size_t)b * SEQ + (size_t)(4 * g + 2 * pr + (q >> 4)) * 64 + cbk + (q & 15);
        *(u32x4*)(MIX + orow * DM + 256 + h * 64 + ch * 8) = v; }
}
}


__device__ __forceinline__ float reduce64(float (&v)[64], int lane) {
#pragma unroll
    for (int i = 0; i < 32; ++i) { auto r = __builtin_amdgcn_permlane32_swap(__float_as_uint(v[i]), __float_as_uint(v[i + 32]), false, false); v[i] = __uint_as_float(r[0]) + __uint_as_float(r[1]); }
#pragma unroll
    for (int i = 0; i < 16; ++i) { auto r = __builtin_amdgcn_permlane16_swap(__float_as_uint(v[i]), __float_as_uint(v[i + 16]), false, false); v[i] = __uint_as_float(r[0]) + __uint_as_float(r[1]); }
    const bool b3 = lane & 8, b2 = lane & 4, b1 = lane & 2, b0 = lane & 1;
#pragma unroll
    for (int i = 0; i < 8; ++i) { const float keep = b3 ? v[i + 8] : v[i], send = b3 ? v[i] : v[i + 8]; v[i] = keep + dpp_f<0x140>(send); }
#pragma unroll
    for (int i = 0; i < 4; ++i) { const float keep = b2 ? v[i + 4] : v[i], send = b2 ? v[i] : v[i + 4]; v[i] = keep + dpp_f<0x141>(send); }
#pragma unroll
    for (int i = 0; i < 2; ++i) { const float keep = b1 ? v[i + 2] : v[i], send = b1 ? v[i] : v[i + 2]; v[i] = keep + dpp_f<0x4E>(send); }
    { const float keep = b0 ? v[1] : v[0], send = b0 ? v[0] : v[1]; v[0] = keep + dpp_f<0xB1>(send); }
    return v[0];
}
#define PROBE_SET 0
#ifndef PHASE_INLINE
#define PHASE_INLINE __forceinline__
#endif

namespace rt {
using fa::bf16x8; using fa::f32x16; using fa::u32x4; using fa::crow; using fa::cvtpk;
constexpr int KP = 144, KBY = 128 * KP, VP = 264, VBY = 64 * VP, SP = 144, SBY = 64 * SP;
constexpr int OK_ = 0, OV = KBY, OSF = OV + VBY, OSB = OSF + SBY, UNIT = OSB + SBY, STG = 2 * UNIT, BYTES = STG + 8 * 4096;
static_assert(UNIT % 16 == 0 && BYTES <= 144 * 1024 - 64, "retention LDS map");
template <int CTRL> __device__ __forceinline__ float dppf(float v) { return __uint_as_float((unsigned)__builtin_amdgcn_mov_dpp((int)__float_as_uint(v), CTRL, 0xF, 0xF, true)); }
__device__ __forceinline__ float half_sum(float v) {
    v += dppf<0xB1>(v); v += dppf<0x4E>(v); v += dppf<0x141>(v); v += dppf<0x140>(v);
    auto r = __builtin_amdgcn_permlane16_swap(__float_as_uint(v), __float_as_uint(v), false, false); return __uint_as_float(r[0]) + __uint_as_float(r[1]);
}
__device__ __forceinline__ void rope8(uint4& a, uint4& b, const float2* tab) {
    unsigned* pa = (unsigned*)&a; unsigned* pb = (unsigned*)&b;
#pragma unroll
    for (int w = 0; w < 4; ++w) {
        const float4 t = *(const float4*)(tab + 2 * w);
        const float x1l = __uint_as_float(pa[w] << 16), x1h = __uint_as_float(pa[w] & 0xffff0000u), x2l = __uint_as_float(pb[w] << 16), x2h = __uint_as_float(pb[w] & 0xffff0000u);
        pa[w] = cvtpk(x1l * t.x - x2l * t.y, x1h * t.z - x2h * t.w); pb[w] = cvtpk(x2l * t.x + x1l * t.y, x2h * t.z + x1h * t.w);
    }
}
#define RT_KITEM(item, A, B, R, CC) const int R = (item) >> 2, pc_ = (item) & 3, CC = (pc_ & 1) + 4 * (pc_ >> 1); \
        const bf16_t* ksrc_ = P + (size_t)(row0 + R) * LDP + PC_RK + hd * 64; uint4 A = *(const uint4*)(ksrc_ + CC * 8), B = *(const uint4*)(ksrc_ + (CC + 2) * 8); \
        if (lat) { const int tok_ = j * 128 + R, pos_ = pc_ < 2 ? tok_ >> 6 : tok_ & 63; rope8(A, B, TAB + pos_ * 16 + 8 * (pc_ & 1)); }
__device__ __forceinline__ void ret_pair(char* smem, int it0, int n_it, const bf16_t* P, const float* RKV, const float2* TAB, const float* dec_f, const float* dec_b, bf16_t* MIX) {
    const int tid = tid_(), lane = tid & 63, r32 = lane & 31, hi = lane >> 5; const int wid = __builtin_amdgcn_readfirstlane(tid >> 6);
    const int hw = wid >> 2, w4 = wid & 3, t4 = tid & 255;
    const int it = it0 + hw; const bool valid = it < n_it;
    int b, hd, j, row0;
    if (it < 1024) { b = it >> 8; hd = (it >> 6) & 3; j = it & 63; row0 = b * SEQ + j * 128; } else { const int q = it - 1024; b = q >> 3; hd = (q >> 1) & 3; j = q & 1; row0 = NLAT + b * CTXL + j * 128; }
    char* un = smem + hw * UNIT; const bool lat = it < 1024;
    __syncthreads();
    if (valid) {
#pragma unroll
        for (int c = 0; c < 2; ++c) { RT_KITEM(t4 + 256 * c, ka, kb2, r, cc) *(uint4*)(un + OK_ + r * KP + cc * 16) = ka; *(uint4*)(un + OK_ + r * KP + (cc + 2) * 16) = kb2; }
#pragma unroll
        for (int c = 0; c < 4; ++c) { const int ch = t4 + 256 * c, r = ch >> 3, cc = ch & 7; const bf16_t* src = P + (size_t)(row0 + r) * LDP + hd * 64 + cc * 8;
            const uint4 v = *(const uint4*)(src + PC_RV); bf16_t* vt = (bf16_t*)(un + OV) + (cc * 8) * (VP / 2) + r;
            vt[0 * (VP / 2)] = (bf16_t)(v.x & 0xffff); vt[1 * (VP / 2)] = (bf16_t)(v.x >> 16); vt[2 * (VP / 2)] = (bf16_t)(v.y & 0xffff); vt[3 * (VP / 2)] = (bf16_t)(v.y >> 16);
            vt[4 * (VP / 2)] = (bf16_t)(v.z & 0xffff); vt[5 * (VP / 2)] = (bf16_t)(v.z >> 16); vt[6 * (VP / 2)] = (bf16_t)(v.w & 0xffff); vt[7 * (VP / 2)] = (bf16_t)(v.w >> 16); }
#pragma unroll
        for (int c = 0; c < 16; ++c) { const int idx = t4 + 256 * c, d = idx >> 6, e = idx & 63;
            ((bf16_t*)(un + OSF))[e * (SP / 2) + d] = f2bf(RKV[((size_t)it * 2 + 0) * 4096 + idx]); ((bf16_t*)(un + OSB))[e * (SP / 2) + d] = f2bf(RKV[((size_t)it * 2 + 1) * 4096 + idx]); }
    }
    __syncthreads();
    if (valid) {
        const float lgf2 = log_sigmoid_f(dec_f[hd]) * 1.4426950408889634f, lgb2 = log_sigmoid_f(dec_b[hd]) * 1.4426950408889634f;
        const int qi = w4 * 32 + r32;
        bf16x8 qf[4];
#pragma unroll
        for (int ks = 0; ks < 4; ++ks) qf[ks] = *(const bf16x8*)(P + (size_t)(row0 + qi) * LDP + PC_RQ + hd * 64 + ks * 16 + hi * 8);
        if (lat) { const int tq = j * 128 + qi; uint4 a = __builtin_bit_cast(uint4, qf[0]), b2 = __builtin_bit_cast(uint4, qf[1]), c2 = __builtin_bit_cast(uint4, qf[2]), d2 = __builtin_bit_cast(uint4, qf[3]);
            rope8(a, b2, TAB + (tq >> 6) * 16 + 8 * hi); rope8(c2, d2, TAB + (tq & 63) * 16 + 8 * hi);
            qf[0] = __builtin_bit_cast(bf16x8, a); qf[1] = __builtin_bit_cast(bf16x8, b2); qf[2] = __builtin_bit_cast(bf16x8, c2); qf[3] = __builtin_bit_cast(bf16x8, d2); }
        f32x16 o0, o1;
#pragma unroll
        for (int r = 0; r < 16; ++r) { o0[r] = 0.f; o1[r] = 0.f; }
#pragma unroll
        for (int kb = 0; kb < 4; ++kb) {
            f32x16 pz;
#pragma unroll
            for (int r = 0; r < 16; ++r) pz[r] = 0.f;
            const char* kp = un + OK_ + (kb * 32 + r32) * KP + hi * 16;
#pragma unroll
            for (int ks = 0; ks < 4; ++ks) { const bf16x8 a = *(const bf16x8*)(kp + ks * 32); pz = __builtin_amdgcn_mfma_f32_32x32x16_bf16(a, qf[ks], pz, 0, 0, 0); }
#pragma unroll
            for (int r = 0; r < 16; ++r) { const int dI = qi - (kb * 32 + crow(r, hi)); const float arg = dI >= 0 ? lgf2 * (float)dI : -lgb2 * (float)dI; pz[r] *= __builtin_amdgcn_exp2f(arg); }
            u32x4 w0, w1;
            w0.x = cvtpk(pz[0], pz[1]); w0.y = cvtpk(pz[2], pz[3]); w0.z = cvtpk(pz[4], pz[5]); w0.w = cvtpk(pz[6], pz[7]);
            w1.x = cvtpk(pz[8], pz[9]); w1.y = cvtpk(pz[10], pz[11]); w1.z = cvtpk(pz[12], pz[13]); w1.w = cvtpk(pz[14], pz[15]);
            const char* vb = un + OV + r32 * VP + (kb * 32 + 4 * hi) * 2;
            { const bf16x8 pa = __builtin_bit_cast(bf16x8, w0); const uint2 a0 = *(const uint2*)(vb), a1 = *(const uint2*)(vb + 16), b0 = *(const uint2*)(vb + 32 * VP), b1 = *(const uint2*)(vb + 32 * VP + 16);
              o0 = __builtin_amdgcn_mfma_f32_32x32x16_bf16(pa, __builtin_bit_cast(bf16x8, make_uint4(a0.x, a0.y, a1.x, a1.y)), o0, 0, 0, 0);
              o1 = __builtin_amdgcn_mfma_f32_32x32x16_bf16(pa, __builtin_bit_cast(bf16x8, make_uint4(b0.x, b0.y, b1.x, b1.y)), o1, 0, 0, 0); }
            { const bf16x8 pa = __builtin_bit_cast(bf16x8, w1); const uint2 a0 = *(const uint2*)(vb + 32), a1 = *(const uint2*)(vb + 48), b0 = *(const uint2*)(vb + 32 * VP + 32), b1 = *(const uint2*)(vb + 32 * VP + 48);
              o0 = __builtin_amdgcn_mfma_f32_32x32x16_bf16(pa, __builtin_bit_cast(bf16x8, make_uint4(a0.x, a0.y, a1.x, a1.y)), o0, 0, 0, 0);
              o1 = __builtin_amdgcn_mfma_f32_32x32x16_bf16(pa, __builtin_bit_cast(bf16x8, make_uint4(b0.x, b0.y, b1.x, b1.y)), o1, 0, 0, 0); }
        }
        {
            f32x16 tf0, tf1, tb0, tb1;
#pragma unroll
            for (int r = 0; r < 16; ++r) { tf0[r] = 0.f; tf1[r] = 0.f; tb0[r] = 0.f; tb1[r] = 0.f; }
            const char* sf = un + OSF + r32 * SP + hi * 16; const char* sb = un + OSB + r32 * SP + hi * 16;
#pragma unroll
            for (int ks = 0; ks < 4; ++ks) {
                tf0 = __builtin_amdgcn_mfma_f32_32x32x16_bf16(qf[ks], *(const bf16x8*)(sf + ks * 32), tf0, 0, 0, 0); tf1 = __builtin_amdgcn_mfma_f32_32x32x16_bf16(qf[ks], *(const bf16x8*)(sf + 32 * SP + ks * 32), tf1, 0, 0, 0);
                tb0 = __builtin_amdgcn_mfma_f32_32x32x16_bf16(qf[ks], *(const bf16x8*)(sb + ks * 32), tb0, 0, 0, 0); tb1 = __builtin_amdgcn_mfma_f32_32x32x16_bf16(qf[ks], *(const bf16x8*)(sb + 32 * SP + ks * 32), tb1, 0, 0, 0);
            }
#pragma unroll
            for (int r = 0; r < 16; ++r) { const int i = w4 * 32 + crow(r, hi); const float cf = __builtin_amdgcn_exp2f(lgf2 * (float)(i + 1)), cb = __builtin_amdgcn_exp2f(lgb2 * (float)(128 - i));
                o0[r] += cf * tf0[r] + cb * tb0[r]; o1[r] += cf * tf1[r] + cb * tb1[r]; }
        }
        bf16_t* stg = (bf16_t*)(smem + STG) + wid * 2048;
#pragma unroll
        for (int r = 0; r < 16; ++r) {
            const float mu = half_sum(o0[r] + o1[r]) * (1.f / 64.f); const float d0 = o0[r] - mu, d1 = o1[r] - mu;
            const float rs = rsqrtf(half_sum(d0 * d0 + d1 * d1) * (1.f / 64.f) + 1e-6f);
            const int q = crow(r, hi); stg[q * 64 + r32] = f2bf(d0 * rs); stg[q * 64 + 32 + r32] = f2bf(d1 * rs);
        }
        asm volatile("s_waitcnt lgkmcnt(0)" ::: "memory");
#pragma unroll
        for (int i = 0; i < 4; ++i) { const int q = i * 8 + (lane >> 3), ch = lane & 7; const size_t row = (size_t)row0 + w4 * 32 + q;
            const u32x4 y = *(const u32x4*)(stg + q * 64 + ch * 8), gg = *(const u32x4*)(P + row * LDP + PC_RG + hd * 64 + ch * 8); u32x4 o;
#define RT_G(yv, gv) cvtpk(__uint_as_float((yv) << 16) * silu_f(__uint_as_float((gv) << 16)), __uint_as_float((yv) & 0xffff0000u) * silu_f(__uint_as_float((gv) & 0xffff0000u)))
            o.x = RT_G(y.x, gg.x); o.y = RT_G(y.y, gg.y); o.z = RT_G(y.z, gg.z); o.w = RT_G(y.w, gg.w);
#undef RT_G
            *(u32x4*)(MIX + row * DM + hd * 64 + ch * 8) = o; }
    }
}
constexpr int TP = 272, TBY = 64 * TP, SUNIT = 3 * TBY;
static_assert(2 * SUNIT <= BYTES, "summary LDS map");
__device__ __forceinline__ void sum_pair(char* smem, int it0, int n_it, const bf16_t* P, float* RKV, const float2* TAB, const float* dec_f, const float* dec_b) {
    const int tid = tid_(), lane = tid & 63, r32 = lane & 31, hi = lane >> 5; const int wid = __builtin_amdgcn_readfirstlane(tid >> 6);
    const int hw = wid >> 2, w4 = wid & 3, t4 = tid & 255;
    const int it = it0 + hw; const bool valid = it < n_it, lat = it < 1024;
    int b, hd, j, row0;
    if (it < 1024) { b = it >> 8; hd = (it >> 6) & 3; j = it & 63; row0 = b * SEQ + j * 128; } else { const int q = it - 1024; b = q >> 3; hd = (q >> 1) & 3; j = q & 1; row0 = NLAT + b * CTXL + j * 128; }
    bf16_t* kt = (bf16_t*)(smem + hw * SUNIT); bf16_t* vf = kt + TBY / 2; bf16_t* vb = vf + TBY / 2;
    __syncthreads();
    if (valid) {
        const float lgf2 = log_sigmoid_f(dec_f[hd]) * 1.4426950408889634f, lgb2 = log_sigmoid_f(dec_b[hd]) * 1.4426950408889634f;
#pragma unroll
        for (int c = 0; c < 2; ++c) { RT_KITEM(t4 + 256 * c, ka, kb2, r, cc) const unsigned* pa = (const unsigned*)&ka; const unsigned* pb = (const unsigned*)&kb2;
#pragma unroll
            for (int w = 0; w < 4; ++w) { kt[(cc * 8 + 2 * w) * (TP / 2) + r] = (bf16_t)(pa[w] & 0xffff); kt[(cc * 8 + 2 * w + 1) * (TP / 2) + r] = (bf16_t)(pa[w] >> 16);
                kt[((cc + 2) * 8 + 2 * w) * (TP / 2) + r] = (bf16_t)(pb[w] & 0xffff); kt[((cc + 2) * 8 + 2 * w + 1) * (TP / 2) + r] = (bf16_t)(pb[w] >> 16); } }
#pragma unroll
        for (int c = 0; c < 4; ++c) { const int ch = t4 + 256 * c, r = ch >> 3, cc = ch & 7; const uint4 v = *(const uint4*)(P + (size_t)(row0 + r) * LDP + PC_RV + hd * 64 + cc * 8); const unsigned* pv = (const unsigned*)&v;
            const float wf = __builtin_amdgcn_exp2f(lgf2 * (float)(127 - r)), wb = __builtin_amdgcn_exp2f(lgb2 * (float)r);
#pragma unroll
            for (int w = 0; w < 4; ++w) { const float lo = __uint_as_float(pv[w] << 16), hh = __uint_as_float(pv[w] & 0xffff0000u);
                vf[(cc * 8 + 2 * w) * (TP / 2) + r] = f2bf(lo * wf); vf[(cc * 8 + 2 * w + 1) * (TP / 2) + r] = f2bf(hh * wf);
                vb[(cc * 8 + 2 * w) * (TP / 2) + r] = f2bf(lo * wb); vb[(cc * 8 + 2 * w + 1) * (TP / 2) + r] = f2bf(hh * wb); } }
    }
    __syncthreads();
    if (valid) {
        const int dblk = w4 >> 1, eblk = w4 & 1;
        f32x16 af, ab;
#pragma unroll
        for (int r = 0; r < 16; ++r) { af[r] = 0.f; ab[r] = 0.f; }
        const char* ka = (const char*)kt + (dblk * 32 + r32) * TP + hi * 16; const char* fa_ = (const char*)vf + (eblk * 32 + r32) * TP + hi * 16; const char* ba_ = (const char*)vb + (eblk * 32 + r32) * TP + hi * 16;
#pragma unroll
        for (int ks = 0; ks < 8; ++ks) { const bf16x8 a = *(const bf16x8*)(ka + ks * 32);
            af = __builtin_amdgcn_mfma_f32_32x32x16_bf16(a, *(const bf16x8*)(fa_ + ks * 32), af, 0, 0, 0); ab = __builtin_amdgcn_mfma_f32_32x32x16_bf16(a, *(const bf16x8*)(ba_ + ks * 32), ab, 0, 0, 0); }
        float* of = RKV + ((size_t)it * 2 + 0) * 4096 + eblk * 32 + r32; float* ob = RKV + ((size_t)it * 2 + 1) * 4096 + eblk * 32 + r32;
#pragma unroll
        for (int r = 0; r < 16; ++r) { const int d = dblk * 32 + crow(r, hi); of[d * 64] = af[r]; ob[d * 64] = ab[r]; }
    }
}
}

template <int KIND> __device__ PHASE_INLINE void phase(const Params& p, const int l, char* smem) {
    __syncthreads();
    const int tid = tid_(), lane = tid & 63, wid = tid >> 6;
    const int nblk = gridDim.x, bid = bid_();
    size_t zoff = 0; asm volatile("" : "+s"(zoff));
    unsigned char* ws = p.ws + zoff;
    float* MOD = (float*)(ws + WS_MOD);
    bf16_t* U = (bf16_t*)(ws + WS_U);
    bf16_t* P = (bf16_t*)(ws + WS_P);
    bf16_t* QM = (bf16_t*)(ws + WS_QM);
    bf16_t* KM = (bf16_t*)(ws + WS_KM);
    bf16_t* VM = (bf16_t*)(ws + WS_VM);
    float* RKV = (float*)(ws + WS_RKV);
    bf16_t* XS = (bf16_t*)(ws + WS_XS);
    bf16_t* HDN = (bf16_t*)(ws + WS_HDN);
    int2* RTE = (int2*)(ws + WS_RT + RT_E);
    float2* RTW = (float2*)(ws + WS_RT + RT_W);
    float* RTR = (float*)(ws + WS_RT + RT_RSTD);
    int2* RTS = (int2*)(ws + WS_RT + RT_SLOT);
    int* CNT = (int*)(ws + WS_RT + RT_CNT);
    int* SEG = (int*)(ws + WS_RT + RT_SEG);
    int* TILE = (int*)(ws + WS_RT + RT_TILE);
    bf16_t* VT = (bf16_t*)(ws + WS_VT);
    bf16_t* NVT = (bf16_t*)(ws + WS_NVT);
    bf16_t* WT = (bf16_t*)(ws + WS_WT);
    PG8_LAS unsigned char* lds3 = (PG8_LAS unsigned char*)smem;
    float* const Hlat = p.out; float* const Hctx = (float*)(ws + WS_HC);

    if constexpr (KIND == 0) {
        {
            float* sc = (float*)smem;
            float* red = sc + 5 * DM;
            for (int i = tid; i < 5 * DM; i += 512) { const int v = i / DM, k = i % DM; const float x = v < 4 ? p.in[I_C][v * DM + k] : p.in[I_CCTX][k]; sc[i] = silu_f(x); }
            __syncthreads();
            for (int it = bid; it < 2 * 96; it += nblk) {
                const int ll = it / 96, j = (it % 96) * 64 + lane;
                const float* wm = p.in[I_WMOD] + (size_t)ll * DM * 6144 + (size_t)(wid * 128) * 6144 + j;
                float a0 = 0.f, a1 = 0.f, a2 = 0.f, a3 = 0.f, a4 = 0.f;
#pragma unroll 8
                for (int k = 0; k < 128; ++k) { const float w = wm[(size_t)k * 6144]; const int kk = wid * 128 + k; a0 = fmaf(sc[kk], w, a0); a1 = fmaf(sc[DM + kk], w, a1); a2 = fmaf(sc[2 * DM + kk], w, a2); a3 = fmaf(sc[3 * DM + kk], w, a3); a4 = fmaf(sc[4 * DM + kk], w, a4); }
                __syncthreads();
                red[(wid * 5 + 0) * 64 + lane] = a0; red[(wid * 5 + 1) * 64 + lane] = a1; red[(wid * 5 + 2) * 64 + lane] = a2; red[(wid * 5 + 3) * 64 + lane] = a3; red[(wid * 5 + 4) * 64 + lane] = a4;
                __syncthreads();
                if (tid < 320) { const int v = tid >> 6, c = tid & 63; float t = p.in[I_BMOD][ll * 6144 + (it % 96) * 64 + c];
#pragma unroll
                    for (int w8 = 0; w8 < 8; ++w8) t += red[(w8 * 5 + v) * 64 + c];
                    MOD[((size_t)ll * 5 + v) * 6144 + (it % 96) * 64 + c] = t; }
            }
            __syncthreads();
        }
        for (int idx = bid * 512 + tid; idx < 128 * 16; idx += nblk * 512) { const int pos = idx >> 4, i = idx & 15; float sn, cs; sincosf((float)pos * powf(10000.0f, -(float)i / 16.0f), &sn, &cs); ((float2*)(ws + WS_TAB))[idx] = make_float2(cs, sn); }
        {
            float* tl = (float*)smem; int base = 0;
            for (int ll = 0; ll < 2; ++ll) {
                transpose_mat(tl, p.in[I_WIN] + (size_t)ll * DM * DPROJ, DM, DPROJ, 3328, WT + WT_IN + ll * WT_IN_L, 1, 0, base, WScale{nullptr, PC_RQ, PC_RQ + 256, 0.125f, PC_NQ, PC_NQ + 512, 0.125f * 1.4426950408889634f});
                transpose_mat(tl, p.in[I_WUQ] + (size_t)ll * 384 * 384, 384, 384, 512, WT + WT_UQ + ll * WT_UQ_L, 1, 0, base, WScale{p.in[I_QN] + ll * 384, 0, 384, 0.10206207261596577f * 1.4426950408889634f, 0, 0, 1.f});
                transpose_mat(tl, p.in[I_WUKV] + (size_t)ll * 256 * 512, 256, 512, 512, WT + WT_UKV + ll * WT_UKV_L, 1, 0, base, WScale{p.in[I_KVN] + ll * 256, 0, 0, 1.f, 0, 0, 1.f});
                transpose_mat(tl, p.in[I_WOUT] + (size_t)ll * DM * DM, DM, DM, DM, WT + WT_OUT + ll * WT_OUT_L, 1, 0, base, WScale{nullptr, 0, 0, 1.f, 0, 0, 1.f});
                for (int e = 0; e < NE; ++e) {
                    transpose_mat(tl, p.in[I_W1] + ((size_t)ll * NE + e) * DM * FF, DM, FF, FF, WT + WT_13 + ll * WT_13_L + (size_t)e * 512 * 1024, 2, 0, base, WScale{nullptr, 0, 0, 1.f, 0, 0, 1.f});
                    transpose_mat(tl, p.in[I_W3] + ((size_t)ll * NE + e) * DM * FF, DM, FF, FF, WT + WT_13 + ll * WT_13_L + (size_t)e * 512 * 1024, 2, 1, base, WScale{nullptr, 0, 0, 1.f, 0, 0, 1.f});
                    transpose_mat(tl, p.in[I_W2] + ((size_t)ll * NE + e) * FF * DM, FF, DM, DM, WT + WT_2 + ll * WT_2_L + (size_t)e * 1024 * 256, 1, 0, base, WScale{nullptr, 0, 0, 1.f, 0, 0, 1.f});
                }
            }
        }
    }

    {
        const bool last = (l == 1);
        const float* modl = MOD + (size_t)l * 5 * 6144;
        const int rows_mix = last ? NLAT : NROW;

        if constexpr (KIND == 1) {
            const float* g = p.in[I_N1G] + l * DM; const float* modp = MOD + (size_t)(l - 1) * 5 * 6144;
            for (int row = bid * 8 + wid; row < NROW; row += nblk * 8) {
                const float* mv = modl + row_modv(row) * 6144;
                float4 x[4]; float ss = 0.f;
                if (l == 0) {
                    const float* h = row < NLAT ? p.in[I_X] + (size_t)row * DM : p.in[I_CTX] + (size_t)(row - NLAT) * DM;
#pragma unroll
                    for (int i = 0; i < 4; ++i) x[i] = *(const float4*)(h + lane * 4 + 256 * i);
                } else {
                    float* h = hrow2(Hlat, Hctx, row); const float* mg = modp + row_modv(row) * 6144 + 5120;
                    const int2 s2 = RTS[row]; const float2 w2 = RTW[row];
#pragma unroll
                    for (int i = 0; i < 4; ++i) {
                        const int c = lane * 4 + 256 * i;
                        const uint2 ya = *(const uint2*)(XS + (size_t)s2.x * DM + c), yb = *(const uint2*)(XS + (size_t)s2.y * DM + c);
                        float4 xx = *(const float4*)(h + c); const float4 gg = *(const float4*)(mg + c);
                        xx.x += gg.x * (w2.x * __uint_as_float(ya.x << 16) + w2.y * __uint_as_float(yb.x << 16));
                        xx.y += gg.y * (w2.x * __uint_as_float(ya.x & 0xffff0000u) + w2.y * __uint_as_float(yb.x & 0xffff0000u));
                        xx.z += gg.z * (w2.x * __uint_as_float(ya.y << 16) + w2.y * __uint_as_float(yb.y << 16));
                        xx.w += gg.w * (w2.x * __uint_as_float(ya.y & 0xffff0000u) + w2.y * __uint_as_float(yb.y & 0xffff0000u));
                        *(float4*)(h + c) = xx; x[i] = xx;
                    }
                }
#pragma unroll
                for (int i = 0; i < 4; ++i) ss += x[i].x * x[i].x + x[i].y * x[i].y + x[i].z * x[i].z + x[i].w * x[i].w;
                ss = wave_sum(ss);
                const float rstd = rsqrtf(ss * (1.f / DM) + 1e-6f);
#pragma unroll
                for (int i = 0; i < 4; ++i) {
                    const int c = lane * 4 + 256 * i;
                    const float4 gg = *(const float4*)(g + c), sh = *(const float4*)(mv + c), sc = *(const float4*)(mv + 1024 + c);
                    const float y0 = x[i].x * rstd * gg.x * (1.f + sc.x) + sh.x, y1 = x[i].y * rstd * gg.y * (1.f + sc.y) + sh.y;
                    const float y2 = x[i].z * rstd * gg.z * (1.f + sc.z) + sh.z, y3 = x[i].w * rstd * gg.w * (1.f + sc.w) + sh.w;
                    uint2 o; o.x = (unsigned)f2bf(y0) | ((unsigned)f2bf(y1) << 16); o.y = (unsigned)f2bf(y2) | ((unsigned)f2bf(y3) << 16);
                    *(uint2*)(U + (size_t)row * DM + c) = o;
                }
            }
        }
        if constexpr (KIND == 2) {
            pg8::Gemm g{U, WT + WT_IN + l * WT_IN_L, DM, DM, DM, nullptr}; pg8::StaticOrder S; S.init(NROW, 3328, nblk, bid);
            pg8::EpiP E{P, LDP, (float*)(ws + WS_PS)};
            pg8::gemm_phase<pg8::EpiP, pg8::StaticOrder, true, true>(lds3, g, S, E);
        }
        if constexpr (KIND == 14) {
            pg8::Gemm g{P + PC_CKV, WT + WT_UKV + l * WT_UKV_L, LDP, 256, 256, nullptr}; pg8::StaticOrder S; S.init(NROW, 512, nblk, bid);
            pg8::EpiUKV E{KM, VM, (const float*)(ws + WS_PS)};
            pg8::gemm_phase<pg8::EpiUKV, pg8::StaticOrder, true, true>(lds3, g, S, E);
        }
        if constexpr (KIND == 4) {
            {
                pg8::Gemm g{P + PC_CQ, WT + WT_UQ + l * WT_UQ_L, LDP, 384, 384, nullptr}; pg8::StaticOrder S; S.init(NROW, 512, nblk, bid);
                pg8::EpiUQ E{QM, (const float*)(ws + WS_PS)};
                pg8::gemm_phase<pg8::EpiUQ, pg8::StaticOrder, true, true>(lds3, g, S, E);
            }
            __syncthreads();
            for (int pi = bid; pi * 2 < RET_ITEMS; pi += nblk) rt::sum_pair(smem, pi * 2, RET_ITEMS, P, RKV, (const float2*)(ws + WS_TAB), p.in[I_RDF] + l * 4, p.in[I_RDB] + l * 4);
        }
        if constexpr (KIND == 5) {
            for (int row = bid * 8 + wid; row < NROW; row += nblk * 8) {
                const bool lat = row < NLAT; const int tt = row & (SEQ - 1);
                const float posr = (float)(tt >> 6), posc = (float)(tt & 63);
                if (lat) {
                    const int hd = lane >> 4, pp = lane & 15, sec = pp >> 3, ii = pp & 7;
                    bf16_t* b = QM + (size_t)row * 384 + hd * 96 + 64 + sec * 16 + ii;
                    float x1 = bf2f(b[0]), x2 = bf2f(b[8]);
                    rope_pair(x1, x2, sec ? posc : posr, ii, 8);
                    b[0] = f2bf(x1); b[8] = f2bf(x2);
                }
                if (lane < 16) {
                    const int sec = lane >> 3, ii = lane & 7;
                    const bf16_t* b = P + (size_t)row * LDP + PC_KPE + sec * 16 + ii;
                    float x1 = bf2f(b[0]), x2 = bf2f(b[8]);
                    if (lat) rope_pair(x1, x2, sec ? posc : posr, ii, 8);
                    const bf16_t y1 = f2bf(x1), y2 = f2bf(x2);
#pragma unroll
                    for (int hd = 0; hd < 4; ++hd) { bf16_t* k = KM + (size_t)row * 384 + hd * 96 + 64 + sec * 16 + ii; k[0] = y1; k[8] = y2; }
                }
            }
            {
                bf16_t* tl = (bf16_t*)smem;
                for (int it0 = bid * 4; it0 < 16 * 132; it0 += nblk * 4) {
                    __syncthreads();
#pragma unroll
                    for (int u = 0; u < 4; ++u) { const int it = it0 + u; if (it < 16 * 132) {
                        const int bh = it / 132, tile = it % 132, b = bh >> 2, hd = bh & 3;
                        const size_t row0 = tile < 128 ? (size_t)b * SEQ + tile * 64 : (size_t)NLAT + b * CTXL + (tile - 128) * 64;
                        const int r = tid >> 3, d8 = (tid & 7) * 8; const uint4 v = *(const uint4*)(VM + (row0 + r) * 256 + hd * 64 + d8);
                        unsigned* d = (unsigned*)(tl + u * 4224 + r * 66 + d8); d[0] = v.x; d[1] = v.y; d[2] = v.z; d[3] = v.w; } }
                    __syncthreads();
#pragma unroll
                    for (int u = 0; u < 4; ++u) { const int it = it0 + u; if (it < 16 * 132) {
                        const int dv = tid >> 3, g = tid & 7, s4 = g >> 1, hh = g & 1; unsigned short e[8];
#pragma unroll
                        for (int j = 0; j < 8; ++j) e[j] = tl[u * 4224 + (16 * s4 + 8 * (j >> 2) + 4 * hh + (j & 3)) * 66 + dv];
                        uint4 o; o.x = e[0] | ((unsigned)e[1] << 16); o.y = e[2] | ((unsigned)e[3] << 16); o.z = e[4] | ((unsigned)e[5] << 16); o.w = e[6] | ((unsigned)e[7] << 16);
                        *(uint4*)(VT + ((size_t)it * 64 + dv) * 64 + g * 8) = o; } }
                }
                __syncthreads();
            }
            {
                bf16_t* tl = (bf16_t*)smem;
                for (int it0 = bid * 4; it0 < 32 * 132; it0 += nblk * 4) {
                    __syncthreads();
#pragma unroll
                    for (int u = 0; u < 4; ++u) { const int it = it0 + u;
                        const int bh = it / 132, tile = it % 132, b = bh >> 3, hd = bh & 7;
                        const size_t row0 = tile < 128 ? (size_t)b * SEQ + tile * 64 : (size_t)NLAT + b * CTXL + (tile - 128) * 64;
                        const int r = tid >> 3, d8 = (tid & 7) * 8; const uint4 v = *(const uint4*)(P + (row0 + r) * LDP + PC_NV + hd * 64 + d8);
                        unsigned* d = (unsigned*)(tl + u * 4224 + r * 66 + d8); d[0] = v.x; d[1] = v.y; d[2] = v.z; d[3] = v.w; }
                    __syncthreads();
#pragma unroll
                    for (int u = 0; u < 4; ++u) { const int it = it0 + u;
                        const int dv = tid >> 3, g = tid & 7; unsigned short e[8];
#pragma unroll
                        for (int j = 0; j < 8; ++j) e[j] = tl[u * 4224 + (8 * g + j) * 66 + dv];
                        uint4 o; o.x = e[0] | ((unsigned)e[1] << 16); o.y = e[2] | ((unsigned)e[3] << 16); o.z = e[4] | ((unsigned)e[5] << 16); o.w = e[6] | ((unsigned)e[7] << 16);
                        *(uint4*)(NVT + ((size_t)it * 64 + dv) * 64 + g * 8) = o; }
                }
                __syncthreads();
            }
            for (int gid = bid * 512 + tid; gid < 2 * 16 * 4096; gid += nblk * 512) {
                const int el = gid & 4095, bh = (gid >> 12) & 15, dir = gid >> 16, hd = bh & 3;
                const float lg = log_sigmoid_f(dir ? p.in[I_RDB][l * 4 + hd] : p.in[I_RDF][l * 4 + hd]);
                const float g128 = expf(128.f * lg);
                float* c0p = RKV + ((size_t)(1024 + bh * 2 + 0) * 2 + dir) * 4096 + el;
                float* c1p = RKV + ((size_t)(1024 + bh * 2 + 1) * 2 + dir) * 4096 + el;
                const float c0 = *c0p, c1 = *c1p; float S;
                if (dir == 0) { *c0p = 0.f; *c1p = c0; S = g128 * c0 + c1; } else { *c1p = 0.f; *c0p = c1; S = g128 * c1 + c0; }
                float* qb = RKV + ((size_t)(bh * 64) * 2 + dir) * 4096 + el;
                float kv[64];
#pragma unroll
                for (int j = 0; j < 64; ++j) kv[j] = qb[(size_t)j * 8192];
                if (dir == 0) {
#pragma unroll
                    for (int j = 0; j < 64; ++j) { const float tmp = kv[j]; kv[j] = S; S = fmaf(g128, S, tmp); }
                } else {
#pragma unroll
                    for (int j = 63; j >= 0; --j) { const float tmp = kv[j]; kv[j] = S; S = fmaf(g128, S, tmp); }
                }
#pragma unroll
                for (int j = 0; j < 64; ++j) qb[(size_t)j * 8192] = kv[j];
            }
        }
        if constexpr (KIND == 6) {
            bf16_t* MIX = U;
            {
                const int n_mla = 512 + (last ? 0 : 16);
                for (int it = bid; it < n_mla; it += nblk) {
                    const bool cu = it >= 512; const int itl = it & 255, rnd = it >> 8;
                    const int bh = cu ? it - 512 : ((nblk == 256) ? (rnd * 8 + (itl & 7)) : (it >> 5)), qb = (nblk == 256) ? (itl >> 3) : (it & 31), b = bh >> 2, hd = bh & 3;
                    const size_t cr0 = (size_t)NLAT + b * CTXL, kr0 = (size_t)b * SEQ, r0 = cu ? cr0 : kr0 + qb * 256;
                    const bf16_t* k0 = KM + (cu ? cr0 : kr0) * 384 + hd * 96; const bf16_t* k1 = KM + cr0 * 384 + hd * 96;
                    fa::attn_unit<96>(smem, QM + r0 * 384 + hd * 96, 384, k0, cu ? 4 : 128, k1, cu ? 0 : 4, 384, VT + ((size_t)bh * 132 + (cu ? 128 : 0)) * 4096, MIX + r0 * DM + 768 + hd * 64, DM);
                }
            }
        }
        if constexpr (KIND == 15) {
            bf16_t* MIX = U;
            {
                const int n_na = 1024 + (last ? 0 : 32);
                for (int it = bid; it < n_na; it += nblk) {
                    const bool cu = it >= 1024; const int itl = it & 255, rnd = it >> 8;
                    const int bh = cu ? it - 1024 : ((nblk == 256) ? (rnd * 8 + (itl & 7)) : (it >> 5)), g = cu ? 0 : ((nblk == 256) ? (itl >> 3) : (it & 31));
                    na::na_unit(smem, cu, bh >> 3, bh & 7, g, P, NVT, p.in[I_RPB] + ((size_t)l * 8 + (bh & 7)) * 465, MIX);
                }
                __syncthreads();
            }
        }
        if constexpr (KIND == 16) {
            bf16_t* MIX = U;
            const int n_it = last ? 1024 : RET_ITEMS;
            for (int pi = bid; pi * 2 < n_it; pi += nblk) rt::ret_pair(smem, pi * 2, n_it, P, RKV, (const float2*)(ws + WS_TAB), p.in[I_RDF] + l * 4, p.in[I_RDB] + l * 4, MIX);
        }
        if constexpr (KIND == 7) {
            pg8::Gemm g{U, WT + WT_OUT + l * WT_OUT_L, DM, DM, DM, nullptr}; pg8::StaticOrder S; S.init(rows_mix, DM, nblk, bid);
            pg8::EpiOut E{Hlat, Hctx, l == 0 ? p.in[I_X] : Hlat, l == 0 ? p.in[I_CTX] : Hctx, modl + 2048};
            pg8::gemm_phase<pg8::EpiOut, pg8::StaticOrder, true, true>(lds3, g, S, E);
        }
        if constexpr (KIND == 8) {
            const float* g = p.in[I_N2G] + l * DM; const float* rb = p.in[I_RB];
            float* rwl = (float*)smem;
            int* hist = (int*)(smem + 69632); float* wl = (float*)(smem + 69632 + 64) + wid * 64;
            for (int idx = tid; idx < 1024 * 4; idx += 512) { const int c = idx >> 2, q = idx & 3; const float4 v = *(const float4*)(p.in[I_RW] + (size_t)c * 16 + q * 4); *(float4*)(rwl + (c >> 2) * 68 + (c & 3) * 16 + q * 4) = v; }
            for (int ch = bid; ch < 256; ch += nblk) {
                __syncthreads();
                if (tid < 16) hist[tid] = 0;
                __syncthreads();
                const int ngrp = 4 + ((!last && wid == 0) ? 1 : 0);
                for (int gi = 0; gi < ngrp; ++gi) {
                    const int row0 = gi < 4 ? ch * 128 + wid * 16 + gi * 4 : NLAT + ch * 4;
                    const float* mv = modl + row_modv(row0) * 6144;
                    float4 u[4][4]; float rstd[4];
#pragma unroll
                    for (int t = 0; t < 4; ++t) { const float* h = hrow2(Hlat, Hctx, row0 + t); float ss = 0.f;
#pragma unroll
                        for (int k = 0; k < 4; ++k) { u[t][k] = *(const float4*)(h + lane * 4 + 256 * k); ss += u[t][k].x * u[t][k].x + u[t][k].y * u[t][k].y + u[t][k].z * u[t][k].z + u[t][k].w * u[t][k].w; }
                        rstd[t] = rsqrtf(wave_sum(ss) * (1.f / DM) + 1e-6f); }
#pragma unroll
                    for (int k = 0; k < 4; ++k) { const int c = lane * 4 + 256 * k;
                        const float4 gg = *(const float4*)(g + c), sh = *(const float4*)(mv + 3072 + c), sc = *(const float4*)(mv + 4096 + c);
                        const float4 a = make_float4(gg.x * (1.f + sc.x), gg.y * (1.f + sc.y), gg.z * (1.f + sc.z), gg.w * (1.f + sc.w));
#pragma unroll
                        for (int t = 0; t < 4; ++t) { u[t][k].x = u[t][k].x * rstd[t] * a.x + sh.x; u[t][k].y = u[t][k].y * rstd[t] * a.y + sh.y; u[t][k].z = u[t][k].z * rstd[t] * a.z + sh.z; u[t][k].w = u[t][k].w * rstd[t] * a.w + sh.w; } }
#pragma unroll
                    for (int t = 0; t < 4; ++t)
#pragma unroll
                        for (int k = 0; k < 4; ++k) { uint2 o; o.x = pg8::cvt_pk_bf16(u[t][k].x, u[t][k].y); o.y = pg8::cvt_pk_bf16(u[t][k].z, u[t][k].w); *(uint2*)(U + (size_t)(row0 + t) * DM + lane * 4 + 256 * k) = o; }
                    float lg[64];
#pragma unroll
                    for (int i = 0; i < 64; ++i) lg[i] = 0.f;
#pragma unroll
                    for (int k = 0; k < 4; ++k) {
                        const float* wb = rwl + (lane + 64 * k) * 68;
#pragma unroll
                        for (int r = 0; r < 4; ++r) {
                            const float4 w0 = *(const float4*)(wb + r * 16), w1 = *(const float4*)(wb + r * 16 + 4), w2 = *(const float4*)(wb + r * 16 + 8), w3 = *(const float4*)(wb + r * 16 + 12);
#pragma unroll
                            for (int t = 0; t < 4; ++t) { const float us = r == 0 ? u[t][k].x : (r == 1 ? u[t][k].y : (r == 2 ? u[t][k].z : u[t][k].w));
                                lg[t * 16 + 0] = fmaf(us, w0.x, lg[t * 16 + 0]); lg[t * 16 + 1] = fmaf(us, w0.y, lg[t * 16 + 1]); lg[t * 16 + 2] = fmaf(us, w0.z, lg[t * 16 + 2]); lg[t * 16 + 3] = fmaf(us, w0.w, lg[t * 16 + 3]);
                                lg[t * 16 + 4] = fmaf(us, w1.x, lg[t * 16 + 4]); lg[t * 16 + 5] = fmaf(us, w1.y, lg[t * 16 + 5]); lg[t * 16 + 6] = fmaf(us, w1.z, lg[t * 16 + 6]); lg[t * 16 + 7] = fmaf(us, w1.w, lg[t * 16 + 7]);
                                lg[t * 16 + 8] = fmaf(us, w2.x, lg[t * 16 + 8]); lg[t * 16 + 9] = fmaf(us, w2.y, lg[t * 16 + 9]); lg[t * 16 + 10] = fmaf(us, w2.z, lg[t * 16 + 10]); lg[t * 16 + 11] = fmaf(us, w2.w, lg[t * 16 + 11]);
                                lg[t * 16 + 12] = fmaf(us, w3.x, lg[t * 16 + 12]); lg[t * 16 + 13] = fmaf(us, w3.y, lg[t * 16 + 13]); lg[t * 16 + 14] = fmaf(us, w3.z, lg[t * 16 + 14]); lg[t * 16 + 15] = fmaf(us, w3.w, lg[t * 16 + 15]); }
                        }
                    }
                    wl[lane] = reduce64(lg, lane);
                    asm volatile("s_waitcnt lgkmcnt(0)" ::: "memory");
                    if (lane < 4) {
                        float scv[16], sel[16];
#pragma unroll
                        for (int e = 0; e < 16; ++e) { scv[e] = 1.f / (1.f + expf(-wl[lane * 16 + e])); sel[e] = scv[e] + rb[e]; }
                        int best = 0; float bestv = -INFINITY;
#pragma unroll
                        for (int gI = 0; gI < 4; ++gI) {
                            float m1 = -INFINITY, m2 = -INFINITY;
#pragma unroll
                            for (int k = 0; k < 4; ++k) { const float v = sel[gI * 4 + k]; if (v > m1) { m2 = m1; m1 = v; } else if (v > m2) m2 = v; }
                            const float gs = m1 + m2; if (gs > bestv) { bestv = gs; best = gI; }
                        }
                        int ia = -1, ib = -1; float va = -INFINITY, vb = -INFINITY, wa = 0.f, wb2 = 0.f;
#pragma unroll
                        for (int e = 0; e < 16; ++e) {
                            if ((e >> 2) == best) { const float v = sel[e]; if (v > va) { vb = va; ib = ia; wb2 = wa; va = v; ia = e; wa = scv[e]; } else if (v > vb) { vb = v; ib = e; wb2 = scv[e]; } }
                        }
                        const float inv = 1.f / (wa + wb2); const int row = row0 + lane;
                        RTE[row] = make_int2(ia, ib); RTW[row] = make_float2(wa * inv, wb2 * inv); RTR[row] = lane == 0 ? rstd[0] : (lane == 1 ? rstd[1] : (lane == 2 ? rstd[2] : rstd[3]));
                        atomicAdd(&hist[ia], 1); atomicAdd(&hist[ib], 1);
                    }
                }
                __syncthreads();
                if (tid < 16) CNT[ch * 16 + tid] = hist[tid];
            }
        }
        if constexpr (KIND == 9) {
            const float* g = p.in[I_N2G] + l * DM;
            int* cnts = (int*)smem;
            int* tots = cnts + 4096; int* befo = tots + 16; int* offs = befo + 16; int* sla = offs + 32; int* slb = sla + 136; int* ea = slb + 136; int* eb = ea + 136;
            const int ntok = last ? 128 : 132;
            for (int ch = bid; ch < 256; ch += nblk) {
                __syncthreads();
                for (int i = tid; i < 4096; i += 512) cnts[i] = CNT[i];
                if (tid < ntok) { const int row = tid < 128 ? ch * 128 + tid : NLAT + ch * 4 + (tid - 128); const int2 e2 = RTE[row]; ea[tid] = e2.x; eb[tid] = e2.y; }
                __syncthreads();
                if (tid < 16) { int tot = 0, bef = 0; for (int c2 = 0; c2 < 256; ++c2) { const int v = cnts[c2 * 16 + tid]; bef += c2 < ch ? v : 0; tot += v; } tots[tid] = tot; befo[tid] = bef; }
                __syncthreads();
                if (tid == 0) { int o = 0; for (int e = 0; e < 16; ++e) { offs[e] = o; o += (tots[e] + 255) & ~255; } offs[16] = o; }
                __syncthreads();
                if (tid < 16) { int pos = offs[tid] + befo[tid]; for (int i = 0; i < ntok; ++i) { if (ea[i] == tid) sla[i] = pos++; else if (eb[i] == tid) slb[i] = pos++; } }
                if (ch == 0 && tid == 128) { int rt = 0; for (int e = 0; e < 16; ++e) { const int nte = (tots[e] + 255) >> 8; for (int k = 0; k < nte; ++k) { TILE[16 + 2 * rt] = e; TILE[17 + 2 * rt] = (offs[e] >> 8) + k; ++rt; } } TILE[0] = rt; }
                __syncthreads();
                int* TOK = (int*)(ws + WS_TOK);
                if (tid < ntok) { const int row = tid < 128 ? ch * 128 + tid : NLAT + ch * 4 + (tid - 128); const int sa = sla[tid], sb = slb[tid]; TOK[sa] = row; TOK[sb] = row; RTS[row] = make_int2(sa, sb); }
                if (ch == 0) for (int e = 0; e < 16; ++e) for (int sl = offs[e] + tots[e] + tid; sl < offs[e + 1]; sl += 512) TOK[sl] = 0;
            }
        }
        if constexpr (KIND == 10) {
            PG8_LAS int* ul = (PG8_LAS int*)(lds3 + 131072); const int nu = pg8::grouped_units(ul, TILE, 2, nblk, bid);
            pg8::Gemm g{U, WT + WT_13 + l * WT_13_L, DM, DM, DM, (const int*)(ws + WS_TOK)}; pg8::GroupedOrder S{ul, nu};
            pg8::EpiMoe1 E{HDN};
            pg8::gemm_phase<pg8::EpiMoe1, pg8::GroupedOrder, true, true, true>(lds3, g, S, E);
        }
        if constexpr (KIND == 11) {
            PG8_LAS int* ul = (PG8_LAS int*)(lds3 + 131072); const int nu = pg8::grouped_units(ul, TILE, 4, nblk, bid);
            pg8::Gemm g{HDN, WT + WT_2 + l * WT_2_L, FF, FF, FF, nullptr}; pg8::GroupedOrder S{ul, nu};
            pg8::EpiMoe2 E{XS};
            pg8::gemm_phase<pg8::EpiMoe2, pg8::GroupedOrder, true, true>(lds3, g, S, E);
        }
    }
    if constexpr (KIND == 13) {
        const float* g = p.in[I_FNG]; const float* modp = MOD + (size_t)1 * 5 * 6144;
        for (int row = bid * 8 + wid; row < NLAT; row += nblk * 8) {
            float* h = p.out + (size_t)row * DM; const float* mg = modp + row_modv(row) * 6144 + 5120;
            const int2 s2 = RTS[row]; const float2 w2 = RTW[row];
            float4 x[4]; float ss = 0.f;
#pragma unroll
            for (int i = 0; i < 4; ++i) {
                const int c = lane * 4 + 256 * i;
                const uint2 ya = *(const uint2*)(XS + (size_t)s2.x * DM + c), yb = *(const uint2*)(XS + (size_t)s2.y * DM + c);
                float4 xx = *(const float4*)(h + c); const float4 gg = *(const float4*)(mg + c);
                xx.x += gg.x * (w2.x * __uint_as_float(ya.x << 16) + w2.y * __uint_as_float(yb.x << 16));
                xx.y += gg.y * (w2.x * __uint_as_float(ya.x & 0xffff0000u) + w2.y * __uint_as_float(yb.x & 0xffff0000u));
                xx.z += gg.z * (w2.x * __uint_as_float(ya.y << 16) + w2.y * __uint_as_float(yb.y << 16));
                xx.w += gg.w * (w2.x * __uint_as_float(ya.y & 0xffff0000u) + w2.y * __uint_as_float(yb.y & 0xffff0000u));
                x[i] = xx; ss += xx.x * xx.x + xx.y * xx.y + xx.z * xx.z + xx.w * xx.w;
            }
            ss = wave_sum(ss);
            const float rstd = rsqrtf(ss * (1.f / DM) + 1e-6f);
#pragma unroll
            for (int i = 0; i < 4; ++i) { const int c = lane * 4 + 256 * i; const float4 gg = *(const float4*)(g + c); float4 y; y.x = x[i].x * rstd * gg.x; y.y = x[i].y * rstd * gg.y; y.z = x[i].z * rstd * gg.z; y.w = x[i].w * rstd * gg.w; *(float4*)(h + c) = y; }
        }
    }
}

constexpr int LDS_BYTES = 144 * 1024;
template <int KIND> __global__ void __launch_bounds__(512, 2) k_ph(Params p, int l) {
    extern __shared__ __attribute__((aligned(16))) char smem[];
    phase<KIND>(p, l, smem);
}
__device__ __forceinline__ void grid_sync(unsigned char* wsp, char* smem) {
    unsigned* bw = (unsigned*)(wsp + WS_CTL); asm volatile("" : "+s"(bw));
    XcdBarrier b; b.bar = bw; b.x = xb_xcc_id(); b.st = (volatile LAS unsigned*)(smem + LDS_BYTES - 16);
    xcd_barrier(b);
}
__global__ void __launch_bounds__(512, 2) k_one(Params p) {
    extern __shared__ __attribute__((aligned(16))) char smem[];
    {
        volatile LAS unsigned* st = (volatile LAS unsigned*)(smem + LDS_BYTES - 16);
        if (threadIdx.x == 0) { st[0] = 0u; st[1] = 0u; st[2] = 0u; st[3] = 0u; }
        __syncthreads();
        (void)xcd_barrier_post((unsigned*)(p.ws + WS_CTL), st);
    }
#define SYNC() grid_sync(p.ws, smem)
    phase<0>(p, 0, smem); SYNC();
    if (PROBE_SET == 1) { phase<0>(p, 0, smem); SYNC(); }
#define DUP(k, stmt) do { stmt; if (PROBE_SET == (k)) { SYNC(); stmt; } } while (0)
#define LAYER(l) \
        phase<1>(p, l, smem); SYNC(); \
        DUP(2, phase<2>(p, l, smem)); SYNC(); \
        DUP(8, phase<4>(p, l, smem); phase<14>(p, l, smem)); SYNC(); \
        phase<5>(p, l, smem); SYNC(); \
        DUP(3, phase<6>(p, l, smem)); DUP(4, phase<15>(p, l, smem)); DUP(5, phase<16>(p, l, smem)); SYNC(); \
        phase<7>(p, l, smem); SYNC(); \
        DUP(7, phase<8>(p, l, smem)); SYNC(); \
        DUP(9, phase<9>(p, l, smem)); SYNC(); \
        DUP(6, phase<10>(p, l, smem)); SYNC(); \
        DUP(6, phase<11>(p, l, smem)); SYNC();
    LAYER(0)
    LAYER(1)
#undef LAYER
    phase<13>(p, 0, smem);
#undef SYNC
}
template <int KIND> static void launch_ph(const Params& p, int l, int grid, hipStream_t stream) {
    static bool attr_done = false;
    if (!attr_done) { (void)hipFuncSetAttribute((const void*)k_ph<KIND>, hipFuncAttributeMaxDynamicSharedMemorySize, LDS_BYTES); attr_done = true; }
    hipLaunchKernelGGL(k_ph<KIND>, dim3(grid), dim3(512), LDS_BYTES, stream, p, l);
}

extern "C" void kernel_launch(void* const* d_in, const int* in_sizes, int n_in, void* d_out, int out_size, void* d_ws, size_t ws_size, hipStream_t stream) {
    (void)in_sizes; (void)n_in; (void)out_size; (void)ws_size;
    static int grid = 0;
    if (!grid) {
        int dev = 0, cus = 0; (void)hipGetDevice(&dev); (void)hipDeviceGetAttribute(&cus, hipDeviceAttributeMultiprocessorCount, dev);
        grid = cus > 0 ? cus : 256;
        (void)hipFuncSetAttribute((const void*)k_one, hipFuncAttributeMaxDynamicSharedMemorySize, LDS_BYTES);
    }
    Params p{};
    for (int i = 0; i < 23; ++i) p.in[i] = (const float*)d_in[i];
    p.out = (float*)d_out; p.ws = (unsigned char*)d_ws;
#ifdef MULTI_LAUNCH
    launch_ph<0>(p, 0, grid, stream);
    for (int l = 0; l < 2; ++l) {
        launch_ph<1>(p, l, grid, stream); launch_ph<2>(p, l, grid, stream); launch_ph<4>(p, l, grid, stream); launch_ph<14>(p, l, grid, stream);
        launch_ph<5>(p, l, grid, stream); launch_ph<6>(p, l, grid, stream); launch_ph<15>(p, l, grid, stream); launch_ph<16>(p, l, grid, stream); launch_ph<7>(p, l, grid, stream); launch_ph<8>(p, l, grid, stream);
        launch_ph<9>(p, l, grid, stream); launch_ph<10>(p, l, grid, stream); launch_ph<11>(p, l, grid, stream);
    }
    launch_ph<13>(p, 0, grid, stream);
#else
    (void)hipMemsetAsync((char*)d_ws + WS_CTL, 0, XCD_BAR_WORDS * sizeof(unsigned), stream);
    hipLaunchKernelGGL(k_one, dim3(grid), dim3(512), LDS_BYTES, stream, p);
#endif
}
```

```cpp
#include <hip/hip_runtime.h>
#include <stdint.h>
#include <math.h>

typedef unsigned short bf16_t;
#define LAS __attribute__((address_space(3)))

constexpr int DM = 1024, NB = 4, SEQ = 8192, GW = 64, CTXL = 256;
constexpr int NLAT = NB * SEQ;
constexpr int NCTX = NB * CTXL;
constexpr int NROW = NLAT + NCTX;
constexpr int DPROJ = 3232, LDP = 3328;
constexpr int PC_RQ = 0, PC_RK = 256, PC_RV = 512, PC_RG = 768, PC_NQ = 1024, PC_NK = 1536, PC_NV = 2048, PC_CQ = 2560, PC_CKV = 2944, PC_KPE = 3200;
constexpr int NE = 16, FF = 256;
constexpr int MAXSLOT = 2 * NROW + NE * 256;
constexpr int NCHUNK_TOK = 128;
constexpr int RET_ITEMS = 16 * 64 + 16 * 2;

constexpr size_t MiB = 1u << 20;
constexpr size_t WS_CTL = 0;
constexpr size_t WS_MOD = 1 * MiB;
constexpr size_t WS_HC = 2 * MiB;
constexpr size_t WS_RT = 6 * MiB;
constexpr size_t WS_U = 8 * MiB;
constexpr size_t WS_QM = 74 * MiB;
constexpr size_t WS_KM = 99 * MiB;
constexpr size_t WS_VM = 124 * MiB;
constexpr size_t WS_RKV = 141 * MiB;
constexpr size_t WS_P = 174 * MiB;
constexpr size_t WS_XS = WS_P;
constexpr size_t WS_HDN = WS_P + 140 * MiB;
constexpr size_t WS_WT = 389 * MiB;
constexpr size_t WT_IN = 0, WT_IN_L = (size_t)3328 * 1024;
constexpr size_t WT_UQ = WT_IN + 2 * WT_IN_L, WT_UQ_L = (size_t)512 * 384;
constexpr size_t WT_UKV = WT_UQ + 2 * WT_UQ_L, WT_UKV_L = (size_t)512 * 256;
constexpr size_t WT_OUT = WT_UKV + 2 * WT_UKV_L, WT_OUT_L = (size_t)1024 * 1024;
constexpr size_t WT_13 = WT_OUT + 2 * WT_OUT_L, WT_13_L = (size_t)16 * 512 * 1024;
constexpr size_t WT_2 = WT_13 + 2 * WT_13_L, WT_2_L = (size_t)16 * 1024 * 256;
constexpr size_t WT_END = WT_2 + 2 * WT_2_L;
static_assert(WS_WT + WT_END * 2 <= 512 * MiB, "workspace");
constexpr size_t WS_VT = 456 * MiB;
constexpr size_t WS_NVT = 473 * MiB;
static_assert(WS_NVT + (size_t)32 * 132 * 4096 * 2 <= 512 * MiB, "workspace");
constexpr size_t WS_PS = 506 * MiB;
constexpr size_t WS_TAB = 510 * MiB;
constexpr size_t WS_TOK = 1536 * 1024;
constexpr size_t RT_TILE = 1984 * 1024;
constexpr size_t RT_E = 0, RT_W = 512 * 1024, RT_RSTD = 1024 * 1024, RT_SLOT = 1280 * 1024, RT_CNT = 1792 * 1024, RT_SEG = 1920 * 1024;

struct Params { const float* in[23]; float* out; unsigned char* ws; int lo, hi; };
enum { I_X = 0, I_C, I_CTX, I_CCTX, I_WMOD, I_BMOD, I_N1G, I_N2G, I_WIN, I_RDF, I_RDB, I_RPB, I_QN, I_KVN, I_WUQ, I_WUKV, I_WOUT, I_RW, I_RB, I_W1, I_W3, I_W2, I_FNG };

__device__ __forceinline__ float bf2f(bf16_t v) { return __uint_as_float(((unsigned)v) << 16); }
__device__ __forceinline__ bf16_t f2bf(float f) { unsigned u = __float_as_uint(f); return (bf16_t)((u + 0x7fffu + ((u >> 16) & 1u)) >> 16); }
template <int CTRL> __device__ __forceinline__ float dpp_f(float v) { return __uint_as_float((unsigned)__builtin_amdgcn_mov_dpp((int)__float_as_uint(v), CTRL, 0xF, 0xF, true)); }
__device__ __forceinline__ float xor1_f(float v) { return dpp_f<0xB1>(v); }
__device__ __forceinline__ float xor2_f(float v) { return dpp_f<0x4E>(v); }
__device__ __forceinline__ float wave_sum(float v) {
    v += dpp_f<0xB1>(v); v += dpp_f<0x4E>(v); v += dpp_f<0x141>(v); v += dpp_f<0x140>(v);
    { auto r = __builtin_amdgcn_permlane16_swap(__float_as_uint(v), __float_as_uint(v), false, false); v = __uint_as_float(r[0]) + __uint_as_float(r[1]); }
    { auto r = __builtin_amdgcn_permlane32_swap(__float_as_uint(v), __float_as_uint(v), false, false); v = __uint_as_float(r[0]) + __uint_as_float(r[1]); }
    return v;
}
__device__ __forceinline__ float wave_max(float v) {
    v = fmaxf(v, dpp_f<0xB1>(v)); v = fmaxf(v, dpp_f<0x4E>(v)); v = fmaxf(v, dpp_f<0x141>(v)); v = fmaxf(v, dpp_f<0x140>(v));
    { auto r = __builtin_amdgcn_permlane16_swap(__float_as_uint(v), __float_as_uint(v), false, false); v = fmaxf(__uint_as_float(r[0]), __uint_as_float(r[1])); }
    { auto r = __builtin_amdgcn_permlane32_swap(__float_as_uint(v), __float_as_uint(v), false, false); v = fmaxf(__uint_as_float(r[0]), __uint_as_float(r[1])); }
    return v;
}
__device__ __forceinline__ int tid_() { int t = threadIdx.x; asm volatile("" : "+v"(t)); return t; }
__device__ __forceinline__ int bid_() { int b = blockIdx.x; asm volatile("" : "+s"(b)); return b; }
__device__ __forceinline__ float silu_f(float x) { return x / (1.f + expf(-x)); }
__device__ __forceinline__ int row_modv(int row) { return row < NLAT ? (row >> 13) : 4; }
__device__ __forceinline__ float* hrow2(float* hl, float* hc, int row) { return row < NLAT ? hl + (size_t)row * DM : hc + (size_t)(row - NLAT) * DM; }

#define XB_TMO      128
#define XB_XCNT(j)  (256  + 64 * (j))
#define XB_XSUB(j)  (1280 + 64 * (j))
#define XB_XGEN(j)  (2304 + 64 * (j))
#define XB_TOP      3328
#define XB_TOPGEN   3392
#define XCD_BAR_WORDS 3456
#define XB_SPIN_CAP (1u << 18)
__device__ __forceinline__ unsigned xb_ld(unsigned* p)              { return __hip_atomic_load(p, __ATOMIC_RELAXED, __HIP_MEMORY_SCOPE_AGENT); }
__device__ __forceinline__ unsigned xb_add(unsigned* p, unsigned v) { return __hip_atomic_fetch_add(p, v, __ATOMIC_RELAXED, __HIP_MEMORY_SCOPE_AGENT); }
__device__ __forceinline__ unsigned xb_xcc_id() { return (unsigned)__builtin_amdgcn_s_getreg((3 << 11) | 20) & 0xFu; }
#define XB_SPIN(cond, bar) do { unsigned _sp = 0; while (cond) { __builtin_amdgcn_s_sleep(1); \
    if ((++_sp & 255u) == 0u) { if (xb_ld(&(bar)[XB_TMO])) break; if (_sp > XB_SPIN_CAP) { atomicAdd(&(bar)[XB_TMO], 1u); break; } } } } while (0)
struct XcdBarrier { unsigned* bar; unsigned x; volatile LAS unsigned* st; };
__device__ __forceinline__ XcdBarrier xcd_barrier_post(unsigned* bar, volatile LAS unsigned* st) {
    XcdBarrier b; b.bar = bar; b.x = xb_xcc_id(); b.st = st;
    if (threadIdx.x == 0) (void)xb_add(&bar[XB_XCNT(b.x)], 1u);
    return b;
}
__device__ __forceinline__ void xcd_barrier_complete(unsigned* bar, unsigned x, unsigned& nloc, unsigned& nx) {
    const unsigned G = gridDim.x * gridDim.y * gridDim.z;
    unsigned sum, cnt, mine, sp = 0u;
    for (;;) {
        sum = 0u; cnt = 0u; mine = 0u;
#pragma unroll
        for (unsigned j = 0; j < 16; ++j) { const unsigned c = xb_ld(&bar[XB_XCNT(j)]); sum += c; cnt += (c > 0u) ? 1u : 0u; mine = (j == x) ? c : mine; }
        if (sum == G) break;
        __builtin_amdgcn_s_sleep(1);
        if ((++sp & 255u) == 0u) { if (xb_ld(&bar[XB_TMO])) break; if (sp > XB_SPIN_CAP) { atomicAdd(&bar[XB_TMO], 1u); break; } }
    }
    nloc = mine > 0u ? mine : 1u; nx = cnt > 0u ? cnt : 1u;
}
__device__ __forceinline__ void xcd_barrier(const XcdBarrier& b) {
    asm volatile("s_waitcnt vmcnt(0)" ::: "memory");
    __syncthreads();
    if (threadIdx.x == 0) {
        unsigned* bar = b.bar;
        __builtin_amdgcn_s_waitcnt(0);
        unsigned nloc = b.st[0], nx = b.st[1];
        if (nloc == 0u) { xcd_barrier_complete(bar, b.x, nloc, nx); b.st[0] = nloc; b.st[1] = nx; }
        const unsigned old = xb_add(&bar[XB_XSUB(b.x)], 1u);
        const unsigned gen = old / nloc;
        if (old + 1u == (gen + 1u) * nloc) {
            __builtin_amdgcn_fence(__ATOMIC_RELEASE, "agent");
            asm volatile("s_waitcnt vmcnt(0)" ::: "memory");
            const unsigned og = xb_add(&bar[XB_TOP], 1u);
            const unsigned tg = og / nx;
            if (og + 1u == (tg + 1u) * nx) xb_add(&bar[XB_TOPGEN], 1u);
            else XB_SPIN(xb_ld(&bar[XB_TOPGEN]) == tg, bar);
            __builtin_amdgcn_fence(__ATOMIC_ACQUIRE, "agent");
            xb_add(&bar[XB_XGEN(b.x)], 1u);
            asm volatile("s_waitcnt vmcnt(0)" ::: "memory");
        } else {
            XB_SPIN(xb_ld(&bar[XB_XGEN(b.x)]) == gen, bar);
            __builtin_amdgcn_fence(__ATOMIC_ACQUIRE, "agent");
            asm volatile("s_waitcnt vmcnt(0)" ::: "memory");
        }
    }
    __syncthreads();
}

struct SegInfo { const int* seg; size_t wstride; };
template <bool DUAL, class Epi>
__device__ __forceinline__ void gemm_simple(char* smem, const bf16_t* A, int lda, int M, const float* W, const float* W2, int ldw, int N, int K, SegInfo sg, const Epi& epi) {
    float* As = (float*)smem;
    float* Ws = As + 16 * 132;
    float* Ws2 = Ws + 16 * 68;
    const int t = tid_(), ty = t >> 4, tx = t & 15;
    const int ntm = (M + 127) / 128, ntn = (N + 63) / 64;
    for (int tile = blockIdx.x; tile < ntm * ntn; tile += gridDim.x) {
        const int tm = tile / ntn, tn = tile % ntn, m0 = tm * 128, n0 = tn * 64;
        const float* Wt = W; const float* Wt2 = W2; int mvalid = M;
        if (sg.seg) {
            int e = 0;
#pragma unroll
            for (int i = 1; i < 16; ++i) if (m0 >= sg.seg[i]) e = i;
            mvalid = sg.seg[e] + sg.seg[17 + e];
            if (m0 >= sg.seg[16] || m0 >= mvalid) continue;
            Wt = W + (size_t)e * sg.wstride; if (DUAL) Wt2 = W2 + (size_t)e * sg.wstride;
        }
        float acc[4][4], acc2[4][4];
#pragma unroll
        for (int i = 0; i < 4; ++i)
#pragma unroll
            for (int j = 0; j < 4; ++j) { acc[i][j] = 0.f; acc2[i][j] = 0.f; }
        for (int k0 = 0; k0 < K; k0 += 16) {
            {
                const int r = t >> 2, kq = (t & 3) * 4, row = m0 + r;
                uint2 v = make_uint2(0u, 0u);
                if (row < M) v = *(const uint2*)(A + (size_t)row * lda + k0 + kq);
                As[(kq + 0) * 132 + r] = __uint_as_float(v.x << 16);
                As[(kq + 1) * 132 + r] = __uint_as_float(v.x & 0xffff0000u);
                As[(kq + 2) * 132 + r] = __uint_as_float(v.y << 16);
                As[(kq + 3) * 132 + r] = __uint_as_float(v.y & 0xffff0000u);
            }
            {
                const int k = t >> 5, n = (t & 31) * 2, col = n0 + n;
                float2 w = make_float2(0.f, 0.f), w2 = make_float2(0.f, 0.f);
                if (col < N) { w = *(const float2*)(Wt + (size_t)(k0 + k) * ldw + col); if (DUAL) w2 = *(const float2*)(Wt2 + (size_t)(k0 + k) * ldw + col); }
                Ws[k * 68 + n] = w.x; Ws[k * 68 + n + 1] = w.y;
                if (DUAL) { Ws2[k * 68 + n] = w2.x; Ws2[k * 68 + n + 1] = w2.y; }
            }
            __syncthreads();
#pragma unroll
            for (int kk = 0; kk < 16; ++kk) {
                const float4 a = *(const float4*)&As[kk * 132 + ty * 4];
                const float4 w = *(const float4*)&Ws[kk * 68 + tx * 4];
                const float av[4] = {a.x, a.y, a.z, a.w}, wv[4] = {w.x, w.y, w.z, w.w};
#pragma unroll
                for (int i = 0; i < 4; ++i)
#pragma unroll
                    for (int j = 0; j < 4; ++j) acc[i][j] = fmaf(av[i], wv[j], acc[i][j]);
                if (DUAL) {
                    const float4 w2 = *(const float4*)&Ws2[kk * 68 + tx * 4];
                    const float wv2[4] = {w2.x, w2.y, w2.z, w2.w};
#pragma unroll
                    for (int i = 0; i < 4; ++i)
#pragma unroll
                        for (int j = 0; j < 4; ++j) acc2[i][j] = fmaf(av[i], wv2[j], acc2[i][j]);
                }
            }
            __syncthreads();
        }
#pragma unroll
        for (int i = 0; i < 4; ++i) {
            const int row = m0 + ty * 4 + i;
            if (row < M && row < mvalid) {
#pragma unroll
                for (int j = 0; j < 4; ++j) { const int col = n0 + tx * 4 + j; if (col < N) epi(row, col, acc[i][j], acc2[i][j]); }
            }
        }
    }
}

template <int DQK, int DV>
__device__ __forceinline__ void attn_simple(char* smem, const bf16_t* Q, int ldq, int nq, const bf16_t* K0, const bf16_t* V0, int n0, const bf16_t* K1, const bf16_t* V1, int n1,
                                            int ldk, int ldv, float qscale_log2, bf16_t* O, int ldo) {
    float* Ks = (float*)smem;
    float* Vs = Ks + 32 * DQK;
    const int t = tid_();
    const bool act = t < nq;
    float q[DQK];
#pragma unroll
    for (int c = 0; c < DQK; ++c) q[c] = act ? bf2f(Q[(size_t)t * ldq + c]) * qscale_log2 : 0.f;
    float o[DV];
#pragma unroll
    for (int e = 0; e < DV; ++e) o[e] = 0.f;
    float mrun = -INFINITY, lrun = 0.f;
    const int ntile = (n0 + n1) / 32;
    for (int tl = 0; tl < ntile; ++tl) {
        const int j0 = tl * 32;
        const bf16_t* Kp; const bf16_t* Vp;
        if (j0 < n0) { Kp = K0 + (size_t)j0 * ldk; Vp = V0 + (size_t)j0 * ldv; } else { Kp = K1 + (size_t)(j0 - n0) * ldk; Vp = V1 + (size_t)(j0 - n0) * ldv; }
        __syncthreads();
        for (int idx = t; idx < 32 * DQK; idx += 512) { const int r = idx / DQK, c = idx % DQK; Ks[idx] = bf2f(Kp[(size_t)r * ldk + c]); }
        for (int idx = t; idx < 32 * DV; idx += 512) { const int r = idx / DV, c = idx % DV; Vs[idx] = bf2f(Vp[(size_t)r * ldv + c]); }
        __syncthreads();
#pragma unroll 1
        for (int r = 0; r < 32; ++r) {
            float a = 0.f;
#pragma unroll
            for (int c = 0; c < DQK; c += 4) { const float4 kv = *(const float4*)&Ks[r * DQK + c]; a = fmaf(q[c], kv.x, a); a = fmaf(q[c + 1], kv.y, a); a = fmaf(q[c + 2], kv.z, a); a = fmaf(q[c + 3], kv.w, a); }
            if (a > mrun) {
                const float alpha = exp2f(mrun - a);
                mrun = a; lrun *= alpha;
#pragma unroll
                for (int e = 0; e < DV; ++e) o[e] *= alpha;
            }
            const float pr = exp2f(a - mrun);
            lrun += pr;
#pragma unroll
            for (int e = 0; e < DV; e += 4) { const float4 vv = *(const float4*)&Vs[r * DV + e]; o[e] = fmaf(pr, vv.x, o[e]); o[e + 1] = fmaf(pr, vv.y, o[e + 1]); o[e + 2] = fmaf(pr, vv.z, o[e + 2]); o[e + 3] = fmaf(pr, vv.w, o[e + 3]); }
        }
    }
    if (act) {
        const float inv = 1.f / lrun;
#pragma unroll
        for (int e = 0; e < DV; ++e) O[(size_t)t * ldo + e] = f2bf(o[e] * inv);
    }
    __syncthreads();
}

__device__ __forceinline__ void rope_pair(float& x1, float& x2, float pos, int i, int half) {
    const float inv = powf(10000.0f, -(float)i / (float)half);
    float sn, cs; sincosf(pos * inv, &sn, &cs);
    const float a = x1 * cs - x2 * sn, b = x2 * cs + x1 * sn; x1 = a; x2 = b;
}
__device__ __forceinline__ float log_sigmoid_f(float x) { return -log1pf(expf(-x)); }

namespace pg8 {
#define PG8_LAS __attribute__((address_space(3)))
typedef unsigned short bf16_t;
typedef short bf16x8 __attribute__((ext_vector_type(8)));
typedef float f32x4 __attribute__((ext_vector_type(4)));
typedef unsigned u32x4 __attribute__((ext_vector_type(4)));
constexpr int BM = 256, BK = 64, HALF = 128, HTB = HALF * BK * 2  , STAGE_BYTES = 8 * HTB, NXCD = 8, WGM = 8;

__host__ __device__ __forceinline__ int lds_byte(int r, int c) { const int st = (r >> 4) * 2 + (c >> 5), rr = r & 15, cc = c & 31, ob = rr * 64 + cc * 2; return st * 1024 + (ob ^ (((ob >> 9) & 1) << 5)); }
__host__ __device__ __forceinline__ void stage_rc(int b, int& R, int& C) { const int st = b / 1024, sb = b % 1024, swz = sb ^ (((sb >> 9) & 1) << 5); R = (st >> 1) * 16 + swz / 64; C = (st & 1) * 32 + (swz % 64) / 2; }
__host__ __device__ __forceinline__ int perm32(int rho) { const int n = rho >> 4, i = rho & 15; return 8 * (i >> 2) + 4 * n + (i & 3); }

struct Unit { int pm, pn; };
struct Gemm { const bf16_t* A; const bf16_t* Bt; int lda, ldb, K; const int* tok; };

typedef float f32x2c __attribute__((ext_vector_type(2))); typedef __bf16 bf16x2c __attribute__((ext_vector_type(2)));
__device__ __forceinline__ unsigned cvt_pk_bf16(float lo, float hi) { const f32x2c v = {lo, hi}; const bf16x2c b = __builtin_convertvector(v, bf16x2c); return __builtin_bit_cast(unsigned, b); }
template <class Epi, class Sched, bool ALIGN_EPI = false, bool SP2 = false, bool GATHER = false>
__device__ __forceinline__ void gemm_phase(PG8_LAS unsigned char* lds, const Gemm g, const Sched& S, const Epi& E) {
    const int tid = tid_(), wid = __builtin_amdgcn_readfirstlane(tid >> 6), lane = tid & 63, wr = wid >> 2, wc = wid & 3, fr = lane & 15, fq = lane >> 4;
    int K = g.K; asm volatile("" : "+s"(K));
    const int nt = K / BK;
    unsigned voffA[2], voffB[2];
#pragma unroll
    for (int i = 0; i < 2; ++i) { int R, C; stage_rc(tid * 16 + i * 8192, R, C); const int Rb = Epi::PERM ? ((R & ~31) + perm32(R & 31)) : R;
        voffA[i] = (unsigned)(R * g.lda + C) * 2u; voffB[i] = (unsigned)(Rb * g.ldb + C) * 2u; }
    const size_t kstep = (size_t)(BK * 2);
    static_assert(!GATHER || SP2, "the gather variant is written for the two-super-phase loop");
    const size_t hstepA = GATHER ? 0 : (size_t)HALF * g.lda * 2, hstepB = (size_t)HALF * g.ldb * 2;
    const size_t tstepA = 2 * hstepA  , tstepB = 2 * hstepB;
    const unsigned ldsw = (unsigned)wid * 1024u;
    const int aoff = lds_byte(wr * 64 + fr, fq * 8), boff = lds_byte(wc * 32 + fr, fq * 8);
#define PG8_SA(b, h) (((b) * 2 + (h)) * HTB)
#define PG8_SB(b, h) ((4 + (b) * 2 + (h)) * HTB)
#define PG8_STAGE(bufoff, gbase, voff) do { _Pragma("unroll") for (int _i = 0; _i < 2; ++_i) \
        __builtin_amdgcn_global_load_lds((const unsigned*)((const char*)(gbase) + (voff)[_i]), (PG8_LAS unsigned*)(lds + (bufoff) + ldsw + _i * 8192), 16, 0, 0); } while (0)
    unsigned vA[2][2], vN[2][2];
#define PG8_GOFF(V, pm_) do { _Pragma("unroll") for (int h_ = 0; h_ < 2; ++h_) _Pragma("unroll") for (int i_ = 0; i_ < 2; ++i_) { int R_, C_; stage_rc(tid * 16 + i_ * 8192, R_, C_); \
        V[h_][i_] = (unsigned)(g.tok[(pm_) * BM + h_ * HALF + R_] * g.lda + C_) * 2u; } } while (0)
#define PG8_STAGE_A(bufoff, gbase, h, nx) do { if constexpr (GATHER) { const unsigned vv_[2] = {(nx) ? vN[h][0] : vA[h][0], (nx) ? vN[h][1] : vA[h][1]}; PG8_STAGE(bufoff, gbase, vv_); } else { PG8_STAGE(bufoff, gbase, voffA); } } while (0)
#define PG8_LDA(dst, b, h) do { _Pragma("unroll") for (int m = 0; m < 4; ++m) _Pragma("unroll") for (int k = 0; k < 2; ++k) dst[m][k] = *(const PG8_LAS bf16x8*)(lds + PG8_SA(b, h) + aoff + m * 2048 + k * 1024); } while (0)
#define PG8_LDB(dst, b, h) do { _Pragma("unroll") for (int n = 0; n < 2; ++n) _Pragma("unroll") for (int k = 0; k < 2; ++k) dst[n][k] = *(const PG8_LAS bf16x8*)(lds + PG8_SB(b, h) + boff + n * 2048 + k * 1024); } while (0)
#define PG8_MMA(ai, bj, At, Bt) do { __builtin_amdgcn_s_setprio(1); _Pragma("unroll") for (int m = 0; m < 4; ++m) _Pragma("unroll") for (int n = 0; n < 2; ++n) _Pragma("unroll") for (int k = 0; k < 2; ++k) \
        acc[ai][bj][m][n] = __builtin_amdgcn_mfma_f32_16x16x32_bf16(Bt[n][k], At[m][k], acc[ai][bj][m][n], 0, 0, 0); __builtin_amdgcn_s_setprio(0); } while (0)
#define PG8_WAIT_V(n) asm volatile("s_waitcnt vmcnt(" #n ")" ::: "memory")
#define PG8_WAIT_L(n) asm volatile("s_waitcnt lgkmcnt(" #n ")" ::: "memory")
#define PG8_BAR __builtin_amdgcn_s_barrier()
#define PG8_SCHED __builtin_amdgcn_sched_barrier(0)
    Unit cur, nxt; int ui = 0;
    if (!S.next(0, cur)) return;
    f32x4 acc[2][2][4][2];
#pragma unroll
    for (int a = 0; a < 2; ++a)
#pragma unroll
        for (int b = 0; b < 2; ++b)
#pragma unroll
            for (int m = 0; m < 4; ++m)
#pragma unroll
                for (int n = 0; n < 2; ++n) acc[a][b][m][n] = (f32x4){0.f, 0.f, 0.f, 0.f};
    bf16x8 At[4][2], B0[2][2], B1[2][2];
    const char* cA = (const char*)g.A + (size_t)cur.pm * tstepA; const char* cB = (const char*)g.Bt + (size_t)cur.pn * tstepB;
    if constexpr (GATHER) { PG8_GOFF(vA, cur.pm); }
    S.a_ready(cur);
    if constexpr (SP2) {
        PG8_STAGE(PG8_SB(0, 0), cB, voffB); PG8_STAGE(PG8_SB(0, 1), cB + hstepB, voffB); PG8_STAGE_A(PG8_SA(0, 0), cA, 0, false); PG8_STAGE_A(PG8_SA(0, 1), cA + hstepA, 1, false);
        if (wr == 1) PG8_BAR;
        PG8_WAIT_V(2); PG8_BAR;
        PG8_STAGE(PG8_SB(1, 0), cB + kstep, voffB); PG8_STAGE_A(PG8_SA(1, 0), cA + kstep, 0, false); PG8_STAGE(PG8_SB(1, 1), cB + hstepB + kstep, voffB);
        PG8_WAIT_V(6); PG8_BAR;
    } else {
        PG8_STAGE(PG8_SB(0, 0), cB, voffB); PG8_STAGE(PG8_SA(0, 0), cA, voffA); PG8_STAGE(PG8_SB(0, 1), cB + hstepB, voffB); PG8_STAGE(PG8_SA(0, 1), cA + hstepA, voffA);
        if (wr == 1) PG8_BAR;
        PG8_WAIT_V(4); PG8_BAR;
        PG8_STAGE(PG8_SB(1, 0), cB + kstep, voffB); PG8_STAGE(PG8_SA(1, 0), cA + kstep, voffA); PG8_STAGE(PG8_SB(1, 1), cB + hstepB + kstep, voffB);
        PG8_WAIT_V(6); PG8_BAR;
    }
    for (;;) {
        const bool has_next = S.next(ui + 1, nxt);
        if constexpr (GATHER) { if (has_next) { PG8_GOFF(vN, nxt.pm); } else { _Pragma("unroll") for (int h_ = 0; h_ < 2; ++h_) { vN[h_][0] = vA[h_][0]; vN[h_][1] = vA[h_][1]; } } }
        const char* nA = has_next ? (const char*)g.A + (size_t)nxt.pm * tstepA : cA; const char* nB = has_next ? (const char*)g.Bt + (size_t)nxt.pn * tstepB : cB;
        for (int t = 0; t < nt; t += 2) {
            const bool last = (t == nt - 2);
            const char* a1 = cA + (size_t)(t + 1) * kstep;
            const char* a2 = last ? nA : cA + (size_t)(t + 2) * kstep; const char* b2 = last ? nB : cB + (size_t)(t + 2) * kstep;
            const char* a3 = a2 + kstep; const char* b3 = b2 + kstep;
            if (last && has_next) S.a_ready(nxt);
            if constexpr (SP2) {
            PG8_LDB(B0, 0, 0); PG8_LDB(B1, 0, 1); PG8_SCHED; PG8_LDA(At, 0, 0); PG8_STAGE_A(PG8_SA(1, 1), a1 + hstepA, 1, false);
            PG8_WAIT_V(8); PG8_WAIT_L(0); PG8_BAR; PG8_MMA(0, 0, At, B0); PG8_MMA(0, 1, At, B1); PG8_BAR; PG8_SCHED;
            PG8_LDA(At, 0, 1); PG8_STAGE(PG8_SB(0, 0), b2, voffB); PG8_STAGE(PG8_SB(0, 1), b2 + hstepB, voffB); PG8_STAGE_A(PG8_SA(0, 0), a2, 0, last);
            PG8_WAIT_V(8); PG8_WAIT_L(0); PG8_BAR; PG8_MMA(1, 0, At, B0); PG8_MMA(1, 1, At, B1); PG8_BAR; PG8_SCHED;
            PG8_LDB(B0, 1, 0); PG8_LDB(B1, 1, 1); PG8_SCHED; PG8_LDA(At, 1, 0); PG8_STAGE_A(PG8_SA(0, 1), a2 + hstepA, 1, last);
            PG8_WAIT_V(8); PG8_WAIT_L(0); PG8_BAR; PG8_MMA(0, 0, At, B0); PG8_MMA(0, 1, At, B1); PG8_BAR; PG8_SCHED;
            PG8_LDA(At, 1, 1); PG8_STAGE(PG8_SB(1, 0), b3, voffB); PG8_STAGE(PG8_SB(1, 1), b3 + hstepB, voffB); PG8_STAGE_A(PG8_SA(1, 0), a3, 0, last);
            PG8_WAIT_V(8); PG8_WAIT_L(0); PG8_BAR; PG8_MMA(1, 0, At, B0); PG8_MMA(1, 1, At, B1); PG8_BAR; PG8_SCHED;
            } else {
            PG8_LDB(B0, 0, 0); PG8_SCHED; PG8_LDA(At, 0, 0); PG8_STAGE(PG8_SA(1, 1), a1 + hstepA, voffA);
            PG8_WAIT_L(8); PG8_BAR; PG8_WAIT_L(0); PG8_MMA(0, 0, At, B0); PG8_BAR; PG8_SCHED;
            PG8_LDB(B1, 0, 1); PG8_STAGE(PG8_SB(0, 0), b2, voffB);
            PG8_BAR; PG8_WAIT_L(0); PG8_MMA(0, 1, At, B1); PG8_BAR;
            PG8_LDA(At, 0, 1); PG8_STAGE(PG8_SA(0, 0), a2, voffA);
            PG8_BAR; PG8_WAIT_L(0); PG8_MMA(1, 0, At, B0); PG8_BAR; PG8_SCHED;
            PG8_STAGE(PG8_SB(0, 1), b2 + hstepB, voffB);
            PG8_WAIT_V(6); PG8_BAR; PG8_MMA(1, 1, At, B1); PG8_BAR;
            PG8_LDB(B0, 1, 0); PG8_SCHED; PG8_LDA(At, 1, 0); PG8_STAGE(PG8_SA(0, 1), a2 + hstepA, voffA);
            PG8_WAIT_L(8); PG8_BAR; PG8_WAIT_L(0); PG8_MMA(0, 0, At, B0); PG8_BAR; PG8_SCHED;
            PG8_LDB(B1, 1, 1); PG8_STAGE(PG8_SB(1, 0), b3, voffB);
            PG8_BAR; PG8_WAIT_L(0); PG8_MMA(0, 1, At, B1); PG8_BAR;
            PG8_LDA(At, 1, 1); PG8_STAGE(PG8_SA(1, 0), a3, voffA);
            PG8_BAR; PG8_WAIT_L(0); PG8_MMA(1, 0, At, B0); PG8_BAR; PG8_SCHED;
            PG8_STAGE(PG8_SB(1, 1), b3 + hstepB, voffB);
            PG8_WAIT_V(6); PG8_BAR; PG8_MMA(1, 1, At, B1); PG8_BAR;
            }
        }
        if constexpr (ALIGN_EPI) { if (wr == 0) PG8_BAR; }
        if constexpr (!Epi::AFTER_DRAIN) { E(acc, cur, wr, wc, fr, fq); S.done(cur); }
        if (!has_next) break;
#pragma unroll
        for (int a = 0; a < 2; ++a)
#pragma unroll
            for (int b = 0; b < 2; ++b)
#pragma unroll
                for (int m = 0; m < 4; ++m)
#pragma unroll
                    for (int n = 0; n < 2; ++n) acc[a][b][m][n] = (f32x4){0.f, 0.f, 0.f, 0.f};
        cur = nxt; cA = nA; cB = nB; ++ui;
        if constexpr (GATHER) { _Pragma("unroll") for (int h_ = 0; h_ < 2; ++h_) { vA[h_][0] = vN[h_][0]; vA[h_][1] = vN[h_][1]; } }
        if constexpr (ALIGN_EPI) { if (wr == 1) PG8_BAR; }
    }
    PG8_WAIT_V(0);
    if constexpr (!ALIGN_EPI) { if (wr == 0) PG8_BAR; }
    PG8_BAR;
    if constexpr (Epi::AFTER_DRAIN) { E.fused(acc, cur, wr, wc, fr, fq, lds, wid, lane); S.done(cur); }
#undef PG8_SA
#undef PG8_SB
#undef PG8_STAGE
#undef PG8_LDA
#undef PG8_GOFF
#undef PG8_STAGE_A
#undef PG8_LDB
#undef PG8_MMA
#undef PG8_WAIT_V
#undef PG8_WAIT_L
#undef PG8_BAR
#undef PG8_SCHED
}


struct StaticOrder {
    int nM, nN, nwg, G, c;
    __device__ void init(int M, int N, int G_, int c_) { nM = M / BM; nN = N / BM; nwg = nM * nN; G = G_; c = c_; }
    __device__ bool next(int i, Unit& u) const {
        const long L = (long)i * G + c; if (L >= nwg) return false;
        int wgid = (int)L; { const int q = nwg / NXCD, r = nwg % NXCD, xcd = wgid % NXCD, off = wgid / NXCD; wgid = (xcd < r ? xcd * (q + 1) : r * (q + 1) + (xcd - r) * q) + off; }
        const int nig = WGM * nN, gid = wgid / nig, fm = gid * WGM, gsz = (nM - fm) < WGM ? (nM - fm) : WGM;
        u.pm = fm + ((wgid % nig) % gsz); u.pn = (wgid % nig) / gsz; return true;
    }
    __device__ __forceinline__ void a_ready(const Unit&) const {}
    __device__ __forceinline__ void done(const Unit&) const {}
};
struct GroupedOrder {
    const PG8_LAS int* list; int n;
    __device__ __forceinline__ bool next(int i, Unit& u) const { if (i >= n) return false; u.pm = __builtin_amdgcn_readfirstlane(list[2 * i]); u.pn = __builtin_amdgcn_readfirstlane(list[2 * i + 1]); return true; }
    __device__ __forceinline__ void a_ready(const Unit&) const {}
    __device__ __forceinline__ void done(const Unit&) const {}
};
__device__ __forceinline__ int grouped_units(PG8_LAS int* list, const int* tile, int ncol, int G, int c) {
#define TLD(i) ((int)__hip_atomic_load((const unsigned*)tile + (i), __ATOMIC_RELAXED, __HIP_MEMORY_SCOPE_AGENT))
    const int nrt = TLD(0); int n = 0;
    for (int i = 0; i < 16; ++i) { const int L = i * G + c, rt = L / ncol; if (rt >= nrt) break; if (threadIdx.x == 0) { list[2 * i] = TLD(17 + 2 * rt); list[2 * i + 1] = TLD(16 + 2 * rt) * ncol + (L % ncol); } ++n; }
#undef TLD
    __syncthreads();
    return n;
}
__device__ __forceinline__ u32x4 pack8(const f32x4& v0, const f32x4& v1) { u32x4 w; w.x = cvt_pk_bf16(v0[0], v0[1]); w.y = cvt_pk_bf16(v0[2], v0[3]); w.z = cvt_pk_bf16(v1[0], v1[1]); w.w = cvt_pk_bf16(v1[2], v1[3]); return w; }
#define EPI_ROWS_BEGIN _Pragma("unroll") for (int ai = 0; ai < 2; ++ai) _Pragma("unroll") for (int m = 0; m < 4; ++m) { const int row = u.pm * BM + ai * HALF + wr * 64 + m * 16 + fr; \
    _Pragma("unroll") for (int bj = 0; bj < 2; ++bj) { const f32x4 v0 = acc[ai][bj][m][0], v1 = acc[ai][bj][m][1];
#define EPI_ROWS_END } }
__device__ __forceinline__ float ssq32(const f32x4& v0, const f32x4& v1) {
    float q = (v0[0] * v0[0] + v0[1] * v0[1]) + (v0[2] * v0[2] + v0[3] * v0[3]) + (v1[0] * v1[0] + v1[1] * v1[1]) + (v1[2] * v1[2] + v1[3] * v1[3]);
    { auto r = __builtin_amdgcn_permlane16_swap(__float_as_uint(q), __float_as_uint(q), false, false); q = __uint_as_float(r[0]) + __uint_as_float(r[1]); }
    { auto r = __builtin_amdgcn_permlane32_swap(__float_as_uint(q), __float_as_uint(q), false, false); q = __uint_as_float(r[0]) + __uint_as_float(r[1]); }
    return q;
}
__device__ __forceinline__ void row_tile(int row, int& b, int& tl, int& key) { if (row < 32768) { b = row >> 13; tl = (row & 8191) >> 6; } else { const int r2 = row - 32768; b = r2 >> 8; tl = 128 + ((r2 & 255) >> 6); } key = row & 63; }
struct EpiP { static constexpr bool PERM = true, AFTER_DRAIN = false; bf16_t* O; int ldc; float* PS; bf16_t* NVT;
    __device__ __forceinline__ void operator()(const f32x4 (&acc)[2][2][4][2], const Unit& u, int wr, int wc, int fr, int fq) const {
        if (u.pn == 8 || u.pn == 9) {
            _Pragma("unroll") for (int ai = 0; ai < 2; ++ai) _Pragma("unroll") for (int m = 0; m < 4; ++m) { const int row = u.pm * BM + ai * HALF + wr * 64 + m * 16 + fr; int b, tl, key; row_tile(row, b, tl, key);
                _Pragma("unroll") for (int bj = 0; bj < 2; ++bj) { const int c0 = (u.pn - 8) * BM + bj * HALF + wc * 32 + 8 * fq, hd = c0 >> 6, dv0 = c0 & 63;
                    bf16_t* d = NVT + ((size_t)((b * 8 + hd) * 132 + tl) * 64 + dv0) * 64 + key; const u32x4 w = pack8(acc[ai][bj][m][0], acc[ai][bj][m][1]);
                    d[0] = (bf16_t)(w.x & 0xffff); d[64] = (bf16_t)(w.x >> 16); d[128] = (bf16_t)(w.y & 0xffff); d[192] = (bf16_t)(w.y >> 16);
                    d[256] = (bf16_t)(w.z & 0xffff); d[320] = (bf16_t)(w.z >> 16); d[384] = (bf16_t)(w.w & 0xffff); d[448] = (bf16_t)(w.w >> 16); } }
            return;
        }
        EPI_ROWS_BEGIN const int col = u.pn * BM + bj * HALF + wc * 32 + 8 * fq; *(u32x4*)(O + (size_t)row * ldc + col) = pack8(v0, v1);
            if (u.pn >= 10) { const float q = ssq32(v0, v1); if (fq == 0) PS[(size_t)row * 24 + (u.pn - 10) * 8 + bj * 4 + wc] = q; } EPI_ROWS_END } };
struct EpiUQ { static constexpr bool PERM = true, AFTER_DRAIN = false; bf16_t* Q; const float* PS;
    __device__ __forceinline__ void operator()(const f32x4 (&acc)[2][2][4][2], const Unit& u, int wr, int wc, int fr, int fq) const {
        _Pragma("unroll") for (int ai = 0; ai < 2; ++ai) _Pragma("unroll") for (int m = 0; m < 4; ++m) { const int row = u.pm * BM + ai * HALF + wr * 64 + m * 16 + fr;
            const f32x4 s0 = *(const f32x4*)(PS + (size_t)row * 24), s1 = *(const f32x4*)(PS + (size_t)row * 24 + 4), s2 = *(const f32x4*)(PS + (size_t)row * 24 + 8);
            const float rstd = rsqrtf(((s0[0] + s0[1]) + (s0[2] + s0[3]) + (s1[0] + s1[1]) + (s1[2] + s1[3]) + (s2[0] + s2[1]) + (s2[2] + s2[3])) * (1.f / 384.f) + 1e-6f);
            _Pragma("unroll") for (int bj = 0; bj < 2; ++bj) { const int col = u.pn * BM + bj * HALF + wc * 32 + 8 * fq;
                if (col < 384) *(u32x4*)(Q + (size_t)row * 384 + col) = pack8(acc[ai][bj][m][0] * rstd, acc[ai][bj][m][1] * rstd); } } } };
struct EpiUKV { static constexpr bool PERM = true, AFTER_DRAIN = false; bf16_t* Kn; bf16_t* VT; const float* PS;
    __device__ __forceinline__ void operator()(const f32x4 (&acc)[2][2][4][2], const Unit& u, int wr, int wc, int fr, int fq) const {
        _Pragma("unroll") for (int ai = 0; ai < 2; ++ai) _Pragma("unroll") for (int m = 0; m < 4; ++m) { const int row = u.pm * BM + ai * HALF + wr * 64 + m * 16 + fr;
            const f32x4 s0 = *(const f32x4*)(PS + (size_t)row * 24 + 12), s1 = *(const f32x4*)(PS + (size_t)row * 24 + 16);
            const float rstd = rsqrtf(((s0[0] + s0[1]) + (s0[2] + s0[3]) + (s1[0] + s1[1]) + (s1[2] + s1[3])) * (1.f / 256.f) + 1e-6f);
            if (wc < 2) {
                _Pragma("unroll") for (int bj = 0; bj < 2; ++bj) { const int hd = u.pn * 2 + bj; *(u32x4*)(Kn + (size_t)row * 384 + hd * 96 + wc * 32 + 8 * fq) = pack8(acc[ai][bj][m][0] * rstd, acc[ai][bj][m][1] * rstd); }
            } else {
                int b, tl, key; row_tile(row, b, tl, key); const int c = key & 15, slot = (key & 48) + 8 * ((c >> 2) & 1) + 4 * (c >> 3) + (c & 3), dv0 = (wc - 2) * 32 + 8 * fq;
                _Pragma("unroll") for (int bj = 0; bj < 2; ++bj) { const int hd = u.pn * 2 + bj; bf16_t* d = VT + ((size_t)((b * 4 + hd) * 132 + tl) * 64 + dv0) * 64 + slot; const u32x4 w = pack8(acc[ai][bj][m][0] * rstd, acc[ai][bj][m][1] * rstd);
                    d[0] = (bf16_t)(w.x & 0xffff); d[64] = (bf16_t)(w.x >> 16); d[128] = (bf16_t)(w.y & 0xffff); d[192] = (bf16_t)(w.y >> 16);
                    d[256] = (bf16_t)(w.z & 0xffff); d[320] = (bf16_t)(w.z >> 16); d[384] = (bf16_t)(w.w & 0xffff); d[448] = (bf16_t)(w.w >> 16); }
            } } } };
struct EpiOut { static constexpr bool PERM = true, AFTER_DRAIN = false; float* hl; float* hc; const float* rl; const float* rc; const float* gate;
    __device__ __forceinline__ void operator()(const f32x4 (&acc)[2][2][4][2], const Unit& u, int wr, int wc, int fr, int fq) const {
        EPI_ROWS_BEGIN const int col = u.pn * BM + bj * HALF + wc * 32 + 8 * fq;
            const size_t off = (row < 32768 ? (size_t)row * 1024 : (size_t)(row - 32768) * 1024) + col;
            float* h = (row < 32768 ? hl : hc) + off; const float* r = (row < 32768 ? rl : rc) + off; const float* g = gate + (row < 32768 ? (row >> 13) : 4) * 6144 + col;
            const f32x4 g0 = *(const f32x4*)g, g1 = *(const f32x4*)(g + 4); f32x4 h0 = *(const f32x4*)r, h1 = *(const f32x4*)(r + 4);
            h0 = h0 + g0 * v0; h1 = h1 + g1 * v1; *(f32x4*)h = h0; *(f32x4*)(h + 4) = h1; EPI_ROWS_END } };
__device__ __forceinline__ float silu_fast(float x) { return x / (1.f + __expf(-x)); }
struct EpiMoe1 { static constexpr bool PERM = true, AFTER_DRAIN = false; bf16_t* Hd;
    __device__ __forceinline__ void operator()(const f32x4 (&acc)[2][2][4][2], const Unit& u, int wr, int wc, int fr, int fq) const {
        EPI_ROWS_BEGIN const int col = (u.pn & 1) * BM + bj * HALF + wc * 32 + 8 * fq;
            uint2 w; w.x = cvt_pk_bf16(silu_fast(v0[0]) * v0[1], silu_fast(v0[2]) * v0[3]); w.y = cvt_pk_bf16(silu_fast(v1[0]) * v1[1], silu_fast(v1[2]) * v1[3]);
            *(uint2*)(Hd + (size_t)row * 256 + (col >> 1)) = w; EPI_ROWS_END } };
struct EpiMoe2 { static constexpr bool PERM = true, AFTER_DRAIN = false; bf16_t* Y;
    __device__ __forceinline__ void operator()(const f32x4 (&acc)[2][2][4][2], const Unit& u, int wr, int wc, int fr, int fq) const {
        EPI_ROWS_BEGIN const int col = (u.pn & 3) * BM + bj * HALF + wc * 32 + 8 * fq; *(u32x4*)(Y + (size_t)row * 1024 + col) = pack8(v0, v1); EPI_ROWS_END } };
}

struct WScale { const float* rowgain; int c0lo, c0hi; float s0; int c1lo, c1hi; float s1; };
__device__ __forceinline__ void transpose_tile(float* tl, const float* W, int K, int N, bf16_t* dst, int rs, int ro, int tile, int ntn, const WScale& ws_) {
    const int t = tid_(), k0 = (tile / ntn) * 64, n0 = (tile % ntn) * 64;
    __syncthreads();
    { const int k = t >> 3, n8 = (t & 7) * 8; const float rg = ws_.rowgain ? ws_.rowgain[k0 + k] : 1.f;
      float wv[8];
      if (n0 + n8 + 8 <= N) { const float4 a = *(const float4*)(W + (size_t)(k0 + k) * N + n0 + n8), b = *(const float4*)(W + (size_t)(k0 + k) * N + n0 + n8 + 4);
          wv[0] = a.x; wv[1] = a.y; wv[2] = a.z; wv[3] = a.w; wv[4] = b.x; wv[5] = b.y; wv[6] = b.z; wv[7] = b.w; }
      else {
#pragma unroll
          for (int i = 0; i < 8; ++i) wv[i] = (n0 + n8 + i) < N ? W[(size_t)(k0 + k) * N + n0 + n8 + i] : 0.f; }
#pragma unroll
      for (int i = 0; i < 8; ++i) { const int n = n0 + n8 + i; const float cs = (n >= ws_.c0lo && n < ws_.c0hi) ? ws_.s0 : ((n >= ws_.c1lo && n < ws_.c1hi) ? ws_.s1 : 1.f);
          tl[k * 65 + n8 + i] = wv[i] * rg * cs; } }
    __syncthreads();
    { const int n = t >> 3, k8 = (t & 7) * 8; uint4 o;
      o.x = (unsigned)f2bf(tl[(k8 + 0) * 65 + n]) | ((unsigned)f2bf(tl[(k8 + 1) * 65 + n]) << 16); o.y = (unsigned)f2bf(tl[(k8 + 2) * 65 + n]) | ((unsigned)f2bf(tl[(k8 + 3) * 65 + n]) << 16);
      o.z = (unsigned)f2bf(tl[(k8 + 4) * 65 + n]) | ((unsigned)f2bf(tl[(k8 + 5) * 65 + n]) << 16); o.w = (unsigned)f2bf(tl[(k8 + 6) * 65 + n]) | ((unsigned)f2bf(tl[(k8 + 7) * 65 + n]) << 16);
      *(uint4*)(dst + (size_t)((n0 + n) * rs + ro) * K + k0 + k8) = o; }
}
__device__ __forceinline__ void transpose_mat(float* tl, const float* W, int K, int N, int Npad, bf16_t* dst, int rs, int ro, int& base, const WScale& ws_) {
    const int ntn = Npad / 64, nt = (K / 64) * ntn, G = gridDim.x;
    const int first = (((int)blockIdx.x - base) % G + G) % G;
    for (int tile = first; tile < nt; tile += G) transpose_tile(tl, W, K, N, dst, rs, ro, tile, ntn, ws_);
    base = (base + nt) % G;
}


namespace fa {
typedef short bf16x8 __attribute__((ext_vector_type(8)));
typedef float f32x16 __attribute__((ext_vector_type(16)));
typedef unsigned u32x4 __attribute__((ext_vector_type(4)));
__device__ __forceinline__ int crow(int r, int hi) { return (r & 3) + 8 * (r >> 2) + 4 * hi; }
__device__ __forceinline__ unsigned cvtpk(float lo, float hi) { return pg8::cvt_pk_bf16(lo, hi); }
__device__ __forceinline__ float max3f(float a, float b, float c) { return __builtin_fmaxf(__builtin_fmaxf(a, b), c); }
__device__ __forceinline__ float xhalf_max(float m) { auto rr = __builtin_amdgcn_permlane32_swap(__float_as_uint(m), __float_as_uint(m), false, false); return fmaxf(__uint_as_float(rr[0]), __uint_as_float(rr[1])); }
__device__ __forceinline__ float xhalf_sum(float m) { auto rr = __builtin_amdgcn_permlane32_swap(__float_as_uint(m), __float_as_uint(m), false, false); return __uint_as_float(rr[0]) + __uint_as_float(rr[1]); }
template <int DQK> struct Lds { static constexpr int KP = DQK * 2 + 16, VP = 144, KB = 64 * KP, VB = 64 * VP, K0 = 0, V0 = 3 * KB, WSF = V0 + 3 * VB, OST = WSF + 8 * 64 * 4, BYTES = OST + 8 * 4096; };
template <int DQK>
__device__ __forceinline__ void attn_unit(char* smem, const bf16_t* Q, int ldq, const bf16_t* K0, int nt0, const bf16_t* K1, int nt1, int ldk, const bf16_t* VT, bf16_t* O, int ldo) {
    typedef Lds<DQK> L; constexpr int KC = DQK / 8, NKC = 64 * KC, NKS = DQK / 16; constexpr float THR = 8.f;
    const int tid = tid_(), lane = tid & 63, r32 = lane & 31, hi = lane >> 5; const int wid = __builtin_amdgcn_readfirstlane(tid >> 6);
    float* wsf = (float*)(smem + L::WSF) + wid * 64;
    bf16x8 qf[NKS];
#pragma unroll
    for (int ks = 0; ks < NKS; ++ks) qf[ks] = *(const bf16x8*)(Q + (size_t)(wid * 32 + r32) * ldq + ks * 16 + hi * 8);
    f32x16 o0, o1, negm;
#pragma unroll
    for (int r = 0; r < 16; ++r) { o0[r] = 0.f; o1[r] = 0.f; negm[r] = 0.f; }
    float mhat = 0.f, lsum = 0.f; bool resc = false;
    const int NT = nt0 + nt1;
    const int kr0 = tid / KC, kc0 = tid % KC, kr1 = (tid + 512) / KC, kc1 = (tid + 512) % KC; const bool has1 = (tid + 512) < NKC;
    const int vdv = tid >> 3, vg = tid & 7;
    uint4 sk0, sk1 = make_uint4(0u, 0u, 0u, 0u), sv;
    u32x4 w0, w1, w2, w3;
    f32x16 pA0, pA1, pB0, pB1;
#define FA_SB() __builtin_amdgcn_sched_barrier(0)
#define FA_GLOAD(t) do { const bf16_t* kt = ((t) < nt0) ? K0 + (size_t)(t) * 64 * ldk : K1 + (size_t)((t) - nt0) * 64 * ldk; \
        sk0 = *(const uint4*)(kt + (size_t)kr0 * ldk + kc0 * 8); if (has1) sk1 = *(const uint4*)(kt + (size_t)kr1 * ldk + kc1 * 8); \
        sv = *(const uint4*)(VT + (size_t)(t) * 4096 + tid * 8); } while (0)
#define FA_SWRITE(bo) do { *(uint4*)(smem + L::K0 + (bo) * L::KB + kr0 * L::KP + kc0 * 16) = sk0; if (has1) *(uint4*)(smem + L::K0 + (bo) * L::KB + kr1 * L::KP + kc1 * 16) = sk1; \
        *(uint4*)(smem + L::V0 + (bo) * L::VB + vdv * L::VP + vg * 16) = sv; } while (0)
#define FA_QK(P0, P1, bo) do { const char* kb = smem + L::K0 + (bo) * L::KB + r32 * L::KP + hi * 16; P0 = negm; P1 = negm; __builtin_amdgcn_s_setprio(1); \
        _Pragma("unroll") for (int ks = 0; ks < NKS; ++ks) { const bf16x8 a0 = *(const bf16x8*)(kb + ks * 32), a1 = *(const bf16x8*)(kb + 32 * L::KP + ks * 32); \
            P0 = __builtin_amdgcn_mfma_f32_32x32x16_bf16(a0, qf[ks], P0, 0, 0, 0); P1 = __builtin_amdgcn_mfma_f32_32x32x16_bf16(a1, qf[ks], P1, 0, 0, 0); } __builtin_amdgcn_s_setprio(0); } while (0)
#define FA_PARTIAL(P0, P1, FIRST) do { float rm = max3f(P0[0], P1[0], P0[1]); rm = max3f(rm, P1[1], P0[2]); rm = max3f(rm, P1[2], P0[3]); rm = max3f(rm, P1[3], P0[4]); \
        _Pragma("unroll") for (int r = 4; r < 15; ++r) rm = max3f(rm, P1[r], P0[r + 1]); \
        rm = fmaxf(rm, P1[15]); \
        rm = xhalf_max(rm); resc = false; \
        if ((FIRST) || __any(rm > THR)) { const float dl = (FIRST) ? rm : fmaxf(rm, 0.f); mhat += dl; \
            _Pragma("unroll") for (int r = 0; r < 16; ++r) { P0[r] -= dl; P1[r] -= dl; negm[r] = -mhat; } \
            if (!(FIRST)) { const float f = __builtin_amdgcn_exp2f(-dl); lsum *= f; if (hi == 0) wsf[r32] = f; resc = true; } } \
        _Pragma("unroll") for (int r = 0; r < 16; ++r) P0[r] = __builtin_amdgcn_exp2f(P0[r]); } while (0)
#define FA_FINISH(P0, P1) do { float ps = 0.f; \
        _Pragma("unroll") for (int r = 0; r < 16; ++r) { P1[r] = __builtin_amdgcn_exp2f(P1[r]); ps += P0[r] + P1[r]; } \
        lsum += ps; \
        w0.x = cvtpk(P0[0], P0[1]); w0.y = cvtpk(P0[2], P0[3]); w0.z = cvtpk(P0[4], P0[5]); w0.w = cvtpk(P0[6], P0[7]); \
        w1.x = cvtpk(P0[8], P0[9]); w1.y = cvtpk(P0[10], P0[11]); w1.z = cvtpk(P0[12], P0[13]); w1.w = cvtpk(P0[14], P0[15]); \
        w2.x = cvtpk(P1[0], P1[1]); w2.y = cvtpk(P1[2], P1[3]); w2.z = cvtpk(P1[4], P1[5]); w2.w = cvtpk(P1[6], P1[7]); \
        w3.x = cvtpk(P1[8], P1[9]); w3.y = cvtpk(P1[10], P1[11]); w3.z = cvtpk(P1[12], P1[13]); w3.w = cvtpk(P1[14], P1[15]); } while (0)
#define FA_PV1(W, s, vb) do { const bf16x8 pa = __builtin_bit_cast(bf16x8, W); \
        const bf16x8 v0 = *(const bf16x8*)((vb) + (s) * 32), v1 = *(const bf16x8*)((vb) + 32 * L::VP + (s) * 32); \
        o0 = __builtin_amdgcn_mfma_f32_32x32x16_bf16(pa, v0, o0, 0, 0, 0); o1 = __builtin_amdgcn_mfma_f32_32x32x16_bf16(pa, v1, o1, 0, 0, 0); } while (0)
#define FA_PV(bo) do { const char* vb_ = smem + L::V0 + (bo) * L::VB + r32 * L::VP + hi * 16; __builtin_amdgcn_s_setprio(1); FA_PV1(w0, 0, vb_); FA_PV1(w1, 1, vb_); FA_PV1(w2, 2, vb_); FA_PV1(w3, 3, vb_); __builtin_amdgcn_s_setprio(0); } while (0)
#define FA_RESC() do { if (resc) { asm volatile("s_waitcnt lgkmcnt(0)" ::: "memory"); \
        _Pragma("unroll") for (int r = 0; r < 16; ++r) { const float fr = wsf[crow(r, hi)]; o0[r] *= fr; o1[r] *= fr; } } } while (0)
#define FA_STEP(C0, C1, P0, P1, t) do { \
        if ((t) + 1 < NT) FA_SWRITE(bn);         \
        if ((t) + 2 < NT) FA_GLOAD((t) + 2); \
        FA_SB(); FA_QK(C0, C1, bc); FA_FINISH(P0, P1); FA_SB(); \
        FA_PV(bp); FA_PARTIAL(C0, C1, false); \
        FA_RESC(); \
        __syncthreads(); \
        { const int nb = bp; bp = bc; bc = bn; bn = nb; } } while (0)
    __syncthreads();
    FA_GLOAD(0); FA_SWRITE(0);
    FA_GLOAD(1); FA_SWRITE(1);
    if (2 < NT) FA_GLOAD(2);
    __syncthreads();
    FA_QK(pA0, pA1, 0); FA_PARTIAL(pA0, pA1, true);
    int bp = 0, bc = 1, bn = 2;
    for (int t = 1; t + 1 < NT; t += 2) {
        FA_STEP(pB0, pB1, pA0, pA1, t);
        FA_STEP(pA0, pA1, pB0, pB1, t + 1);
    }
    FA_STEP(pB0, pB1, pA0, pA1, NT - 1);
    FA_FINISH(pB0, pB1); FA_PV(bp);
#undef FA_STEP
#undef FA_RESC
#undef FA_PV
#undef FA_PV1
#undef FA_FINISH
#undef FA_PARTIAL
#undef FA_QK
#undef FA_GLOAD
#undef FA_SWRITE
#undef FA_SB
    lsum = xhalf_sum(lsum);
    if (hi == 0) wsf[32 + r32] = lsum;
    asm volatile("s_waitcnt lgkmcnt(0)" ::: "memory");
    bf16_t* stg = (bf16_t*)(smem + L::OST) + wid * 2048;
#pragma unroll
    for (int r = 0; r < 16; ++r) { const int orow = crow(r, hi); const float rl = 1.f / wsf[32 + orow]; stg[orow * 64 + r32] = f2bf(o0[r] * rl); stg[orow * 64 + 32 + r32] = f2bf(o1[r] * rl); }
    asm volatile("s_waitcnt lgkmcnt(0)" ::: "memory");
#pragma unroll
    for (int i = 0; i < 4; ++i) { const int row = i * 8 + (lane >> 3), ch = lane & 7; const u32x4 v = *(const u32x4*)(stg + row * 64 + ch * 8); *(u32x4*)(O + (size_t)(wid * 32 + row) * ldo + ch * 8) = v; }
}
}


namespace na {
using fa::bf16x8; using fa::f32x16; using fa::u32x4; using fa::crow; using fa::cvtpk; using fa::xhalf_max; using fa::xhalf_sum;
constexpr int KP = 144, KB = 64 * KP, VP = 136, VB = 64 * VP, K0 = 0, V0 = 2 * KB, WSF = V0 + 2 * VB, OST = WSF + 2048, TBL = OST + 8 * 4096, BYTES = TBL + 17 * 64 * 4;
__device__ __forceinline__ int clampi(int v, int lo, int hi) { return v < lo ? lo : (v > hi ? hi : v); }
__device__ __forceinline__ void na_unit(char* smem, bool ctxu, int b, int h, int g, const bf16_t* P, const bf16_t* NVT, const float* rpb, bf16_t* MIX) {
    constexpr float THR = 8.f, NEG = -1e30f;
    const int tid = tid_(), lane = tid & 63, r32 = lane & 31, hi = lane >> 5; const int wid = __builtin_amdgcn_readfirstlane(tid >> 6);
    float* wsf = (float*)(smem + WSF) + wid * 64; float* tb = (float*)(smem + TBL);
    const int pr = wid >> 2, cbk = (wid & 3) * 16, kc0 = clampi(cbk - 8, 0, 32);
    const int qr = 4 * g + 2 * pr + (r32 >> 4), qc = cbk + (r32 & 15);
    const size_t qrow = ctxu ? (size_t)NLAT + b * CTXL + wid * 32 + r32 : (size_t)b * SEQ + qr * 64 + qc;
    bf16x8 qf[4];
#pragma unroll
    for (int ks = 0; ks < 4; ++ks) qf[ks] = *(const bf16x8*)(P + qrow * LDP + PC_NQ + h * 64 + ks * 16 + hi * 8);
    const int r0q = clampi(qr - 4, 0, 120), c0q = clampi(qc - 8, 0, 48);
    const int cbase = kc0 + 4 * hi - c0q, bidx = kc0 + 4 * hi - qc + 15 + 16;
    const int ra = 4 * g + 2 * pr, wlo = clampi(ra - 4, 0, 120), whi = clampi(ra - 3, 0, 120) + 8;
    const int krU = clampi(4 * g - 4, 0, 117);
    const int NL = ctxu ? 0 : 11, NT = NL + 4;
    f32x16 o0, o1, negm;
#pragma unroll
    for (int r = 0; r < 16; ++r) { o0[r] = 0.f; o1[r] = 0.f; negm[r] = 0.f; }
    float mhat = 0.f, lsum = 0.f; bool first = true;
    const size_t vt_base = (size_t)(b * 8 + h) * 132 * 4096;
    const int skr = tid >> 3, skc = tid & 7;
    uint4 sk, sv;
#define NA_GLOAD(t) do { const size_t krow = (t) < NL ? (size_t)b * SEQ + (size_t)(krU + (t)) * 64 : (size_t)NLAT + b * CTXL + ((t) - NL) * 64; const int vtile = (t) < NL ? krU + (t) : 128 + ((t) - NL); \
        sk = *(const uint4*)(P + (krow + skr) * LDP + PC_NK + h * 64 + skc * 8); sv = *(const uint4*)(NVT + vt_base + (size_t)vtile * 4096 + tid * 8); } while (0)
#define NA_SWRITE(buf) do { *(uint4*)(smem + K0 + (buf) * KB + skr * KP + skc * 16) = sk; uint2* vd = (uint2*)(smem + V0 + (buf) * VB + skr * VP + skc * 16); vd[0] = make_uint2(sv.x, sv.y); vd[1] = make_uint2(sv.z, sv.w); } while (0)
    __syncthreads();
    if (!ctxu) for (int idx = tid; idx < 17 * 64; idx += 512) { const int dr = (idx >> 6) - 8, dci = (idx & 63) - 16; tb[idx] = (dr >= -7 && dr <= 7 && dci >= 0 && dci <= 30) ? rpb[(dr + 7) * 31 + dci] * 1.4426950408889634f : 0.f; }
    NA_GLOAD(0); NA_SWRITE(0);
    __syncthreads();
#define NA_BLOCK(koff, MASKED, kr) do { \
        const char* kb = smem + K0 + buf * KB + ((koff) + r32) * KP + hi * 16; \
        f32x16 p = negm; \
        _Pragma("unroll") for (int ks = 0; ks < 4; ++ks) { const bf16x8 a = *(const bf16x8*)(kb + ks * 32); p = __builtin_amdgcn_mfma_f32_32x32x16_bf16(a, qf[ks], p, 0, 0, 0); } \
        if (MASKED) { const bool rowok = (unsigned)((kr) - r0q) < 8u; const float* tbr = tb + ((kr) - qr + 8) * 64 + bidx; \
            _Pragma("unroll") for (int r = 0; r < 16; ++r) { const int cst = (r & 3) + 8 * (r >> 2); const bool ok = rowok && (unsigned)(cbase + cst) < 16u; p[r] = ok ? p[r] + tbr[cst] : NEG; } } \
        float rm = fa::max3f(p[0], p[1], p[2]); \
        _Pragma("unroll") for (int r = 3; r < 15; r += 2) rm = fa::max3f(rm, p[r], p[r + 1]); \
        rm = fmaxf(rm, p[15]); \
        rm = xhalf_max(rm); \
        if (first || __any(rm > THR)) { \
            const float dl = first ? (rm > -1e29f ? rm : 0.f) : fmaxf(rm, 0.f); \
            mhat += dl; \
            _Pragma("unroll") for (int r = 0; r < 16; ++r) { p[r] -= dl; negm[r] = -mhat; } \
            if (!first) { const float f = __builtin_amdgcn_exp2f(-dl); lsum *= f; if (hi == 0) wsf[r32] = f; asm volatile("s_waitcnt lgkmcnt(0)" ::: "memory"); \
                _Pragma("unroll") for (int r = 0; r < 16; ++r) { const float fr = wsf[crow(r, hi)]; o0[r] *= fr; o1[r] *= fr; } } \
            first = false; } \
        float ps = 0.f; \
        _Pragma("unroll") for (int r = 0; r < 16; ++r) { p[r] = __builtin_amdgcn_exp2f(p[r]); ps += p[r]; } \
        lsum += ps; \
        u32x4 w0, w1; \
        w0.x = cvtpk(p[0], p[1]); w0.y = cvtpk(p[2], p[3]); w0.z = cvtpk(p[4], p[5]); w0.w = cvtpk(p[6], p[7]); \
        w1.x = cvtpk(p[8], p[9]); w1.y = cvtpk(p[10], p[11]); w1.z = cvtpk(p[12], p[13]); w1.w = cvtpk(p[14], p[15]); \
        const char* vb = smem + V0 + buf * VB + r32 * VP + ((koff) + 4 * hi) * 2; \
        { const bf16x8 pa = __builtin_bit_cast(bf16x8, w0); const uint2 a0 = *(const uint2*)(vb), a1 = *(const uint2*)(vb + 16), b0 = *(const uint2*)(vb + 32 * VP), b1 = *(const uint2*)(vb + 32 * VP + 16); \
          const bf16x8 v0 = __builtin_bit_cast(bf16x8, make_uint4(a0.x, a0.y, a1.x, a1.y)), v1 = __builtin_bit_cast(bf16x8, make_uint4(b0.x, b0.y, b1.x, b1.y)); \
          o0 = __builtin_amdgcn_mfma_f32_32x32x16_bf16(pa, v0, o0, 0, 0, 0); o1 = __builtin_amdgcn_mfma_f32_32x32x16_bf16(pa, v1, o1, 0, 0, 0); } \
        { const bf16x8 pa = __builtin_bit_cast(bf16x8, w1); const uint2 a0 = *(const uint2*)(vb + 32), a1 = *(const uint2*)(vb + 48), b0 = *(const uint2*)(vb + 32 * VP + 32), b1 = *(const uint2*)(vb + 32 * VP + 48); \
          const bf16x8 v0 = __builtin_bit_cast(bf16x8, make_uint4(a0.x, a0.y, a1.x, a1.y)), v1 = __builtin_bit_cast(bf16x8, make_uint4(b0.x, b0.y, b1.x, b1.y)); \
          o0 = __builtin_amdgcn_mfma_f32_32x32x16_bf16(pa, v0, o0, 0, 0, 0); o1 = __builtin_amdgcn_mfma_f32_32x32x16_bf16(pa, v1, o1, 0, 0, 0); } \
    } while (0)
    for (int t = 0; t < NT; ++t) {
        const int buf = t & 1;
        if (t + 1 < NT) NA_GLOAD(t + 1);
        if (t < NL) { const int kr = krU + t; if (kr >= wlo && kr < whi) NA_BLOCK(kc0, true, kr); }
        else { NA_BLOCK(0, false, 0); NA_BLOCK(32, false, 0); }
        if (t + 1 < NT) NA_SWRITE(buf ^ 1);
        __syncthreads();
    }
#undef NA_BLOCK
#undef NA_GLOAD
#undef NA_SWRITE
    lsum = xhalf_sum(lsum);
    if (hi == 0) wsf[32 + r32] = lsum;
    asm volatile("s_waitcnt lgkmcnt(0)" ::: "memory");
    bf16_t* stg = (bf16_t*)(smem + OST) + wid * 2048;
#pragma unroll
    for (int r = 0; r < 16; ++r) { const int orow = crow(r, hi); const float rl = 1.f / wsf[32 + orow]; stg[orow * 64 + r32] = f2bf(o0[r] * rl); stg[orow * 64 + 32 + r32] = f2bf(o1[r] * rl); }
    asm volatile("s_waitcnt lgkmcnt(0)" ::: "memory");
#pragma unroll
    for (int i = 0; i < 4; ++i) { const int q = i * 8 + (lane >> 3), ch = lane & 7; const u32x4 v = *(const u32x4*)(stg + q * 64 + ch * 8);
        const size_t orow = ctxu ? (size_t)NLAT + b * CTXL + wid * 32 + q : (size_t)b * SEQ + (size_t)(4 * g + 2 * pr + (q >> 4)) * 64 + cbk + (q & 15);
        *(u32x4*)(MIX + orow * DM + 256 + h * 64 + ch * 8) = v; }
}
}


__device__ __forceinline__ float reduce64(float (&v)[64], int lane) {
#pragma unroll
    for (int i = 0; i < 32; ++i) { auto r = __builtin_amdgcn_permlane32_swap(__float_as_uint(v[i]), __float_as_uint(v[i + 32]), false, false); v[i] = __uint_as_float(r[0]) + __uint_as_float(r[1]); }
#pragma unroll
    for (int i = 0; i < 16; ++i) { auto r = __builtin_amdgcn_permlane16_swap(__float_as_uint(v[i]), __float_as_uint(v[i + 16]), false, false); v[i] = __uint_as_float(r[0]) + __uint_as_float(r[1]); }
    const bool b3 = lane & 8, b2 = lane & 4, b1 = lane & 2, b0 = lane & 1;
#pragma unroll
    for (int i = 0; i < 8; ++i) { const float keep = b3 ? v[i + 8] : v[i], send = b3 ? v[i] : v[i + 8]; v[i] = keep + dpp_f<0x140>(send); }
#pragma unroll
    for (int i = 0; i < 4; ++i) { const float keep = b2 ? v[i + 4] : v[i], send = b2 ? v[i] : v[i + 4]; v[i] = keep + dpp_f<0x141>(send); }
#pragma unroll
    for (int i = 0; i < 2; ++i) { const float keep = b1 ? v[i + 2] : v[i], send = b1 ? v[i] : v[i + 2]; v[i] = keep + dpp_f<0x4E>(send); }
    { const float keep = b0 ? v[1] : v[0], send = b0 ? v[0] : v[1]; v[0] = keep + dpp_f<0xB1>(send); }
    return v[0];
}
#define PROBE_SET 0
#ifndef PHASE_INLINE
#define PHASE_INLINE __forceinline__
#endif

namespace rt {
using fa::bf16x8; using fa::f32x16; using fa::u32x4; using fa::crow; using fa::cvtpk;
constexpr int KP = 144, KBY = 128 * KP, VP = 264, VBY = 64 * VP, SP = 144, SBY = 64 * SP;
constexpr int OK_ = 0, OV = KBY, OSF = OV + VBY, OSB = OSF + SBY, UNIT = OSB + SBY, STG = 2 * UNIT, BYTES = STG + 8 * 4096;
static_assert(UNIT % 16 == 0 && BYTES <= 144 * 1024 - 64, "retention LDS map");
template <int CTRL> __device__ __forceinline__ float dppf(float v) { return __uint_as_float((unsigned)__builtin_amdgcn_mov_dpp((int)__float_as_uint(v), CTRL, 0xF, 0xF, true)); }
__device__ __forceinline__ float half_sum(float v) {
    v += dppf<0xB1>(v); v += dppf<0x4E>(v); v += dppf<0x141>(v); v += dppf<0x140>(v);
    auto r = __builtin_amdgcn_permlane16_swap(__float_as_uint(v), __float_as_uint(v), false, false); return __uint_as_float(r[0]) + __uint_as_float(r[1]);
}
__device__ __forceinline__ void rope8(uint4& a, uint4& b, const float2* tab) {
    unsigned* pa = (unsigned*)&a; unsigned* pb = (unsigned*)&b;
#pragma unroll
    for (int w = 0; w < 4; ++w) {
        const float4 t = *(const float4*)(tab + 2 * w);
        const float x1l = __uint_as_float(pa[w] << 16), x1h = __uint_as_float(pa[w] & 0xffff0000u), x2l = __uint_as_float(pb[w] << 16), x2h = __uint_as_float(pb[w] & 0xffff0000u);
        pa[w] = cvtpk(x1l * t.x - x2l * t.y, x1h * t.z - x2h * t.w); pb[w] = cvtpk(x2l * t.x + x1l * t.y, x2h * t.z + x1h * t.w);
    }
}
#define RT_KITEM(item, A, B, R, CC) const int R = (item) >> 2, pc_ = (item) & 3, CC = (pc_ & 1) + 4 * (pc_ >> 1); \
        const bf16_t* ksrc_ = P + (size_t)(row0 + R) * LDP + PC_RK + hd * 64; uint4 A = *(const uint4*)(ksrc_ + CC * 8), B = *(const uint4*)(ksrc_ + (CC + 2) * 8); \
        if (lat) { const int tok_ = j * 128 + R, pos_ = pc_ < 2 ? tok_ >> 6 : tok_ & 63; rope8(A, B, TAB + pos_ * 16 + 8 * (pc_ & 1)); }
__device__ __forceinline__ void ret_pair(char* smem, int it0, int n_it, const bf16_t* P, const float* RKV, const float2* TAB, const float* dec_f, const float* dec_b, bf16_t* MIX) {
    const int tid = tid_(), lane = tid & 63, r32 = lane & 31, hi = lane >> 5; const int wid = __builtin_amdgcn_readfirstlane(tid >> 6);
    const int hw = wid >> 2, w4 = wid & 3, t4 = tid & 255;
    const int it = it0 + hw; const bool valid = it < n_it;
    int b, hd, j, row0;
    if (it < 1024) { b = it >> 8; hd = (it >> 6) & 3; j = it & 63; row0 = b * SEQ + j * 128; } else { const int q = it - 1024; b = q >> 3; hd = (q >> 1) & 3; j = q & 1; row0 = NLAT + b * CTXL + j * 128; }
    char* un = smem + hw * UNIT; const bool lat = it < 1024;
    __syncthreads();
    if (valid) {
#pragma unroll
        for (int c = 0; c < 2; ++c) { RT_KITEM(t4 + 256 * c, ka, kb2, r, cc) *(uint4*)(un + OK_ + r * KP + cc * 16) = ka; *(uint4*)(un + OK_ + r * KP + (cc + 2) * 16) = kb2; }
#pragma unroll
        for (int c = 0; c < 4; ++c) { const int ch = t4 + 256 * c, r = ch >> 3, cc = ch & 7; const bf16_t* src = P + (size_t)(row0 + r) * LDP + hd * 64 + cc * 8;
            const uint4 v = *(const uint4*)(src + PC_RV); bf16_t* vt = (bf16_t*)(un + OV) + (cc * 8) * (VP / 2) + r;
            vt[0 * (VP / 2)] = (bf16_t)(v.x & 0xffff); vt[1 * (VP / 2)] = (bf16_t)(v.x >> 16); vt[2 * (VP / 2)] = (bf16_t)(v.y & 0xffff); vt[3 * (VP / 2)] = (bf16_t)(v.y >> 16);
            vt[4 * (VP / 2)] = (bf16_t)(v.z & 0xffff); vt[5 * (VP / 2)] = (bf16_t)(v.z >> 16); vt[6 * (VP / 2)] = (bf16_t)(v.w & 0xffff); vt[7 * (VP / 2)] = (bf16_t)(v.w >> 16); }
#pragma unroll
        for (int c = 0; c < 16; ++c) { const int idx = t4 + 256 * c, d = idx >> 6, e = idx & 63;
            ((bf16_t*)(un + OSF))[e * (SP / 2) + d] = f2bf(RKV[((size_t)it * 2 + 0) * 4096 + idx]); ((bf16_t*)(un + OSB))[e * (SP / 2) + d] = f2bf(RKV[((size_t)it * 2 + 1) * 4096 + idx]); }
    }
    __syncthreads();
    if (valid) {
        const float lgf2 = log_sigmoid_f(dec_f[hd]) * 1.4426950408889634f, lgb2 = log_sigmoid_f(dec_b[hd]) * 1.4426950408889634f;
        const int qi = w4 * 32 + r32;
        bf16x8 qf[4];
#pragma unroll
        for (int ks = 0; ks < 4; ++ks) qf[ks] = *(const bf16x8*)(P + (size_t)(row0 + qi) * LDP + PC_RQ + hd * 64 + ks * 16 + hi * 8);
        if (lat) { const int tq = j * 128 + qi; uint4 a = __builtin_bit_cast(uint4, qf[0]), b2 = __builtin_bit_cast(uint4, qf[1]), c2 = __builtin_bit_cast(uint4, qf[2]), d2 = __builtin_bit_cast(uint4, qf[3]);
            rope8(a, b2, TAB + (tq >> 6) * 16 + 8 * hi); rope8(c2, d2, TAB + (tq & 63) * 16 + 8 * hi);
            qf[0] = __builtin_bit_cast(bf16x8, a); qf[1] = __builtin_bit_cast(bf16x8, b2); qf[2] = __builtin_bit_cast(bf16x8, c2); qf[3] = __builtin_bit_cast(bf16x8, d2); }
        f32x16 o0, o1;
#pragma unroll
        for (int r = 0; r < 16; ++r) { o0[r] = 0.f; o1[r] = 0.f; }
#pragma unroll
        for (int kb = 0; kb < 4; ++kb) {
            f32x16 pz;
#pragma unroll
            for (int r = 0; r < 16; ++r) pz[r] = 0.f;
            const char* kp = un + OK_ + (kb * 32 + r32) * KP + hi * 16;
#pragma unroll
            for (int ks = 0; ks < 4; ++ks) { const bf16x8 a = *(const bf16x8*)(kp + ks * 32); pz = __builtin_amdgcn_mfma_f32_32x32x16_bf16(a, qf[ks], pz, 0, 0, 0); }
#pragma unroll
            for (int r = 0; r < 16; ++r) { const int dI = qi - (kb * 32 + crow(r, hi)); const float arg = dI >= 0 ? lgf2 * (float)dI : -lgb2 * (float)dI; pz[r] *= __builtin_amdgcn_exp2f(arg); }
            u32x4 w0, w1;
            w0.x = cvtpk(pz[0], pz[1]); w0.y = cvtpk(pz[2], pz[3]); w0.z = cvtpk(pz[4], pz[5]); w0.w = cvtpk(pz[6], pz[7]);
            w1.x = cvtpk(pz[8], pz[9]); w1.y = cvtpk(pz[10], pz[11]); w1.z = cvtpk(pz[12], pz[13]); w1.w = cvtpk(pz[14], pz[15]);
            const char* vb = un + OV + r32 * VP + (kb * 32 + 4 * hi) * 2;
            { const bf16x8 pa = __builtin_bit_cast(bf16x8, w0); const uint2 a0 = *(const uint2*)(vb), a1 = *(const uint2*)(vb + 16), b0 = *(const uint2*)(vb + 32 * VP), b1 = *(const uint2*)(vb + 32 * VP + 16);
              o0 = __builtin_amdgcn_mfma_f32_32x32x16_bf16(pa, __builtin_bit_cast(bf16x8, make_uint4(a0.x, a0.y, a1.x, a1.y)), o0, 0, 0, 0);
              o1 = __builtin_amdgcn_mfma_f32_32x32x16_bf16(pa, __builtin_bit_cast(bf16x8, make_uint4(b0.x, b0.y, b1.x, b1.y)), o1, 0, 0, 0); }
            { const bf16x8 pa = __builtin_bit_cast(bf16x8, w1); const uint2 a0 = *(const uint2*)(vb + 32), a1 = *(const uint2*)(vb + 48), b0 = *(const uint2*)(vb + 32 * VP + 32), b1 = *(const uint2*)(vb + 32 * VP + 48);
              o0 = __builtin_amdgcn_mfma_f32_32x32x16_bf16(pa, __builtin_bit_cast(bf16x8, make_uint4(a0.x, a0.y, a1.x, a1.y)), o0, 0, 0, 0);
              o1 = __builtin_amdgcn_mfma_f32_32x32x16_bf16(pa, __builtin_bit_cast(bf16x8, make_uint4(b0.x, b0.y, b1.x, b1.y)), o1, 0, 0, 0); }
        }
        {
            f32x16 tf0, tf1, tb0, tb1;
#pragma unroll
            for (int r = 0; r < 16; ++r) { tf0[r] = 0.f; tf1[r] = 0.f; tb0[r] = 0.f; tb1[r] = 0.f; }
            const char* sf = un + OSF + r32 * SP + hi * 16; const char* sb = un + OSB + r32 * SP + hi * 16;
#pragma unroll
            for (int ks = 0; ks < 4; ++ks) {
                tf0 = __builtin_amdgcn_mfma_f32_32x32x16_bf16(qf[ks], *(const bf16x8*)(sf + ks * 32), tf0, 0, 0, 0); tf1 = __builtin_amdgcn_mfma_f32_32x32x16_bf16(qf[ks], *(const bf16x8*)(sf + 32 * SP + ks * 32), tf1, 0, 0, 0);
                tb0 = __builtin_amdgcn_mfma_f32_32x32x16_bf16(qf[ks], *(const bf16x8*)(sb + ks * 32), tb0, 0, 0, 0); tb1 = __builtin_amdgcn_mfma_f32_32x32x16_bf16(qf[ks], *(const bf16x8*)(sb + 32 * SP + ks * 32), tb1, 0, 0, 0);
            }
#pragma unroll
            for (int r = 0; r < 16; ++r) { const int i = w4 * 32 + crow(r, hi); const float cf = __builtin_amdgcn_exp2f(lgf2 * (float)(i + 1)), cb = __builtin_amdgcn_exp2f(lgb2 * (float)(128 - i));
                o0[r] += cf * tf0[r] + cb * tb0[r]; o1[r] += cf * tf1[r] + cb * tb1[r]; }
        }
        bf16_t* stg = (bf16_t*)(smem + STG) + wid * 2048;
#pragma unroll
        for (int r = 0; r < 16; ++r) {
            const float mu = half_sum(o0[r] + o1[r]) * (1.f / 64.f); const float d0 = o0[r] - mu, d1 = o1[r] - mu;
            const float rs = rsqrtf(half_sum(d0 * d0 + d1 * d1) * (1.f / 64.f) + 1e-6f);
            const int q = crow(r, hi); stg[q * 64 + r32] = f2bf(d0 * rs); stg[q * 64 + 32 + r32] = f2bf(d1 * rs);
        }
        asm volatile("s_waitcnt lgkmcnt(0)" ::: "memory");
#pragma unroll
        for (int i = 0; i < 4; ++i) { const int q = i * 8 + (lane >> 3), ch = lane & 7; const size_t row = (size_t)row0 + w4 * 32 + q;
            const u32x4 y = *(const u32x4*)(stg + q * 64 + ch * 8), gg = *(const u32x4*)(P + row * LDP + PC_RG + hd * 64 + ch * 8); u32x4 o;
#define RT_G(yv, gv) cvtpk(__uint_as_float((yv) << 16) * silu_f(__uint_as_float((gv) << 16)), __uint_as_float((yv) & 0xffff0000u) * silu_f(__uint_as_float((gv) & 0xffff0000u)))
            o.x = RT_G(y.x, gg.x); o.y = RT_G(y.y, gg.y); o.z = RT_G(y.z, gg.z); o.w = RT_G(y.w, gg.w);
#undef RT_G
            *(u32x4*)(MIX + row * DM + hd * 64 + ch * 8) = o; }
    }
}
constexpr int TP = 272, TBY = 64 * TP, SUNIT = 3 * TBY;
static_assert(2 * SUNIT <= BYTES, "summary LDS map");
__device__ __forceinline__ void sum_pair(char* smem, int it0, int n_it, const bf16_t* P, float* RKV, const float2* TAB, const float* dec_f, const float* dec_b) {
    const int tid = tid_(), lane = tid & 63, r32 = lane & 31, hi = lane >> 5; const int wid = __builtin_amdgcn_readfirstlane(tid >> 6);
    const int hw = wid >> 2, w4 = wid & 3, t4 = tid & 255;
    const int it = it0 + hw; const bool valid = it < n_it, lat = it < 1024;
    int b, hd, j, row0;
    if (it < 1024) { b = it >> 8; hd = (it >> 6) & 3; j = it & 63; row0 = b * SEQ + j * 128; } else { const int q = it - 1024; b = q >> 3; hd = (q >> 1) & 3; j = q & 1; row0 = NLAT + b * CTXL + j * 128; }
    bf16_t* kt = (bf16_t*)(smem + hw * SUNIT); bf16_t* vf = kt + TBY / 2; bf16_t* vb = vf + TBY / 2;
    __syncthreads();
    if (valid) {
        const float lgf2 = log_sigmoid_f(dec_f[hd]) * 1.4426950408889634f, lgb2 = log_sigmoid_f(dec_b[hd]) * 1.4426950408889634f;
#pragma unroll
        for (int c = 0; c < 2; ++c) { RT_KITEM(t4 + 256 * c, ka, kb2, r, cc) const unsigned* pa = (const unsigned*)&ka; const unsigned* pb = (const unsigned*)&kb2;
#pragma unroll
            for (int w = 0; w < 4; ++w) { kt[(cc * 8 + 2 * w) * (TP / 2) + r] = (bf16_t)(pa[w] & 0xffff); kt[(cc * 8 + 2 * w + 1) * (TP / 2) + r] = (bf16_t)(pa[w] >> 16);
                kt[((cc + 2) * 8 + 2 * w) * (TP / 2) + r] = (bf16_t)(pb[w] & 0xffff); kt[((cc + 2) * 8 + 2 * w + 1) * (TP / 2) + r] = (bf16_t)(pb[w] >> 16); } }
#pragma unroll
        for (int c = 0; c < 4; ++c) { const int ch = t4 + 256 * c, r = ch >> 3, cc = ch & 7; const uint4 v = *(const uint4*)(P + (size_t)(row0 + r) * LDP + PC_RV + hd * 64 + cc * 8); const unsigned* pv = (const unsigned*)&v;
            const float wf = __builtin_amdgcn_exp2f(lgf2 * (float)(127 - r)), wb = __builtin_amdgcn_exp2f(lgb2 * (float)r);
#pragma unroll
            for (int w = 0; w < 4; ++w) { const float lo = __uint_as_float(pv[w] << 16), hh = __uint_as_float(pv[w] & 0xffff0000u);
                vf[(cc * 8 + 2 * w) * (TP / 2) + r] = f2bf(lo * wf); vf[(cc * 8 + 2 * w + 1) * (TP / 2) + r] = f2bf(hh * wf);
                vb[(cc * 8 + 2 * w) * (TP / 2) + r] = f2bf(lo * wb); vb[(cc * 8 + 2 * w + 1) * (TP / 2) + r] = f2bf(hh * wb); } }
    }
    __syncthreads();
    if (valid) {
        const int dblk = w4 >> 1, eblk = w4 & 1;
        f32x16 af, ab;
#pragma unroll
        for (int r = 0; r < 16; ++r) { af[r] = 0.f; ab[r] = 0.f; }
        const char* ka = (const char*)kt + (dblk * 32 + r32) * TP + hi * 16; const char* fa_ = (const char*)vf + (eblk * 32 + r32) * TP + hi * 16; const char* ba_ = (const char*)vb + (eblk * 32 + r32) * TP + hi * 16;
#pragma unroll
        for (int ks = 0; ks < 8; ++ks) { const bf16x8 a = *(const bf16x8*)(ka + ks * 32);
            af = __builtin_amdgcn_mfma_f32_32x32x16_bf16(a, *(const bf16x8*)(fa_ + ks * 32), af, 0, 0, 0); ab = __builtin_amdgcn_mfma_f32_32x32x16_bf16(a, *(const bf16x8*)(ba_ + ks * 32), ab, 0, 0, 0); }
        float* of = RKV + ((size_t)it * 2 + 0) * 4096 + eblk * 32 + r32; float* ob = RKV + ((size_t)it * 2 + 1) * 4096 + eblk * 32 + r32;
#pragma unroll
        for (int r = 0; r < 16; ++r) { const int d = dblk * 32 + crow(r, hi); of[d * 64] = af[r]; ob[d * 64] = ab[r]; }
    }
}
}

template <int KIND> __device__ PHASE_INLINE void phase(const Params& p, const int l, char* smem) {
    __syncthreads();
    const int tid = tid_(), lane = tid & 63, wid = tid >> 6;
    const int nblk = gridDim.x, bid = bid_();
    size_t zoff = 0; asm volatile("" : "+s"(zoff));
    unsigned char* ws = p.ws + zoff;
    float* MOD = (float*)(ws + WS_MOD);
    bf16_t* U = (bf16_t*)(ws + WS_U);
    bf16_t* P = (bf16_t*)(ws + WS_P);
    bf16_t* QM = (bf16_t*)(ws + WS_QM);
    bf16_t* KM = (bf16_t*)(ws + WS_KM);
    bf16_t* VM = (bf16_t*)(ws + WS_VM);
    float* RKV = (float*)(ws + WS_RKV);
    bf16_t* XS = (bf16_t*)(ws + WS_XS);
    bf16_t* HDN = (bf16_t*)(ws + WS_HDN);
    int2* RTE = (int2*)(ws + WS_RT + RT_E);
    float2* RTW = (float2*)(ws + WS_RT + RT_W);
    float* RTR = (float*)(ws + WS_RT + RT_RSTD);
    int2* RTS = (int2*)(ws + WS_RT + RT_SLOT);
    int* CNT = (int*)(ws + WS_RT + RT_CNT);
    int* SEG = (int*)(ws + WS_RT + RT_SEG);
    int* TILE = (int*)(ws + WS_RT + RT_TILE);
    bf16_t* VT = (bf16_t*)(ws + WS_VT);
    bf16_t* NVT = (bf16_t*)(ws + WS_NVT);
    bf16_t* WT = (bf16_t*)(ws + WS_WT);
    PG8_LAS unsigned char* lds3 = (PG8_LAS unsigned char*)smem;
    float* const Hlat = p.out; float* const Hctx = (float*)(ws + WS_HC);

    if constexpr (KIND == 0) {
        {
            float* sc = (float*)smem;
            float* red = sc + 5 * DM;
            for (int i = tid; i < 5 * DM; i += 512) { const int v = i / DM, k = i % DM; const float x = v < 4 ? p.in[I_C][v * DM + k] : p.in[I_CCTX][k]; sc[i] = silu_f(x); }
            __syncthreads();
            for (int it = bid; it < 2 * 96; it += nblk) {
                const int ll = it / 96, j = (it % 96) * 64 + lane;
                const float* wm = p.in[I_WMOD] + (size_t)ll * DM * 6144 + (size_t)(wid * 128) * 6144 + j;
                float a0 = 0.f, a1 = 0.f, a2 = 0.f, a3 = 0.f, a4 = 0.f;
#pragma unroll 8
                for (int k = 0; k < 128; ++k) { const float w = wm[(size_t)k * 6144]; const int kk = wid * 128 + k; a0 = fmaf(sc[kk], w, a0); a1 = fmaf(sc[DM + kk], w, a1); a2 = fmaf(sc[2 * DM + kk], w, a2); a3 = fmaf(sc[3 * DM + kk], w, a3); a4 = fmaf(sc[4 * DM + kk], w, a4); }
                __syncthreads();
                red[(wid * 5 + 0) * 64 + lane] = a0; red[(wid * 5 + 1) * 64 + lane] = a1; red[(wid * 5 + 2) * 64 + lane] = a2; red[(wid * 5 + 3) * 64 + lane] = a3; red[(wid * 5 + 4) * 64 + lane] = a4;
                __syncthreads();
                if (tid < 320) { const int v = tid >> 6, c = tid & 63; float t = p.in[I_BMOD][ll * 6144 + (it % 96) * 64 + c];
#pragma unroll
                    for (int w8 = 0; w8 < 8; ++w8) t += red[(w8 * 5 + v) * 64 + c];
                    MOD[((size_t)ll * 5 + v) * 6144 + (it % 96) * 64 + c] = t; }
            }
            __syncthreads();
        }
        for (int idx = bid * 512 + tid; idx < 128 * 16; idx += nblk * 512) { const int pos = idx >> 4, i = idx & 15; float sn, cs; sincosf((float)pos * powf(10000.0f, -(float)i / 16.0f), &sn, &cs); ((float2*)(ws + WS_TAB))[idx] = make_float2(cs, sn); }
        {
            float* tl = (float*)smem; int base = 0;
            for (int ll = 0; ll < 2; ++ll) {
                transpose_mat(tl, p.in[I_WIN] + (size_t)ll * DM * DPROJ, DM, DPROJ, 3328, WT + WT_IN + ll * WT_IN_L, 1, 0, base, WScale{nullptr, PC_RQ, PC_RQ + 256, 0.125f, PC_NQ, PC_NQ + 512, 0.125f * 1.4426950408889634f});
                transpose_mat(tl, p.in[I_WUQ] + (size_t)ll * 384 * 384, 384, 384, 512, WT + WT_UQ + ll * WT_UQ_L, 1, 0, base, WScale{p.in[I_QN] + ll * 384, 0, 384, 0.10206207261596577f * 1.4426950408889634f, 0, 0, 1.f});
                transpose_mat(tl, p.in[I_WUKV] + (size_t)ll * 256 * 512, 256, 512, 512, WT + WT_UKV + ll * WT_UKV_L, 1, 0, base, WScale{p.in[I_KVN] + ll * 256, 0, 0, 1.f, 0, 0, 1.f});
                transpose_mat(tl, p.in[I_WOUT] + (size_t)ll * DM * DM, DM, DM, DM, WT + WT_OUT + ll * WT_OUT_L, 1, 0, base, WScale{nullptr, 0, 0, 1.f, 0, 0, 1.f});
                for (int e = 0; e < NE; ++e) {
                    transpose_mat(tl, p.in[I_W1] + ((size_t)ll * NE + e) * DM * FF, DM, FF, FF, WT + WT_13 + ll * WT_13_L + (size_t)e * 512 * 1024, 2, 0, base, WScale{nullptr, 0, 0, 1.f, 0, 0, 1.f});
                    transpose_mat(tl, p.in[I_W3] + ((size_t)ll * NE + e) * DM * FF, DM, FF, FF, WT + WT_13 + ll * WT_13_L + (size_t)e * 512 * 1024, 2, 1, base, WScale{nullptr, 0, 0, 1.f, 0, 0, 1.f});
                    transpose_mat(tl, p.in[I_W2] + ((size_t)ll * NE + e) * FF * DM, FF, DM, DM, WT + WT_2 + ll * WT_2_L + (size_t)e * 1024 * 256, 1, 0, base, WScale{nullptr, 0, 0, 1.f, 0, 0, 1.f});
                }
            }
        }
    }

    {
        const bool last = (l == 1);
        const float* modl = MOD + (size_t)l * 5 * 6144;
        const int rows_mix = last ? NLAT : NROW;

        if constexpr (KIND == 1) {
            const float* g = p.in[I_N1G] + l * DM; const float* modp = MOD + (size_t)(l - 1) * 5 * 6144;
            for (int row = bid * 8 + wid; row < NROW; row += nblk * 8) {
                const float* mv = modl + row_modv(row) * 6144;
                float4 x[4]; float ss = 0.f;
                if (l == 0) {
                    const float* h = row < NLAT ? p.in[I_X] + (size_t)row * DM : p.in[I_CTX] + (size_t)(row - NLAT) * DM;
#pragma unroll
                    for (int i = 0; i < 4; ++i) x[i] = *(const float4*)(h + lane * 4 + 256 * i);
                } else {
                    float* h = hrow2(Hlat, Hctx, row); const float* mg = modp + row_modv(row) * 6144 + 5120;
                    const int2 s2 = RTS[row]; const float2 w2 = RTW[row];
#pragma unroll
                    for (int i = 0; i < 4; ++i) {
                        const int c = lane * 4 + 256 * i;
                        const uint2 ya = *(const uint2*)(XS + (size_t)s2.x * DM + c), yb = *(const uint2*)(XS + (size_t)s2.y * DM + c);
                        float4 xx = *(const float4*)(h + c); const float4 gg = *(const float4*)(mg + c);
                        xx.x += gg.x * (w2.x * __uint_as_float(ya.x << 16) + w2.y * __uint_as_float(yb.x << 16));
                        xx.y += gg.y * (w2.x * __uint_as_float(ya.x & 0xffff0000u) + w2.y * __uint_as_float(yb.x & 0xffff0000u));
                        xx.z += gg.z * (w2.x * __uint_as_float(ya.y << 16) + w2.y * __uint_as_float(yb.y << 16));
                        xx.w += gg.w * (w2.x * __uint_as_float(ya.y & 0xffff0000u) + w2.y * __uint_as_float(yb.y & 0xffff0000u));
                        *(float4*)(h + c) = xx; x[i] = xx;
                    }
                }
#pragma unroll
                for (int i = 0; i < 4; ++i) ss += x[i].x * x[i].x + x[i].y * x[i].y + x[i].z * x[i].z + x[i].w * x[i].w;
                ss = wave_sum(ss);
                const float rstd = rsqrtf(ss * (1.f / DM) + 1e-6f);
#pragma unroll
                for (int i = 0; i < 4; ++i) {
                    const int c = lane * 4 + 256 * i;
                    const float4 gg = *(const float4*)(g + c), sh = *(const float4*)(mv + c), sc = *(const float4*)(mv + 1024 + c);
                    const float y0 = x[i].x * rstd * gg.x * (1.f + sc.x) + sh.x, y1 = x[i].y * rstd * gg.y * (1.f + sc.y) + sh.y;
                    const float y2 = x[i].z * rstd * gg.z * (1.f + sc.z) + sh.z, y3 = x[i].w * rstd * gg.w * (1.f + sc.w) + sh.w;
                    uint2 o; o.x = (unsigned)f2bf(y0) | ((unsigned)f2bf(y1) << 16); o.y = (unsigned)f2bf(y2) | ((unsigned)f2bf(y3) << 16);
                    *(uint2*)(U + (size_t)row * DM + c) = o;
                }
            }
        }
        if constexpr (KIND == 2) {
            pg8::Gemm g{U, WT + WT_IN + l * WT_IN_L, DM, DM, DM, nullptr}; pg8::StaticOrder S; S.init(NROW, 3328, nblk, bid);
            pg8::EpiP E{P, LDP, (float*)(ws + WS_PS), NVT};
            pg8::gemm_phase<pg8::EpiP, pg8::StaticOrder, true, true>(lds3, g, S, E);
        }
        if constexpr (KIND == 14) {
            pg8::Gemm g{P + PC_CKV, WT + WT_UKV + l * WT_UKV_L, LDP, 256, 256, nullptr}; pg8::StaticOrder S; S.init(NROW, 512, nblk, (bid + 64) % nblk);
            pg8::EpiUKV E{KM, VT, (const float*)(ws + WS_PS)};
            pg8::gemm_phase<pg8::EpiUKV, pg8::StaticOrder, true, true>(lds3, g, S, E);
        }
        if constexpr (KIND == 4) {
            {
                pg8::Gemm g{P + PC_CQ, WT + WT_UQ + l * WT_UQ_L, LDP, 384, 384, nullptr}; pg8::StaticOrder S; S.init(NROW, 512, nblk, bid);
                pg8::EpiUQ E{QM, (const float*)(ws + WS_PS)};
                pg8::gemm_phase<pg8::EpiUQ, pg8::StaticOrder, true, true>(lds3, g, S, E);
            }
            __syncthreads();
            for (int pi = (bid + 128) % nblk; pi * 2 < RET_ITEMS; pi += nblk) rt::sum_pair(smem, pi * 2, RET_ITEMS, P, RKV, (const float2*)(ws + WS_TAB), p.in[I_RDF] + l * 4, p.in[I_RDB] + l * 4);
        }
        if constexpr (KIND == 5) {
            for (int row = bid * 8 + wid; row < NROW; row += nblk * 8) {
                const bool lat = row < NLAT; const int tt = row & (SEQ - 1);
                const float posr = (float)(tt >> 6), posc = (float)(tt & 63);
                if (lat) {
                    const int hd = lane >> 4, pp = lane & 15, sec = pp >> 3, ii = pp & 7;
                    bf16_t* b = QM + (size_t)row * 384 + hd * 96 + 64 + sec * 16 + ii;
                    float x1 = bf2f(b[0]), x2 = bf2f(b[8]);
                    rope_pair(x1, x2, sec ? posc : posr, ii, 8);
                    b[0] = f2bf(x1); b[8] = f2bf(x2);
                }
                if (lane < 16) {
                    const int sec = lane >> 3, ii = lane & 7;
                    const bf16_t* b = P + (size_t)row * LDP + PC_KPE + sec * 16 + ii;
                    float x1 = bf2f(b[0]), x2 = bf2f(b[8]);
                    if (lat) rope_pair(x1, x2, sec ? posc : posr, ii, 8);
                    const bf16_t y1 = f2bf(x1), y2 = f2bf(x2);
#pragma unroll
                    for (int hd = 0; hd < 4; ++hd) { bf16_t* k = KM + (size_t)row * 384 + hd * 96 + 64 + sec * 16 + ii; k[0] = y1; k[8] = y2; }
                }
            }
            for (int gid = bid * 512 + tid; gid < 2 * 16 * 4096; gid += nblk * 512) {
                const int el = gid & 4095, bh = (gid >> 12) & 15, dir = gid >> 16, hd = bh & 3;
                const float lg = log_sigmoid_f(dir ? p.in[I_RDB][l * 4 + hd] : p.in[I_RDF][l * 4 + hd]);
                const float g128 = expf(128.f * lg);
                float* c0p = RKV + ((size_t)(1024 + bh * 2 + 0) * 2 + dir) * 4096 + el;
                float* c1p = RKV + ((size_t)(1024 + bh * 2 + 1) * 2 + dir) * 4096 + el;
                const float c0 = *c0p, c1 = *c1p; float S;
                if (dir == 0) { *c0p = 0.f; *c1p = c0; S = g128 * c0 + c1; } else { *c1p = 0.f; *c0p = c1; S = g128 * c1 + c0; }
                float* qb = RKV + ((size_t)(bh * 64) * 2 + dir) * 4096 + el;
                float kv[64];
#pragma unroll
                for (int j = 0; j < 64; ++j) kv[j] = qb[(size_t)j * 8192];
                if (dir == 0) {
#pragma unroll
                    for (int j = 0; j < 64; ++j) { const float tmp = kv[j]; kv[j] = S; S = fmaf(g128, S, tmp); }
                } else {
#pragma unroll
                    for (int j = 63; j >= 0; --j) { const float tmp = kv[j]; kv[j] = S; S = fmaf(g128, S, tmp); }
                }
#pragma unroll
                for (int j = 0; j < 64; ++j) qb[(size_t)j * 8192] = kv[j];
            }
        }
        if constexpr (KIND == 6) {
            bf16_t* MIX = U;
            {
                const int n_lat = (512 - bid + nblk - 1) / nblk, cxi = nblk - 1 - bid, n_mine = n_lat + ((!last && cxi < 16) ? 1 : 0);
                for (int kk = 0; kk < n_mine; ++kk) {
                    const int it = kk < n_lat ? bid + kk * nblk : 512 + cxi;
                    const bool cu = it >= 512; const int itl = it & 255, rnd = it >> 8;
                    const int bh = cu ? it - 512 : ((nblk == 256) ? (rnd * 8 + (itl & 7)) : (it >> 5)), qb = (nblk == 256) ? (itl >> 3) : (it & 31), b = bh >> 2, hd = bh & 3;
                    const size_t cr0 = (size_t)NLAT + b * CTXL, kr0 = (size_t)b * SEQ, r0 = cu ? cr0 : kr0 + qb * 256;
                    const bf16_t* k0 = KM + (cu ? cr0 : kr0) * 384 + hd * 96; const bf16_t* k1 = KM + cr0 * 384 + hd * 96;
                    fa::attn_unit<96>(smem, QM + r0 * 384 + hd * 96, 384, k0, cu ? 4 : 128, k1, cu ? 0 : 4, 384, VT + ((size_t)bh * 132 + (cu ? 128 : 0)) * 4096, MIX + r0 * DM + 768 + hd * 64, DM);
                }
            }
        }
        if constexpr (KIND == 15) {
            bf16_t* MIX = U;
            {
                const int n_lat = (1024 - bid + nblk - 1) / nblk, cxi = nblk - 17 - bid, n_mine = n_lat + ((!last && cxi >= 0 && cxi < 32) ? 1 : 0);
                for (int kk = 0; kk < n_mine; ++kk) {
                    const int it = kk < n_lat ? bid + kk * nblk : 1024 + cxi;
                    const bool cu = it >= 1024; const int itl = it & 255, rnd = it >> 8;
                    const int bh = cu ? it - 1024 : ((nblk == 256) ? (rnd * 8 + (itl & 7)) : (it >> 5)), g = cu ? 0 : ((nblk == 256) ? (itl >> 3) : (it & 31));
                    na::na_unit(smem, cu, bh >> 3, bh & 7, g, P, NVT, p.in[I_RPB] + ((size_t)l * 8 + (bh & 7)) * 465, MIX);
                }
                __syncthreads();
            }
        }
        if constexpr (KIND == 16) {
            bf16_t* MIX = U;
            const int n_it = last ? 1024 : RET_ITEMS;
            const int n_lat = (512 - bid + nblk - 1) / nblk, cxi = nblk - 49 - bid, n_mine = n_lat + ((!last && cxi >= 0 && cxi < 16) ? 1 : 0);
            for (int kk = 0; kk < n_mine; ++kk) { const int pi = kk < n_lat ? bid + kk * nblk : 512 + cxi; rt::ret_pair(smem, pi * 2, n_it, P, RKV, (const float2*)(ws + WS_TAB), p.in[I_RDF] + l * 4, p.in[I_RDB] + l * 4, MIX); }
        }
        if constexpr (KIND == 7) {
            pg8::Gemm g{U, WT + WT_OUT + l * WT_OUT_L, DM, DM, DM, nullptr}; pg8::StaticOrder S; S.init(rows_mix, DM, nblk, bid);
            pg8::EpiOut E{Hlat, Hctx, l == 0 ? p.in[I_X] : Hlat, l == 0 ? p.in[I_CTX] : Hctx, modl + 2048};
            pg8::gemm_phase<pg8::EpiOut, pg8::StaticOrder, true, true>(lds3, g, S, E);
        }
        if constexpr (KIND == 8) {
            const float* g = p.in[I_N2G] + l * DM; const float* rb = p.in[I_RB];
            float* rwl = (float*)smem;
            int* hist = (int*)(smem + 69632); float* wl = (float*)(smem + 69632 + 64) + wid * 64;
            for (int idx = tid; idx < 1024 * 4; idx += 512) { const int c = idx >> 2, q = idx & 3; const float4 v = *(const float4*)(p.in[I_RW] + (size_t)c * 16 + q * 4); *(float4*)(rwl + (c >> 2) * 68 + (c & 3) * 16 + q * 4) = v; }
            for (int ch = bid; ch < 256; ch += nblk) {
                __syncthreads();
                if (tid < 16) hist[tid] = 0;
                __syncthreads();
                const int ngrp = 4 + ((!last && wid == 0) ? 1 : 0);
                for (int gi = 0; gi < ngrp; ++gi) {
                    const int row0 = gi < 4 ? ch * 128 + wid * 16 + gi * 4 : NLAT + ch * 4;
                    const float* mv = modl + row_modv(row0) * 6144;
                    float4 u[4][4]; float rstd[4];
#pragma unroll
                    for (int t = 0; t < 4; ++t) { const float* h = hrow2(Hlat, Hctx, row0 + t); float ss = 0.f;
#pragma unroll
                        for (int k = 0; k < 4; ++k) { u[t][k] = *(const float4*)(h + lane * 4 + 256 * k); ss += u[t][k].x * u[t][k].x + u[t][k].y * u[t][k].y + u[t][k].z * u[t][k].z + u[t][k].w * u[t][k].w; }
                        rstd[t] = rsqrtf(wave_sum(ss) * (1.f / DM) + 1e-6f); }
#pragma unroll
                    for (int k = 0; k < 4; ++k) { const int c = lane * 4 + 256 * k;
                        const float4 gg = *(const float4*)(g + c), sh = *(const float4*)(mv + 3072 + c), sc = *(const float4*)(mv + 4096 + c);
                        const float4 a = make_float4(gg.x * (1.f + sc.x), gg.y * (1.f + sc.y), gg.z * (1.f + sc.z), gg.w * (1.f + sc.w));
#pragma unroll
                        for (int t = 0; t < 4; ++t) { u[t][k].x = u[t][k].x * rstd[t] * a.x + sh.x; u[t][k].y = u[t][k].y * rstd[t] * a.y + sh.y; u[t][k].z = u[t][k].z * rstd[t] * a.z + sh.z; u[t][k].w = u[t][k].w * rstd[t] * a.w + sh.w; } }
#pragma unroll
                    for (int t = 0; t < 4; ++t)
#pragma unroll
                        for (int k = 0; k < 4; ++k) { uint2 o; o.x = pg8::cvt_pk_bf16(u[t][k].x, u[t][k].y); o.y = pg8::cvt_pk_bf16(u[t][k].z, u[t][k].w); *(uint2*)(U + (size_t)(row0 + t) * DM + lane * 4 + 256 * k) = o; }
                    float lg[64];
#pragma unroll
                    for (int i = 0; i < 64; ++i) lg[i] = 0.f;
#pragma unroll
                    for (int k = 0; k < 4; ++k) {
                        const float* wb = rwl + (lane + 64 * k) * 68;
#pragma unroll
                        for (int r = 0; r < 4; ++r) {
                            const float4 w0 = *(const float4*)(wb + r * 16), w1 = *(const float4*)(wb + r * 16 + 4), w2 = *(const float4*)(wb + r * 16 + 8), w3 = *(const float4*)(wb + r * 16 + 12);
#pragma unroll
                            for (int t = 0; t < 4; ++t) { const float us = r == 0 ? u[t][k].x : (r == 1 ? u[t][k].y : (r == 2 ? u[t][k].z : u[t][k].w));
                                lg[t * 16 + 0] = fmaf(us, w0.x, lg[t * 16 + 0]); lg[t * 16 + 1] = fmaf(us, w0.y, lg[t * 16 + 1]); lg[t * 16 + 2] = fmaf(us, w0.z, lg[t * 16 + 2]); lg[t * 16 + 3] = fmaf(us, w0.w, lg[t * 16 + 3]);
                                lg[t * 16 + 4] = fmaf(us, w1.x, lg[t * 16 + 4]); lg[t * 16 + 5] = fmaf(us, w1.y, lg[t * 16 + 5]); lg[t * 16 + 6] = fmaf(us, w1.z, lg[t * 16 + 6]); lg[t * 16 + 7] = fmaf(us, w1.w, lg[t * 16 + 7]);
                                lg[t * 16 + 8] = fmaf(us, w2.x, lg[t * 16 + 8]); lg[t * 16 + 9] = fmaf(us, w2.y, lg[t * 16 + 9]); lg[t * 16 + 10] = fmaf(us, w2.z, lg[t * 16 + 10]); lg[t * 16 + 11] = fmaf(us, w2.w, lg[t * 16 + 11]);
                                lg[t * 16 + 12] = fmaf(us, w3.x, lg[t * 16 + 12]); lg[t * 16 + 13] = fmaf(us, w3.y, lg[t * 16 + 13]); lg[t * 16 + 14] = fmaf(us, w3.z, lg[t * 16 + 14]); lg[t * 16 + 15] = fmaf(us, w3.w, lg[t * 16 + 15]); }
                        }
                    }
                    wl[lane] = reduce64(lg, lane);
                    asm volatile("s_waitcnt lgkmcnt(0)" ::: "memory");
                    if (lane < 4) {
                        float scv[16], sel[16];
#pragma unroll
                        for (int e = 0; e < 16; ++e) { scv[e] = 1.f / (1.f + expf(-wl[lane * 16 + e])); sel[e] = scv[e] + rb[e]; }
                        int best = 0; float bestv = -INFINITY;
#pragma unroll
                        for (int gI = 0; gI < 4; ++gI) {
                            float m1 = -INFINITY, m2 = -INFINITY;
#pragma unroll
                            for (int k = 0; k < 4; ++k) { const float v = sel[gI * 4 + k]; if (v > m1) { m2 = m1; m1 = v; } else if (v > m2) m2 = v; }
                            const float gs = m1 + m2; if (gs > bestv) { bestv = gs; best = gI; }
                        }
                        int ia = -1, ib = -1; float va = -INFINITY, vb = -INFINITY, wa = 0.f, wb2 = 0.f;
#pragma unroll
                        for (int e = 0; e < 16; ++e) {
                            if ((e >> 2) == best) { const float v = sel[e]; if (v > va) { vb = va; ib = ia; wb2 = wa; va = v; ia = e; wa = scv[e]; } else if (v > vb) { vb = v; ib = e; wb2 = scv[e]; } }
                        }
                        const float inv = 1.f / (wa + wb2); const int row = row0 + lane;
                        RTE[row] = make_int2(ia, ib); RTW[row] = make_float2(wa * inv, wb2 * inv); RTR[row] = lane == 0 ? rstd[0] : (lane == 1 ? rstd[1] : (lane == 2 ? rstd[2] : rstd[3]));
                        atomicAdd(&hist[ia], 1); atomicAdd(&hist[ib], 1);
                    }
                }
                __syncthreads();
                if (tid < 16) CNT[ch * 16 + tid] = hist[tid];
            }
        }
        if constexpr (KIND == 9) {
            const float* g = p.in[I_N2G] + l * DM;
            int* cnts = (int*)smem;
            int* tots = cnts + 4096; int* befo = tots + 16; int* offs = befo + 16; int* sla = offs + 32; int* slb = sla + 136; int* ea = slb + 136; int* eb = ea + 136;
            const int ntok = last ? 128 : 132;
            for (int ch = bid; ch < 256; ch += nblk) {
                __syncthreads();
                for (int i = tid; i < 4096; i += 512) cnts[i] = CNT[i];
                if (tid < ntok) { const int row = tid < 128 ? ch * 128 + tid : NLAT + ch * 4 + (tid - 128); const int2 e2 = RTE[row]; ea[tid] = e2.x; eb[tid] = e2.y; }
                __syncthreads();
                if (tid < 16) { int tot = 0, bef = 0; for (int c2 = 0; c2 < 256; ++c2) { const int v = cnts[c2 * 16 + tid]; bef += c2 < ch ? v : 0; tot += v; } tots[tid] = tot; befo[tid] = bef; }
                __syncthreads();
                if (tid == 0) { int o = 0; for (int e = 0; e < 16; ++e) { offs[e] = o; o += (tots[e] + 255) & ~255; } offs[16] = o; }
                __syncthreads();
                if (tid < 16) { int pos = offs[tid] + befo[tid]; for (int i = 0; i < ntok; ++i) { if (ea[i] == tid) sla[i] = pos++; else if (eb[i] == tid) slb[i] = pos++; } }
                if (ch == 0 && tid == 128) { int rt = 0; for (int e = 0; e < 16; ++e) { const int nte = (tots[e] + 255) >> 8; for (int k = 0; k < nte; ++k) { TILE[16 + 2 * rt] = e; TILE[17 + 2 * rt] = (offs[e] >> 8) + k; ++rt; } } TILE[0] = rt; }
                __syncthreads();
                int* TOK = (int*)(ws + WS_TOK);
                if (tid < ntok) { const int row = tid < 128 ? ch * 128 + tid : NLAT + ch * 4 + (tid - 128); const int sa = sla[tid], sb = slb[tid]; TOK[sa] = row; TOK[sb] = row; RTS[row] = make_int2(sa, sb); }
                if (ch == 0) for (int e = 0; e < 16; ++e) for (int sl = offs[e] + tots[e] + tid; sl < offs[e + 1]; sl += 512) TOK[sl] = 0;
            }
        }
        if constexpr (KIND == 10) {
            PG8_LAS int* ul = (PG8_LAS int*)(lds3 + 131072); const int nu = pg8::grouped_units(ul, TILE, 2, nblk, bid);
            pg8::Gemm g{U, WT + WT_13 + l * WT_13_L, DM, DM, DM, (const int*)(ws + WS_TOK)}; pg8::GroupedOrder S{ul, nu};
            pg8::EpiMoe1 E{HDN};
            pg8::gemm_phase<pg8::EpiMoe1, pg8::GroupedOrder, true, true, true>(lds3, g, S, E);
        }
        if constexpr (KIND == 11) {
            PG8_LAS int* ul = (PG8_LAS int*)(lds3 + 131072); const int nu = pg8::grouped_units(ul, TILE, 4, nblk, bid);
            pg8::Gemm g{HDN, WT + WT_2 + l * WT_2_L, FF, FF, FF, nullptr}; pg8::GroupedOrder S{ul, nu};
            pg8::EpiMoe2 E{XS};
            pg8::gemm_phase<pg8::EpiMoe2, pg8::GroupedOrder, true, true>(lds3, g, S, E);
        }
    }
    if constexpr (KIND == 13) {
        const float* g = p.in[I_FNG]; const float* modp = MOD + (size_t)1 * 5 * 6144;
        for (int row = bid * 8 + wid; row < NLAT; row += nblk * 8) {
            float* h = p.out + (size_t)row * DM; const float* mg = modp + row_modv(row) * 6144 + 5120;
            const int2 s2 = RTS[row]; const float2 w2 = RTW[row];
            float4 x[4]; float ss = 0.f;
#pragma unroll
            for (int i = 0; i < 4; ++i) {
                const int c = lane * 4 + 256 * i;
                const uint2 ya = *(const uint2*)(XS + (size_t)s2.x * DM + c), yb = *(const uint2*)(XS + (size_t)s2.y * DM + c);
                float4 xx = *(const float4*)(h + c); const float4 gg = *(const float4*)(mg + c);
                xx.x += gg.x * (w2.x * __uint_as_float(ya.x << 16) + w2.y * __uint_as_float(yb.x << 16));
                xx.y += gg.y * (w2.x * __uint_as_float(ya.x & 0xffff0000u) + w2.y * __uint_as_float(yb.x & 0xffff0000u));
                xx.z += gg.z * (w2.x * __uint_as_float(ya.y << 16) + w2.y * __uint_as_float(yb.y << 16));
                xx.w += gg.w * (w2.x * __uint_as_float(ya.y & 0xffff0000u) + w2.y * __uint_as_float(yb.y & 0xffff0000u));
                x[i] = xx; ss += xx.x * xx.x + xx.y * xx.y + xx.z * xx.z + xx.w * xx.w;
            }
            ss = wave_sum(ss);
            const float rstd = rsqrtf(ss * (1.f / DM) + 1e-6f);
#pragma unroll
            for (int i = 0; i < 4; ++i) { const int c = lane * 4 + 256 * i; const float4 gg = *(const float4*)(g + c); float4 y; y.x = x[i].x * rstd * gg.x; y.y = x[i].y * rstd * gg.y; y.z = x[i].z * rstd * gg.z; y.w = x[i].w * rstd * gg.w; *(float4*)(h + c) = y; }
        }
    }
}

constexpr int LDS_BYTES = 144 * 1024;
template <int KIND> __global__ void __launch_bounds__(512, 2) k_ph(Params p, int l) {
    extern __shared__ __attribute__((aligned(16))) char smem[];
    phase<KIND>(p, l, smem);
}
__device__ __forceinline__ void grid_sync(unsigned char* wsp, char* smem) {
    unsigned* bw = (unsigned*)(wsp + WS_CTL); asm volatile("" : "+s"(bw));
    XcdBarrier b; b.bar = bw; b.x = xb_xcc_id(); b.st = (volatile LAS unsigned*)(smem + LDS_BYTES - 16);
    xcd_barrier(b);
}
__global__ void __launch_bounds__(512, 2) k_one(Params p) {
    extern __shared__ __attribute__((aligned(16))) char smem[];
    {
        volatile LAS unsigned* st = (volatile LAS unsigned*)(smem + LDS_BYTES - 16);
        if (threadIdx.x == 0) { st[0] = 0u; st[1] = 0u; st[2] = 0u; st[3] = 0u; }
        __syncthreads();
        (void)xcd_barrier_post((unsigned*)(p.ws + WS_CTL), st);
    }
#define SYNC() grid_sync(p.ws, smem)
    phase<0>(p, 0, smem); SYNC();
    if (PROBE_SET == 1) { phase<0>(p, 0, smem); SYNC(); }
#define DUP(k, stmt) do { stmt; if (PROBE_SET == (k)) { SYNC(); stmt; } } while (0)
#define LAYER(l) \
        phase<1>(p, l, smem); SYNC(); \
        DUP(2, phase<2>(p, l, smem)); SYNC(); \
        DUP(8, phase<4>(p, l, smem); phase<14>(p, l, smem)); SYNC(); \
        phase<5>(p, l, smem); SYNC(); \
        DUP(3, phase<6>(p, l, smem)); DUP(4, phase<15>(p, l, smem)); DUP(5, phase<16>(p, l, smem)); SYNC(); \
        phase<7>(p, l, smem); SYNC(); \
        DUP(7, phase<8>(p, l, smem)); SYNC(); \
        DUP(9, phase<9>(p, l, smem)); SYNC(); \
        DUP(6, phase<10>(p, l, smem)); SYNC(); \
        DUP(6, phase<11>(p, l, smem)); SYNC();
    LAYER(0)
    LAYER(1)
#undef LAYER
    phase<13>(p, 0, smem);
#undef SYNC
}
template <int KIND> static void launch_ph(const Params& p, int l, int grid, hipStream_t stream) {
    static bool attr_done = false;
    if (!attr_done) { (void)hipFuncSetAttribute((const void*)k_ph<KIND>, hipFuncAttributeMaxDynamicSharedMemorySize, LDS_BYTES); attr_done = true; }
    hipLaunchKernelGGL(k_ph<KIND>, dim3(grid), dim3(512), LDS_BYTES, stream, p, l);
}

extern "C" void kernel_launch(void* const* d_in, const int* in_sizes, int n_in, void* d_out, int out_size, void* d_ws, size_t ws_size, hipStream_t stream) {
    (void)in_sizes; (void)n_in; (void)out_size; (void)ws_size;
    static int grid = 0;
    if (!grid) {
        int dev = 0, cus = 0; (void)hipGetDevice(&dev); (void)hipDeviceGetAttribute(&cus, hipDeviceAttributeMultiprocessorCount, dev);
        grid = cus > 0 ? cus : 256;
        (void)hipFuncSetAttribute((const void*)k_one, hipFuncAttributeMaxDynamicSharedMemorySize, LDS_BYTES);
    }
    Params p{};
    for (int i = 0; i < 23; ++i) p.in[i] = (const float*)d_in[i];
    p.out = (float*)d_out; p.ws = (unsigned char*)d_ws;
#ifdef MULTI_LAUNCH
    launch_ph<0>(p, 0, grid, stream);
    for (int l = 0; l < 2; ++l) {
        launch_ph<1>(p, l, grid, stream); launch_ph<2>(p, l, grid, stream); launch_ph<4>(p, l, grid, stream); launch_ph<14>(p, l, grid, stream);
        launch_ph<5>(p, l, grid, stream); launch_ph<6>(p, l, grid, stream); launch_ph<15>(p, l, grid, stream); launch_ph<16>(p, l, grid, stream); launch_ph<7>(p, l, grid, stream); launch_ph<8>(p, l, grid, stream);
        launch_ph<9>(p, l, grid, stream); launch_ph<10>(p, l, grid, stream); launch_ph<11>(p, l, grid, stream);
    }
    launch_ph<13>(p, 0, grid, stream);
#else
    (void)hipMemsetAsync((char*)d_ws + WS_CTL, 0, XCD_BAR_WORDS * sizeof(unsigned), stream);
    hipLaunchKernelGGL(k_one, dim3(grid), dim3(512), LDS_BYTES, stream, p);
#endif
}
```
